# Optimizing an MI355X kernel written in HIP

```python
import jax, jax.numpy as jnp
from jax import lax
import numpy as np

D_MODEL = 1024
BATCH = 32
SEQ = 2048
DEPTH = 1

ATT_GROUPS = ((128, 1), (512, 4), (2048, 16))
ATT_HEADS_PER_GROUP = 4
ATT_HEAD_DIM = 64
ATT_HEADS = ATT_HEADS_PER_GROUP * len(ATT_GROUPS)
ROPE_THETA = 500000.0
ROPE_DIM = ATT_HEAD_DIM // 4
MLSTM_HEADS = 4
MLSTM_QK_DIM = 128
MLSTM_V_DIM = 256
MLSTM_CHUNK = 64
CONV_WIDTH = 4
N_EXPERTS = 256
TOP_K = 8
N_GROUPS = 8
TOPK_GROUPS = 4
EXPERT_FF = 256
SHARED_FF = 256
ROUTED_SCALE = 2.5
MOE_BLOCK = 128
NORM_EPS = 1e-6

ATT_W = ATT_HEADS * ATT_HEAD_DIM
ATT_OUT_W = ATT_HEADS_PER_GROUP * ATT_HEAD_DIM
MQK_W = MLSTM_HEADS * MLSTM_QK_DIM
MV_W = MLSTM_HEADS * MLSTM_V_DIM
IN_SPLITS = (ATT_W, ATT_W, ATT_W, MQK_W, MQK_W, MV_W, MV_W, MLSTM_HEADS, MLSTM_HEADS, D_MODEL, D_MODEL)
IN_WIDTH = int(sum(IN_SPLITS))
IN_OFFSETS = tuple(int(o) for o in np.cumsum(IN_SPLITS)[:-1])

kernel_name = "hybrid_dilated_attn_mlstm_moe_block"


def rms_norm(x, g):
    xf = x.astype(jnp.float32)
    y = xf * lax.rsqrt(jnp.mean(xf * xf, axis=-1, keepdims=True) + NORM_EPS)
    return (y * g.astype(jnp.float32)).astype(x.dtype)


def partial_rope(x, positions):
    half = ROPE_DIM // 2
    inv = jnp.power(ROPE_THETA, -jnp.arange(half, dtype=jnp.float32) / half)
    ang = positions.astype(jnp.float32)[..., None] * inv
    cos = jnp.cos(ang)[:, :, None, :]
    sin = jnp.sin(ang)[:, :, None, :]
    xf = x.astype(jnp.float32)
    x1, x2 = xf[..., :half], xf[..., half:ROPE_DIM]
    out = jnp.concatenate([x1 * cos - x2 * sin, x2 * cos + x1 * sin, xf[..., ROPE_DIM:]], axis=-1)
    return out.astype(x.dtype)


def dilated_window_attention(q, k, v, window, dilation):
    B, S, H, E = q.shape
    w_sub = window // dilation
    blk = w_sub
    L = S // dilation
    nb = -(-L // blk)
    Lp = nb * blk

    def to_blocks(t):
        t = t.astype(jnp.float32).reshape(B, L, dilation, H, E).transpose(0, 2, 1, 3, 4)
        t = jnp.pad(t, ((0, 0), (0, 0), (0, Lp - L), (0, 0), (0, 0)))
        return t.reshape(B, dilation, nb, blk, H, E)

    def with_prev(t):
        prev = jnp.pad(t[:, :, :-1], ((0, 0), (0, 0), (1, 0), (0, 0), (0, 0), (0, 0)))
        return jnp.concatenate([prev, t], axis=3)

    qb = to_blocks(q)
    kc = with_prev(to_blocks(k))
    vc = with_prev(to_blocks(v))
    s = jnp.einsum('brnqhe,brnkhe->brnhqk', qb, kc) * (E ** -0.5)
    qi = jnp.arange(blk)[:, None]
    ki = jnp.arange(2 * blk)[None, :]
    dist = blk + qi - ki
    n = jnp.arange(nb)[:, None, None]
    valid = (dist >= 0) & (dist <= w_sub) & ((n - 1) * blk + ki >= 0)
    s = jnp.where(valid[None, None, :, None], s, -jnp.inf)
    m = jnp.max(s, axis=-1, keepdims=True)
    p = jnp.exp(s - m)
    den = jnp.sum(p, axis=-1)
    den_t = den.transpose(0, 1, 2, 4, 3)
    o = jnp.einsum('brnhqk,brnkhe->brnqhe', p, vc) / den_t[..., None]
    lse = m[..., 0].transpose(0, 1, 2, 4, 3) + jnp.log(den_t)

    def from_blocks(t):
        t = t.reshape((B, dilation, Lp) + t.shape[4:])[:, :, :L]
        t = jnp.swapaxes(t, 1, 2)
        return t.reshape((B, S) + t.shape[3:])

    return from_blocks(o), from_blocks(lse)


def causal_short_conv(x, w, b):
    K = w.shape[0]
    S = x.shape[1]
    xp = jnp.pad(x, ((0, 0), (K - 1, 0), (0, 0)))
    y = b
    for j in range(K):
        y = y + xp[:, j:j + S] * w[j]
    return y


def mlstm_chunkwise(q, k, v, i_pre, f_pre):
    B, S, H, DK = q.shape
    DV = v.shape[-1]
    L = MLSTM_CHUNK
    nc = S // L
    logf = jax.nn.log_sigmoid(f_pre)

    def chunks4(t):
        return t.reshape(B, nc, L, H, t.shape[-1]).transpose(1, 0, 3, 2, 4)

    def chunks3(t):
        return t.reshape(B, nc, L, H).transpose(1, 0, 3, 2)

    causal = jnp.tril(jnp.ones((L, L), dtype=bool))

    def step(carry, xs):
        C, nvec, m = carry
        qc, kc, vc, ic, lfc = xs
        b = jnp.cumsum(lfc, axis=-1)
        dmat = jnp.where(causal, b[..., :, None] - b[..., None, :] + ic[..., None, :], -jnp.inf)
        m_t = jnp.maximum(b + m[..., None], jnp.max(dmat, axis=-1))
        wts = jnp.exp(dmat - m_t[..., None])
        sc = jnp.einsum('bhld,bhsd->bhls', qc, kc) * wts
        inter = jnp.exp(b + m[..., None] - m_t)
        num = jnp.einsum('bhls,bhsv->bhlv', sc, vc) + inter[..., None] * jnp.einsum('bhvd,bhld->bhlv', C, qc)
        den = jnp.sum(sc, axis=-1) + inter * jnp.einsum('bhd,bhld->bhl', nvec, qc)
        h = num / jnp.maximum(jnp.abs(den), jnp.exp(-m_t))[..., None]
        b_end = b[..., -1]
        g = b_end[..., None] - b + ic
        m_new = jnp.maximum(b_end + m, jnp.max(g, axis=-1))
        decay = jnp.exp(b_end + m - m_new)
        wk = jnp.exp(g - m_new[..., None])[..., None] * kc
        C_new = decay[..., None, None] * C + jnp.einsum('bhlv,bhld->bhvd', vc, wk)
        n_new = decay[..., None] * nvec + jnp.sum(wk, axis=-2)
        return (C_new, n_new, m_new), h

    init = (jnp.zeros((B, H, DV, DK), jnp.float32), jnp.zeros((B, H, DK), jnp.float32),
            jnp.zeros((B, H), jnp.float32))
    _, h = lax.scan(step, init, (chunks4(q), chunks4(k), chunks4(v), chunks3(i_pre), chunks3(logf)))
    return h.transpose(1, 0, 3, 2, 4).reshape(B, S, H, DV)


def mixer(h, positions, w_in, conv_w, conv_b, b_gates, g_mlstm, w_branch_a, w_branch_b, w_out):
    B, S, _ = h.shape
    proj = jnp.matmul(h, w_in)
    aq, ak, av, mq, mk, mv, mo, mi, mf, ga, gb = jnp.split(proj, IN_OFFSETS, axis=-1)
    aq = partial_rope(aq.reshape(B, S, ATT_HEADS, ATT_HEAD_DIM), positions)
    ak = partial_rope(ak.reshape(B, S, ATT_HEADS, ATT_HEAD_DIM), positions)
    av = av.reshape(B, S, ATT_HEADS, ATT_HEAD_DIM)
    outs, lses = [], []
    for g, (window, dil) in enumerate(ATT_GROUPS):
        sl = slice(g * ATT_HEADS_PER_GROUP, (g + 1) * ATT_HEADS_PER_GROUP)
        o, l = dilated_window_attention(aq[:, :, sl], ak[:, :, sl], av[:, :, sl], window, dil)
        outs.append(o)
        lses.append(l)
    alpha = jax.nn.softmax(jnp.stack(lses), axis=0)
    y_a = jnp.einsum('gbsh,gbshe->bshe', alpha, jnp.stack(outs)).reshape(B, S, ATT_OUT_W).astype(h.dtype)
    qk = jax.nn.silu(causal_short_conv(jnp.concatenate([mq, mk], axis=-1), conv_w, conv_b))
    mq, mk = jnp.split(qk, 2, axis=-1)
    q_m = mq.astype(jnp.float32).reshape(B, S, MLSTM_HEADS, MLSTM_QK_DIM)
    k_m = mk.astype(jnp.float32).reshape(B, S, MLSTM_HEADS, MLSTM_QK_DIM) * (MLSTM_QK_DIM ** -0.5)
    v_m = mv.astype(jnp.float32).reshape(B, S, MLSTM_HEADS, MLSTM_V_DIM)
    bg = b_gates.astype(jnp.float32)
    i_pre = mi.astype(jnp.float32) + bg[:MLSTM_HEADS]
    f_pre = mf.astype(jnp.float32) + bg[MLSTM_HEADS:]
    hb = mlstm_chunkwise(q_m, k_m, v_m, i_pre, f_pre)
    hb = rms_norm(hb, g_mlstm.reshape(MLSTM_HEADS, MLSTM_V_DIM)).reshape(B, S, MV_W)
    y_b = (hb * jax.nn.sigmoid(mo.astype(jnp.float32))).astype(h.dtype)
    merged = (jax.nn.sigmoid(ga) * jnp.matmul(y_a, w_branch_a)
              + jax.nn.sigmoid(gb) * jnp.matmul(y_b, w_branch_b))
    return jnp.matmul(merged, w_out)


def moe_ffn(h, router_w, router_bias, w_gate, w_up, w_down, ws_gate, ws_up, ws_down):
    B, S, D = h.shape
    T = B * S
    E, M = N_EXPERTS, MOE_BLOCK
    xt = h.reshape(T, D)
    scores = jax.nn.sigmoid(jnp.matmul(xt.astype(jnp.float32), router_w.astype(jnp.float32)))
    sel = scores + router_bias.astype(jnp.float32)
    group_score = jnp.sum(lax.top_k(sel.reshape(T, N_GROUPS, E // N_GROUPS), 2)[0], axis=-1)
    _, gidx = lax.top_k(group_score, TOPK_GROUPS)
    gmask = jnp.sum(jax.nn.one_hot(gidx, N_GROUPS, dtype=jnp.int32), axis=1) > 0
    sel = jnp.where(jnp.repeat(gmask, E // N_GROUPS, axis=-1), sel, -jnp.inf)
    _, idx = lax.top_k(sel, TOP_K)
    top_w = jnp.take_along_axis(scores, idx, axis=-1)
    top_w = top_w / jnp.sum(top_w, axis=-1, keepdims=True) * ROUTED_SCALE
    A = T * TOP_K
    NB = (A + E * (M - 1)) // M
    P = NB * M
    flat_e = idx.reshape(-1).astype(jnp.int32)
    flat_w = top_w.reshape(-1)
    order = jnp.argsort(flat_e)
    sorted_e = flat_e[order]
    counts = jnp.zeros((E,), jnp.int32).at[flat_e].add(1)
    padded = (counts + M - 1) // M * M
    pend = jnp.cumsum(padded)
    pstart = pend - padded
    ustart = jnp.cumsum(counts) - counts
    dest = pstart[sorted_e] + jnp.arange(A, dtype=jnp.int32) - ustart[sorted_e]
    buf_tok = jnp.zeros((P,), jnp.int32).at[dest].set((order // TOP_K).astype(jnp.int32))
    buf_w = jnp.zeros((P,), jnp.float32).at[dest].set(flat_w[order])
    blk_e = jnp.minimum(jnp.searchsorted(pend, jnp.arange(NB, dtype=jnp.int32) * M, side='right'),
                        E - 1).astype(jnp.int32)

    def expert_block(acc, blk):
        tok, wt, e = blk
        xb = xt[tok]
        hid = jax.nn.silu(jnp.matmul(xb, w_gate[e])) * jnp.matmul(xb, w_up[e])
        out = jnp.matmul(hid, w_down[e]).astype(jnp.float32) * wt[:, None]
        return acc.at[tok].add(out), None

    routed, _ = lax.scan(expert_block, jnp.zeros((T, D), jnp.float32),
                         (buf_tok.reshape(NB, M), buf_w.reshape(NB, M), blk_e))
    shared = jnp.matmul(jax.nn.silu(jnp.matmul(xt, ws_gate)) * jnp.matmul(xt, ws_up), ws_down)
    return (routed + shared.astype(jnp.float32)).astype(h.dtype).reshape(B, S, D)


def setup_inputs(seed: int = 0) -> dict:
    key = jax.random.key(seed)
    ks = jax.random.split(key, 28)
    D, Ly, H, E = D_MODEL, DEPTH, MLSTM_HEADS, N_EXPERTS

    def nrm(k, shape, fan):
        return jax.random.normal(k, shape, jnp.float32) * (fan ** -0.5)

    def gain(k, shape):
        return 1.0 + 0.05 * jax.random.normal(k, shape, jnp.float32)

    x = jax.random.normal(ks[0], (BATCH, SEQ, D), jnp.float32)
    c = jax.random.normal(ks[1], (BATCH, D), jnp.float32)
    positions = (jnp.arange(SEQ, dtype=jnp.int32)[None, :]
                 + jax.random.randint(ks[2], (BATCH, 1), 0, 4096, dtype=jnp.int32))
    b_gates = jnp.concatenate([0.1 * jax.random.normal(ks[12], (Ly, H), jnp.float32),
                               jax.random.uniform(ks[13], (Ly, H), jnp.float32, 3.0, 6.0)], axis=-1)
    return {
        "x": x,
        "c": c,
        "positions": positions,
        "w_ada": 0.5 * nrm(ks[3], (Ly, D, 6 * D), D),
        "b_ada": 0.02 * jax.random.normal(ks[4], (Ly, 6 * D), jnp.float32),
        "g_pre_mix": gain(ks[5], (Ly, D)),
        "g_post_mix": gain(ks[6], (Ly, D)),
        "g_pre_ffn": gain(ks[7], (Ly, D)),
        "g_post_ffn": gain(ks[8], (Ly, D)),
        "w_in": nrm(ks[9], (Ly, D, IN_WIDTH), D),
        "conv_w": nrm(ks[10], (Ly, CONV_WIDTH, 2 * MQK_W), CONV_WIDTH),
        "conv_b": 0.02 * jax.random.normal(ks[11], (Ly, 2 * MQK_W), jnp.float32),
        "b_gates": b_gates,
        "g_mlstm": gain(ks[14], (Ly, MV_W)),
        "w_branch_a": nrm(ks[15], (Ly, ATT_OUT_W, D), ATT_OUT_W),
        "w_branch_b": nrm(ks[16], (Ly, MV_W, D), MV_W),
        "w_out": nrm(ks[17], (Ly, D, D), D),
        "router_w": nrm(ks[18], (Ly, D, E), D),
        "router_bias": 0.01 * jax.random.normal(ks[19], (Ly, E), jnp.float32),
        "w_exp_gate": nrm(ks[20], (Ly, E, D, EXPERT_FF), D),
        "w_exp_up": nrm(ks[21], (Ly, E, D, EXPERT_FF), D),
        "w_exp_down": nrm(ks[22], (Ly, E, EXPERT_FF, D), EXPERT_FF),
        "w_sh_gate": nrm(ks[23], (Ly, D, SHARED_FF), D),
        "w_sh_up": nrm(ks[24], (Ly, D, SHARED_FF), D),
        "w_sh_down": nrm(ks[25], (Ly, SHARED_FF, D), SHARED_FF),
    }


def reference(x, c, positions, w_ada, b_ada, g_pre_mix, g_post_mix, g_pre_ffn, g_post_ffn,
              w_in, conv_w, conv_b, b_gates, g_mlstm, w_branch_a, w_branch_b, w_out,
              router_w, router_bias, w_exp_gate, w_exp_up, w_exp_down,
              w_sh_gate, w_sh_up, w_sh_down):
    for layer in range(DEPTH):
        mod = jnp.matmul(jax.nn.silu(c), w_ada[layer]) + b_ada[layer]
        sh1, sc1, gt1, sh2, sc2, gt2 = [m[:, None, :] for m in jnp.split(mod, 6, axis=-1)]
        h = rms_norm(x, g_pre_mix[layer]) * (1.0 + sc1) + sh1
        y = mixer(h, positions, w_in[layer], conv_w[layer], conv_b[layer], b_gates[layer],
                  g_mlstm[layer], w_branch_a[layer], w_branch_b[layer], w_out[layer])
        x = x + gt1 * rms_norm(y, g_post_mix[layer])
        h = rms_norm(x, g_pre_ffn[layer]) * (1.0 + sc2) + sh2
        y = moe_ffn(h, router_w[layer], router_bias[layer], w_exp_gate[layer], w_exp_up[layer],
                    w_exp_down[layer], w_sh_gate[layer], w_sh_up[layer], w_sh_down[layer])
        x = x + gt2 * rms_norm(y, g_post_ffn[layer])
    return x
```

```cpp
#include <hip/hip_runtime.h>
#include <cstdio>
#include <cstdint>

#define GAS __attribute__((address_space(1)))
#define LAS __attribute__((address_space(3)))
typedef unsigned short bf16;
typedef float f32x4 __attribute__((ext_vector_type(4)));
typedef float f32x2 __attribute__((ext_vector_type(2)));
typedef unsigned u32x4 __attribute__((ext_vector_type(4)));
typedef unsigned u32x2 __attribute__((ext_vector_type(2)));

#ifndef DBG_MOE_SCALE
#define DBG_MOE_SCALE 1.0f
#endif
#ifndef DBG_BRUTE
#define DBG_BRUTE 0
#endif
#ifndef DBG_TOPK_SERIAL
#define DBG_TOPK_SERIAL 1
#endif

#ifndef MK_SPLIT
#define MK_SPLIT 0
#endif

constexpr int D = 1024, NB = 32, SEQ = 2048, T = NB * SEQ;
constexpr int INW = 7432;
constexpr int NE = 256, TOPK = 8;
constexpr int NTHR = 512, NWAVES = 8;
constexpr float EPS = 1e-6f;

enum { I_X = 0, I_C, I_POS, I_WADA, I_BADA, I_GPREMIX, I_GPOSTMIX, I_GPREFFN, I_GPOSTFFN, I_WIN, I_CONVW, I_CONVB, I_BGATES, I_GMLSTM,
       I_WBA, I_WBB, I_WOUT, I_RW, I_RB, I_WEG, I_WEU, I_WED, I_WSG, I_WSU, I_WSD, N_IN };

constexpr size_t MiB = 1u << 20;
constexpr size_t WS_CTL = 0, CTL_ZERO_BYTES = 1 * MiB;
constexpr size_t WS_MOD = 1 * MiB;
constexpr size_t WS_GATES = 2 * MiB;
constexpr size_t WS_TOPI = 4 * MiB;
constexpr size_t WS_TOPW = 6 * MiB;
constexpr size_t WS_ROWTOK = 8 * MiB;
constexpr size_t WS_ROWW = 12 * MiB;
constexpr size_t WS_UNITEXP = 16 * MiB;
constexpr size_t WS_EXPTILE0 = 16 * MiB + 65536;
constexpr size_t WS_Q = 64 * MiB, WS_K = 160 * MiB, WS_V = 256 * MiB;
constexpr size_t WS_MQK = 352 * MiB, WS_MV = 480 * MiB, WS_MO = 608 * MiB;
constexpr size_t WS_GAB = 736 * MiB;
constexpr size_t WS_MERGED = 192 * MiB;
constexpr size_t WS_YMIX = 64 * MiB;
constexpr size_t WS_H2 = 192 * MiB;
constexpr size_t WS_LOGITS = 320 * MiB;
constexpr size_t WS_NEED = 992 * MiB;
constexpr size_t OUT_H = 0;
constexpr size_t OUT_YA = 0;
constexpr size_t OUT_YB = 128 * MiB;

constexpr int CW_BAR = 4096;
constexpr int CW_COUNTS = 16384, CW_CURSOR = 16384 + 256, CW_NT = 16384 + 512;

constexpr int LDS_BYTES = 147456;
constexpr int MISC_OFF = 131072 + 320;

__device__ __forceinline__ float bf2f(bf16 b) { return __uint_as_float(((unsigned)b) << 16); }
__device__ __forceinline__ unsigned f2bf(float f) { unsigned u = __float_as_uint(f); return (u + 0x7fffu + ((u >> 16) & 1u)) >> 16; }
__device__ __forceinline__ unsigned pk2(float lo, float hi) { return f2bf(lo) | (f2bf(hi) << 16); }
__device__ __forceinline__ float wave_sum(float v) {
#pragma unroll
    for (int o = 1; o < 64; o <<= 1) v += __shfl_xor(v, o);
    return v;
}
__device__ __forceinline__ float sigmoidf_(float x) { return 1.0f / (1.0f + expf(-x)); }
__device__ __forceinline__ float logsigmoidf_(float x) { return fminf(x, 0.f) - log1pf(expf(-fabsf(x))); }

#define XB_TMO      128
#define XB_XCNT(j)  (256  + 64 * (j))
#define XB_XSUB(j)  (1280 + 64 * (j))
#define XB_XGEN(j)  (2304 + 64 * (j))
#define XB_TOP      3328
#define XB_TOPGEN   3392
#define XCD_BAR_WORDS 3456
#define XB_SPIN_CAP (1u << 23)

__device__ __forceinline__ unsigned xb_ld(unsigned* p)              { return __hip_atomic_load(p, __ATOMIC_RELAXED, __HIP_MEMORY_SCOPE_AGENT); }
__device__ __forceinline__ unsigned xb_add(unsigned* p, unsigned v) { return __hip_atomic_fetch_add(p, v, __ATOMIC_RELAXED, __HIP_MEMORY_SCOPE_AGENT); }
__device__ __forceinline__ unsigned xb_xcc_id() { return (unsigned)__builtin_amdgcn_s_getreg((3 << 11) | 20) & 0xFu; }
#define XB_SPIN(cond, bar) do { unsigned _sp = 0; while (cond) { __builtin_amdgcn_s_sleep(1); \
    if ((++_sp & 255u) == 0u) { if (xb_ld(&(bar)[XB_TMO])) break; if (_sp > XB_SPIN_CAP) { atomicAdd(&(bar)[XB_TMO], 1u); break; } } } } while (0)

struct XcdBarrier { unsigned* bar; unsigned x; volatile LAS unsigned* st; };

__device__ __forceinline__ XcdBarrier xcd_barrier_post(unsigned* bar, volatile LAS unsigned* st) {
    XcdBarrier b; b.bar = bar; b.x = xb_xcc_id(); b.st = st;
    if (threadIdx.x == 0) (void)xb_add(&bar[XB_XCNT(b.x)], 1u);
    return b;
}
__device__ __forceinline__ void xcd_barrier_complete(unsigned* bar, unsigned x, unsigned& nloc, unsigned& nx) {
    const unsigned G = gridDim.x * gridDim.y * gridDim.z;
    unsigned sum, cnt, mine, sp = 0u;
    for (;;) {
        sum = 0u; cnt = 0u; mine = 0u;
#pragma unroll
        for (unsigned j = 0; j < 16; ++j) { const unsigned c = xb_ld(&bar[XB_XCNT(j)]); sum += c; cnt += (c > 0u) ? 1u : 0u; mine = (j == x) ? c : mine; }
        if (sum == G) break;
        __builtin_amdgcn_s_sleep(1);
        if ((++sp & 255u) == 0u) { if (xb_ld(&bar[XB_TMO])) break; if (sp > XB_SPIN_CAP) { atomicAdd(&bar[XB_TMO], 1u); break; } }
    }
    nloc = mine > 0u ? mine : 1u; nx = cnt > 0u ? cnt : 1u;
}
__device__ __forceinline__ void xcd_barrier(const XcdBarrier& b) {
    asm volatile("s_waitcnt vmcnt(0)" ::: "memory");
    __syncthreads();
    if (threadIdx.x == 0) {
        unsigned* bar = b.bar;
        __builtin_amdgcn_s_waitcnt(0);
        unsigned nloc = b.st[0], nx = b.st[1];
        if (nloc == 0u) { xcd_barrier_complete(bar, b.x, nloc, nx); b.st[0] = nloc; b.st[1] = nx; }
        const unsigned old = xb_add(&bar[XB_XSUB(b.x)], 1u);
        const unsigned gen = old / nloc;
        if (old + 1u == (gen + 1u) * nloc) {
            __builtin_amdgcn_fence(__ATOMIC_RELEASE, "agent");
            asm volatile("s_waitcnt vmcnt(0)" ::: "memory");
            const unsigned og = xb_add(&bar[XB_TOP], 1u);
            const unsigned tg = og / nx;
            if (og + 1u == (tg + 1u) * nx) xb_add(&bar[XB_TOPGEN], 1u);
            else XB_SPIN(xb_ld(&bar[XB_TOPGEN]) == tg, bar);
            __builtin_amdgcn_fence(__ATOMIC_ACQUIRE, "agent");
            xb_add(&bar[XB_XGEN(b.x)], 1u);
            asm volatile("s_waitcnt vmcnt(0)" ::: "memory");
        } else {
            XB_SPIN(xb_ld(&bar[XB_XGEN(b.x)]) == gen, bar);
            __builtin_amdgcn_fence(__ATOMIC_ACQUIRE, "agent");
            asm volatile("s_waitcnt vmcnt(0)" ::: "memory");
        }
    }
    __syncthreads();
}

struct Args { const float* in[N_IN]; float* out; unsigned char* ws; int ph_lo, ph_hi; };

struct Frame {
    LAS unsigned char* lds;
    unsigned* ctl;
    int tid, lane, wave, G;
    const float* in[N_IN];
    const int* pos;
    float* out; unsigned char* outb; unsigned char* ws;
};

struct ARowGlobal {
    const bf16* base; size_t ld; int m0; const int* gather;
    __device__ __forceinline__ void load4(int r, int k, float (&o)[4]) const {
        const size_t row = gather ? (size_t)gather[m0 + r] : (size_t)(m0 + r);
        const u32x2 v = *(const u32x2*)(base + row * ld + k);
        o[0] = __uint_as_float(v.x << 16); o[1] = __uint_as_float(v.x & 0xffff0000u); o[2] = __uint_as_float(v.y << 16); o[3] = __uint_as_float(v.y & 0xffff0000u);
    }
};
struct ARowLds {
    const LAS bf16* base;
    __device__ __forceinline__ void load4(int r, int k, float (&o)[4]) const {
        const u32x2 v = *(const LAS u32x2*)(base + r * 256 + k);
        o[0] = __uint_as_float(v.x << 16); o[1] = __uint_as_float(v.x & 0xffff0000u); o[2] = __uint_as_float(v.y << 16); o[3] = __uint_as_float(v.y & 0xffff0000u);
    }
};
template <class ARow>
__device__ __forceinline__ void ngemm_acc(LAS float* As, LAS float* Bs, const ARow& arow, const float* __restrict__ W, int ldw, int K, int n0, int Nvalid, float (&acc)[8][4]) {
    const int tid = threadIdx.x, ty = tid >> 5, tx = tid & 31;
    const int ar = tid >> 2, ak = (tid & 3) * 4;
    const int bk = tid >> 5, bn = (tid & 31) * 4;
    for (int k0 = 0; k0 < K; k0 += 16) {
        float a4[4]; arow.load4(ar, k0 + ak, a4);
        f32x4 b4 = (f32x4){0.f, 0.f, 0.f, 0.f};
        if (n0 + bn < Nvalid) b4 = *(const f32x4*)(W + (size_t)(k0 + bk) * ldw + n0 + bn);
        __syncthreads();
        As[(ak + 0) * 132 + ar] = a4[0]; As[(ak + 1) * 132 + ar] = a4[1]; As[(ak + 2) * 132 + ar] = a4[2]; As[(ak + 3) * 132 + ar] = a4[3];
        *(LAS f32x4*)(Bs + bk * 132 + bn) = b4;
        __syncthreads();
#pragma unroll 4
        for (int kk = 0; kk < 16; ++kk) {
            const f32x4 a0 = *(const LAS f32x4*)(As + kk * 132 + ty * 8), a1 = *(const LAS f32x4*)(As + kk * 132 + ty * 8 + 4);
            const f32x4 b = *(const LAS f32x4*)(Bs + kk * 132 + tx * 4);
#pragma unroll
            for (int j = 0; j < 4; ++j) {
                acc[0][j] += a0[0] * b[j]; acc[1][j] += a0[1] * b[j]; acc[2][j] += a0[2] * b[j]; acc[3][j] += a0[3] * b[j];
                acc[4][j] += a1[0] * b[j]; acc[5][j] += a1[1] * b[j]; acc[6][j] += a1[2] * b[j]; acc[7][j] += a1[3] * b[j];
            }
        }
    }
    __syncthreads();
}
#define ZERO_ACC(a) do { _Pragma("unroll") for (int _i = 0; _i < 8; ++_i) _Pragma("unroll") for (int _j = 0; _j < 4; ++_j) a[_i][_j] = 0.f; } while (0)

__device__ __forceinline__ void ph_mod(Frame& F) {
    LAS float* sc = (LAS float*)F.lds;
    const float* c = F.in[I_C]; const float* W = F.in[I_WADA]; const float* bias = F.in[I_BADA];
    float* mod = (float*)(F.ws + WS_MOD);
    for (int vb = blockIdx.x; vb < 12; vb += F.G) {
        __syncthreads();
        for (int i = F.tid; i < 32 * 1024; i += NTHR) { const int b = i >> 10, k = i & 1023; const float v = c[i]; sc[k * 32 + b] = v / (1.0f + expf(-v)); }
        __syncthreads();
        const int n = vb * 512 + F.tid;
        float acc[32];
#pragma unroll
        for (int b = 0; b < 32; ++b) acc[b] = 0.f;
        for (int k = 0; k < 1024; ++k) {
            const float w = W[(size_t)k * 6144 + n];
#pragma unroll
            for (int b4 = 0; b4 < 8; ++b4) { const f32x4 s = *(const LAS f32x4*)(sc + k * 32 + b4 * 4);
                acc[b4 * 4 + 0] += s[0] * w; acc[b4 * 4 + 1] += s[1] * w; acc[b4 * 4 + 2] += s[2] * w; acc[b4 * 4 + 3] += s[3] * w; }
        }
        const float bb = bias[n];
#pragma unroll
        for (int b = 0; b < 32; ++b) mod[b * 6144 + n] = acc[b] + bb;
    }
}

__device__ __forceinline__ void ph_norm1(Frame& F) {
    const float* x = F.in[I_X]; const float* g = F.in[I_GPREMIX]; const float* mod = (const float*)(F.ws + WS_MOD);
    bf16* H = (bf16*)(F.outb + OUT_H);
    for (int t = blockIdx.x * NWAVES + F.wave; t < T; t += F.G * NWAVES) {
        const int b = t / SEQ; const float* xr = x + (size_t)t * D; const float* sh = mod + b * 6144, *scl = sh + 1024;
        f32x4 v[4]; float ss = 0.f;
#pragma unroll
        for (int j = 0; j < 4; ++j) { v[j] = *(const f32x4*)(xr + F.lane * 4 + 256 * j); ss += v[j][0] * v[j][0] + v[j][1] * v[j][1] + v[j][2] * v[j][2] + v[j][3] * v[j][3]; }
        const float rstd = rsqrtf(wave_sum(ss) * (1.0f / D) + EPS);
#pragma unroll
        for (int j = 0; j < 4; ++j) { const int c = F.lane * 4 + 256 * j; const f32x4 gg = *(const f32x4*)(g + c), s1 = *(const f32x4*)(scl + c), h1 = *(const f32x4*)(sh + c);
            float o[4];
#pragma unroll
            for (int e = 0; e < 4; ++e) o[e] = v[j][e] * rstd * gg[e] * (1.0f + s1[e]) + h1[e];
            u32x2 w; w.x = pk2(o[0], o[1]); w.y = pk2(o[2], o[3]); *(u32x2*)(H + (size_t)t * D + c) = w; }
    }
}

__device__ __forceinline__ void ph_inproj_naive(Frame& F) {
    LAS float* As = (LAS float*)F.lds; LAS float* Bs = As + 16 * 132;
    const bf16* H = (const bf16*)(F.outb + OUT_H); const float* W = F.in[I_WIN]; const float* bg = F.in[I_BGATES];
    bf16* Q = (bf16*)(F.ws + WS_Q); bf16* Kt = (bf16*)(F.ws + WS_K); bf16* V = (bf16*)(F.ws + WS_V); bf16* MQK = (bf16*)(F.ws + WS_MQK); bf16* MV = (bf16*)(F.ws + WS_MV);
    bf16* MO = (bf16*)(F.ws + WS_MO); bf16* GAB = (bf16*)(F.ws + WS_GAB); float* GATES = (float*)(F.ws + WS_GATES);
    constexpr int NTN = (INW + 127) / 128;
    const int ty = F.tid >> 5, tx = F.tid & 31;
    for (int vb = blockIdx.x; vb < (T / 128) * NTN; vb += F.G) {
        const int tm = vb / NTN, tn = vb % NTN, m0 = tm * 128, n0 = tn * 128;
        float acc[8][4]; ZERO_ACC(acc);
        ARowGlobal ar{H, (size_t)D, m0, nullptr};
        ngemm_acc(As, Bs, ar, W, INW, D, n0, INW, acc);
#pragma unroll
        for (int i = 0; i < 8; ++i)
#pragma unroll
            for (int j = 0; j < 4; ++j) {
                const size_t row = (size_t)(m0 + ty * 8 + i); const int col = n0 + tx * 4 + j; const float v = acc[i][j];
                if (col < 768) Q[row * 768 + col] = (bf16)f2bf(v);
                else if (col < 1536) Kt[row * 768 + col - 768] = (bf16)f2bf(v);
                else if (col < 2304) V[row * 768 + col - 1536] = (bf16)f2bf(v);
                else if (col < 3328) MQK[row * 1024 + col - 2304] = (bf16)f2bf(v);
                else if (col < 4352) MV[row * 1024 + col - 3328] = (bf16)f2bf(v);
                else if (col < 5376) MO[row * 1024 + col - 4352] = (bf16)f2bf(v);
                else if (col < 5384) GATES[row * 8 + col - 5376] = v + bg[col - 5376];
                else if (col < INW) GAB[row * 2048 + col - 5384] = (bf16)f2bf(v);
            }
    }
}

__device__ __forceinline__ void ph_rope_naive(Frame& F) {
    bf16* Q = (bf16*)(F.ws + WS_Q); bf16* Kt = (bf16*)(F.ws + WS_K);
    for (int t = blockIdx.x * NWAVES + F.wave; t < T; t += F.G * NWAVES) {
        const float p = (float)F.pos[t];
#pragma unroll
        for (int r = 0; r < 3; ++r) {
            const int it = r * 64 + F.lane;
            const int i = it & 7, head = (it >> 3) % 12, qk = it / 96;
            const float inv = powf(500000.0f, -(float)i / 8.0f);
            const float ang = p * inv; const float cs = cosf(ang), sn = sinf(ang);
            bf16* base = (qk ? Kt : Q) + (size_t)t * 768 + head * 64;
            const float x1 = bf2f(base[i]), x2 = bf2f(base[i + 8]);
            base[i] = (bf16)f2bf(x1 * cs - x2 * sn); base[i + 8] = (bf16)f2bf(x2 * cs + x1 * sn);
        }
    }
}

__device__ __forceinline__ void ph_attn_naive_block(Frame& F, int vb) {
    const bf16* Q = (const bf16*)(F.ws + WS_Q); const bf16* Kt = (const bf16*)(F.ws + WS_K); const bf16* V = (const bf16*)(F.ws + WS_V);
    bf16* YA = (bf16*)(F.outb + OUT_YA);
    const int item = vb * NTHR + F.tid; const int t = item >> 2, j = item & 3; const int b = t / SEQ, s = t % SEQ;
    float acc[64];
#pragma unroll
    for (int d = 0; d < 64; ++d) acc[d] = 0.f;
    float m = -INFINITY, l = 0.f;
    for (int g = 0; g < 3; ++g) {
        const int dil = (g == 0) ? 1 : (g == 1) ? 4 : 16; const int head = g * 4 + j;
        float q[64];
        { const u32x4* qp = (const u32x4*)(Q + (size_t)t * 768 + head * 64);
#pragma unroll
          for (int c = 0; c < 8; ++c) { const u32x4 w = qp[c];
#pragma unroll
              for (int e = 0; e < 4; ++e) { q[c * 8 + 2 * e] = __uint_as_float(w[e] << 16) * 0.125f; q[c * 8 + 2 * e + 1] = __uint_as_float(w[e] & 0xffff0000u) * 0.125f; } } }
        const int lq = s / dil; const int nk = (lq < 128 ? lq : 128) + 1;
        for (int jj = 0; jj < nk; ++jj) {
            const size_t tk = (size_t)b * SEQ + (s - jj * dil);
            const u32x4* kp = (const u32x4*)(Kt + tk * 768 + head * 64);
            float dot = 0.f;
#pragma unroll
            for (int c = 0; c < 8; ++c) { const u32x4 w = kp[c];
#pragma unroll
                for (int e = 0; e < 4; ++e) { dot += q[c * 8 + 2 * e] * __uint_as_float(w[e] << 16); dot += q[c * 8 + 2 * e + 1] * __uint_as_float(w[e] & 0xffff0000u); } }
            const float mn = fmaxf(m, dot); const float corr = expf(m - mn), p = expf(dot - mn);
            l = l * corr + p; m = mn;
            const u32x4* vp = (const u32x4*)(V + tk * 768 + head * 64);
#pragma unroll
            for (int c = 0; c < 8; ++c) { const u32x4 w = vp[c];
#pragma unroll
                for (int e = 0; e < 4; ++e) { acc[c * 8 + 2 * e] = acc[c * 8 + 2 * e] * corr + p * __uint_as_float(w[e] << 16); acc[c * 8 + 2 * e + 1] = acc[c * 8 + 2 * e + 1] * corr + p * __uint_as_float(w[e] & 0xffff0000u); } }
        }
    }
    const float rl = 1.0f / l;
    u32x4* op = (u32x4*)(YA + (size_t)t * 256 + j * 64);
#pragma unroll
    for (int c = 0; c < 8; ++c) { u32x4 w;
#pragma unroll
        for (int e = 0; e < 4; ++e) w[e] = pk2(acc[c * 8 + 2 * e] * rl, acc[c * 8 + 2 * e + 1] * rl);
        op[c] = w; }
}

__device__ __forceinline__ void ph_mlstm_naive_unit(Frame& F, int bh) {
    const int b = bh >> 2, h = bh & 3, tid = F.tid, v = tid & 255, dh = tid >> 8;
    LAS float* qs = (LAS float*)F.lds; LAS float* ks = qs + 128; LAS float* red = ks + 128; LAS float* sc = red + 512;
    const bf16* MQK = (const bf16*)(F.ws + WS_MQK); const bf16* MV = (const bf16*)(F.ws + WS_MV); const bf16* MO = (const bf16*)(F.ws + WS_MO);
    const float* GATES = (const float*)(F.ws + WS_GATES); bf16* YB = (bf16*)(F.outb + OUT_YB);
    const float* cw = F.in[I_CONVW]; const float* cbv = F.in[I_CONVB];
    float C[64];
#pragma unroll
    for (int d = 0; d < 64; ++d) C[d] = 0.f;
    float nst = 0.f, m = 0.f;
    const int ch = (tid < 128) ? (h * 128 + tid) : (512 + h * 128 + ((tid - 128) & 127));
    const float w0 = cw[ch], w1 = cw[1024 + ch], w2 = cw[2048 + ch], w3 = cw[3072 + ch], cb = cbv[ch];
    float xh0 = 0.f, xh1 = 0.f, xh2 = 0.f;
    const float gm = F.in[I_GMLSTM][h * 256 + v];
    __syncthreads();
    for (int s = 0; s < SEQ; ++s) {
        const size_t t = (size_t)b * SEQ + s;
        if (tid < 256) {
            const float xc = bf2f(MQK[t * 1024 + ch]);
            float y = cb + w0 * xh0 + w1 * xh1 + w2 * xh2 + w3 * xc; xh0 = xh1; xh1 = xh2; xh2 = xc;
            y = y / (1.0f + expf(-y));
            if (tid < 128) qs[tid] = y; else ks[tid - 128] = y * 0.08838834764831845f;
        }
        const float ig = GATES[t * 8 + h], fg = GATES[t * 8 + 4 + h];
        const float lf = logsigmoidf_(fg); const float mn = fmaxf(lf + m, ig); const float fd = expf(lf + m - mn), iw = expf(ig - mn); m = mn;
        const float vv = bf2f(MV[t * 1024 + h * 256 + v]);
        __syncthreads();
        float part = 0.f; const float ivv = iw * vv;
#pragma unroll
        for (int d4 = 0; d4 < 16; ++d4) { const f32x4 k4 = *(const LAS f32x4*)(ks + dh * 64 + d4 * 4), q4 = *(const LAS f32x4*)(qs + dh * 64 + d4 * 4);
#pragma unroll
            for (int e = 0; e < 4; ++e) { C[d4 * 4 + e] = fd * C[d4 * 4 + e] + ivv * k4[e]; part += C[d4 * 4 + e] * q4[e]; } }
        red[tid] = part;
        float nq = 0.f;
        if (tid < 128) { nst = fd * nst + iw * ks[tid]; nq = nst * qs[tid]; }
        nq = wave_sum(nq);
        if (F.lane == 0 && F.wave < 2) sc[F.wave] = nq;
        __syncthreads();
        const float num = red[v] + red[v + 256]; const float den = sc[0] + sc[1];
        const float hv = num / fmaxf(fabsf(den), expf(-mn));
        float sq = (dh == 0) ? hv * hv : 0.f; sq = wave_sum(sq);
        if (F.lane == 0) sc[2 + F.wave] = sq;
        __syncthreads();
        if (dh == 0) {
            const float ssum = sc[2] + sc[3] + sc[4] + sc[5];
            float y = hv * rsqrtf(ssum * (1.0f / 256.0f) + EPS) * gm;
            y *= sigmoidf_(bf2f(MO[t * 1024 + h * 256 + v]));
            YB[t * 1024 + h * 256 + v] = (bf16)f2bf(y);
        }
    }
    __syncthreads();
}

__device__ __forceinline__ void ph_branch_naive(Frame& F) {
    LAS float* As = (LAS float*)F.lds; LAS float* Bs = As + 16 * 132;
    const bf16* YA = (const bf16*)(F.outb + OUT_YA); const bf16* YB = (const bf16*)(F.outb + OUT_YB); const bf16* GAB = (const bf16*)(F.ws + WS_GAB);
    bf16* MG = (bf16*)(F.ws + WS_MERGED);
    const int ty = F.tid >> 5, tx = F.tid & 31;
    for (int vb = blockIdx.x; vb < (T / 128) * 8; vb += F.G) {
        const int tm = vb >> 3, tn = vb & 7, m0 = tm * 128, n0 = tn * 128;
        float a1[8][4], a2[8][4]; ZERO_ACC(a1); ZERO_ACC(a2);
        ARowGlobal ra{YA, (size_t)256, m0, nullptr}; ngemm_acc(As, Bs, ra, F.in[I_WBA], D, 256, n0, D, a1);
        ARowGlobal rb{YB, (size_t)D, m0, nullptr};  ngemm_acc(As, Bs, rb, F.in[I_WBB], D, D, n0, D, a2);
#pragma unroll
        for (int i = 0; i < 8; ++i) { const size_t row = (size_t)(m0 + ty * 8 + i); const int col = n0 + tx * 4;
            const u32x2 ga = *(const u32x2*)(GAB + row * 2048 + col), gb = *(const u32x2*)(GAB + row * 2048 + 1024 + col);
            const float sga[4] = {sigmoidf_(__uint_as_float(ga.x << 16)), sigmoidf_(__uint_as_float(ga.x & 0xffff0000u)), sigmoidf_(__uint_as_float(ga.y << 16)), sigmoidf_(__uint_as_float(ga.y & 0xffff0000u))};
            const float sgb[4] = {sigmoidf_(__uint_as_float(gb.x << 16)), sigmoidf_(__uint_as_float(gb.x & 0xffff0000u)), sigmoidf_(__uint_as_float(gb.y << 16)), sigmoidf_(__uint_as_float(gb.y & 0xffff0000u))};
            float o[4];
#pragma unroll
            for (int j = 0; j < 4; ++j) o[j] = sga[j] * a1[i][j] + sgb[j] * a2[i][j];
            u32x2 w; w.x = pk2(o[0], o[1]); w.y = pk2(o[2], o[3]); *(u32x2*)(MG + row * D + col) = w; }
    }
}

__device__ __forceinline__ void ph_outproj_naive(Frame& F) {
    LAS float* As = (LAS float*)F.lds; LAS float* Bs = As + 16 * 132;
    const bf16* MG = (const bf16*)(F.ws + WS_MERGED); bf16* YM = (bf16*)(F.ws + WS_YMIX);
    const int ty = F.tid >> 5, tx = F.tid & 31;
    for (int vb = blockIdx.x; vb < (T / 128) * 8; vb += F.G) {
        const int tm = vb >> 3, tn = vb & 7, m0 = tm * 128, n0 = tn * 128;
        float a1[8][4]; ZERO_ACC(a1);
        ARowGlobal ra{MG, (size_t)D, m0, nullptr}; ngemm_acc(As, Bs, ra, F.in[I_WOUT], D, D, n0, D, a1);
#pragma unroll
        for (int i = 0; i < 8; ++i) { const size_t row = (size_t)(m0 + ty * 8 + i); const int col = n0 + tx * 4;
            u32x2 w; w.x = pk2(a1[i][0], a1[i][1]); w.y = pk2(a1[i][2], a1[i][3]); *(u32x2*)(YM + row * D + col) = w; }
    }
}

__device__ __forceinline__ void x1_row(Frame& F, int t, f32x4 (&x1)[4]) {
    const float* x = F.in[I_X]; const bf16* YM = (const bf16*)(F.ws + WS_YMIX); const float* mod = (const float*)(F.ws + WS_MOD);
    const int b = t / SEQ; const float* gt1 = mod + b * 6144 + 2048; const float* g = F.in[I_GPOSTMIX];
    f32x4 y[4]; float ss = 0.f;
#pragma unroll
    for (int j = 0; j < 4; ++j) { const u32x2 w = *(const u32x2*)(YM + (size_t)t * D + F.lane * 4 + 256 * j);
        y[j][0] = __uint_as_float(w.x << 16); y[j][1] = __uint_as_float(w.x & 0xffff0000u); y[j][2] = __uint_as_float(w.y << 16); y[j][3] = __uint_as_float(w.y & 0xffff0000u);
        ss += y[j][0] * y[j][0] + y[j][1] * y[j][1] + y[j][2] * y[j][2] + y[j][3] * y[j][3]; }
    const float rstd = rsqrtf(wave_sum(ss) * (1.0f / D) + EPS);
#pragma unroll
    for (int j = 0; j < 4; ++j) { const int c = F.lane * 4 + 256 * j; const f32x4 xv = *(const f32x4*)(x + (size_t)t * D + c), gg = *(const f32x4*)(g + c), gt = *(const f32x4*)(gt1 + c);
#pragma unroll
        for (int e = 0; e < 4; ++e) x1[j][e] = xv[e] + gt[e] * (y[j][e] * rstd * gg[e]); }
}

__device__ __forceinline__ void ph_normmid(Frame& F) {
    const float* mod = (const float*)(F.ws + WS_MOD); const float* g = F.in[I_GPREFFN]; bf16* H2 = (bf16*)(F.ws + WS_H2);
    for (int t = blockIdx.x * NWAVES + F.wave; t < T; t += F.G * NWAVES) {
        const int b = t / SEQ; const float* sh2 = mod + b * 6144 + 3072, *sc2 = mod + b * 6144 + 4096;
        f32x4 x1[4]; x1_row(F, t, x1);
        float ss = 0.f;
#pragma unroll
        for (int j = 0; j < 4; ++j) ss += x1[j][0] * x1[j][0] + x1[j][1] * x1[j][1] + x1[j][2] * x1[j][2] + x1[j][3] * x1[j][3];
        const float rstd = rsqrtf(wave_sum(ss) * (1.0f / D) + EPS);
#pragma unroll
        for (int j = 0; j < 4; ++j) { const int c = F.lane * 4 + 256 * j; const f32x4 gg = *(const f32x4*)(g + c), s2 = *(const f32x4*)(sc2 + c), h2 = *(const f32x4*)(sh2 + c);
            float o[4];
#pragma unroll
            for (int e = 0; e < 4; ++e) o[e] = x1[j][e] * rstd * gg[e] * (1.0f + s2[e]) + h2[e];
            u32x2 w; w.x = pk2(o[0], o[1]); w.y = pk2(o[2], o[3]); *(u32x2*)(H2 + (size_t)t * D + c) = w;
            *(f32x4*)(F.out + (size_t)t * D + c) = (f32x4){0.f, 0.f, 0.f, 0.f}; }
    }
}

__device__ __forceinline__ void ph_router_naive(Frame& F) {
    LAS float* As = (LAS float*)F.lds; LAS float* Bs = As + 16 * 132;
    const bf16* H2 = (const bf16*)(F.ws + WS_H2); float* LG = (float*)(F.ws + WS_LOGITS);
    const int ty = F.tid >> 5, tx = F.tid & 31;
    for (int vb = blockIdx.x; vb < (T / 128) * 2; vb += F.G) {
        const int tm = vb >> 1, tn = vb & 1, m0 = tm * 128, n0 = tn * 128;
        float a1[8][4]; ZERO_ACC(a1);
        ARowGlobal ra{H2, (size_t)D, m0, nullptr}; ngemm_acc(As, Bs, ra, F.in[I_RW], NE, D, n0, NE, a1);
#pragma unroll
        for (int i = 0; i < 8; ++i) { const size_t row = (size_t)(m0 + ty * 8 + i); const int col = n0 + tx * 4;
            *(f32x4*)(LG + row * NE + col) = (f32x4){a1[i][0], a1[i][1], a1[i][2], a1[i][3]}; }
    }
}

__device__ __forceinline__ float half_max(float v) {
#pragma unroll
    for (int o = 1; o < 32; o <<= 1) v = fmaxf(v, __shfl_xor(v, o));
    return v;
}
__device__ __forceinline__ void ph_topk(Frame& F) {
    const float* LG = (const float*)(F.ws + WS_LOGITS); const float* rb = F.in[I_RB];
    int* TOPI = (int*)(F.ws + WS_TOPI); float* TOPW = (float*)(F.ws + WS_TOPW); unsigned* counts = F.ctl + CW_COUNTS;
    const int lane = F.lane, hf = lane >> 5;
    for (int t = blockIdx.x * NWAVES + F.wave; t < T; t += F.G * NWAVES) {
        float sc[4], sel[4];
#pragma unroll
        for (int i = 0; i < 4; ++i) { sc[i] = sigmoidf_(LG[(size_t)t * NE + lane + 64 * i]); sel[i] = sc[i] + rb[lane + 64 * i]; }
        float gs[8];
#pragma unroll
        for (int i = 0; i < 4; ++i) {
            const float m1 = half_max(sel[i]);
            const unsigned long long bal = __ballot(sel[i] == m1); const unsigned hb = hf ? (unsigned)(bal >> 32) : (unsigned)bal;
            const int first = __ffs(hb) - 1;
            const float v2 = ((lane & 31) == first) ? -INFINITY : sel[i];
            const float m2 = half_max(v2);
            const float g = m1 + m2;
            const float go = __shfl_xor(g, 32);
            gs[2 * i] = hf ? go : g; gs[2 * i + 1] = hf ? g : go;
        }
        bool gsel[8];
#pragma unroll
        for (int a = 0; a < 8; ++a) { int rank = 0;
#pragma unroll
            for (int c = 0; c < 8; ++c) rank += (gs[c] > gs[a] || (gs[c] == gs[a] && c < a)) ? 1 : 0;
            gsel[a] = rank < 4; }
#pragma unroll
        for (int i = 0; i < 4; ++i) { const bool ok = hf ? gsel[2 * i + 1] : gsel[2 * i]; if (!ok) sel[i] = -INFINITY; }
        int myidx = 0; float myw = 0.f; float wsum = 0.f;
#pragma unroll
        for (int k = 0; k < TOPK; ++k) {
            float bv = sel[0]; int bi = lane;
#pragma unroll
            for (int i = 1; i < 4; ++i) if (sel[i] > bv) { bv = sel[i]; bi = lane + 64 * i; }
#pragma unroll
            for (int o = 1; o < 64; o <<= 1) { const float ov = __shfl_xor(bv, o); const int oi = __shfl_xor(bi, o); if (ov > bv || (ov == bv && oi < bi)) { bv = ov; bi = oi; } }
            const int ol = bi & 63, oi = bi >> 6;
            float s = (oi == 0) ? sc[0] : (oi == 1) ? sc[1] : (oi == 2) ? sc[2] : sc[3];
            s = __shfl(s, ol);
            if (lane == ol) { if (oi == 0) sel[0] = -INFINITY; else if (oi == 1) sel[1] = -INFINITY; else if (oi == 2) sel[2] = -INFINITY; else sel[3] = -INFINITY; }
            wsum += s;
            if (lane == k) { myidx = bi; myw = s; }
        }
        if (lane < TOPK) { TOPI[(size_t)t * TOPK + lane] = myidx; TOPW[(size_t)t * TOPK + lane] = myw / wsum * 2.5f; atomicAdd(&counts[myidx], 1u); }
    }
}


__device__ __forceinline__ void ph_topk_serial(Frame& F) {
    const float* LG = (const float*)(F.ws + WS_LOGITS); const float* rb = F.in[I_RB];
    int* TOPI = (int*)(F.ws + WS_TOPI); float* TOPW = (float*)(F.ws + WS_TOPW); unsigned* counts = F.ctl + CW_COUNTS;
    LAS float* sel = (LAS float*)F.lds + F.wave * 1024; LAS float* scr = sel + 256; LAS float* gsc = scr + 256; LAS int* gok = (LAS int*)(gsc + 8); LAS int* bi = gok + 8; LAS float* bw = (LAS float*)(bi + 8);
    for (int t = blockIdx.x * NWAVES + F.wave; t < T; t += F.G * NWAVES) {
        for (int i = 0; i < 4; ++i) { const int e = F.lane + 64 * i; const float s = sigmoidf_(LG[(size_t)t * NE + e]); scr[e] = s; sel[e] = s + rb[e]; }
        __builtin_amdgcn_s_waitcnt(0);
        if (F.lane == 0) {
            for (int g = 0; g < 8; ++g) { float m1 = -INFINITY, m2 = -INFINITY; for (int q = 0; q < 32; ++q) { const float v = sel[g * 32 + q]; if (v > m1) { m2 = m1; m1 = v; } else if (v > m2) m2 = v; } gsc[g] = m1 + m2; gok[g] = 0; }
            for (int k = 0; k < 4; ++k) { int best = -1; float bv = -INFINITY; for (int g = 0; g < 8; ++g) if (!gok[g] && gsc[g] > bv) { bv = gsc[g]; best = g; } gok[best] = 1; }
            for (int e = 0; e < 256; ++e) if (!gok[e >> 5]) sel[e] = -INFINITY;
            float ws = 0.f;
            for (int k = 0; k < 8; ++k) { int best = 0; float bv = -INFINITY; for (int e = 0; e < 256; ++e) if (sel[e] > bv) { bv = sel[e]; best = e; } sel[best] = -INFINITY; bi[k] = best; bw[k] = scr[best]; ws += scr[best]; }
            for (int k = 0; k < 8; ++k) { TOPI[(size_t)t * 8 + k] = bi[k]; TOPW[(size_t)t * 8 + k] = bw[k] / ws * 2.5f; atomicAdd(&counts[bi[k]], 1u); }
        }
        __builtin_amdgcn_s_waitcnt(0);
    }
}

__device__ __forceinline__ void ph_scan(Frame& F) {
    if (blockIdx.x != 0) return;
    LAS int* pre = (LAS int*)F.lds;
    unsigned* counts = F.ctl + CW_COUNTS; int* ROWTOK = (int*)(F.ws + WS_ROWTOK); float* ROWW = (float*)(F.ws + WS_ROWW);
    int* UNITEXP = (int*)(F.ws + WS_UNITEXP); int* EXPTILE0 = (int*)(F.ws + WS_EXPTILE0);
    __syncthreads();
    int n = 0, nt = 0;
    if (F.tid < NE) { n = (int)counts[F.tid]; nt = (n + 255) >> 8; pre[F.tid] = nt; }
    __syncthreads();
    if (F.tid == 0) { int s = 0; for (int e = 0; e < NE; ++e) { const int c = pre[e]; pre[e] = s; s += c; } F.ctl[CW_NT] = (unsigned)s; }
    __syncthreads();
    if (F.tid < NE) {
        const int t0 = pre[F.tid]; EXPTILE0[F.tid] = t0;
        for (int u = 0; u < nt; ++u) UNITEXP[t0 + u] = F.tid;
        for (int r = n; r < nt * 256; ++r) { ROWTOK[t0 * 256 + r] = 0; ROWW[t0 * 256 + r] = 0.f; }
    }
    __syncthreads();
}

__device__ __forceinline__ void ph_scatter(Frame& F) {
    const int* TOPI = (const int*)(F.ws + WS_TOPI); const float* TOPW = (const float*)(F.ws + WS_TOPW);
    int* ROWTOK = (int*)(F.ws + WS_ROWTOK); float* ROWW = (float*)(F.ws + WS_ROWW); const int* EXPTILE0 = (const int*)(F.ws + WS_EXPTILE0);
    unsigned* cursor = F.ctl + CW_CURSOR;
    for (int i = blockIdx.x * NTHR + F.tid; i < T * TOPK; i += F.G * NTHR) {
        const int e = TOPI[i]; const unsigned p = atomicAdd(&cursor[e], 1u);
        const size_t r = (size_t)EXPTILE0[e] * 256 + p;
        ROWTOK[r] = i >> 3; ROWW[r] = TOPW[i];
    }
}

__device__ __forceinline__ void ph_experts_naive(Frame& F) {
    LAS float* As = (LAS float*)F.lds; LAS float* Bs = As + 16 * 132; LAS bf16* hid = (LAS bf16*)(F.lds + 32768);
    const bf16* H2 = (const bf16*)(F.ws + WS_H2);
    const int* ROWTOK = (const int*)(F.ws + WS_ROWTOK); const float* ROWW = (const float*)(F.ws + WS_ROWW); const int* UNITEXP = (const int*)(F.ws + WS_UNITEXP);
    const int NT = (int)__hip_atomic_load(F.ctl + CW_NT, __ATOMIC_RELAXED, __HIP_MEMORY_SCOPE_AGENT);
    const int ty = F.tid >> 5, tx = F.tid & 31;
    const int nvb = 2 * NT + T / 128;
    for (int vb = blockIdx.x; vb < nvb; vb += F.G) {
        const bool shared = vb >= 2 * NT;
        const float *Wg, *Wu, *Wd; int r0; const int* gather;
        if (shared) { Wg = F.in[I_WSG]; Wu = F.in[I_WSU]; Wd = F.in[I_WSD]; r0 = (vb - 2 * NT) * 128; gather = nullptr; }
        else { const int u = vb >> 1; const int e = UNITEXP[u]; Wg = F.in[I_WEG] + (size_t)e * 1024 * 256; Wu = F.in[I_WEU] + (size_t)e * 1024 * 256; Wd = F.in[I_WED] + (size_t)e * 256 * 1024;
               r0 = u * 256 + (vb & 1) * 128; gather = ROWTOK; }
        ARowGlobal ra{H2, (size_t)D, r0, gather};
        for (int nh = 0; nh < 2; ++nh) {
            float ag[8][4], au[8][4]; ZERO_ACC(ag); ZERO_ACC(au);
            ngemm_acc(As, Bs, ra, Wg, 256, D, nh * 128, 256, ag);
            ngemm_acc(As, Bs, ra, Wu, 256, D, nh * 128, 256, au);
#pragma unroll
            for (int i = 0; i < 8; ++i) { float o[4];
#pragma unroll
                for (int j = 0; j < 4; ++j) { const float g = ag[i][j]; o[j] = g / (1.0f + expf(-g)) * au[i][j]; }
                u32x2 w; w.x = pk2(o[0], o[1]); w.y = pk2(o[2], o[3]); *(LAS u32x2*)(hid + (ty * 8 + i) * 256 + nh * 128 + tx * 4) = w; }
        }
        __syncthreads();
        ARowLds rl{hid};
        for (int nc = 0; nc < 8; ++nc) {
            float ad[8][4]; ZERO_ACC(ad);
            ngemm_acc(As, Bs, rl, Wd, D, 256, nc * 128, D, ad);
#pragma unroll
            for (int i = 0; i < 8; ++i) { const int r = r0 + ty * 8 + i; const int tok = shared ? r : ROWTOK[r]; const float w = shared ? 1.0f : ROWW[r];
                if (w != 0.f) {
#pragma unroll
                    for (int j = 0; j < 4; ++j) unsafeAtomicAdd(F.out + (size_t)tok * D + nc * 128 + tx * 4 + j, ad[i][j] * w); } }
        }
        __syncthreads();
    }
}


__device__ __forceinline__ void ph_experts_brute(Frame& F) {
    LAS float* hs = (LAS float*)F.lds;
    LAS float* hid = hs + 1024;
    LAS float* pg = hid + 256;
    const bf16* H2 = (const bf16*)(F.ws + WS_H2); const int* TOPI = (const int*)(F.ws + WS_TOPI); const float* TOPW = (const float*)(F.ws + WS_TOPW);
    const int tid = F.tid, j = tid & 255, kh = tid >> 8;
    for (int t = blockIdx.x; t < T; t += F.G) {
        __syncthreads();
        hs[tid] = bf2f(H2[(size_t)t * D + tid]); hs[tid + 512] = bf2f(H2[(size_t)t * D + tid + 512]);
        float o0 = 0.f, o1 = 0.f;
        __syncthreads();
        for (int k9 = 0; k9 < 9; ++k9) {
            const float *Wg, *Wu, *Wd; float w;
            if (k9 == 8) { Wg = F.in[I_WSG]; Wu = F.in[I_WSU]; Wd = F.in[I_WSD]; w = 1.0f; }
            else { const int e = TOPI[(size_t)t * 8 + k9]; w = TOPW[(size_t)t * 8 + k9]; Wg = F.in[I_WEG] + (size_t)e * 1024 * 256; Wu = F.in[I_WEU] + (size_t)e * 1024 * 256; Wd = F.in[I_WED] + (size_t)e * 256 * 1024; }
            float g = 0.f, u = 0.f;
            for (int k = kh * 512; k < kh * 512 + 512; ++k) { const float hv = hs[k]; g += hv * Wg[(size_t)k * 256 + j]; u += hv * Wu[(size_t)k * 256 + j]; }
            pg[tid] = g; pg[512 + tid] = u;
            __syncthreads();
            if (tid < 256) { const float gg = pg[tid] + pg[tid + 256], uu = pg[512 + tid] + pg[512 + tid + 256]; hid[tid] = gg / (1.0f + expf(-gg)) * uu * w; }
            __syncthreads();
            for (int q = 0; q < 256; ++q) { const float hv = hid[q]; o0 += hv * Wd[(size_t)q * 1024 + tid]; o1 += hv * Wd[(size_t)q * 1024 + tid + 512]; }
        }
        F.out[(size_t)t * D + tid] = o0; F.out[(size_t)t * D + tid + 512] = o1;
    }
}

__device__ __forceinline__ void ph_final(Frame& F) {
    const float* mod = (const float*)(F.ws + WS_MOD); const float* g = F.in[I_GPOSTFFN];
    for (int t = blockIdx.x * NWAVES + F.wave; t < T; t += F.G * NWAVES) {
        const int b = t / SEQ; const float* gt2 = mod + b * 6144 + 5120;
        f32x4 x1[4]; x1_row(F, t, x1);
        f32x4 y[4]; float ss = 0.f;
#pragma unroll
        for (int j = 0; j < 4; ++j) { y[j] = *(const f32x4*)(F.out + (size_t)t * D + F.lane * 4 + 256 * j); ss += y[j][0] * y[j][0] + y[j][1] * y[j][1] + y[j][2] * y[j][2] + y[j][3] * y[j][3]; }
        const float rstd = rsqrtf(wave_sum(ss) * (1.0f / D) + EPS);
#pragma unroll
        for (int j = 0; j < 4; ++j) { const int c = F.lane * 4 + 256 * j; const f32x4 gg = *(const f32x4*)(g + c), gt = *(const f32x4*)(gt2 + c);
            f32x4 o;
#pragma unroll
            for (int e = 0; e < 4; ++e) o[e] = x1[j][e] + DBG_MOE_SCALE * gt[e] * (y[j][e] * rstd * gg[e]);
            *(f32x4*)(F.out + (size_t)t * D + c) = o; }
    }
}

enum { PH_MOD = 0, PH_NORM1, PH_INPROJ, PH_ROPE, PH_MIX, PH_BRANCH, PH_OUTPROJ, PH_NORMMID, PH_ROUTER, PH_TOPK, PH_SCAN, PH_SCATTER, PH_EXPERTS, PH_FINAL, N_PHASES };

__global__ void __launch_bounds__(NTHR, 2) mk_fwd(Args args) {
    extern __shared__ __attribute__((aligned(16))) unsigned char lds_raw[];
    Frame F;
    F.lds = (LAS unsigned char*)lds_raw;
    F.tid = threadIdx.x; F.lane = F.tid & 63; F.wave = __builtin_amdgcn_readfirstlane(F.tid >> 6); F.G = gridDim.x;
#pragma unroll
    for (int i = 0; i < N_IN; ++i) F.in[i] = args.in[i];
    F.pos = (const int*)args.in[I_POS];
    F.out = args.out; F.outb = (unsigned char*)args.out; F.ws = args.ws; F.ctl = (unsigned*)(args.ws + WS_CTL);
    volatile LAS unsigned* MISC = (volatile LAS unsigned*)(F.lds + MISC_OFF);
    if (F.tid < 32) MISC[F.tid] = 0u;
    __syncthreads();
    const int lo = args.ph_lo, hi = args.ph_hi;
    XcdBarrier bar; bar.bar = F.ctl + CW_BAR; bar.x = 0; bar.st = nullptr;
    if (hi - lo > 1) bar = xcd_barrier_post(F.ctl + CW_BAR, MISC + 8);
#ifndef PH_MASK
#define PH_MASK 0xFFFFFFu
#endif
#define IN(k) ((((PH_MASK) >> (k)) & 1u) && lo <= (k) && (k) < hi)
#define SEAM(k) do { if (IN(k) && IN((k) + 1)) xcd_barrier(bar); } while (0)

    if (IN(PH_MOD)) { ph_mod(F); } SEAM(PH_MOD);
    if (IN(PH_NORM1)) { ph_norm1(F); } SEAM(PH_NORM1);
    if (IN(PH_INPROJ)) { ph_inproj_naive(F); } SEAM(PH_INPROJ);
    if (IN(PH_ROPE)) { ph_rope_naive(F); } SEAM(PH_ROPE);
    if (IN(PH_MIX)) {
        for (int vb = blockIdx.x; vb < 128 + 512; vb += F.G) { if (vb < 128) ph_mlstm_naive_unit(F, vb); else ph_attn_naive_block(F, vb - 128); }
    } SEAM(PH_MIX);
    if (IN(PH_BRANCH)) { ph_branch_naive(F); } SEAM(PH_BRANCH);
    if (IN(PH_OUTPROJ)) { ph_outproj_naive(F); } SEAM(PH_OUTPROJ);
    if (IN(PH_NORMMID)) { ph_normmid(F); } SEAM(PH_NORMMID);
    if (IN(PH_ROUTER)) { ph_router_naive(F); } SEAM(PH_ROUTER);
    #if DBG_TOPK_SERIAL
    if (IN(PH_TOPK)) { ph_topk_serial(F); }
#else
    if (IN(PH_TOPK)) { ph_topk(F); }
#endif
    SEAM(PH_TOPK);
    if (IN(PH_SCAN)) { ph_scan(F); } SEAM(PH_SCAN);
    if (IN(PH_SCATTER)) { ph_scatter(F); } SEAM(PH_SCATTER);
    #if DBG_BRUTE
    if (IN(PH_EXPERTS)) { ph_experts_brute(F); }
#else
    if (IN(PH_EXPERTS)) { ph_experts_naive(F); }
#endif
    SEAM(PH_EXPERTS);
    if (IN(PH_FINAL)) { ph_final(F); }
#undef IN
#undef SEAM
}

extern "C" void kernel_launch(void* const* d_in, const int* in_sizes, int n_in, void* d_out, int out_size, void* d_ws, size_t ws_size, hipStream_t stream) {
    static int grid = 0;
    if (grid == 0) {
        if (n_in != N_IN || out_size != T * D || ws_size < WS_NEED) { fprintf(stderr, "kernel_launch: unexpected shapes (n_in %d, out %d, ws %zu); nothing launched\n", n_in, out_size, ws_size); grid = -1; return; }
        int dev = 0, cus = 0, per_cu = 0;
        if (hipGetDevice(&dev) != hipSuccess || hipDeviceGetAttribute(&cus, hipDeviceAttributeMultiprocessorCount, dev) != hipSuccess) { grid = -1; return; }
        if (hipFuncSetAttribute((const void*)mk_fwd, hipFuncAttributeMaxDynamicSharedMemorySize, LDS_BYTES) != hipSuccess) { fprintf(stderr, "kernel_launch: hipFuncSetAttribute failed\n"); grid = -1; return; }
        if (hipOccupancyMaxActiveBlocksPerMultiprocessor(&per_cu, (const void*)mk_fwd, NTHR, LDS_BYTES) != hipSuccess || per_cu < 1) fprintf(stderr, "kernel_launch: occupancy query reports %d\n", per_cu);
        (void)hipGetLastError();
        grid = cus;
    }
    if (grid < 0) return;
    if (hipMemsetAsync((char*)d_ws + WS_CTL, 0, CTL_ZERO_BYTES, stream) != hipSuccess) return;
    Args a{};
    for (int i = 0; i < N_IN; ++i) a.in[i] = (const float*)d_in[i];
    a.out = (float*)d_out; a.ws = (unsigned char*)d_ws;
#if MK_SPLIT
    for (int p = 0; p < N_PHASES; ++p) { a.ph_lo = p; a.ph_hi = p + 1; hipLaunchKernelGGL(mk_fwd, dim3(grid), dim3(NTHR), LDS_BYTES, stream, a); }
#elif defined(MK_CUTS)
    { const int cuts[] = MK_CUTS; const int nc = sizeof(cuts) / sizeof(int);
      for (int i = 0; i + 1 < nc; ++i) { a.ph_lo = cuts[i]; a.ph_hi = cuts[i + 1];
          if (i) hipMemsetAsync((char*)d_ws + WS_CTL + CW_BAR * 4, 0, XCD_BAR_WORDS * 4, stream);
          hipLaunchKernelGGL(mk_fwd, dim3(grid), dim3(NTHR), LDS_BYTES, stream, a); } }
#else
    a.ph_lo = 0; a.ph_hi = N_PHASES;
    hipLaunchKernelGGL(mk_fwd, dim3(grid), dim3(NTHR), LDS_BYTES, stream, a);
#endif
}
```

```cpp
#include <hip/hip_runtime.h>
#include <cstdio>
#include <cstdint>

#define GAS __attribute__((address_space(1)))
#define LAS __attribute__((address_space(3)))
typedef unsigned short bf16;
typedef float f32x4 __attribute__((ext_vector_type(4)));
typedef float f32x2 __attribute__((ext_vector_type(2)));
typedef unsigned u32x4 __attribute__((ext_vector_type(4)));
typedef unsigned u32x2 __attribute__((ext_vector_type(2)));

#ifndef DBG_MOE_SCALE
#define DBG_MOE_SCALE 1.0f
#endif
#ifndef DBG_BRUTE
#define DBG_BRUTE 0
#endif
#ifndef DBG_TOPK_SERIAL
#define DBG_TOPK_SERIAL 1
#endif

#ifndef FAST_INPROJ
#define FAST_INPROJ 1
#endif
#ifndef FAST_BRANCH
#define FAST_BRANCH 1
#endif
#ifndef FAST_ROUTER
#define FAST_ROUTER 1
#endif
#ifndef FAST_EXPERTS
#define FAST_EXPERTS 1
#endif
#ifndef MK_SPLIT
#define MK_SPLIT 0
#endif

constexpr int D = 1024, NB = 32, SEQ = 2048, T = NB * SEQ;
constexpr int INW = 7432;
constexpr int NE = 256, TOPK = 8;
constexpr int NTHR = 512, NWAVES = 8;
constexpr float EPS = 1e-6f;

enum { I_X = 0, I_C, I_POS, I_WADA, I_BADA, I_GPREMIX, I_GPOSTMIX, I_GPREFFN, I_GPOSTFFN, I_WIN, I_CONVW, I_CONVB, I_BGATES, I_GMLSTM,
       I_WBA, I_WBB, I_WOUT, I_RW, I_RB, I_WEG, I_WEU, I_WED, I_WSG, I_WSU, I_WSD, N_IN };

constexpr size_t MiB = 1u << 20;
constexpr size_t WS_CTL = 0, CTL_ZERO_BYTES = 1 * MiB;
constexpr size_t WS_MOD = 1 * MiB;
constexpr size_t WS_GATES = 2 * MiB;
constexpr size_t WS_TOPI = 4 * MiB;
constexpr size_t WS_TOPW = 6 * MiB;
constexpr size_t WS_ROWTOK = 8 * MiB;
constexpr size_t WS_ROWW = 12 * MiB;
constexpr size_t WS_UNITEXP = 16 * MiB;
constexpr size_t WS_EXPTILE0 = 16 * MiB + 65536;
constexpr size_t WS_DUMP = 18 * MiB;
constexpr size_t WS_ROPE = 20 * MiB;
constexpr size_t WS_W8T = 24 * MiB;
constexpr size_t WS_WIN_T = 25 * MiB;
constexpr size_t WS_WBA_T = 40 * MiB;
constexpr size_t WS_WBB_T = 41 * MiB;
constexpr size_t WS_WOUT_T = 43 * MiB;
constexpr size_t WS_WR_T = 45 * MiB;
constexpr size_t WS_WSGU_T = 46 * MiB;
constexpr size_t WS_WSD_T = 47 * MiB;
constexpr size_t WS_Q = 64 * MiB, WS_K = 160 * MiB, WS_V = 256 * MiB;
constexpr size_t WS_MQK = 352 * MiB, WS_MV = 480 * MiB, WS_MO = 608 * MiB;
constexpr size_t WS_GAB = 736 * MiB;
constexpr size_t WS_MERGED = 192 * MiB;
constexpr size_t WS_YMIX = 64 * MiB;
constexpr size_t WS_H2 = 192 * MiB;
constexpr size_t WS_LOGITS = 320 * MiB;
constexpr size_t WS_WD = 384 * MiB;
constexpr size_t WS_WGU = 512 * MiB;
constexpr size_t WS_HIDS = 320 * MiB;
constexpr size_t WS_HIDR = 768 * MiB;
constexpr size_t WS_NEED = 1056 * MiB;
constexpr size_t OUT_H = 0;
constexpr size_t OUT_YA = 0;
constexpr size_t OUT_YB = 128 * MiB;

constexpr int CW_BAR = 4096;
constexpr int CW_COUNTS = 16384, CW_CURSOR = 16384 + 256, CW_NT = 16384 + 512;

constexpr int LDS_BYTES = 147456;
constexpr int MISC_OFF = 131072 + 320;

__device__ __forceinline__ float bf2f(bf16 b) { return __uint_as_float(((unsigned)b) << 16); }
__device__ __forceinline__ unsigned f2bf(float f) { unsigned u = __float_as_uint(f); return (u + 0x7fffu + ((u >> 16) & 1u)) >> 16; }
__device__ __forceinline__ unsigned pk2(float lo, float hi) { return f2bf(lo) | (f2bf(hi) << 16); }
__device__ __forceinline__ float wave_sum(float v) {
#pragma unroll
    for (int o = 1; o < 64; o <<= 1) v += __shfl_xor(v, o);
    return v;
}
__device__ __forceinline__ float sigmoidf_(float x) { return 1.0f / (1.0f + expf(-x)); }
__device__ __forceinline__ float logsigmoidf_(float x) { return fminf(x, 0.f) - log1pf(expf(-fabsf(x))); }

#define XB_TMO      128
#define XB_XCNT(j)  (256  + 64 * (j))
#define XB_XSUB(j)  (1280 + 64 * (j))
#define XB_XGEN(j)  (2304 + 64 * (j))
#define XB_TOP      3328
#define XB_TOPGEN   3392
#define XCD_BAR_WORDS 3456
#define XB_SPIN_CAP (1u << 23)

__device__ __forceinline__ unsigned xb_ld(unsigned* p)              { return __hip_atomic_load(p, __ATOMIC_RELAXED, __HIP_MEMORY_SCOPE_AGENT); }
__device__ __forceinline__ unsigned xb_add(unsigned* p, unsigned v) { return __hip_atomic_fetch_add(p, v, __ATOMIC_RELAXED, __HIP_MEMORY_SCOPE_AGENT); }
__device__ __forceinline__ unsigned xb_xcc_id() { return (unsigned)__builtin_amdgcn_s_getreg((3 << 11) | 20) & 0xFu; }
#define XB_SPIN(cond, bar) do { unsigned _sp = 0; while (cond) { __builtin_amdgcn_s_sleep(1); \
    if ((++_sp & 255u) == 0u) { if (xb_ld(&(bar)[XB_TMO])) break; if (_sp > XB_SPIN_CAP) { atomicAdd(&(bar)[XB_TMO], 1u); break; } } } } while (0)

struct XcdBarrier { unsigned* bar; unsigned x; volatile LAS unsigned* st; };

__device__ __forceinline__ XcdBarrier xcd_barrier_post(unsigned* bar, volatile LAS unsigned* st) {
    XcdBarrier b; b.bar = bar; b.x = xb_xcc_id(); b.st = st;
    if (threadIdx.x == 0) (void)xb_add(&bar[XB_XCNT(b.x)], 1u);
    return b;
}
__device__ __forceinline__ void xcd_barrier_complete(unsigned* bar, unsigned x, unsigned& nloc, unsigned& nx) {
    const unsigned G = gridDim.x * gridDim.y * gridDim.z;
    unsigned sum, cnt, mine, sp = 0u;
    for (;;) {
        sum = 0u; cnt = 0u; mine = 0u;
#pragma unroll
        for (unsigned j = 0; j < 16; ++j) { const unsigned c = xb_ld(&bar[XB_XCNT(j)]); sum += c; cnt += (c > 0u) ? 1u : 0u; mine = (j == x) ? c : mine; }
        if (sum == G) break;
        __builtin_amdgcn_s_sleep(1);
        if ((++sp & 255u) == 0u) { if (xb_ld(&bar[XB_TMO])) break; if (sp > XB_SPIN_CAP) { atomicAdd(&bar[XB_TMO], 1u); break; } }
    }
    nloc = mine > 0u ? mine : 1u; nx = cnt > 0u ? cnt : 1u;
}
__device__ __forceinline__ void xcd_barrier(const XcdBarrier& b) {
    asm volatile("s_waitcnt vmcnt(0)" ::: "memory");
    __syncthreads();
    if (threadIdx.x == 0) {
        unsigned* bar = b.bar;
        __builtin_amdgcn_s_waitcnt(0);
        unsigned nloc = b.st[0], nx = b.st[1];
        if (nloc == 0u) { xcd_barrier_complete(bar, b.x, nloc, nx); b.st[0] = nloc; b.st[1] = nx; }
        const unsigned old = xb_add(&bar[XB_XSUB(b.x)], 1u);
        const unsigned gen = old / nloc;
        if (old + 1u == (gen + 1u) * nloc) {
            __builtin_amdgcn_fence(__ATOMIC_RELEASE, "agent");
            asm volatile("s_waitcnt vmcnt(0)" ::: "memory");
            const unsigned og = xb_add(&bar[XB_TOP], 1u);
            const unsigned tg = og / nx;
            if (og + 1u == (tg + 1u) * nx) xb_add(&bar[XB_TOPGEN], 1u);
            else XB_SPIN(xb_ld(&bar[XB_TOPGEN]) == tg, bar);
            __builtin_amdgcn_fence(__ATOMIC_ACQUIRE, "agent");
            xb_add(&bar[XB_XGEN(b.x)], 1u);
            asm volatile("s_waitcnt vmcnt(0)" ::: "memory");
        } else {
            XB_SPIN(xb_ld(&bar[XB_XGEN(b.x)]) == gen, bar);
            __builtin_amdgcn_fence(__ATOMIC_ACQUIRE, "agent");
            asm volatile("s_waitcnt vmcnt(0)" ::: "memory");
        }
    }
    __syncthreads();
}

struct Args { const float* in[N_IN]; float* out; unsigned char* ws; int ph_lo, ph_hi; };

struct Frame {
    LAS unsigned char* lds;
    unsigned* ctl;
    int tid, lane, wave, G;
    const float* in[N_IN];
    const int* pos;
    float* out; unsigned char* outb; unsigned char* ws;
};

struct ARowGlobal {
    const bf16* base; size_t ld; int m0; const int* gather;
    __device__ __forceinline__ void load4(int r, int k, float (&o)[4]) const {
        const size_t row = gather ? (size_t)gather[m0 + r] : (size_t)(m0 + r);
        const u32x2 v = *(const u32x2*)(base + row * ld + k);
        o[0] = __uint_as_float(v.x << 16); o[1] = __uint_as_float(v.x & 0xffff0000u); o[2] = __uint_as_float(v.y << 16); o[3] = __uint_as_float(v.y & 0xffff0000u);
    }
};
struct ARowLds {
    const LAS bf16* base;
    __device__ __forceinline__ void load4(int r, int k, float (&o)[4]) const {
        const u32x2 v = *(const LAS u32x2*)(base + r * 256 + k);
        o[0] = __uint_as_float(v.x << 16); o[1] = __uint_as_float(v.x & 0xffff0000u); o[2] = __uint_as_float(v.y << 16); o[3] = __uint_as_float(v.y & 0xffff0000u);
    }
};
template <class ARow>
__device__ __forceinline__ void ngemm_acc(LAS float* As, LAS float* Bs, const ARow& arow, const float* __restrict__ W, int ldw, int K, int n0, int Nvalid, float (&acc)[8][4]) {
    const int tid = threadIdx.x, ty = tid >> 5, tx = tid & 31;
    const int ar = tid >> 2, ak = (tid & 3) * 4;
    const int bk = tid >> 5, bn = (tid & 31) * 4;
    for (int k0 = 0; k0 < K; k0 += 16) {
        float a4[4]; arow.load4(ar, k0 + ak, a4);
        f32x4 b4 = (f32x4){0.f, 0.f, 0.f, 0.f};
        if (n0 + bn < Nvalid) b4 = *(const f32x4*)(W + (size_t)(k0 + bk) * ldw + n0 + bn);
        __syncthreads();
        As[(ak + 0) * 132 + ar] = a4[0]; As[(ak + 1) * 132 + ar] = a4[1]; As[(ak + 2) * 132 + ar] = a4[2]; As[(ak + 3) * 132 + ar] = a4[3];
        *(LAS f32x4*)(Bs + bk * 132 + bn) = b4;
        __syncthreads();
#pragma unroll 4
        for (int kk = 0; kk < 16; ++kk) {
            const f32x4 a0 = *(const LAS f32x4*)(As + kk * 132 + ty * 8), a1 = *(const LAS f32x4*)(As + kk * 132 + ty * 8 + 4);
            const f32x4 b = *(const LAS f32x4*)(Bs + kk * 132 + tx * 4);
#pragma unroll
            for (int j = 0; j < 4; ++j) {
                acc[0][j] += a0[0] * b[j]; acc[1][j] += a0[1] * b[j]; acc[2][j] += a0[2] * b[j]; acc[3][j] += a0[3] * b[j];
                acc[4][j] += a1[0] * b[j]; acc[5][j] += a1[1] * b[j]; acc[6][j] += a1[2] * b[j]; acc[7][j] += a1[3] * b[j];
            }
        }
    }
    __syncthreads();
}
#define ZERO_ACC(a) do { _Pragma("unroll") for (int _i = 0; _i < 8; ++_i) _Pragma("unroll") for (int _j = 0; _j < 4; ++_j) a[_i][_j] = 0.f; } while (0)


namespace g2 {
typedef short bf16x8 __attribute__((ext_vector_type(8)));
constexpr int BM = 256, BK = 64, HALF = 128, HTB = HALF * BK * 2, STAGE_BYTES = 8 * HTB, NXCD = 8, WGM = 8;
__host__ __device__ __forceinline__ int lds_byte(int r, int c) { const int st = (r >> 4) * 2 + (c >> 5), rr = r & 15, cc = c & 31, ob = rr * 64 + cc * 2; return st * 1024 + (ob ^ (((ob >> 9) & 1) << 5)); }
__host__ __device__ __forceinline__ void stage_rc(int b, int& R, int& C) { const int st = b / 1024, sb = b % 1024, swz = sb ^ (((sb >> 9) & 1) << 5); R = (st >> 1) * 16 + swz / 64; C = (st & 1) * 32 + (swz % 64) / 2; }
__host__ __device__ __forceinline__ int perm32(int rho) { const int n = rho >> 4, i = rho & 15; return 8 * (i >> 2) + 4 * n + (i & 3); }
__device__ __forceinline__ unsigned cvt_pk_bf16(float lo, float hi) { unsigned r; asm volatile("v_cvt_pk_bf16_f32 %0, %1, %2" : "=v"(r) : "v"(lo), "v"(hi)); return r; }

struct UnitMN { int pm, pn; };
struct DenseOrder {
    typedef UnitMN Unit;
    int nM, nN, nwg, G, c, Kk;
    const char* A; const char* Bt;
    __device__ void init(int M, int N, int K, const void* A_, const void* Bt_, int G_, int c_) { nM = M / BM; nN = N / BM; nwg = nM * nN; G = G_; c = c_; Kk = K; A = (const char*)A_; Bt = (const char*)Bt_; }
    __device__ __forceinline__ bool next(int i, Unit& u) const {
        const long L = (long)i * G + c; if (L >= nwg) return false;
        int wgid = (int)L; { const int q = nwg / NXCD, r = nwg % NXCD, xcd = wgid % NXCD, off = wgid / NXCD; wgid = (xcd < r ? xcd * (q + 1) : r * (q + 1) + (xcd - r) * q) + off; }
        const int nig = WGM * nN, gid = wgid / nig, fm = gid * WGM, gsz = (nM - fm) < WGM ? (nM - fm) : WGM;
        u.pm = fm + ((wgid % nig) % gsz); u.pn = (wgid % nig) / gsz; return true;
    }
    __device__ __forceinline__ int K(const Unit&) const { return Kk; }
    __device__ __forceinline__ const char* a_base(const Unit&) const { return A; }
    __device__ __forceinline__ unsigned a_row_off(const Unit& u, int r) const { return (unsigned)(u.pm * BM + r) * (unsigned)(Kk * 2); }
    __device__ __forceinline__ const char* b_base(const Unit& u) const { return Bt + (size_t)u.pn * BM * Kk * 2; }
};

template <class Epi, class Sched>
__device__ __forceinline__ void gemm_phase(LAS unsigned char* lds, const Sched& S, const Epi& E) {
    const int tid = threadIdx.x, wid = __builtin_amdgcn_readfirstlane(tid >> 6), lane = tid & 63, wr = wid >> 2, wc = wid & 3, fr = lane & 15, fq = lane >> 4;
#define G2_RC(i, R, Rb, C2) int R, Rb; unsigned C2; { int _R, _C; stage_rc(tid * 16 + (i) * 8192, _R, _C); R = _R; Rb = Epi::PERM ? ((_R & ~31) + perm32(_R & 31)) : _R; C2 = (unsigned)_C * 2u; }
    const size_t kstep = (size_t)(BK * 2);
    const unsigned ldsw = (unsigned)wid * 1024u;
    const int aoff = lds_byte(wr * 64 + fr, fq * 8), boff = lds_byte(wc * 32 + fr, fq * 8);
#define G2_SA(b, h) (((b) * 2 + (h)) * HTB)
#define G2_SB(b, h) ((4 + (b) * 2 + (h)) * HTB)
#define G2_STAGE(bufoff, gbase, voff) do { _Pragma("unroll") for (int _i = 0; _i < 2; ++_i) \
        __builtin_amdgcn_global_load_lds((const unsigned*)((const char*)(gbase) + (voff)[_i]), (LAS unsigned*)(lds + (bufoff) + ldsw + _i * 8192), 16, 0, 0); } while (0)
#define G2_LDA(dst, b, h) do { _Pragma("unroll") for (int m = 0; m < 4; ++m) _Pragma("unroll") for (int k = 0; k < 2; ++k) dst[m][k] = *(const LAS bf16x8*)(lds + G2_SA(b, h) + aoff + m * 2048 + k * 1024); } while (0)
#define G2_LDB(dst, b, h) do { _Pragma("unroll") for (int n = 0; n < 2; ++n) _Pragma("unroll") for (int k = 0; k < 2; ++k) dst[n][k] = *(const LAS bf16x8*)(lds + G2_SB(b, h) + boff + n * 2048 + k * 1024); } while (0)
#define G2_MMA(ai, bj, At, Bt) do { __builtin_amdgcn_s_setprio(1); _Pragma("unroll") for (int m = 0; m < 4; ++m) _Pragma("unroll") for (int n = 0; n < 2; ++n) _Pragma("unroll") for (int k = 0; k < 2; ++k) \
        acc[ai][bj][m][n] = __builtin_amdgcn_mfma_f32_16x16x32_bf16(Bt[n][k], At[m][k], acc[ai][bj][m][n], 0, 0, 0); __builtin_amdgcn_s_setprio(0); } while (0)
#define G2_WAIT_V(n) asm volatile("s_waitcnt vmcnt(" #n ")" ::: "memory")
#define G2_WAIT_L(n) asm volatile("s_waitcnt lgkmcnt(" #n ")" ::: "memory")
#define G2_BAR __builtin_amdgcn_s_barrier()
#define G2_SCHED __builtin_amdgcn_sched_barrier(0)
    typename Sched::Unit cur, nxt; int ui = 0;
    if (!S.next(0, cur)) return;
    f32x4 acc[2][2][4][2];
#pragma unroll
    for (int a = 0; a < 2; ++a)
#pragma unroll
        for (int b = 0; b < 2; ++b)
#pragma unroll
            for (int m = 0; m < 4; ++m)
#pragma unroll
                for (int n = 0; n < 2; ++n) acc[a][b][m][n] = (f32x4){0.f, 0.f, 0.f, 0.f};
    bf16x8 At[4][2], B0[2][2], B1[2][2];
    unsigned vA0[2], vA1[2], vN0[2], vN1[2], vBc[2], vBN[2];
    int Kc = S.K(cur); asm volatile("" : "+s"(Kc)); int nt = Kc / BK;
    size_t hc = (size_t)HALF * Kc * 2, hN = hc;
#pragma unroll
    for (int i = 0; i < 2; ++i) { G2_RC(i, R, Rb, C2); vA0[i] = S.a_row_off(cur, R) + C2; vA1[i] = S.a_row_off(cur, HALF + R) + C2; vN0[i] = vA0[i]; vN1[i] = vA1[i];
        vBc[i] = (unsigned)(Rb * Kc) * 2u + C2; vBN[i] = vBc[i]; }
    const char* cA = S.a_base(cur);
    const char* cB = S.b_base(cur);
    G2_STAGE(G2_SB(0, 0), cB, vBc); G2_STAGE(G2_SB(0, 1), cB + hc, vBc); G2_STAGE(G2_SA(0, 0), cA, vA0); G2_STAGE(G2_SA(0, 1), cA, vA1);
    if (wr == 1) G2_BAR;
    G2_WAIT_V(2); G2_BAR;
    G2_STAGE(G2_SB(1, 0), cB + kstep, vBc); G2_STAGE(G2_SA(1, 0), cA + kstep, vA0); G2_STAGE(G2_SB(1, 1), cB + hc + kstep, vBc);
    G2_WAIT_V(6); G2_BAR;
    for (;;) {
        const bool has_next = S.next(ui + 1, nxt);
        const char* nA = has_next ? S.a_base(nxt) : cA; const char* nB = has_next ? S.b_base(nxt) : cB;
        int Kn = has_next ? S.K(nxt) : Kc; asm volatile("" : "+s"(Kn));
        for (int t = 0; t < nt; t += 2) {
            const bool last = (t == nt - 2);
            const char* a1 = cA + (size_t)(t + 1) * kstep;
            const char* a2 = last ? nA : cA + (size_t)(t + 2) * kstep; const char* b2 = last ? nB : cB + (size_t)(t + 2) * kstep;
            const char* a3 = a2 + kstep; const char* b3 = b2 + kstep;
            if (last && has_next) { hN = (size_t)HALF * Kn * 2;
#pragma unroll
                for (int i = 0; i < 2; ++i) { G2_RC(i, R, Rb, C2); vN0[i] = S.a_row_off(nxt, R) + C2; vN1[i] = S.a_row_off(nxt, HALF + R) + C2; vBN[i] = (unsigned)(Rb * Kn) * 2u + C2; } }
            G2_LDB(B0, 0, 0); G2_LDB(B1, 0, 1); G2_SCHED; G2_LDA(At, 0, 0); G2_STAGE(G2_SA(1, 1), a1, vA1);
            G2_WAIT_V(8); G2_WAIT_L(0); G2_BAR; G2_MMA(0, 0, At, B0); G2_MMA(0, 1, At, B1); G2_BAR; G2_SCHED;
            G2_LDA(At, 0, 1); G2_STAGE(G2_SB(0, 0), b2, vBN); G2_STAGE(G2_SB(0, 1), b2 + hN, vBN); G2_STAGE(G2_SA(0, 0), a2, vN0);
            G2_WAIT_V(8); G2_WAIT_L(0); G2_BAR; G2_MMA(1, 0, At, B0); G2_MMA(1, 1, At, B1); G2_BAR; G2_SCHED;
            G2_LDB(B0, 1, 0); G2_LDB(B1, 1, 1); G2_SCHED; G2_LDA(At, 1, 0); G2_STAGE(G2_SA(0, 1), a2, vN1);
            G2_WAIT_V(8); G2_WAIT_L(0); G2_BAR; G2_MMA(0, 0, At, B0); G2_MMA(0, 1, At, B1); G2_BAR; G2_SCHED;
            G2_LDA(At, 1, 1); G2_STAGE(G2_SB(1, 0), b3, vBN); G2_STAGE(G2_SB(1, 1), b3 + hN, vBN); G2_STAGE(G2_SA(1, 0), a3, vN0);
            G2_WAIT_V(8); G2_WAIT_L(0); G2_BAR; G2_MMA(1, 0, At, B0); G2_MMA(1, 1, At, B1); G2_BAR; G2_SCHED;
        }
        if (wr == 0) G2_BAR;
        int t2 = threadIdx.x; asm volatile("" : "+v"(t2));
        const bool zero = E(acc, cur, wr, wc, t2 & 15, (t2 & 63) >> 4);
        if (!has_next) break;
        if (zero) {
#pragma unroll
        for (int a = 0; a < 2; ++a)
#pragma unroll
            for (int b = 0; b < 2; ++b)
#pragma unroll
                for (int m = 0; m < 4; ++m)
#pragma unroll
                    for (int n = 0; n < 2; ++n) acc[a][b][m][n] = (f32x4){0.f, 0.f, 0.f, 0.f};
        }
        cur = nxt; cA = nA; cB = nB; Kc = Kn; nt = Kc / BK; hc = hN; ++ui;
#pragma unroll
        for (int i = 0; i < 2; ++i) { vA0[i] = vN0[i]; vA1[i] = vN1[i]; vBc[i] = vBN[i]; }
        if (wr == 1) G2_BAR;
    }
    G2_WAIT_V(0);
    G2_BAR;
#undef G2_RC
#undef G2_SA
#undef G2_SB
#undef G2_STAGE
#undef G2_LDA
#undef G2_LDB
#undef G2_MMA
#undef G2_WAIT_V
#undef G2_WAIT_L
#undef G2_BAR
#undef G2_SCHED
}
}

__device__ __forceinline__ void tr_item(const float* __restrict__ W, int ldw, int k0, int n0src, bf16* WT, int Kd, int drow0, LAS float* scr, int lane) {
#pragma unroll 8
    for (int i = 0; i < 32; ++i) { const int kk = 2 * i + (lane >> 5); scr[kk * 33 + (lane & 31)] = W[(size_t)(k0 + kk) * ldw + n0src + (lane & 31)]; }
    asm volatile("s_waitcnt lgkmcnt(0)" ::: "memory");
    const int c = lane & 7;
#pragma unroll
    for (int j = 0; j < 4; ++j) { const int n = (lane >> 3) + 8 * j; const LAS float* sp = scr + (8 * c) * 33 + n;
        u32x4 o; o.x = pk2(sp[0 * 33], sp[1 * 33]); o.y = pk2(sp[2 * 33], sp[3 * 33]); o.z = pk2(sp[4 * 33], sp[5 * 33]); o.w = pk2(sp[6 * 33], sp[7 * 33]);
        *(u32x4*)(WT + (size_t)(drow0 + n) * Kd + k0 + 8 * c) = o; }
    asm volatile("s_waitcnt lgkmcnt(0)" ::: "memory");
}

__device__ __forceinline__ void ph_cvt_small(Frame& F) {
    LAS float* scr = (LAS float*)(F.lds) + F.wave * (64 * 33);
    const int gw = blockIdx.x * NWAVES + F.wave, NGW = F.G * NWAVES;
    constexpr int I_IN = 16 * 232, I_BA = 4 * 32, I_BB = 16 * 32, I_OUT = 16 * 32, I_R = 16 * 8, I_SGU = 16 * 16, I_SD = 4 * 32;
    constexpr int NIT = I_IN + I_BA + I_BB + I_OUT + I_R + I_SGU + I_SD;
    for (int it = gw; it < NIT + 1; it += NGW) {
        int r = it;
        if (r < I_IN) { const int kb = r / 232, nb = r % 232, d0 = nb * 32; tr_item(F.in[I_WIN], INW, kb * 64, d0 < 5376 ? d0 : d0 + 8, (bf16*)(F.ws + WS_WIN_T), 1024, d0, scr, F.lane); continue; } r -= I_IN;
        if (r < I_BA) { const int kb = r / 32, nb = r % 32; tr_item(F.in[I_WBA], 1024, kb * 64, nb * 32, (bf16*)(F.ws + WS_WBA_T), 256, nb * 32, scr, F.lane); continue; } r -= I_BA;
        if (r < I_BB) { const int kb = r / 32, nb = r % 32; tr_item(F.in[I_WBB], 1024, kb * 64, nb * 32, (bf16*)(F.ws + WS_WBB_T), 1024, nb * 32, scr, F.lane); continue; } r -= I_BB;
        if (r < I_OUT) { const int kb = r / 32, nb = r % 32; tr_item(F.in[I_WOUT], 1024, kb * 64, nb * 32, (bf16*)(F.ws + WS_WOUT_T), 1024, nb * 32, scr, F.lane); continue; } r -= I_OUT;
        if (r < I_R) { const int kb = r / 8, nb = r % 8; tr_item(F.in[I_RW], 256, kb * 64, nb * 32, (bf16*)(F.ws + WS_WR_T), 1024, nb * 32, scr, F.lane); continue; } r -= I_R;
        if (r < I_SGU) { const int kb = r / 16, nb = r % 16, d0 = nb * 32, pn = d0 >> 8, q = d0 & 255; const bool up = q >= 128; const int src = pn * 128 + (q & 127);
            tr_item(up ? F.in[I_WSU] : F.in[I_WSG], 256, kb * 64, src, (bf16*)(F.ws + WS_WSGU_T), 1024, d0, scr, F.lane); continue; } r -= I_SGU;
        if (r < I_SD) { const int kb = r / 32, nb = r % 32; tr_item(F.in[I_WSD], 1024, kb * 64, nb * 32, (bf16*)(F.ws + WS_WSD_T), 256, nb * 32, scr, F.lane); continue; } r -= I_SD;
        { float* W8T = (float*)(F.ws + WS_W8T); const float* W = F.in[I_WIN];
          for (int i = F.lane; i < 8 * 1024; i += 64) { const int g = i >> 10, k = i & 1023; W8T[i] = W[(size_t)k * INW + 5376 + g]; } }
    }
}

__device__ __forceinline__ void ph_mod(Frame& F) {
    LAS float* sc = (LAS float*)F.lds;
    const float* c = F.in[I_C]; const float* W = F.in[I_WADA]; const float* bias = F.in[I_BADA];
    float* mod = (float*)(F.ws + WS_MOD);
    for (int vb = blockIdx.x; vb < 12; vb += F.G) {
        __syncthreads();
        for (int i = F.tid; i < 32 * 1024; i += NTHR) { const int b = i >> 10, k = i & 1023; const float v = c[i]; sc[k * 32 + b] = v / (1.0f + expf(-v)); }
        __syncthreads();
        const int n = vb * 512 + F.tid;
        float acc[32];
#pragma unroll
        for (int b = 0; b < 32; ++b) acc[b] = 0.f;
        for (int k = 0; k < 1024; ++k) {
            const float w = W[(size_t)k * 6144 + n];
#pragma unroll
            for (int b4 = 0; b4 < 8; ++b4) { const f32x4 s = *(const LAS f32x4*)(sc + k * 32 + b4 * 4);
                acc[b4 * 4 + 0] += s[0] * w; acc[b4 * 4 + 1] += s[1] * w; acc[b4 * 4 + 2] += s[2] * w; acc[b4 * 4 + 3] += s[3] * w; }
        }
        const float bb = bias[n];
#pragma unroll
        for (int b = 0; b < 32; ++b) mod[b * 6144 + n] = acc[b] + bb;
    }
}

__device__ __forceinline__ void ph_norm1(Frame& F) {
    const float* x = F.in[I_X]; const float* g = F.in[I_GPREMIX]; const float* mod = (const float*)(F.ws + WS_MOD);
    bf16* H = (bf16*)(F.outb + OUT_H);
    const float* W8T = (const float*)(F.ws + WS_W8T); float* GATES = (float*)(F.ws + WS_GATES); float* ROPE = (float*)(F.ws + WS_ROPE); const float* bg = F.in[I_BGATES];
    for (int t = blockIdx.x * NWAVES + F.wave; t < T; t += F.G * NWAVES) {
        const int b = t / SEQ; const float* xr = x + (size_t)t * D; const float* sh = mod + b * 6144, *scl = sh + 1024;
        f32x4 v[4]; float ss = 0.f;
#if FAST_INPROJ
        float gacc[8];
#pragma unroll
        for (int gi = 0; gi < 8; ++gi) gacc[gi] = 0.f;
#endif
#pragma unroll
        for (int j = 0; j < 4; ++j) { v[j] = *(const f32x4*)(xr + F.lane * 4 + 256 * j); ss += v[j][0] * v[j][0] + v[j][1] * v[j][1] + v[j][2] * v[j][2] + v[j][3] * v[j][3]; }
        const float rstd = rsqrtf(wave_sum(ss) * (1.0f / D) + EPS);
#pragma unroll
        for (int j = 0; j < 4; ++j) { const int c = F.lane * 4 + 256 * j; const f32x4 gg = *(const f32x4*)(g + c), s1 = *(const f32x4*)(scl + c), h1 = *(const f32x4*)(sh + c);
            float o[4];
#pragma unroll
            for (int e = 0; e < 4; ++e) o[e] = v[j][e] * rstd * gg[e] * (1.0f + s1[e]) + h1[e];
            u32x2 w; w.x = pk2(o[0], o[1]); w.y = pk2(o[2], o[3]); *(u32x2*)(H + (size_t)t * D + c) = w;
#if FAST_INPROJ
#pragma unroll
            for (int gi = 0; gi < 8; ++gi) { const f32x4 wv = *(const f32x4*)(W8T + gi * 1024 + c); gacc[gi] += o[0] * wv[0] + o[1] * wv[1] + o[2] * wv[2] + o[3] * wv[3]; }
#endif
        }
#if FAST_INPROJ
#pragma unroll
        for (int gi = 0; gi < 8; ++gi) gacc[gi] = wave_sum(gacc[gi]);
        float gmine = 0.f;
#pragma unroll
        for (int gi = 0; gi < 8; ++gi) gmine = (F.lane == gi) ? gacc[gi] : gmine;
        if (F.lane < 8) { GATES[(size_t)t * 8 + F.lane] = gmine + bg[F.lane];
            const float inv = powf(500000.0f, -(float)F.lane / 8.0f); const float ang = (float)F.pos[t] * inv;
            ROPE[(size_t)t * 16 + F.lane] = cosf(ang); ROPE[(size_t)t * 16 + 8 + F.lane] = sinf(ang); }
#endif
    }
}

__device__ __forceinline__ void ph_inproj_naive(Frame& F) {
    LAS float* As = (LAS float*)F.lds; LAS float* Bs = As + 16 * 132;
    const bf16* H = (const bf16*)(F.outb + OUT_H); const float* W = F.in[I_WIN]; const float* bg = F.in[I_BGATES];
    bf16* Q = (bf16*)(F.ws + WS_Q); bf16* Kt = (bf16*)(F.ws + WS_K); bf16* V = (bf16*)(F.ws + WS_V); bf16* MQK = (bf16*)(F.ws + WS_MQK); bf16* MV = (bf16*)(F.ws + WS_MV);
    bf16* MO = (bf16*)(F.ws + WS_MO); bf16* GAB = (bf16*)(F.ws + WS_GAB); float* GATES = (float*)(F.ws + WS_GATES);
    constexpr int NTN = (INW + 127) / 128;
    const int ty = F.tid >> 5, tx = F.tid & 31;
    for (int vb = blockIdx.x; vb < (T / 128) * NTN; vb += F.G) {
        const int tm = vb / NTN, tn = vb % NTN, m0 = tm * 128, n0 = tn * 128;
        float acc[8][4]; ZERO_ACC(acc);
        ARowGlobal ar{H, (size_t)D, m0, nullptr};
        ngemm_acc(As, Bs, ar, W, INW, D, n0, INW, acc);
#pragma unroll
        for (int i = 0; i < 8; ++i)
#pragma unroll
            for (int j = 0; j < 4; ++j) {
                const size_t row = (size_t)(m0 + ty * 8 + i); const int col = n0 + tx * 4 + j; const float v = acc[i][j];
                if (col < 768) Q[row * 768 + col] = (bf16)f2bf(v);
                else if (col < 1536) Kt[row * 768 + col - 768] = (bf16)f2bf(v);
                else if (col < 2304) V[row * 768 + col - 1536] = (bf16)f2bf(v);
                else if (col < 3328) MQK[row * 1024 + col - 2304] = (bf16)f2bf(v);
                else if (col < 4352) MV[row * 1024 + col - 3328] = (bf16)f2bf(v);
                else if (col < 5376) MO[row * 1024 + col - 4352] = (bf16)f2bf(v);
                else if (col < 5384) GATES[row * 8 + col - 5376] = v + bg[col - 5376];
                else if (col < INW) GAB[row * 2048 + col - 5384] = (bf16)f2bf(v);
            }
    }
}


struct EpiInproj {
    static constexpr bool PERM = true;
    unsigned char* ws; const float* rope;
    __device__ __forceinline__ bool operator()(const f32x4 (&acc)[2][2][4][2], const g2::UnitMN& u, int wr, int wc, int fr, int fq) const {
        const int pn = u.pn; size_t boff; int ld, colt;
        if (pn < 9) { boff = pn < 3 ? WS_Q : (pn < 6 ? WS_K : WS_V); ld = 768; colt = (pn % 3) * 256; }
        else if (pn < 13) { boff = WS_MQK; ld = 1024; colt = (pn - 9) * 256; }
        else if (pn < 17) { boff = WS_MV; ld = 1024; colt = (pn - 13) * 256; }
        else if (pn < 21) { boff = WS_MO; ld = 1024; colt = (pn - 17) * 256; }
        else { boff = WS_GAB; ld = 2048; colt = (pn - 21) * 256; }
        bf16* base = (bf16*)(ws + boff);
        const bool do_rope = (pn < 6) && ((wc & 1) == 0);
        const int row0 = u.pm * 256 + wr * 64 + fr, col0 = colt + wc * 32 + 8 * fq;
#pragma unroll
        for (int ai = 0; ai < 2; ++ai)
#pragma unroll
            for (int m = 0; m < 4; ++m) {
                const size_t row = (size_t)(row0 + ai * 128 + m * 16);
                f32x4 c0 = (f32x4){1.f, 1.f, 1.f, 1.f}, c1 = c0, s0 = (f32x4){0.f, 0.f, 0.f, 0.f}, s1 = s0;
                if (do_rope) { const f32x4* rp = (const f32x4*)(rope + row * 16); c0 = rp[0]; c1 = rp[1]; s0 = rp[2]; s1 = rp[3]; }
#pragma unroll
                for (int bj = 0; bj < 2; ++bj) {
                    f32x4 v0 = acc[ai][bj][m][0], v1 = acc[ai][bj][m][1];
                    if (do_rope) {
                        f32x4 p0, p1;
#pragma unroll
                        for (int e = 0; e < 4; ++e) { p0[e] = __shfl_xor(v0[e], 16); p1[e] = __shfl_xor(v1[e], 16); }
                        if (fq == 0) { v0 = v0 * c0 - p0 * s0; v1 = v1 * c1 - p1 * s1; }
                        else if (fq == 1) { v0 = v0 * c0 + p0 * s0; v1 = v1 * c1 + p1 * s1; }
                    }
                    u32x4 w; w.x = g2::cvt_pk_bf16(v0[0], v0[1]); w.y = g2::cvt_pk_bf16(v0[2], v0[3]); w.z = g2::cvt_pk_bf16(v1[0], v1[1]); w.w = g2::cvt_pk_bf16(v1[2], v1[3]);
                    *(u32x4*)(base + row * ld + col0 + bj * 128) = w;
                }
            }
        return true;
    }
};
__device__ __forceinline__ void ph_inproj_fast(Frame& F) {
    g2::DenseOrder S; S.init(T, 7424, D, F.outb + OUT_H, F.ws + WS_WIN_T, F.G, (int)blockIdx.x);
    EpiInproj E{F.ws, (const float*)(F.ws + WS_ROPE)};
    g2::gemm_phase<EpiInproj, g2::DenseOrder>(F.lds, S, E);
}


__device__ __forceinline__ float fsig(float x) { return __builtin_amdgcn_rcpf(1.0f + __builtin_amdgcn_exp2f(-1.4426950408889634f * x)); }
__device__ __forceinline__ void unpack8(const u32x4 w, float (&o)[8]) {
#pragma unroll
    for (int e = 0; e < 4; ++e) { o[2 * e] = __uint_as_float(w[e] << 16); o[2 * e + 1] = __uint_as_float(w[e] & 0xffff0000u); }
}
struct UnitBr { int pm, pn, sub; };
struct BranchOrder {
    typedef UnitBr Unit;
    g2::DenseOrder d; const char *YA, *YB, *WA, *WB;
    __device__ __forceinline__ bool next(int i, Unit& u) const { g2::UnitMN t; if (!d.next(i >> 1, t)) return false; u.pm = t.pm; u.pn = t.pn; u.sub = i & 1; return true; }
    __device__ __forceinline__ int K(const Unit& u) const { return u.sub ? 1024 : 256; }
    __device__ __forceinline__ const char* a_base(const Unit& u) const { return u.sub ? YB : YA; }
    __device__ __forceinline__ unsigned a_row_off(const Unit& u, int r) const { return (unsigned)(u.pm * 256 + r) * (u.sub ? 2048u : 512u); }
    __device__ __forceinline__ const char* b_base(const Unit& u) const { return u.sub ? WB + (size_t)u.pn * 256 * 2048 : WA + (size_t)u.pn * 256 * 512; }
};
struct EpiBranch {
    static constexpr bool PERM = true;
    const bf16* GAB; bf16* MG;
    __device__ __forceinline__ bool operator()(f32x4 (&acc)[2][2][4][2], const UnitBr& u, int wr, int wc, int fr, int fq) const {
        const int row0 = u.pm * 256 + wr * 64 + fr, col0 = u.pn * 256 + wc * 32 + 8 * fq;
#pragma unroll
        for (int ai = 0; ai < 2; ++ai)
#pragma unroll
            for (int m = 0; m < 4; ++m) { const size_t row = (size_t)(row0 + ai * 128 + m * 16);
#pragma unroll
                for (int bj = 0; bj < 2; ++bj) { const int col = col0 + bj * 128;
                    float gb[8]; unpack8(*(const u32x4*)(GAB + row * 2048 + 1024 + col), gb);
                    if (u.sub == 0) { float ga[8]; unpack8(*(const u32x4*)(GAB + row * 2048 + col), ga);
#pragma unroll
                        for (int e = 0; e < 4; ++e) { acc[ai][bj][m][0][e] *= fsig(ga[e]) * (1.0f + __builtin_amdgcn_exp2f(-1.4426950408889634f * gb[e]));
                                                      acc[ai][bj][m][1][e] *= fsig(ga[4 + e]) * (1.0f + __builtin_amdgcn_exp2f(-1.4426950408889634f * gb[4 + e])); } }
                    else { f32x4 v0, v1;
#pragma unroll
                        for (int e = 0; e < 4; ++e) { v0[e] = acc[ai][bj][m][0][e] * fsig(gb[e]); v1[e] = acc[ai][bj][m][1][e] * fsig(gb[4 + e]); }
                        u32x4 w; w.x = g2::cvt_pk_bf16(v0[0], v0[1]); w.y = g2::cvt_pk_bf16(v0[2], v0[3]); w.z = g2::cvt_pk_bf16(v1[0], v1[1]); w.w = g2::cvt_pk_bf16(v1[2], v1[3]);
                        *(u32x4*)(MG + row * 1024 + col) = w; } } }
        return u.sub != 0;
    }
};
__device__ __forceinline__ void ph_branch_fast(Frame& F) {
    BranchOrder S; S.d.init(T, 1024, 1024, nullptr, nullptr, F.G, (int)blockIdx.x);
    S.YA = (const char*)(F.outb + OUT_YA); S.YB = (const char*)(F.outb + OUT_YB); S.WA = (const char*)(F.ws + WS_WBA_T); S.WB = (const char*)(F.ws + WS_WBB_T);
    EpiBranch E{(const bf16*)(F.ws + WS_GAB), (bf16*)(F.ws + WS_MERGED)};
    g2::gemm_phase<EpiBranch, BranchOrder>(F.lds, S, E);
}
struct EpiBf16Plain {
    static constexpr bool PERM = true;
    bf16* O; int ld;
    __device__ __forceinline__ bool operator()(const f32x4 (&acc)[2][2][4][2], const g2::UnitMN& u, int wr, int wc, int fr, int fq) const {
        const int row0 = u.pm * 256 + wr * 64 + fr, col0 = u.pn * 256 + wc * 32 + 8 * fq;
#pragma unroll
        for (int ai = 0; ai < 2; ++ai)
#pragma unroll
            for (int m = 0; m < 4; ++m) { bf16* rp = O + (size_t)(row0 + ai * 128 + m * 16) * ld + col0;
#pragma unroll
                for (int bj = 0; bj < 2; ++bj) { const f32x4 v0 = acc[ai][bj][m][0], v1 = acc[ai][bj][m][1];
                    u32x4 w; w.x = g2::cvt_pk_bf16(v0[0], v0[1]); w.y = g2::cvt_pk_bf16(v0[2], v0[3]); w.z = g2::cvt_pk_bf16(v1[0], v1[1]); w.w = g2::cvt_pk_bf16(v1[2], v1[3]);
                    *(u32x4*)(rp + bj * 128) = w; } }
        return true;
    }
};
struct EpiF32Plain {
    static constexpr bool PERM = false;
    float* O; int ld;
    __device__ __forceinline__ bool operator()(const f32x4 (&acc)[2][2][4][2], const g2::UnitMN& u, int wr, int wc, int fr, int fq) const {
        const int row0 = u.pm * 256 + wr * 64 + fr, col0 = u.pn * 256 + wc * 32 + 4 * fq;
#pragma unroll
        for (int ai = 0; ai < 2; ++ai)
#pragma unroll
            for (int m = 0; m < 4; ++m) { float* rp = O + (size_t)(row0 + ai * 128 + m * 16) * ld + col0;
#pragma unroll
                for (int bj = 0; bj < 2; ++bj)
#pragma unroll
                    for (int n = 0; n < 2; ++n) *(f32x4*)(rp + bj * 128 + n * 16) = acc[ai][bj][m][n]; }
        return true;
    }
};
__device__ __forceinline__ void ph_outproj_fast(Frame& F) {
    g2::DenseOrder S; S.init(T, 1024, 1024, F.ws + WS_MERGED, F.ws + WS_WOUT_T, F.G, (int)blockIdx.x);
    EpiBf16Plain E{(bf16*)(F.ws + WS_YMIX), 1024};
    g2::gemm_phase<EpiBf16Plain, g2::DenseOrder>(F.lds, S, E);
}
__device__ __forceinline__ void ph_router_fast(Frame& F) {
    g2::DenseOrder S; S.init(T, 256, 1024, F.ws + WS_H2, F.ws + WS_WR_T, F.G, (int)blockIdx.x);
    EpiF32Plain E{(float*)(F.ws + WS_LOGITS), 256};
    g2::gemm_phase<EpiF32Plain, g2::DenseOrder>(F.lds, S, E);
}
__device__ __forceinline__ void ph_cvt_experts(Frame& F) {
    LAS float* scr = (LAS float*)(F.lds) + F.wave * (64 * 33);
    const int gw = blockIdx.x * NWAVES + F.wave, NGW = F.G * NWAVES;
    for (int it = gw; it < NE * 384; it += NGW) {
        const int e = it / 384, r = it % 384;
        if (r < 256) { const int kb = r >> 4, nb = r & 15, d0 = nb * 32, pn = d0 >> 8, q = d0 & 255; const bool up = q >= 128; const int src = pn * 128 + (q & 127);
            tr_item((up ? F.in[I_WEU] : F.in[I_WEG]) + (size_t)e * 1024 * 256, 256, kb * 64, src, (bf16*)(F.ws + WS_WGU) + (size_t)e * 512 * 1024, 1024, d0, scr, F.lane); }
        else { const int q = r - 256, kb = q >> 5, nb = q & 31;
            tr_item(F.in[I_WED] + (size_t)e * 256 * 1024, 1024, kb * 64, nb * 32, (bf16*)(F.ws + WS_WD) + (size_t)e * 1024 * 256, 256, nb * 32, scr, F.lane); }
    }
}
struct UnitEx { int u, sub, e; };
struct GuOrder {
    typedef UnitEx Unit;
    int NT, nun, G, vcu; const int* UNITEXP; const int* ROWTOK; const char *H2, *WGU, *WSGU;
    __device__ __forceinline__ bool next(int i, Unit& x) const { const int L = i * G + vcu; if (L >= nun) return false; x.u = L >> 1; x.sub = L & 1; x.e = x.u < NT ? UNITEXP[x.u] : -1; return true; }
    __device__ __forceinline__ int K(const Unit&) const { return 1024; }
    __device__ __forceinline__ const char* a_base(const Unit&) const { return H2; }
    __device__ __forceinline__ unsigned a_row_off(const Unit& x, int r) const { return (unsigned)ROWTOK[(unsigned)(x.u * 256 + r)] * 2048u; }
    __device__ __forceinline__ const char* b_base(const Unit& x) const { return (x.e >= 0 ? WGU + (size_t)x.e * (512 * 1024 * 2) : WSGU) + (size_t)x.sub * (256 * 1024 * 2); }
};
struct EpiGu {
    static constexpr bool PERM = true;
    int NT; bf16 *HIDR, *HIDS;
    __device__ __forceinline__ bool operator()(const f32x4 (&acc)[2][2][4][2], const UnitEx& x, int wr, int wc, int fr, int fq) const {
        bf16* base = x.e >= 0 ? HIDR + (size_t)x.u * 256 * 256 : HIDS + (size_t)(x.u - NT) * 256 * 256;
        const int row0 = wr * 64 + fr, col0 = x.sub * 128 + wc * 32 + 8 * fq;
#pragma unroll
        for (int ai = 0; ai < 2; ++ai)
#pragma unroll
            for (int m = 0; m < 4; ++m) { const f32x4 g0 = acc[ai][0][m][0], g1 = acc[ai][0][m][1], u0 = acc[ai][1][m][0], u1 = acc[ai][1][m][1]; f32x4 h0, h1;
#pragma unroll
                for (int e = 0; e < 4; ++e) { h0[e] = g0[e] * fsig(g0[e]) * u0[e]; h1[e] = g1[e] * fsig(g1[e]) * u1[e]; }
                u32x4 w; w.x = g2::cvt_pk_bf16(h0[0], h0[1]); w.y = g2::cvt_pk_bf16(h0[2], h0[3]); w.z = g2::cvt_pk_bf16(h1[0], h1[1]); w.w = g2::cvt_pk_bf16(h1[2], h1[3]);
                *(u32x4*)(base + (size_t)(row0 + ai * 128 + m * 16) * 256 + col0) = w; asm volatile("" ::: "memory"); }
        return true;
    }
};
struct DownOrder {
    typedef UnitEx Unit;
    int NT, nun, G, vcu; const int* UNITEXP; const char *HIDR, *HIDS, *WD, *WSD;
    __device__ __forceinline__ bool next(int i, Unit& x) const { const int L = i * G + vcu; if (L >= nun) return false; x.u = L >> 2; x.sub = L & 3; x.e = x.u < NT ? UNITEXP[x.u] : -1; return true; }
    __device__ __forceinline__ int K(const Unit&) const { return 256; }
    __device__ __forceinline__ const char* a_base(const Unit& x) const { return x.e >= 0 ? HIDR : HIDS; }
    __device__ __forceinline__ unsigned a_row_off(const Unit& x, int r) const { return (unsigned)((x.e >= 0 ? x.u : x.u - NT) * 256 + r) * 512u; }
    __device__ __forceinline__ const char* b_base(const Unit& x) const { return (x.e >= 0 ? WD + (size_t)x.e * (1024 * 256 * 2) : WSD) + (size_t)x.sub * (256 * 256 * 2); }
};
struct EpiDown {
    static constexpr bool PERM = false;
    const int* ROWTOK; const float* ROWW; float* out;
    __device__ __forceinline__ bool operator()(const f32x4 (&acc)[2][2][4][2], const UnitEx& x, int wr, int wc, int fr, int fq) const {
        const int row0 = x.u * 256 + wr * 64 + fr; const unsigned col0 = (unsigned)(x.sub * 256 + wc * 32 + 4 * fq);
#pragma unroll
        for (int ai = 0; ai < 2; ++ai)
#pragma unroll
            for (int m = 0; m < 4; ++m) { const int r = row0 + ai * 128 + m * 16; const unsigned tok = (unsigned)ROWTOK[r]; const float w = ROWW[r];
                const unsigned off = tok * 1024u + col0;
#pragma unroll
                for (int bj = 0; bj < 2; ++bj)
#pragma unroll
                    for (int n = 0; n < 2; ++n)
#pragma unroll
                        for (int e = 0; e < 4; ++e) unsafeAtomicAdd(out + (off + (unsigned)(bj * 128 + n * 16 + e)), acc[ai][bj][m][n][e] * w);
                asm volatile("" ::: "memory"); }
        return true;
    }
};
__device__ __forceinline__ void ph_gu_fast(Frame& F) {
    const int NT = (int)__hip_atomic_load(F.ctl + CW_NT, __ATOMIC_RELAXED, __HIP_MEMORY_SCOPE_AGENT);
    const int bx = blockIdx.x; const int vcu = (F.G % 8 == 0) ? (bx % 8) * (F.G / 8) + bx / 8 : bx;
    GuOrder S{NT, 2 * (NT + T / 256), F.G, vcu, (const int*)(F.ws + WS_UNITEXP), (const int*)(F.ws + WS_ROWTOK), (const char*)(F.ws + WS_H2), (const char*)(F.ws + WS_WGU), (const char*)(F.ws + WS_WSGU_T)};
    EpiGu E{NT, (bf16*)(F.ws + WS_HIDR), (bf16*)(F.ws + WS_HIDS)};
    g2::gemm_phase<EpiGu, GuOrder>(F.lds, S, E);
}
__device__ __forceinline__ void ph_down_fast(Frame& F) {
    const int NT = (int)__hip_atomic_load(F.ctl + CW_NT, __ATOMIC_RELAXED, __HIP_MEMORY_SCOPE_AGENT);
    const int bx = blockIdx.x; const int vcu = (F.G % 8 == 0) ? (bx % 8) * (F.G / 8) + bx / 8 : bx;
    DownOrder S{NT, 4 * (NT + T / 256), F.G, vcu, (const int*)(F.ws + WS_UNITEXP), (const char*)(F.ws + WS_HIDR), (const char*)(F.ws + WS_HIDS), (const char*)(F.ws + WS_WD), (const char*)(F.ws + WS_WSD_T)};
    EpiDown E{(const int*)(F.ws + WS_ROWTOK), (const float*)(F.ws + WS_ROWW), F.out};
    g2::gemm_phase<EpiDown, DownOrder>(F.lds, S, E);
}

__device__ __forceinline__ void ph_rope_naive(Frame& F) {
    bf16* Q = (bf16*)(F.ws + WS_Q); bf16* Kt = (bf16*)(F.ws + WS_K);
    for (int t = blockIdx.x * NWAVES + F.wave; t < T; t += F.G * NWAVES) {
        const float p = (float)F.pos[t];
#pragma unroll
        for (int r = 0; r < 3; ++r) {
            const int it = r * 64 + F.lane;
            const int i = it & 7, head = (it >> 3) % 12, qk = it / 96;
            const float inv = powf(500000.0f, -(float)i / 8.0f);
            const float ang = p * inv; const float cs = cosf(ang), sn = sinf(ang);
            bf16* base = (qk ? Kt : Q) + (size_t)t * 768 + head * 64;
            const float x1 = bf2f(base[i]), x2 = bf2f(base[i + 8]);
            base[i] = (bf16)f2bf(x1 * cs - x2 * sn); base[i + 8] = (bf16)f2bf(x2 * cs + x1 * sn);
        }
    }
}

__device__ __forceinline__ void ph_attn_naive_block(Frame& F, int vb) {
    const bf16* Q = (const bf16*)(F.ws + WS_Q); const bf16* Kt = (const bf16*)(F.ws + WS_K); const bf16* V = (const bf16*)(F.ws + WS_V);
    bf16* YA = (bf16*)(F.outb + OUT_YA);
    const int item = vb * NTHR + F.tid; const int t = item >> 2, j = item & 3; const int b = t / SEQ, s = t % SEQ;
    float acc[64];
#pragma unroll
    for (int d = 0; d < 64; ++d) acc[d] = 0.f;
    float m = -INFINITY, l = 0.f;
    for (int g = 0; g < 3; ++g) {
        const int dil = (g == 0) ? 1 : (g == 1) ? 4 : 16; const int head = g * 4 + j;
        float q[64];
        { const u32x4* qp = (const u32x4*)(Q + (size_t)t * 768 + head * 64);
#pragma unroll
          for (int c = 0; c < 8; ++c) { const u32x4 w = qp[c];
#pragma unroll
              for (int e = 0; e < 4; ++e) { q[c * 8 + 2 * e] = __uint_as_float(w[e] << 16) * 0.125f; q[c * 8 + 2 * e + 1] = __uint_as_float(w[e] & 0xffff0000u) * 0.125f; } } }
        const int lq = s / dil; const int nk = (lq < 128 ? lq : 128) + 1;
        for (int jj = 0; jj < nk; ++jj) {
            const size_t tk = (size_t)b * SEQ + (s - jj * dil);
            const u32x4* kp = (const u32x4*)(Kt + tk * 768 + head * 64);
            float dot = 0.f;
#pragma unroll
            for (int c = 0; c < 8; ++c) { const u32x4 w = kp[c];
#pragma unroll
                for (int e = 0; e < 4; ++e) { dot += q[c * 8 + 2 * e] * __uint_as_float(w[e] << 16); dot += q[c * 8 + 2 * e + 1] * __uint_as_float(w[e] & 0xffff0000u); } }
            const float mn = fmaxf(m, dot); const float corr = expf(m - mn), p = expf(dot - mn);
            l = l * corr + p; m = mn;
            const u32x4* vp = (const u32x4*)(V + tk * 768 + head * 64);
#pragma unroll
            for (int c = 0; c < 8; ++c) { const u32x4 w = vp[c];
#pragma unroll
                for (int e = 0; e < 4; ++e) { acc[c * 8 + 2 * e] = acc[c * 8 + 2 * e] * corr + p * __uint_as_float(w[e] << 16); acc[c * 8 + 2 * e + 1] = acc[c * 8 + 2 * e + 1] * corr + p * __uint_as_float(w[e] & 0xffff0000u); } }
        }
    }
    const float rl = 1.0f / l;
    u32x4* op = (u32x4*)(YA + (size_t)t * 256 + j * 64);
#pragma unroll
    for (int c = 0; c < 8; ++c) { u32x4 w;
#pragma unroll
        for (int e = 0; e < 4; ++e) w[e] = pk2(acc[c * 8 + 2 * e] * rl, acc[c * 8 + 2 * e + 1] * rl);
        op[c] = w; }
}

__device__ __forceinline__ void ph_mlstm_naive_unit(Frame& F, int bh) {
    const int b = bh >> 2, h = bh & 3, tid = F.tid, v = tid & 255, dh = tid >> 8;
    LAS float* qs = (LAS float*)F.lds; LAS float* ks = qs + 128; LAS float* red = ks + 128; LAS float* sc = red + 512;
    const bf16* MQK = (const bf16*)(F.ws + WS_MQK); const bf16* MV = (const bf16*)(F.ws + WS_MV); const bf16* MO = (const bf16*)(F.ws + WS_MO);
    const float* GATES = (const float*)(F.ws + WS_GATES); bf16* YB = (bf16*)(F.outb + OUT_YB);
    const float* cw = F.in[I_CONVW]; const float* cbv = F.in[I_CONVB];
    float C[64];
#pragma unroll
    for (int d = 0; d < 64; ++d) C[d] = 0.f;
    float nst = 0.f, m = 0.f;
    const int ch = (tid < 128) ? (h * 128 + tid) : (512 + h * 128 + ((tid - 128) & 127));
    const float w0 = cw[ch], w1 = cw[1024 + ch], w2 = cw[2048 + ch], w3 = cw[3072 + ch], cb = cbv[ch];
    float xh0 = 0.f, xh1 = 0.f, xh2 = 0.f;
    const float gm = F.in[I_GMLSTM][h * 256 + v];
    __syncthreads();
    for (int s = 0; s < SEQ; ++s) {
        const size_t t = (size_t)b * SEQ + s;
        if (tid < 256) {
            const float xc = bf2f(MQK[t * 1024 + ch]);
            float y = cb + w0 * xh0 + w1 * xh1 + w2 * xh2 + w3 * xc; xh0 = xh1; xh1 = xh2; xh2 = xc;
            y = y / (1.0f + expf(-y));
            if (tid < 128) qs[tid] = y; else ks[tid - 128] = y * 0.08838834764831845f;
        }
        const float ig = GATES[t * 8 + h], fg = GATES[t * 8 + 4 + h];
        const float lf = logsigmoidf_(fg); const float mn = fmaxf(lf + m, ig); const float fd = expf(lf + m - mn), iw = expf(ig - mn); m = mn;
        const float vv = bf2f(MV[t * 1024 + h * 256 + v]);
        __syncthreads();
        float part = 0.f; const float ivv = iw * vv;
#pragma unroll
        for (int d4 = 0; d4 < 16; ++d4) { const f32x4 k4 = *(const LAS f32x4*)(ks + dh * 64 + d4 * 4), q4 = *(const LAS f32x4*)(qs + dh * 64 + d4 * 4);
#pragma unroll
            for (int e = 0; e < 4; ++e) { C[d4 * 4 + e] = fd * C[d4 * 4 + e] + ivv * k4[e]; part += C[d4 * 4 + e] * q4[e]; } }
        red[tid] = part;
        float nq = 0.f;
        if (tid < 128) { nst = fd * nst + iw * ks[tid]; nq = nst * qs[tid]; }
        nq = wave_sum(nq);
        if (F.lane == 0 && F.wave < 2) sc[F.wave] = nq;
        __syncthreads();
        const float num = red[v] + red[v + 256]; const float den = sc[0] + sc[1];
        const float hv = num / fmaxf(fabsf(den), expf(-mn));
        float sq = (dh == 0) ? hv * hv : 0.f; sq = wave_sum(sq);
        if (F.lane == 0) sc[2 + F.wave] = sq;
        __syncthreads();
        if (dh == 0) {
            const float ssum = sc[2] + sc[3] + sc[4] + sc[5];
            float y = hv * rsqrtf(ssum * (1.0f / 256.0f) + EPS) * gm;
            y *= sigmoidf_(bf2f(MO[t * 1024 + h * 256 + v]));
            YB[t * 1024 + h * 256 + v] = (bf16)f2bf(y);
        }
    }
    __syncthreads();
}

__device__ __forceinline__ void ph_branch_naive(Frame& F) {
    LAS float* As = (LAS float*)F.lds; LAS float* Bs = As + 16 * 132;
    const bf16* YA = (const bf16*)(F.outb + OUT_YA); const bf16* YB = (const bf16*)(F.outb + OUT_YB); const bf16* GAB = (const bf16*)(F.ws + WS_GAB);
    bf16* MG = (bf16*)(F.ws + WS_MERGED);
    const int ty = F.tid >> 5, tx = F.tid & 31;
    for (int vb = blockIdx.x; vb < (T / 128) * 8; vb += F.G) {
        const int tm = vb >> 3, tn = vb & 7, m0 = tm * 128, n0 = tn * 128;
        float a1[8][4], a2[8][4]; ZERO_ACC(a1); ZERO_ACC(a2);
        ARowGlobal ra{YA, (size_t)256, m0, nullptr}; ngemm_acc(As, Bs, ra, F.in[I_WBA], D, 256, n0, D, a1);
        ARowGlobal rb{YB, (size_t)D, m0, nullptr};  ngemm_acc(As, Bs, rb, F.in[I_WBB], D, D, n0, D, a2);
#pragma unroll
        for (int i = 0; i < 8; ++i) { const size_t row = (size_t)(m0 + ty * 8 + i); const int col = n0 + tx * 4;
            const u32x2 ga = *(const u32x2*)(GAB + row * 2048 + col), gb = *(const u32x2*)(GAB + row * 2048 + 1024 + col);
            const float sga[4] = {sigmoidf_(__uint_as_float(ga.x << 16)), sigmoidf_(__uint_as_float(ga.x & 0xffff0000u)), sigmoidf_(__uint_as_float(ga.y << 16)), sigmoidf_(__uint_as_float(ga.y & 0xffff0000u))};
            const float sgb[4] = {sigmoidf_(__uint_as_float(gb.x << 16)), sigmoidf_(__uint_as_float(gb.x & 0xffff0000u)), sigmoidf_(__uint_as_float(gb.y << 16)), sigmoidf_(__uint_as_float(gb.y & 0xffff0000u))};
            float o[4];
#pragma unroll
            for (int j = 0; j < 4; ++j) o[j] = sga[j] * a1[i][j] + sgb[j] * a2[i][j];
            u32x2 w; w.x = pk2(o[0], o[1]); w.y = pk2(o[2], o[3]); *(u32x2*)(MG + row * D + col) = w; }
    }
}

__device__ __forceinline__ void ph_outproj_naive(Frame& F) {
    LAS float* As = (LAS float*)F.lds; LAS float* Bs = As + 16 * 132;
    const bf16* MG = (const bf16*)(F.ws + WS_MERGED); bf16* YM = (bf16*)(F.ws + WS_YMIX);
    const int ty = F.tid >> 5, tx = F.tid & 31;
    for (int vb = blockIdx.x; vb < (T / 128) * 8; vb += F.G) {
        const int tm = vb >> 3, tn = vb & 7, m0 = tm * 128, n0 = tn * 128;
        float a1[8][4]; ZERO_ACC(a1);
        ARowGlobal ra{MG, (size_t)D, m0, nullptr}; ngemm_acc(As, Bs, ra, F.in[I_WOUT], D, D, n0, D, a1);
#pragma unroll
        for (int i = 0; i < 8; ++i) { const size_t row = (size_t)(m0 + ty * 8 + i); const int col = n0 + tx * 4;
            u32x2 w; w.x = pk2(a1[i][0], a1[i][1]); w.y = pk2(a1[i][2], a1[i][3]); *(u32x2*)(YM + row * D + col) = w; }
    }
}

__device__ __forceinline__ void x1_row(Frame& F, int t, f32x4 (&x1)[4]) {
    const float* x = F.in[I_X]; const bf16* YM = (const bf16*)(F.ws + WS_YMIX); const float* mod = (const float*)(F.ws + WS_MOD);
    const int b = t / SEQ; const float* gt1 = mod + b * 6144 + 2048; const float* g = F.in[I_GPOSTMIX];
    f32x4 y[4]; float ss = 0.f;
#pragma unroll
    for (int j = 0; j < 4; ++j) { const u32x2 w = *(const u32x2*)(YM + (size_t)t * D + F.lane * 4 + 256 * j);
        y[j][0] = __uint_as_float(w.x << 16); y[j][1] = __uint_as_float(w.x & 0xffff0000u); y[j][2] = __uint_as_float(w.y << 16); y[j][3] = __uint_as_float(w.y & 0xffff0000u);
        ss += y[j][0] * y[j][0] + y[j][1] * y[j][1] + y[j][2] * y[j][2] + y[j][3] * y[j][3]; }
    const float rstd = rsqrtf(wave_sum(ss) * (1.0f / D) + EPS);
#pragma unroll
    for (int j = 0; j < 4; ++j) { const int c = F.lane * 4 + 256 * j; const f32x4 xv = *(const f32x4*)(x + (size_t)t * D + c), gg = *(const f32x4*)(g + c), gt = *(const f32x4*)(gt1 + c);
#pragma unroll
        for (int e = 0; e < 4; ++e) x1[j][e] = xv[e] + gt[e] * (y[j][e] * rstd * gg[e]); }
}

__device__ __forceinline__ void ph_normmid(Frame& F) {
    const float* mod = (const float*)(F.ws + WS_MOD); const float* g = F.in[I_GPREFFN]; bf16* H2 = (bf16*)(F.ws + WS_H2);
    for (int t = blockIdx.x * NWAVES + F.wave; t < T; t += F.G * NWAVES) {
        const int b = t / SEQ; const float* sh2 = mod + b * 6144 + 3072, *sc2 = mod + b * 6144 + 4096;
        f32x4 x1[4]; x1_row(F, t, x1);
        float ss = 0.f;
#pragma unroll
        for (int j = 0; j < 4; ++j) ss += x1[j][0] * x1[j][0] + x1[j][1] * x1[j][1] + x1[j][2] * x1[j][2] + x1[j][3] * x1[j][3];
        const float rstd = rsqrtf(wave_sum(ss) * (1.0f / D) + EPS);
#pragma unroll
        for (int j = 0; j < 4; ++j) { const int c = F.lane * 4 + 256 * j; const f32x4 gg = *(const f32x4*)(g + c), s2 = *(const f32x4*)(sc2 + c), h2 = *(const f32x4*)(sh2 + c);
            float o[4];
#pragma unroll
            for (int e = 0; e < 4; ++e) o[e] = x1[j][e] * rstd * gg[e] * (1.0f + s2[e]) + h2[e];
            u32x2 w; w.x = pk2(o[0], o[1]); w.y = pk2(o[2], o[3]); *(u32x2*)(H2 + (size_t)t * D + c) = w;
            *(f32x4*)(F.out + (size_t)t * D + c) = (f32x4){0.f, 0.f, 0.f, 0.f}; }
    }
}

__device__ __forceinline__ void ph_router_naive(Frame& F) {
    LAS float* As = (LAS float*)F.lds; LAS float* Bs = As + 16 * 132;
    const bf16* H2 = (const bf16*)(F.ws + WS_H2); float* LG = (float*)(F.ws + WS_LOGITS);
    const int ty = F.tid >> 5, tx = F.tid & 31;
    for (int vb = blockIdx.x; vb < (T / 128) * 2; vb += F.G) {
        const int tm = vb >> 1, tn = vb & 1, m0 = tm * 128, n0 = tn * 128;
        float a1[8][4]; ZERO_ACC(a1);
        ARowGlobal ra{H2, (size_t)D, m0, nullptr}; ngemm_acc(As, Bs, ra, F.in[I_RW], NE, D, n0, NE, a1);
#pragma unroll
        for (int i = 0; i < 8; ++i) { const size_t row = (size_t)(m0 + ty * 8 + i); const int col = n0 + tx * 4;
            *(f32x4*)(LG + row * NE + col) = (f32x4){a1[i][0], a1[i][1], a1[i][2], a1[i][3]}; }
    }
}

__device__ __forceinline__ float half_max(float v) {
#pragma unroll
    for (int o = 1; o < 32; o <<= 1) v = fmaxf(v, __shfl_xor(v, o));
    return v;
}
__device__ __forceinline__ void ph_topk(Frame& F) {
    const float* LG = (const float*)(F.ws + WS_LOGITS); const float* rb = F.in[I_RB];
    int* TOPI = (int*)(F.ws + WS_TOPI); float* TOPW = (float*)(F.ws + WS_TOPW); unsigned* counts = F.ctl + CW_COUNTS;
    const int lane = F.lane, hf = lane >> 5;
    for (int t = blockIdx.x * NWAVES + F.wave; t < T; t += F.G * NWAVES) {
        float sc[4], sel[4];
#pragma unroll
        for (int i = 0; i < 4; ++i) { sc[i] = sigmoidf_(LG[(size_t)t * NE + lane + 64 * i]); sel[i] = sc[i] + rb[lane + 64 * i]; }
        float gs[8];
#pragma unroll
        for (int i = 0; i < 4; ++i) {
            const float m1 = half_max(sel[i]);
            const unsigned long long bal = __ballot(sel[i] == m1); const unsigned hb = hf ? (unsigned)(bal >> 32) : (unsigned)bal;
            const int first = __ffs(hb) - 1;
            const float v2 = ((lane & 31) == first) ? -INFINITY : sel[i];
            const float m2 = half_max(v2);
            const float g = m1 + m2;
            const float go = __shfl_xor(g, 32);
            gs[2 * i] = hf ? go : g; gs[2 * i + 1] = hf ? g : go;
        }
        bool gsel[8];
#pragma unroll
        for (int a = 0; a < 8; ++a) { int rank = 0;
#pragma unroll
            for (int c = 0; c < 8; ++c) rank += (gs[c] > gs[a] || (gs[c] == gs[a] && c < a)) ? 1 : 0;
            gsel[a] = rank < 4; }
#pragma unroll
        for (int i = 0; i < 4; ++i) { const bool ok = hf ? gsel[2 * i + 1] : gsel[2 * i]; if (!ok) sel[i] = -INFINITY; }
        int myidx = 0; float myw = 0.f; float wsum = 0.f;
#pragma unroll
        for (int k = 0; k < TOPK; ++k) {
            float bv = sel[0]; int bi = lane;
#pragma unroll
            for (int i = 1; i < 4; ++i) if (sel[i] > bv) { bv = sel[i]; bi = lane + 64 * i; }
#pragma unroll
            for (int o = 1; o < 64; o <<= 1) { const float ov = __shfl_xor(bv, o); const int oi = __shfl_xor(bi, o); if (ov > bv || (ov == bv && oi < bi)) { bv = ov; bi = oi; } }
            const int ol = bi & 63, oi = bi >> 6;
            float s = (oi == 0) ? sc[0] : (oi == 1) ? sc[1] : (oi == 2) ? sc[2] : sc[3];
            s = __shfl(s, ol);
            if (lane == ol) { if (oi == 0) sel[0] = -INFINITY; else if (oi == 1) sel[1] = -INFINITY; else if (oi == 2) sel[2] = -INFINITY; else sel[3] = -INFINITY; }
            wsum += s;
            if (lane == k) { myidx = bi; myw = s; }
        }
        if (lane < TOPK) { TOPI[(size_t)t * TOPK + lane] = myidx; TOPW[(size_t)t * TOPK + lane] = myw / wsum * 2.5f; atomicAdd(&counts[myidx], 1u); }
    }
}


__device__ __forceinline__ void ph_topk_serial(Frame& F) {
    const float* LG = (const float*)(F.ws + WS_LOGITS); const float* rb = F.in[I_RB];
    int* TOPI = (int*)(F.ws + WS_TOPI); float* TOPW = (float*)(F.ws + WS_TOPW); unsigned* counts = F.ctl + CW_COUNTS;
    LAS float* sel = (LAS float*)F.lds + F.wave * 1024; LAS float* scr = sel + 256; LAS float* gsc = scr + 256; LAS int* gok = (LAS int*)(gsc + 8); LAS int* bi = gok + 8; LAS float* bw = (LAS float*)(bi + 8);
    for (int t = blockIdx.x * NWAVES + F.wave; t < T; t += F.G * NWAVES) {
        for (int i = 0; i < 4; ++i) { const int e = F.lane + 64 * i; const float s = sigmoidf_(LG[(size_t)t * NE + e]); scr[e] = s; sel[e] = s + rb[e]; }
        __builtin_amdgcn_s_waitcnt(0);
        if (F.lane == 0) {
            for (int g = 0; g < 8; ++g) { float m1 = -INFINITY, m2 = -INFINITY; for (int q = 0; q < 32; ++q) { const float v = sel[g * 32 + q]; if (v > m1) { m2 = m1; m1 = v; } else if (v > m2) m2 = v; } gsc[g] = m1 + m2; gok[g] = 0; }
            for (int k = 0; k < 4; ++k) { int best = -1; float bv = -INFINITY; for (int g = 0; g < 8; ++g) if (!gok[g] && gsc[g] > bv) { bv = gsc[g]; best = g; } gok[best] = 1; }
            for (int e = 0; e < 256; ++e) if (!gok[e >> 5]) sel[e] = -INFINITY;
            float ws = 0.f;
            for (int k = 0; k < 8; ++k) { int best = 0; float bv = -INFINITY; for (int e = 0; e < 256; ++e) if (sel[e] > bv) { bv = sel[e]; best = e; } sel[best] = -INFINITY; bi[k] = best; bw[k] = scr[best]; ws += scr[best]; }
            for (int k = 0; k < 8; ++k) { TOPI[(size_t)t * 8 + k] = bi[k]; TOPW[(size_t)t * 8 + k] = bw[k] / ws * 2.5f; atomicAdd(&counts[bi[k]], 1u); }
        }
        __builtin_amdgcn_s_waitcnt(0);
    }
}

__device__ __forceinline__ void ph_scan(Frame& F) {
    if (blockIdx.x != 0) return;
    LAS int* pre = (LAS int*)F.lds;
    unsigned* counts = F.ctl + CW_COUNTS; int* ROWTOK = (int*)(F.ws + WS_ROWTOK); float* ROWW = (float*)(F.ws + WS_ROWW);
    int* UNITEXP = (int*)(F.ws + WS_UNITEXP); int* EXPTILE0 = (int*)(F.ws + WS_EXPTILE0);
    __syncthreads();
    int n = 0, nt = 0;
    if (F.tid < NE) { n = (int)counts[F.tid]; nt = (n + 255) >> 8; pre[F.tid] = nt; }
    __syncthreads();
    if (F.tid == 0) { int s = 0; for (int e = 0; e < NE; ++e) { const int c = pre[e]; pre[e] = s; s += c; } F.ctl[CW_NT] = (unsigned)s; }
    __syncthreads();
    if (F.tid < NE) {
        const int t0 = pre[F.tid]; EXPTILE0[F.tid] = t0;
        for (int u = 0; u < nt; ++u) UNITEXP[t0 + u] = F.tid;
        for (int r = n; r < nt * 256; ++r) { ROWTOK[t0 * 256 + r] = (t0 * 256 + r) & (T - 1); ROWW[t0 * 256 + r] = 0.f; }
    }
    __syncthreads();
    { const int NTv = (int)F.ctl[CW_NT];
      for (int i = F.tid; i < T; i += NTHR) { ROWTOK[NTv * 256 + i] = i; ROWW[NTv * 256 + i] = 1.0f; } }
}

__device__ __forceinline__ void ph_scatter(Frame& F) {
    const int* TOPI = (const int*)(F.ws + WS_TOPI); const float* TOPW = (const float*)(F.ws + WS_TOPW);
    int* ROWTOK = (int*)(F.ws + WS_ROWTOK); float* ROWW = (float*)(F.ws + WS_ROWW); const int* EXPTILE0 = (const int*)(F.ws + WS_EXPTILE0);
    unsigned* cursor = F.ctl + CW_CURSOR;
    for (int i = blockIdx.x * NTHR + F.tid; i < T * TOPK; i += F.G * NTHR) {
        const int e = TOPI[i]; const unsigned p = atomicAdd(&cursor[e], 1u);
        const size_t r = (size_t)EXPTILE0[e] * 256 + p;
        ROWTOK[r] = i >> 3; ROWW[r] = TOPW[i];
    }
}

__device__ __forceinline__ void ph_experts_naive(Frame& F) {
    LAS float* As = (LAS float*)F.lds; LAS float* Bs = As + 16 * 132; LAS bf16* hid = (LAS bf16*)(F.lds + 32768);
    const bf16* H2 = (const bf16*)(F.ws + WS_H2);
    const int* ROWTOK = (const int*)(F.ws + WS_ROWTOK); const float* ROWW = (const float*)(F.ws + WS_ROWW); const int* UNITEXP = (const int*)(F.ws + WS_UNITEXP);
    const int NT = (int)__hip_atomic_load(F.ctl + CW_NT, __ATOMIC_RELAXED, __HIP_MEMORY_SCOPE_AGENT);
    const int ty = F.tid >> 5, tx = F.tid & 31;
    const int nvb = 2 * NT + T / 128;
    for (int vb = blockIdx.x; vb < nvb; vb += F.G) {
        const bool shared = vb >= 2 * NT;
        const float *Wg, *Wu, *Wd; int r0; const int* gather;
        if (shared) { Wg = F.in[I_WSG]; Wu = F.in[I_WSU]; Wd = F.in[I_WSD]; r0 = (vb - 2 * NT) * 128; gather = nullptr; }
        else { const int u = vb >> 1; const int e = UNITEXP[u]; Wg = F.in[I_WEG] + (size_t)e * 1024 * 256; Wu = F.in[I_WEU] + (size_t)e * 1024 * 256; Wd = F.in[I_WED] + (size_t)e * 256 * 1024;
               r0 = u * 256 + (vb & 1) * 128; gather = ROWTOK; }
        ARowGlobal ra{H2, (size_t)D, r0, gather};
        for (int nh = 0; nh < 2; ++nh) {
            float ag[8][4], au[8][4]; ZERO_ACC(ag); ZERO_ACC(au);
            ngemm_acc(As, Bs, ra, Wg, 256, D, nh * 128, 256, ag);
            ngemm_acc(As, Bs, ra, Wu, 256, D, nh * 128, 256, au);
#pragma unroll
            for (int i = 0; i < 8; ++i) { float o[4];
#pragma unroll
                for (int j = 0; j < 4; ++j) { const float g = ag[i][j]; o[j] = g / (1.0f + expf(-g)) * au[i][j]; }
                u32x2 w; w.x = pk2(o[0], o[1]); w.y = pk2(o[2], o[3]); *(LAS u32x2*)(hid + (ty * 8 + i) * 256 + nh * 128 + tx * 4) = w; }
        }
        __syncthreads();
        ARowLds rl{hid};
        for (int nc = 0; nc < 8; ++nc) {
            float ad[8][4]; ZERO_ACC(ad);
            ngemm_acc(As, Bs, rl, Wd, D, 256, nc * 128, D, ad);
#pragma unroll
            for (int i = 0; i < 8; ++i) { const int r = r0 + ty * 8 + i; const int tok = shared ? r : ROWTOK[r]; const float w = shared ? 1.0f : ROWW[r];
                if (w != 0.f) {
#pragma unroll
                    for (int j = 0; j < 4; ++j) unsafeAtomicAdd(F.out + (size_t)tok * D + nc * 128 + tx * 4 + j, ad[i][j] * w); } }
        }
        __syncthreads();
    }
}


__device__ __forceinline__ void ph_experts_brute(Frame& F) {
    LAS float* hs = (LAS float*)F.lds;
    LAS float* hid = hs + 1024;
    LAS float* pg = hid + 256;
    const bf16* H2 = (const bf16*)(F.ws + WS_H2); const int* TOPI = (const int*)(F.ws + WS_TOPI); const float* TOPW = (const float*)(F.ws + WS_TOPW);
    const int tid = F.tid, j = tid & 255, kh = tid >> 8;
    for (int t = blockIdx.x; t < T; t += F.G) {
        __syncthreads();
        hs[tid] = bf2f(H2[(size_t)t * D + tid]); hs[tid + 512] = bf2f(H2[(size_t)t * D + tid + 512]);
        float o0 = 0.f, o1 = 0.f;
        __syncthreads();
        for (int k9 = 0; k9 < 9; ++k9) {
            const float *Wg, *Wu, *Wd; float w;
            if (k9 == 8) { Wg = F.in[I_WSG]; Wu = F.in[I_WSU]; Wd = F.in[I_WSD]; w = 1.0f; }
            else { const int e = TOPI[(size_t)t * 8 + k9]; w = TOPW[(size_t)t * 8 + k9]; Wg = F.in[I_WEG] + (size_t)e * 1024 * 256; Wu = F.in[I_WEU] + (size_t)e * 1024 * 256; Wd = F.in[I_WED] + (size_t)e * 256 * 1024; }
            float g = 0.f, u = 0.f;
            for (int k = kh * 512; k < kh * 512 + 512; ++k) { const float hv = hs[k]; g += hv * Wg[(size_t)k * 256 + j]; u += hv * Wu[(size_t)k * 256 + j]; }
            pg[tid] = g; pg[512 + tid] = u;
            __syncthreads();
            if (tid < 256) { const float gg = pg[tid] + pg[tid + 256], uu = pg[512 + tid] + pg[512 + tid + 256]; hid[tid] = gg / (1.0f + expf(-gg)) * uu * w; }
            __syncthreads();
            for (int q = 0; q < 256; ++q) { const float hv = hid[q]; o0 += hv * Wd[(size_t)q * 1024 + tid]; o1 += hv * Wd[(size_t)q * 1024 + tid + 512]; }
        }
        F.out[(size_t)t * D + tid] = o0; F.out[(size_t)t * D + tid + 512] = o1;
    }
}

__device__ __forceinline__ void ph_final(Frame& F) {
    const float* mod = (const float*)(F.ws + WS_MOD); const float* g = F.in[I_GPOSTFFN];
    for (int t = blockIdx.x * NWAVES + F.wave; t < T; t += F.G * NWAVES) {
        const int b = t / SEQ; const float* gt2 = mod + b * 6144 + 5120;
        f32x4 x1[4]; x1_row(F, t, x1);
        f32x4 y[4]; float ss = 0.f;
#pragma unroll
        for (int j = 0; j < 4; ++j) { y[j] = *(const f32x4*)(F.out + (size_t)t * D + F.lane * 4 + 256 * j); ss += y[j][0] * y[j][0] + y[j][1] * y[j][1] + y[j][2] * y[j][2] + y[j][3] * y[j][3]; }
        const float rstd = rsqrtf(wave_sum(ss) * (1.0f / D) + EPS);
#pragma unroll
        for (int j = 0; j < 4; ++j) { const int c = F.lane * 4 + 256 * j; const f32x4 gg = *(const f32x4*)(g + c), gt = *(const f32x4*)(gt2 + c);
            f32x4 o;
#pragma unroll
            for (int e = 0; e < 4; ++e) o[e] = x1[j][e] + DBG_MOE_SCALE * gt[e] * (y[j][e] * rstd * gg[e]);
            *(f32x4*)(F.out + (size_t)t * D + c) = o; }
    }
}

enum { PH_MOD = 0, PH_NORM1, PH_INPROJ, PH_ROPE, PH_MIX, PH_BRANCH, PH_OUTPROJ, PH_NORMMID, PH_ROUTER, PH_TOPK, PH_SCAN, PH_SCATTER, PH_EXPERTS, PH_FINAL, N_PHASES };

__global__ void __launch_bounds__(NTHR, 2) mk_fwd(Args args) {
    extern __shared__ __attribute__((aligned(16))) unsigned char lds_raw[];
    Frame F;
    F.lds = (LAS unsigned char*)lds_raw;
    F.tid = threadIdx.x; F.lane = F.tid & 63; F.wave = __builtin_amdgcn_readfirstlane(F.tid >> 6); F.G = gridDim.x;
#pragma unroll
    for (int i = 0; i < N_IN; ++i) F.in[i] = args.in[i];
    F.pos = (const int*)args.in[I_POS];
    F.out = args.out; F.outb = (unsigned char*)args.out; F.ws = args.ws; F.ctl = (unsigned*)(args.ws + WS_CTL);
    volatile LAS unsigned* MISC = (volatile LAS unsigned*)(F.lds + MISC_OFF);
    if (F.tid < 32) MISC[F.tid] = 0u;
    __syncthreads();
    const int lo = args.ph_lo, hi = args.ph_hi;
#define REFRESH() do { int _t = threadIdx.x; asm volatile("" : "+v"(_t)); F.tid = _t; F.lane = _t & 63; F.wave = __builtin_amdgcn_readfirstlane(_t >> 6); } while (0)
    XcdBarrier bar; bar.bar = F.ctl + CW_BAR; bar.x = 0; bar.st = nullptr;
    if (hi - lo > 1) bar = xcd_barrier_post(F.ctl + CW_BAR, MISC + 8);
#ifndef PH_MASK
#define PH_MASK 0xFFFFFFu
#endif
#define IN(k) ((((PH_MASK) >> (k)) & 1u) && lo <= (k) && (k) < hi)
#define SEAM(k) do { if (IN(k) && IN((k) + 1)) xcd_barrier(bar); } while (0)

    if (IN(PH_MOD)) { REFRESH(); ph_mod(F); ph_cvt_small(F); } SEAM(PH_MOD);
    if (IN(PH_NORM1)) { REFRESH(); ph_norm1(F); } SEAM(PH_NORM1);
#if FAST_INPROJ
    if (IN(PH_INPROJ)) { REFRESH(); ph_inproj_fast(F); }
    SEAM(PH_INPROJ);
#else
    if (IN(PH_INPROJ)) { REFRESH(); ph_inproj_naive(F); }
    SEAM(PH_INPROJ);
    if (IN(PH_ROPE)) { REFRESH(); ph_rope_naive(F); }
    SEAM(PH_ROPE);
#endif
    if (IN(PH_MIX)) { REFRESH();
        for (int vb = blockIdx.x; vb < 128 + 512; vb += F.G) { if (vb < 128) ph_mlstm_naive_unit(F, vb); else ph_attn_naive_block(F, vb - 128); }
    } SEAM(PH_MIX);
#if FAST_BRANCH
    if (IN(PH_BRANCH)) { REFRESH(); ph_branch_fast(F); }
    SEAM(PH_BRANCH);
    if (IN(PH_OUTPROJ)) { REFRESH(); ph_outproj_fast(F); }
    SEAM(PH_OUTPROJ);
#else
    if (IN(PH_BRANCH)) { REFRESH(); ph_branch_naive(F); }
    SEAM(PH_BRANCH);
    if (IN(PH_OUTPROJ)) { REFRESH(); ph_outproj_naive(F); }
    SEAM(PH_OUTPROJ);
#endif
    if (IN(PH_NORMMID)) { REFRESH(); ph_normmid(F);
#if FAST_EXPERTS
        ph_cvt_experts(F);
#endif
    }
    SEAM(PH_NORMMID);
#if FAST_ROUTER
    if (IN(PH_ROUTER)) { REFRESH(); ph_router_fast(F); }
#else
    if (IN(PH_ROUTER)) { REFRESH(); ph_router_naive(F); }
#endif
    SEAM(PH_ROUTER);
    #if DBG_TOPK_SERIAL
    if (IN(PH_TOPK)) { REFRESH(); ph_topk_serial(F); }
#else
    if (IN(PH_TOPK)) { REFRESH(); ph_topk(F); }
#endif
    SEAM(PH_TOPK);
    if (IN(PH_SCAN)) { REFRESH(); ph_scan(F); } SEAM(PH_SCAN);
    if (IN(PH_SCATTER)) { REFRESH(); ph_scatter(F); } SEAM(PH_SCATTER);
    #if DBG_BRUTE
    if (IN(PH_EXPERTS)) { REFRESH(); ph_experts_brute(F); }
#elif FAST_EXPERTS
    if (IN(PH_EXPERTS)) { REFRESH(); ph_gu_fast(F); xcd_barrier(bar); REFRESH(); ph_down_fast(F); }
#else
    if (IN(PH_EXPERTS)) { REFRESH(); ph_experts_naive(F); }
#endif
    SEAM(PH_EXPERTS);
    if (IN(PH_FINAL)) { REFRESH(); ph_final(F); }
#undef IN
#undef SEAM
}

extern "C" void kernel_launch(void* const* d_in, const int* in_sizes, int n_in, void* d_out, int out_size, void* d_ws, size_t ws_size, hipStream_t stream) {
    static int grid = 0;
    if (grid == 0) {
        if (n_in != N_IN || out_size != T * D || ws_size < WS_NEED) { fprintf(stderr, "kernel_launch: unexpected shapes (n_in %d, out %d, ws %zu); nothing launched\n", n_in, out_size, ws_size); grid = -1; return; }
        int dev = 0, cus = 0, per_cu = 0;
        if (hipGetDevice(&dev) != hipSuccess || hipDeviceGetAttribute(&cus, hipDeviceAttributeMultiprocessorCount, dev) != hipSuccess) { grid = -1; return; }
        if (hipFuncSetAttribute((const void*)mk_fwd, hipFuncAttributeMaxDynamicSharedMemorySize, LDS_BYTES) != hipSuccess) { fprintf(stderr, "kernel_launch: hipFuncSetAttribute failed\n"); grid = -1; return; }
        if (hipOccupancyMaxActiveBlocksPerMultiprocessor(&per_cu, (const void*)mk_fwd, NTHR, LDS_BYTES) != hipSuccess || per_cu < 1) fprintf(stderr, "kernel_launch: occupancy query reports %d\n", per_cu);
        (void)hipGetLastError();
        grid = cus;
    }
    if (grid < 0) return;
    if (hipMemsetAsync((char*)d_ws + WS_CTL, 0, CTL_ZERO_BYTES, stream) != hipSuccess) return;
    Args a{};
    for (int i = 0; i < N_IN; ++i) a.in[i] = (const float*)d_in[i];
    a.out = (float*)d_out; a.ws = (unsigned char*)d_ws;
#if MK_SPLIT
    for (int p = 0; p < N_PHASES; ++p) { a.ph_lo = p; a.ph_hi = p + 1; hipLaunchKernelGGL(mk_fwd, dim3(grid), dim3(NTHR), LDS_BYTES, stream, a); }
#elif defined(MK_CUTS)
    { const int cuts[] = MK_CUTS; const int nc = sizeof(cuts) / sizeof(int);
      for (int i = 0; i + 1 < nc; ++i) { a.ph_lo = cuts[i]; a.ph_hi = cuts[i + 1];
          if (i) hipMemsetAsync((char*)d_ws + WS_CTL + CW_BAR * 4, 0, XCD_BAR_WORDS * 4, stream);
          hipLaunchKernelGGL(mk_fwd, dim3(grid), dim3(NTHR), LDS_BYTES, stream, a); } }
#else
    a.ph_lo = 0; a.ph_hi = N_PHASES;
    hipLaunchKernelGGL(mk_fwd, dim3(grid), dim3(NTHR), LDS_BYTES, stream, a);
#endif
}
```

```cpp
#include <hip/hip_runtime.h>
#include <cstdio>
#include <cstdint>

#define GAS __attribute__((address_space(1)))
#define LAS __attribute__((address_space(3)))
typedef unsigned short bf16;
typedef float f32x4 __attribute__((ext_vector_type(4)));
typedef float f32x2 __attribute__((ext_vector_type(2)));
typedef unsigned u32x4 __attribute__((ext_vector_type(4)));
typedef unsigned u32x2 __attribute__((ext_vector_type(2)));

#ifndef DBG_MOE_SCALE
#define DBG_MOE_SCALE 1.0f
#endif
#ifndef DBG_BRUTE
#define DBG_BRUTE 0
#endif
#ifndef DBG_TOPK_SERIAL
#define DBG_TOPK_SERIAL 1
#endif

#ifndef FAST_INPROJ
#define FAST_INPROJ 1
#endif
#ifndef FAST_BRANCH
#define FAST_BRANCH 1
#endif
#ifndef FAST_ROUTER
#define FAST_ROUTER 1
#endif
#ifndef FAST_EXPERTS
#define FAST_EXPERTS 1
#endif
#ifndef FAST_ATTN
#define FAST_ATTN 1
#endif
#ifndef FAST_MLSTM
#define FAST_MLSTM 1
#endif
#ifndef DBG_STAMP_A
#define DBG_STAMP_A -1
#endif
#ifndef DBG_STAMP_B
#define DBG_STAMP_B 0
#endif
#ifndef FAST_MOE2
#define FAST_MOE2 1
#endif
#ifndef DUP
#define DUP -1
#ifndef ATTN_PIPE
#define ATTN_PIPE 1
#endif
#ifndef FUSE_ATTN_COMBINE
#define FUSE_ATTN_COMBINE 1
#endif
#ifndef MIX_CVT_FIRST
#define MIX_CVT_FIRST 3
#endif
#endif
#ifndef FAST_TOPK4
#define FAST_TOPK4 1
#endif
#ifndef MOE_FP8
#define MOE_FP8 1
#endif
#ifndef STAGGER_NS
#define STAGGER_NS 0
#endif
#ifndef INPROJ_FP8
#define INPROJ_FP8 1
#endif
#ifndef SLOT8
#define SLOT8 1
#endif
#ifndef GATES_GEMM
#define GATES_GEMM 1
#endif
#ifndef GATES_U8
#define GATES_U8 1
#endif
#ifndef DOWN_ALIGN
#define DOWN_ALIGN true
#endif
#ifndef FUSE_ROUTER_TOPK
#define FUSE_ROUTER_TOPK 1
#endif
#ifndef FUSE_TOKBLOCK
#define FUSE_TOKBLOCK 1
#endif
#ifndef MK_SPLIT
#define MK_SPLIT 0
#endif

constexpr int D = 1024, NB = 32, SEQ = 2048, T = NB * SEQ;
constexpr int INW = 7432;
constexpr int NE = 256, TOPK = 8;
constexpr int NTHR = 512, NWAVES = 8;
constexpr float EPS = 1e-6f;

enum { I_X = 0, I_C, I_POS, I_WADA, I_BADA, I_GPREMIX, I_GPOSTMIX, I_GPREFFN, I_GPOSTFFN, I_WIN, I_CONVW, I_CONVB, I_BGATES, I_GMLSTM,
       I_WBA, I_WBB, I_WOUT, I_RW, I_RB, I_WEG, I_WEU, I_WED, I_WSG, I_WSU, I_WSD, N_IN };

constexpr size_t MiB = 1u << 20;
constexpr size_t WS_CTL = 0, CTL_ZERO_BYTES = 1 * MiB;
constexpr size_t WS_MOD = 1 * MiB;
constexpr size_t WS_GATES = 2 * MiB;
constexpr size_t WS_TOPI = 4 * MiB;
constexpr size_t WS_TOPW = 6 * MiB;
constexpr size_t WS_ROWTOK = 8 * MiB;
constexpr size_t WS_ROWW = 12 * MiB;
constexpr size_t WS_UNITEXP = 16 * MiB;
constexpr size_t WS_EXPTILE0 = 16 * MiB + 65536;
constexpr size_t WS_HIST = 17 * MiB;
constexpr size_t WS_BASEREL = 17 * MiB + 262144;
constexpr size_t WS_TSG = 17 * MiB + 524288;
constexpr size_t WS_TE = 17 * MiB + 528384;
constexpr size_t WS_THOFF = 17 * MiB + 544768;
constexpr size_t WS_DEST = 52 * MiB;
constexpr size_t WS_DUMP = 18 * MiB;
constexpr size_t WS_ROPE = 20 * MiB;
constexpr size_t WS_W8T = 24 * MiB;
constexpr size_t WS_WIN_T = 25 * MiB;
constexpr size_t WS_WBA_T = 40 * MiB;
constexpr size_t WS_WBB_T = 41 * MiB;
constexpr size_t WS_WOUT_T = 43 * MiB;
constexpr size_t WS_WR_T = 45 * MiB;
constexpr size_t WS_WSGU_T = 46 * MiB;
constexpr size_t WS_WSD_T = 47 * MiB;
constexpr size_t WS_LSE = 48 * MiB;
constexpr size_t WS_Q = 64 * MiB, WS_K = 160 * MiB, WS_V = 256 * MiB;
constexpr size_t WS_MQK = 352 * MiB, WS_MV = 480 * MiB, WS_MO = 608 * MiB;
constexpr size_t WS_GAB = 736 * MiB;
constexpr size_t WS_MERGED = 192 * MiB;
constexpr size_t WS_YMIX = 64 * MiB;
constexpr size_t WS_H2 = 192 * MiB;
constexpr size_t WS_LOGITS = 384 * MiB;
constexpr size_t WS_WD = 384 * MiB;
constexpr size_t WS_WGU = 512 * MiB;
constexpr size_t WS_HIDS = 320 * MiB;
constexpr size_t WS_HIDR = 768 * MiB;
constexpr size_t WS_NEED = 1064 * MiB;
constexpr size_t WS_H8 = 992 * MiB;
constexpr size_t WS_WIN_T8 = 1056 * MiB;
constexpr size_t WS_H2F8 = 320 * MiB;
constexpr size_t WS_WD8 = 672 * MiB;
constexpr size_t WS_WGU8 = 864 * MiB;
constexpr size_t WS_WSGU8 = 46 * MiB;
constexpr size_t WS_WSD8 = 47 * MiB;
constexpr size_t WS_HIDS8 = 448 * MiB;
constexpr size_t WS_HIDR8 = 480 * MiB;
constexpr size_t OUT_H = 0;
constexpr size_t OUT_YA = 0;
constexpr size_t OUT_YB = 128 * MiB;
constexpr size_t OUT_OG = 32 * MiB;

constexpr int CW_BAR = 4096;
constexpr int CW_STAMP = 8192;
constexpr int CW_CVTQ = 12800;
constexpr int CW_ATTQ = 12288;
constexpr int CW_COUNTS = 16384, CW_CURSOR = 16384 + 256, CW_NT = 16384 + 512, CW_NT0 = 16384 + 576;

constexpr int LDS_BYTES = 147456;
constexpr int MISC_OFF = 131072 + 320;

__device__ __forceinline__ float bf2f(bf16 b) { return __uint_as_float(((unsigned)b) << 16); }
__device__ __forceinline__ unsigned f2bf(float f) { unsigned u = __float_as_uint(f); return (u + 0x7fffu + ((u >> 16) & 1u)) >> 16; }
__device__ __forceinline__ unsigned pk2(float lo, float hi) { return f2bf(lo) | (f2bf(hi) << 16); }
__device__ __forceinline__ float wave_sum(float v) {
#pragma unroll
    for (int o = 1; o < 64; o <<= 1) v += __shfl_xor(v, o);
    return v;
}
__device__ __forceinline__ float sigmoidf_(float x) { return 1.0f / (1.0f + expf(-x)); }
__device__ __forceinline__ float logsigmoidf_(float x) { return fminf(x, 0.f) - log1pf(expf(-fabsf(x))); }

#define XB_TMO      128
#define XB_XCNT(j)  (256  + 64 * (j))
#define XB_XSUB(j)  (1280 + 64 * (j))
#define XB_XGEN(j)  (2304 + 64 * (j))
#define XB_TOP      3328
#define XB_TOPGEN   3392
#define XCD_BAR_WORDS 3456
#define XB_SPIN_CAP (1u << 23)

__device__ __forceinline__ unsigned xb_ld(unsigned* p)              { return __hip_atomic_load(p, __ATOMIC_RELAXED, __HIP_MEMORY_SCOPE_AGENT); }
__device__ __forceinline__ unsigned xb_add(unsigned* p, unsigned v) { return __hip_atomic_fetch_add(p, v, __ATOMIC_RELAXED, __HIP_MEMORY_SCOPE_AGENT); }
__device__ __forceinline__ unsigned xb_xcc_id() { return (unsigned)__builtin_amdgcn_s_getreg((3 << 11) | 20) & 0xFu; }
#define XB_SPIN(cond, bar) do { unsigned _sp = 0; while (cond) { __builtin_amdgcn_s_sleep(1); \
    if ((++_sp & 255u) == 0u) { if (xb_ld(&(bar)[XB_TMO])) break; if (_sp > XB_SPIN_CAP) { atomicAdd(&(bar)[XB_TMO], 1u); break; } } } } while (0)

struct XcdBarrier { unsigned* bar; unsigned x; volatile LAS unsigned* st; };

__device__ __forceinline__ XcdBarrier xcd_barrier_post(unsigned* bar, volatile LAS unsigned* st) {
    XcdBarrier b; b.bar = bar; b.x = xb_xcc_id(); b.st = st;
    if (threadIdx.x == 0) (void)xb_add(&bar[XB_XCNT(b.x)], 1u);
    return b;
}
__device__ __forceinline__ void xcd_barrier_complete(unsigned* bar, unsigned x, unsigned& nloc, unsigned& nx) {
    const unsigned G = gridDim.x * gridDim.y * gridDim.z;
    unsigned sum, cnt, mine, sp = 0u;
    for (;;) {
        sum = 0u; cnt = 0u; mine = 0u;
#pragma unroll
        for (unsigned j = 0; j < 16; ++j) { const unsigned c = xb_ld(&bar[XB_XCNT(j)]); sum += c; cnt += (c > 0u) ? 1u : 0u; mine = (j == x) ? c : mine; }
        if (sum == G) break;
        __builtin_amdgcn_s_sleep(1);
        if ((++sp & 255u) == 0u) { if (xb_ld(&bar[XB_TMO])) break; if (sp > XB_SPIN_CAP) { atomicAdd(&bar[XB_TMO], 1u); break; } }
    }
    nloc = mine > 0u ? mine : 1u; nx = cnt > 0u ? cnt : 1u;
}
__device__ __forceinline__ void xcd_barrier(const XcdBarrier& b) {
    asm volatile("s_waitcnt vmcnt(0)" ::: "memory");
    __syncthreads();
    if (threadIdx.x == 0) {
        unsigned* bar = b.bar;
        __builtin_amdgcn_s_waitcnt(0);
        unsigned nloc = b.st[0], nx = b.st[1];
        if (nloc == 0u) { xcd_barrier_complete(bar, b.x, nloc, nx); b.st[0] = nloc; b.st[1] = nx; }
        const unsigned old = xb_add(&bar[XB_XSUB(b.x)], 1u);
        const unsigned gen = old / nloc;
        if (old + 1u == (gen + 1u) * nloc) {
            __builtin_amdgcn_fence(__ATOMIC_RELEASE, "agent");
            asm volatile("s_waitcnt vmcnt(0)" ::: "memory");
            const unsigned og = xb_add(&bar[XB_TOP], 1u);
            const unsigned tg = og / nx;
            if (og + 1u == (tg + 1u) * nx) xb_add(&bar[XB_TOPGEN], 1u);
            else XB_SPIN(xb_ld(&bar[XB_TOPGEN]) == tg, bar);
            __builtin_amdgcn_fence(__ATOMIC_ACQUIRE, "agent");
            xb_add(&bar[XB_XGEN(b.x)], 1u);
            asm volatile("s_waitcnt vmcnt(0)" ::: "memory");
        } else {
            XB_SPIN(xb_ld(&bar[XB_XGEN(b.x)]) == gen, bar);
            __builtin_amdgcn_fence(__ATOMIC_ACQUIRE, "agent");
            asm volatile("s_waitcnt vmcnt(0)" ::: "memory");
        }
    }
    __syncthreads();
}

struct Args { const float* in[N_IN]; float* out; unsigned char* ws; int ph_lo, ph_hi; };

struct Frame {
    LAS unsigned char* lds;
    unsigned* ctl;
    int tid, lane, wave, G;
    const float* in[N_IN];
    const int* pos;
    float* out; unsigned char* outb; unsigned char* ws;
};

struct ARowGlobal {
    const bf16* base; size_t ld; int m0; const int* gather;
    __device__ __forceinline__ void load4(int r, int k, float (&o)[4]) const {
        const size_t row = gather ? (size_t)gather[m0 + r] : (size_t)(m0 + r);
        const u32x2 v = *(const u32x2*)(base + row * ld + k);
        o[0] = __uint_as_float(v.x << 16); o[1] = __uint_as_float(v.x & 0xffff0000u); o[2] = __uint_as_float(v.y << 16); o[3] = __uint_as_float(v.y & 0xffff0000u);
    }
};
struct ARowLds {
    const LAS bf16* base;
    __device__ __forceinline__ void load4(int r, int k, float (&o)[4]) const {
        const u32x2 v = *(const LAS u32x2*)(base + r * 256 + k);
        o[0] = __uint_as_float(v.x << 16); o[1] = __uint_as_float(v.x & 0xffff0000u); o[2] = __uint_as_float(v.y << 16); o[3] = __uint_as_float(v.y & 0xffff0000u);
    }
};
template <class ARow>
__device__ __forceinline__ void ngemm_acc(LAS float* As, LAS float* Bs, const ARow& arow, const float* __restrict__ W, int ldw, int K, int n0, int Nvalid, float (&acc)[8][4]) {
    const int tid = threadIdx.x, ty = tid >> 5, tx = tid & 31;
    const int ar = tid >> 2, ak = (tid & 3) * 4;
    const int bk = tid >> 5, bn = (tid & 31) * 4;
    for (int k0 = 0; k0 < K; k0 += 16) {
        float a4[4]; arow.load4(ar, k0 + ak, a4);
        f32x4 b4 = (f32x4){0.f, 0.f, 0.f, 0.f};
        if (n0 + bn < Nvalid) b4 = *(const f32x4*)(W + (size_t)(k0 + bk) * ldw + n0 + bn);
        __syncthreads();
        As[(ak + 0) * 132 + ar] = a4[0]; As[(ak + 1) * 132 + ar] = a4[1]; As[(ak + 2) * 132 + ar] = a4[2]; As[(ak + 3) * 132 + ar] = a4[3];
        *(LAS f32x4*)(Bs + bk * 132 + bn) = b4;
        __syncthreads();
#pragma unroll 4
        for (int kk = 0; kk < 16; ++kk) {
            const f32x4 a0 = *(const LAS f32x4*)(As + kk * 132 + ty * 8), a1 = *(const LAS f32x4*)(As + kk * 132 + ty * 8 + 4);
            const f32x4 b = *(const LAS f32x4*)(Bs + kk * 132 + tx * 4);
#pragma unroll
            for (int j = 0; j < 4; ++j) {
                acc[0][j] += a0[0] * b[j]; acc[1][j] += a0[1] * b[j]; acc[2][j] += a0[2] * b[j]; acc[3][j] += a0[3] * b[j];
                acc[4][j] += a1[0] * b[j]; acc[5][j] += a1[1] * b[j]; acc[6][j] += a1[2] * b[j]; acc[7][j] += a1[3] * b[j];
            }
        }
    }
    __syncthreads();
}
#define ZERO_ACC(a) do { _Pragma("unroll") for (int _i = 0; _i < 8; ++_i) _Pragma("unroll") for (int _j = 0; _j < 4; ++_j) a[_i][_j] = 0.f; } while (0)


namespace g2 {
typedef short bf16x8 __attribute__((ext_vector_type(8)));
typedef int v4i_t __attribute__((ext_vector_type(4)));
typedef int v8i_t __attribute__((ext_vector_type(8)));
constexpr int BM = 256, BK = 64, HALF = 128, HTB = HALF * BK * 2, STAGE_BYTES = 8 * HTB, NXCD = 8, WGM = 8;
__host__ __device__ __forceinline__ int lds_byte(int r, int c) { const int st = (r >> 4) * 2 + (c >> 5), rr = r & 15, cc = c & 31, ob = rr * 64 + cc * 2; return st * 1024 + (ob ^ (((ob >> 9) & 1) << 5)); }
__host__ __device__ __forceinline__ void stage_rc(int b, int& R, int& C) { const int st = b / 1024, sb = b % 1024, swz = sb ^ (((sb >> 9) & 1) << 5); R = (st >> 1) * 16 + swz / 64; C = (st & 1) * 32 + (swz % 64) / 2; }
__host__ __device__ __forceinline__ int perm32(int rho) { const int n = rho >> 4, i = rho & 15; return 8 * (i >> 2) + 4 * n + (i & 3); }
__device__ __forceinline__ unsigned cvt_pk_bf16(float lo, float hi) { unsigned r; asm volatile("v_cvt_pk_bf16_f32 %0, %1, %2" : "=v"(r) : "v"(lo), "v"(hi)); return r; }

struct UnitMN { int pm, pn; };
struct DenseOrder {
    typedef UnitMN Unit;
    int nM, nN, nwg, G, c, Kk, pnoff, pncut, pnskip;
    const char* A; const char* Bt;
    __device__ void init(int M, int N, int K, const void* A_, const void* Bt_, int G_, int c_) { nM = M / BM; nN = N / BM; nwg = nM * nN; G = G_; c = c_; Kk = K; A = (const char*)A_; Bt = (const char*)Bt_; pnoff = 0; pncut = 1 << 20; pnskip = 0; }
    __device__ __forceinline__ bool next(int i, Unit& u) const {
        const long L = (long)i * G + c; if (L >= nwg) return false;
        int wgid = (int)L; { const int q = nwg / NXCD, r = nwg % NXCD, xcd = wgid % NXCD, off = wgid / NXCD; wgid = (xcd < r ? xcd * (q + 1) : r * (q + 1) + (xcd - r) * q) + off; }
        const int nig = WGM * nN, gid = wgid / nig, fm = gid * WGM, gsz = (nM - fm) < WGM ? (nM - fm) : WGM;
        u.pm = fm + ((wgid % nig) % gsz); u.pn = (wgid % nig) / gsz; if (u.pn >= pncut) u.pn += pnskip; u.pn += pnoff; return true;
    }
    __device__ __forceinline__ int K(const Unit&) const { return Kk; }
    __device__ __forceinline__ const char* a_base(const Unit&) const { return A; }
    __device__ __forceinline__ unsigned a_row_off(const Unit& u, int r) const { return (unsigned)(u.pm * BM + r) * (unsigned)(Kk * 2); }
    __device__ __forceinline__ const char* b_base(const Unit& u) const { return Bt + (size_t)u.pn * BM * Kk * 2; }
};

template <class Epi, class Sched, bool F8 = false, bool ALIGN_EPI = true>
__device__ __forceinline__ void gemm_phase(LAS unsigned char* lds, const Sched& S, const Epi& E, int f8_scale_b = 127) {
    const int tid = threadIdx.x, wid = __builtin_amdgcn_readfirstlane(tid >> 6), lane = tid & 63, wr = wid >> 2, wc = wid & 3, fr = lane & 15, fq = lane >> 4;
#define G2_RC(i, R, Rb, C2) int R, Rb; unsigned C2; { int _R, _C; stage_rc(tid * 16 + (i) * 8192, _R, _C); R = _R; Rb = Epi::PERM ? (64 * (_R >> 5) + 16 * ((_R & 15) >> 2) + 4 * ((_R & 31) >> 4) + (_R & 3)) : _R; C2 = (unsigned)_C * 2u; }
    const size_t kstep = (size_t)(BK * 2);
    const unsigned ldsw = (unsigned)wid * 1024u;
    const int aoff = lds_byte(wr * 64 + fr, fq * 8), boff = lds_byte(wc * 32 + fr, fq * 8);
#define G2_SA(b, h) (((b) * 2 + (h)) * HTB)
#define G2_SB(b, h) ((4 + (b) * 2 + (h)) * HTB)
#define G2_STAGE(bufoff, gbase, voff) do { _Pragma("unroll") for (int _i = 0; _i < 2; ++_i) \
        __builtin_amdgcn_global_load_lds((const unsigned*)((const char*)(gbase) + (voff)[_i]), (LAS unsigned*)(lds + (bufoff) + ldsw + _i * 8192), 16, 0, 0); } while (0)
#define G2_LDA(dst, b, h) do { _Pragma("unroll") for (int m = 0; m < 4; ++m) { const v4i_t _lo = *(const LAS v4i_t*)(lds + G2_SA(b, h) + aoff + m * 2048), _hi = *(const LAS v4i_t*)(lds + G2_SA(b, h) + aoff + m * 2048 + 1024); \
        dst[m] = __builtin_shufflevector(_lo, _hi, 0, 1, 2, 3, 4, 5, 6, 7); } } while (0)
#define G2_LDB(dst, b, h) do { _Pragma("unroll") for (int n = 0; n < 2; ++n) { const v4i_t _lo = *(const LAS v4i_t*)(lds + G2_SB(b, h) + boff + n * 2048), _hi = *(const LAS v4i_t*)(lds + G2_SB(b, h) + boff + n * 2048 + 1024); \
        dst[n] = __builtin_shufflevector(_lo, _hi, 0, 1, 2, 3, 4, 5, 6, 7); } } while (0)
#define G2_MMA(ai, bj, At, Bt) do { __builtin_amdgcn_s_setprio(1); _Pragma("unroll") for (int m = 0; m < 4; ++m) _Pragma("unroll") for (int n = 0; n < 2; ++n) { \
        if constexpr (F8) asm volatile("v_mfma_scale_f32_16x16x128_f8f6f4 %0, %1, %2, %0, %3, %4 op_sel_hi:[0,0,0]" : "+v"(acc[ai][bj][m][n]) : "v"(Bt[n]), "v"(At[m]), "v"(f8_sb), "v"(f8_sa)); \
        else { acc[ai][bj][m][n] = __builtin_amdgcn_mfma_f32_16x16x32_bf16(__builtin_bit_cast(bf16x8, __builtin_shufflevector(Bt[n], Bt[n], 0, 1, 2, 3)), __builtin_bit_cast(bf16x8, __builtin_shufflevector(At[m], At[m], 0, 1, 2, 3)), acc[ai][bj][m][n], 0, 0, 0); \
               acc[ai][bj][m][n] = __builtin_amdgcn_mfma_f32_16x16x32_bf16(__builtin_bit_cast(bf16x8, __builtin_shufflevector(Bt[n], Bt[n], 4, 5, 6, 7)), __builtin_bit_cast(bf16x8, __builtin_shufflevector(At[m], At[m], 4, 5, 6, 7)), acc[ai][bj][m][n], 0, 0, 0); } } \
        __builtin_amdgcn_s_setprio(0); } while (0)
#define G2_WAIT_V(n) asm volatile("s_waitcnt vmcnt(" #n ")" ::: "memory")
#define G2_WAIT_L(n) asm volatile("s_waitcnt lgkmcnt(" #n ")" ::: "memory")
#define G2_BAR __builtin_amdgcn_s_barrier()
#define G2_SCHED __builtin_amdgcn_sched_barrier(0)
    const int f8_sb = f8_scale_b, f8_sa = 127;
    typename Sched::Unit cur, nxt; int ui = 0;
    if (!S.next(0, cur)) return;
    f32x4 acc[2][2][4][2];
#pragma unroll
    for (int a = 0; a < 2; ++a)
#pragma unroll
        for (int b = 0; b < 2; ++b)
#pragma unroll
            for (int m = 0; m < 4; ++m)
#pragma unroll
                for (int n = 0; n < 2; ++n) acc[a][b][m][n] = (f32x4){0.f, 0.f, 0.f, 0.f};
    v8i_t At[4], B0[2], B1[2];
    unsigned vA0[2], vA1[2], vN0[2], vN1[2], vBc[2], vBN[2];
    int Kc = S.K(cur); asm volatile("" : "+s"(Kc)); int nt = Kc / BK;
    constexpr int HROWS = Epi::PERM ? 8 : HALF;
    size_t hc = (size_t)HROWS * Kc * 2, hN = hc;
#pragma unroll
    for (int i = 0; i < 2; ++i) { G2_RC(i, R, Rb, C2); vA0[i] = S.a_row_off(cur, R) + C2; vA1[i] = S.a_row_off(cur, HALF + R) + C2; vN0[i] = vA0[i]; vN1[i] = vA1[i];
        vBc[i] = (unsigned)(Rb * Kc) * 2u + C2; vBN[i] = vBc[i]; }
    const char* cA = S.a_base(cur);
    const char* cB = S.b_base(cur);
    G2_STAGE(G2_SB(0, 0), cB, vBc); G2_STAGE(G2_SB(0, 1), cB + hc, vBc); G2_STAGE(G2_SA(0, 0), cA, vA0); G2_STAGE(G2_SA(0, 1), cA, vA1);
    if (wr == 1) G2_BAR;
    G2_WAIT_V(2); G2_BAR;
    G2_STAGE(G2_SB(1, 0), cB + kstep, vBc); G2_STAGE(G2_SA(1, 0), cA + kstep, vA0); G2_STAGE(G2_SB(1, 1), cB + hc + kstep, vBc);
    G2_WAIT_V(6); G2_BAR;
    bool has_next = S.next(1, nxt);
    typename Sched::Unit nn;
    for (;;) {
        const bool has_nn = has_next ? S.next(ui + 2, nn) : false;
        const char* nA = has_next ? S.a_base(nxt) : cA; const char* nB = has_next ? S.b_base(nxt) : cB;
        int Kn = has_next ? S.K(nxt) : Kc; asm volatile("" : "+s"(Kn));
        unsigned vP0[2], vP1[2];
        if (has_next) {
#pragma unroll
            for (int i = 0; i < 2; ++i) { G2_RC(i, R, Rb, C2); (void)Rb; vP0[i] = S.a_row_off(nxt, R) + C2; vP1[i] = S.a_row_off(nxt, HALF + R) + C2; } }
        for (int t = 0; t < nt; t += 2) {
            const bool last = (t == nt - 2);
            const char* a1 = cA + (size_t)(t + 1) * kstep;
            const char* a2 = last ? nA : cA + (size_t)(t + 2) * kstep; const char* b2 = last ? nB : cB + (size_t)(t + 2) * kstep;
            const char* a3 = a2 + kstep; const char* b3 = b2 + kstep;
            if (last && has_next) { hN = (size_t)HROWS * Kn * 2;
#pragma unroll
                for (int i = 0; i < 2; ++i) { G2_RC(i, R, Rb, C2); (void)R; vN0[i] = vP0[i]; vN1[i] = vP1[i]; vBN[i] = (unsigned)(Rb * Kn) * 2u + C2; } }
            G2_LDB(B0, 0, 0); G2_LDB(B1, 0, 1); G2_SCHED; G2_LDA(At, 0, 0); G2_STAGE(G2_SA(1, 1), a1, vA1);
            G2_WAIT_V(8); G2_WAIT_L(0); G2_BAR; G2_MMA(0, 0, At, B0); G2_MMA(0, 1, At, B1); G2_BAR; G2_SCHED;
            G2_LDA(At, 0, 1); G2_STAGE(G2_SB(0, 0), b2, vBN); G2_STAGE(G2_SB(0, 1), b2 + hN, vBN); G2_STAGE(G2_SA(0, 0), a2, vN0);
            G2_WAIT_V(8); G2_WAIT_L(0); G2_BAR; G2_MMA(1, 0, At, B0); G2_MMA(1, 1, At, B1); G2_BAR; G2_SCHED;
            G2_LDB(B0, 1, 0); G2_LDB(B1, 1, 1); G2_SCHED; G2_LDA(At, 1, 0); G2_STAGE(G2_SA(0, 1), a2, vN1);
            G2_WAIT_V(8); G2_WAIT_L(0); G2_BAR; G2_MMA(0, 0, At, B0); G2_MMA(0, 1, At, B1); G2_BAR; G2_SCHED;
            G2_LDA(At, 1, 1); G2_STAGE(G2_SB(1, 0), b3, vBN); G2_STAGE(G2_SB(1, 1), b3 + hN, vBN); G2_STAGE(G2_SA(1, 0), a3, vN0);
            G2_WAIT_V(8); G2_WAIT_L(0); G2_BAR; G2_MMA(1, 0, At, B0); G2_MMA(1, 1, At, B1); G2_BAR; G2_SCHED;
        }
        if constexpr (ALIGN_EPI) { if (wr == 0) G2_BAR; }
        int t2 = threadIdx.x; asm volatile("" : "+v"(t2));
        const bool zero = E(acc, cur, wr, wc, t2 & 15, (t2 & 63) >> 4);
        if (!has_next) break;
        if (zero) {
#pragma unroll
        for (int a = 0; a < 2; ++a)
#pragma unroll
            for (int b = 0; b < 2; ++b)
#pragma unroll
                for (int m = 0; m < 4; ++m)
#pragma unroll
                    for (int n = 0; n < 2; ++n) acc[a][b][m][n] = (f32x4){0.f, 0.f, 0.f, 0.f};
        }
        cur = nxt; nxt = nn; has_next = has_nn; cA = nA; cB = nB; Kc = Kn; nt = Kc / BK; hc = hN; ++ui;
#pragma unroll
        for (int i = 0; i < 2; ++i) { vA0[i] = vN0[i]; vA1[i] = vN1[i]; vBc[i] = vBN[i]; }
        if constexpr (ALIGN_EPI) { if (wr == 1) G2_BAR; }
    }
    G2_WAIT_V(0);
    if constexpr (!ALIGN_EPI) { if (wr == 0) G2_BAR; }
    G2_BAR;
#undef G2_RC
#undef G2_SA
#undef G2_SB
#undef G2_STAGE
#undef G2_LDA
#undef G2_LDB
#undef G2_MMA
#undef G2_WAIT_V
#undef G2_WAIT_L
#undef G2_BAR
#undef G2_SCHED
}
}

__device__ __forceinline__ void tr_item(const float* __restrict__ W, int ldw, int k0, int n0src, bf16* WT, int Kd, int drow0, LAS float* scr, int lane) {
#pragma unroll 8
    for (int i = 0; i < 32; ++i) { const int kk = 2 * i + (lane >> 5); scr[kk * 33 + (lane & 31)] = W[(size_t)(k0 + kk) * ldw + n0src + (lane & 31)]; }
    asm volatile("s_waitcnt lgkmcnt(0)" ::: "memory");
    const int c = lane & 7;
#pragma unroll
    for (int j = 0; j < 4; ++j) { const int n = (lane >> 3) + 8 * j; const LAS float* sp = scr + (8 * c) * 33 + n;
        u32x4 o; o.x = pk2(sp[0 * 33], sp[1 * 33]); o.y = pk2(sp[2 * 33], sp[3 * 33]); o.z = pk2(sp[4 * 33], sp[5 * 33]); o.w = pk2(sp[6 * 33], sp[7 * 33]);
        *(u32x4*)(WT + (size_t)(drow0 + n) * Kd + k0 + 8 * c) = o; }
    asm volatile("s_waitcnt lgkmcnt(0)" ::: "memory");
}


__device__ __forceinline__ unsigned pk4_fp8(float a, float b, float c, float d) { int r = __builtin_amdgcn_cvt_pk_fp8_f32(a, b, 0, false); r = __builtin_amdgcn_cvt_pk_fp8_f32(c, d, r, true); return (unsigned)r; }
__device__ __forceinline__ void tr_item8p(const float* __restrict__ Wcol  , int ldw, int k0, unsigned char* WT, int Kd, int drow0, float sc, LAS float* scr, int lane) {
#pragma unroll 8
    for (int i = 0; i < 32; ++i) { const int kk = 2 * i + (lane >> 5); scr[kk * 33 + (lane & 31)] = Wcol[(size_t)(k0 + kk) * ldw] * sc; }
    asm volatile("s_waitcnt lgkmcnt(0)" ::: "memory");
    const int c = lane & 7;
#pragma unroll
    for (int j = 0; j < 4; ++j) { const int n = (lane >> 3) + 8 * j; const LAS float* sp = scr + (8 * c) * 33 + n;
        u32x2 o; o.x = pk4_fp8(sp[0 * 33], sp[1 * 33], sp[2 * 33], sp[3 * 33]); o.y = pk4_fp8(sp[4 * 33], sp[5 * 33], sp[6 * 33], sp[7 * 33]);
        *(u32x2*)(WT + (size_t)(drow0 + n) * Kd + k0 + 8 * c) = o; }
    asm volatile("s_waitcnt lgkmcnt(0)" ::: "memory");
}
__device__ __forceinline__ void tr_item8(const float* __restrict__ W, int ldw, int k0, int n0src, unsigned char* WT, int Kd, int drow0, float sc, LAS float* scr, int lane) {
    tr_item8p(W + n0src + (lane & 31), ldw, k0, WT, Kd, drow0, sc, scr, lane);
}
__device__ __forceinline__ void ph_cvt_small(Frame& F) {
    LAS float* scr = (LAS float*)(F.lds) + F.wave * (64 * 33);
    const int gw = blockIdx.x * NWAVES + F.wave, NGW = F.G * NWAVES;
    constexpr int I_IN = 16 * 232, I_BA = 4 * 32, I_BB = 16 * 32, I_OUT = 16 * 32, I_R = 16 * 8, I_SGU = 16 * 16, I_SD = 4 * 32;
    constexpr int NIT = I_IN + I_BA + I_BB + I_OUT + I_R + I_SGU + I_SD;
    for (int it = gw; it < NIT + 1; it += NGW) {
        int r = it;
        if (r < I_IN) { const int kb = r / 232, nb = r % 232, d0 = nb * 32; tr_item(F.in[I_WIN], INW, kb * 64, d0 < 5376 ? d0 : d0 + 8, (bf16*)(F.ws + WS_WIN_T), 1024, d0, scr, F.lane);
#if INPROJ_FP8
            tr_item8(F.in[I_WIN], INW, kb * 64, d0 < 5376 ? d0 : d0 + 8, F.ws + WS_WIN_T8, 1024, d0, 32.0f, scr, F.lane);
#endif
            continue; } r -= I_IN;
        if (r < I_BA) { const int kb = r / 32, nb = r % 32; tr_item(F.in[I_WBA], 1024, kb * 64, nb * 32, (bf16*)(F.ws + WS_WBA_T), 256, nb * 32, scr, F.lane); continue; } r -= I_BA;
        if (r < I_BB) { const int kb = r / 32, nb = r % 32; tr_item(F.in[I_WBB], 1024, kb * 64, nb * 32, (bf16*)(F.ws + WS_WBB_T), 1024, nb * 32, scr, F.lane); continue; } r -= I_BB;
        if (r < I_OUT) { const int kb = r / 32, nb = r % 32; tr_item(F.in[I_WOUT], 1024, kb * 64, nb * 32, (bf16*)(F.ws + WS_WOUT_T), 1024, nb * 32, scr, F.lane); continue; } r -= I_OUT;
        if (r < I_R) { const int kb = r / 8, nb = r % 8; tr_item(F.in[I_RW], 256, kb * 64, nb * 32, (bf16*)(F.ws + WS_WR_T), 1024, nb * 32, scr, F.lane); continue; } r -= I_R;
        if (r < I_SGU) { const int kb = r / 16, nb = r % 16, d0 = nb * 32, pn = d0 >> 8, q = d0 & 255; const bool up = q >= 128; const int src = pn * 128 + (q & 127);
            tr_item(up ? F.in[I_WSU] : F.in[I_WSG], 256, kb * 64, src, (bf16*)(F.ws + WS_WSGU_T), 1024, d0, scr, F.lane); continue; } r -= I_SGU;
        if (r < I_SD) { const int kb = r / 32, nb = r % 32; tr_item(F.in[I_WSD], 1024, kb * 64, nb * 32, (bf16*)(F.ws + WS_WSD_T), 256, nb * 32, scr, F.lane); continue; } r -= I_SD;
        { float* W8T = (float*)(F.ws + WS_W8T); const float* W = F.in[I_WIN];
          for (int i = F.lane; i < 8 * 1024; i += 64) { const int k = i >> 3, g = i & 7; W8T[i] = W[(size_t)k * INW + 5376 + g]; } }
    }
#if GATES_GEMM
    { bf16* WT = (bf16*)(F.ws + WS_WIN_T) + (size_t)7424 * 1024; const float* W = F.in[I_WIN];
      for (int i = blockIdx.x * NTHR + F.tid; i < 256 * 1024 / 8; i += F.G * NTHR) { const int rr = i >> 7, k0 = (i & 127) * 8; u32x4 o = (u32x4){0u, 0u, 0u, 0u};
          if (rr < 8) { float v[8];
#pragma unroll
              for (int e = 0; e < 8; ++e) v[e] = W[(size_t)(k0 + e) * INW + 5376 + rr];
              o.x = pk2(v[0], v[1]); o.y = pk2(v[2], v[3]); o.z = pk2(v[4], v[5]); o.w = pk2(v[6], v[7]); }
          *(u32x4*)(WT + (size_t)rr * 1024 + k0) = o; } }
#endif
}

__device__ __forceinline__ void ph_mod(Frame& F) {
    LAS float* scT = (LAS float*)F.lds;
    const float* c = F.in[I_C]; const float* W = F.in[I_WADA]; const float* bias = F.in[I_BADA];
    float* mod = (float*)(F.ws + WS_MOD);
    bool filled = false;
    for (int vb = blockIdx.x; vb < 96; vb += F.G) {
        __syncthreads();
        if (!filled) { for (int i = F.tid; i < 32 * 1024; i += NTHR) { const int b = i >> 10, k = i & 1023; const float v = c[i]; scT[k * 32 + b] = v / (1.0f + expf(-v)); } filled = true; }
        __syncthreads();
        const int n = vb * 64 + F.lane;
        float acc[32];
#pragma unroll
        for (int b = 0; b < 32; ++b) acc[b] = 0.f;
#pragma unroll 4
        for (int kk = 0; kk < 128; ++kk) { const int k = F.wave * 128 + kk;
            const float w = W[(size_t)k * 6144 + n];
#pragma unroll
            for (int b4 = 0; b4 < 8; ++b4) { const f32x4 sv = *(const LAS f32x4*)(scT + k * 32 + b4 * 4);
                acc[b4 * 4 + 0] += sv[0] * w; acc[b4 * 4 + 1] += sv[1] * w; acc[b4 * 4 + 2] += sv[2] * w; acc[b4 * 4 + 3] += sv[3] * w; } }
        __syncthreads();
        LAS float* part = (LAS float*)F.lds;
#pragma unroll
        for (int b = 0; b < 32; ++b) part[(F.wave * 32 + b) * 64 + F.lane] = acc[b];
        filled = false;
        __syncthreads();
        for (int i = F.tid; i < 32 * 64; i += NTHR) { const int b = i >> 6, col = i & 63; float sum = bias[vb * 64 + col];
#pragma unroll
            for (int w8 = 0; w8 < 8; ++w8) sum += part[(w8 * 32 + b) * 64 + col];
            mod[b * 6144 + vb * 64 + col] = sum; }
    }
}

__device__ __forceinline__ float wave_sum8(const float (&v)[8], int lane) {
    float a[4], b2[2], c;
#pragma unroll
    for (int i = 0; i < 4; ++i) { const float keep = (lane & 1) ? v[2 * i + 1] : v[2 * i], give = (lane & 1) ? v[2 * i] : v[2 * i + 1]; a[i] = keep + __shfl_xor(give, 1); }
#pragma unroll
    for (int i = 0; i < 2; ++i) { const float keep = (lane & 2) ? a[2 * i + 1] : a[2 * i], give = (lane & 2) ? a[2 * i] : a[2 * i + 1]; b2[i] = keep + __shfl_xor(give, 2); }
    { const float keep = (lane & 4) ? b2[1] : b2[0], give = (lane & 4) ? b2[0] : b2[1]; c = keep + __shfl_xor(give, 4); }
    c += __shfl_xor(c, 8); c += __shfl_xor(c, 16); c += __shfl_xor(c, 32);
    return c;
}
__device__ __forceinline__ void ph_norm1(Frame& F, int mode = 0) {
    const float* x = F.in[I_X]; const float* g = F.in[I_GPREMIX]; const float* mod = (const float*)(F.ws + WS_MOD);
    bf16* H = (bf16*)(F.outb + OUT_H);
    const float* W8T = (const float*)(F.ws + WS_W8T); float* GATES = (float*)(F.ws + WS_GATES); float* ROPE = (float*)(F.ws + WS_ROPE); const float* bg = F.in[I_BGATES];
    const float inv = powf(500000.0f, -(float)(F.lane & 7) / 8.0f); const float bgl = bg[F.lane & 7];
    for (int ci = blockIdx.x * NWAVES + F.wave; ci < T / 32; ci += F.G * NWAVES) {
        const int tb = ci * 32, b = tb / SEQ; const float* sh = mod + b * 6144, *scl = sh + 1024;
        f32x4 gs[4], h1[4];
#pragma unroll
        for (int j = 0; j < 4; ++j) { const int c = F.lane * 4 + 256 * j; const f32x4 gg = *(const f32x4*)(g + c), s1 = *(const f32x4*)(scl + c); h1[j] = *(const f32x4*)(sh + c); gs[j] = gg * (s1 + 1.0f); }
        f32x4 vn[4];
#pragma unroll
        for (int j = 0; j < 4; ++j) vn[j] = *(const f32x4*)(x + (size_t)tb * D + F.lane * 4 + 256 * j);
#pragma unroll 1
        for (int i = 0; i < 32; ++i) {
            const int t = tb + i;
            asm volatile("" ::: "memory");
            f32x4 v[4]; float ss = 0.f;
#pragma unroll
            for (int j = 0; j < 4; ++j) { v[j] = vn[j]; ss += v[j][0] * v[j][0] + v[j][1] * v[j][1] + v[j][2] * v[j][2] + v[j][3] * v[j][3]; }
            if (i + 1 < 32) {
#pragma unroll
                for (int j = 0; j < 4; ++j) vn[j] = *(const f32x4*)(x + (size_t)(t + 1) * D + F.lane * 4 + 256 * j); }
            const float rstd = rsqrtf(wave_sum(ss) * (1.0f / D) + EPS);
            float gacc[8];
#pragma unroll
            for (int gi = 0; gi < 8; ++gi) gacc[gi] = 0.f;
#pragma unroll
            for (int j = 0; j < 4; ++j) { const int c = F.lane * 4 + 256 * j;
                const f32x4 o = v[j] * rstd * gs[j] + h1[j];
                u32x2 w; w.x = pk2(o[0], o[1]); w.y = pk2(o[2], o[3]); *(u32x2*)(H + (size_t)t * D + c) = w;
#if INPROJ_FP8
                *(unsigned*)(F.ws + WS_H8 + (size_t)t * D + c) = pk4_fp8(o[0], o[1], o[2], o[3]);
#endif
                if (mode != 1 && !GATES_GEMM)
#pragma unroll
                for (int e = 0; e < 4; ++e) { const f32x4 wa = *(const f32x4*)(W8T + (size_t)(c + e) * 8), wb = *(const f32x4*)(W8T + (size_t)(c + e) * 8 + 4);
                    gacc[0] += o[e] * wa[0]; gacc[1] += o[e] * wa[1]; gacc[2] += o[e] * wa[2]; gacc[3] += o[e] * wa[3]; gacc[4] += o[e] * wb[0]; gacc[5] += o[e] * wb[1]; gacc[6] += o[e] * wb[2]; gacc[7] += o[e] * wb[3]; }
                asm volatile("" ::: "memory"); }
#if GATES_GEMM
            const float gsum = 0.f;
#else
            if (mode == 1) continue;
            const float gsum = wave_sum8(gacc, F.lane);
#endif
            const float ang = (float)F.pos[t] * inv; const float kk = rintf(ang * 0.15915494309189535f);
            float rv = fmaf(ang, 0.15915494309189535f, -kk); rv = fmaf(ang, 6.4206383e-9f, rv);
            if (F.lane < 8) { if (!GATES_GEMM) GATES[(size_t)t * 8 + F.lane] = gsum + bgl; ROPE[(size_t)t * 16 + F.lane] = __builtin_amdgcn_cosf(rv); ROPE[(size_t)t * 16 + 8 + F.lane] = __builtin_amdgcn_sinf(rv); }
        }
    }
}

__device__ __forceinline__ void ph_inproj_naive(Frame& F) {
    LAS float* As = (LAS float*)F.lds; LAS float* Bs = As + 16 * 132;
    const bf16* H = (const bf16*)(F.outb + OUT_H); const float* W = F.in[I_WIN]; const float* bg = F.in[I_BGATES];
    bf16* Q = (bf16*)(F.ws + WS_Q); bf16* Kt = (bf16*)(F.ws + WS_K); bf16* V = (bf16*)(F.ws + WS_V); bf16* MQK = (bf16*)(F.ws + WS_MQK); bf16* MV = (bf16*)(F.ws + WS_MV);
    bf16* MO = (bf16*)(F.ws + WS_MO); bf16* GAB = (bf16*)(F.ws + WS_GAB); float* GATES = (float*)(F.ws + WS_GATES);
    constexpr int NTN = (INW + 127) / 128;
    const int ty = F.tid >> 5, tx = F.tid & 31;
    for (int vb = blockIdx.x; vb < (T / 128) * NTN; vb += F.G) {
        const int tm = vb / NTN, tn = vb % NTN, m0 = tm * 128, n0 = tn * 128;
        float acc[8][4]; ZERO_ACC(acc);
        ARowGlobal ar{H, (size_t)D, m0, nullptr};
        ngemm_acc(As, Bs, ar, W, INW, D, n0, INW, acc);
#pragma unroll
        for (int i = 0; i < 8; ++i)
#pragma unroll
            for (int j = 0; j < 4; ++j) {
                const size_t row = (size_t)(m0 + ty * 8 + i); const int col = n0 + tx * 4 + j; const float v = acc[i][j];
                if (col < 768) Q[row * 768 + col] = (bf16)f2bf(v);
                else if (col < 1536) Kt[row * 768 + col - 768] = (bf16)f2bf(v);
                else if (col < 2304) V[row * 768 + col - 1536] = (bf16)f2bf(v);
                else if (col < 3328) MQK[row * 1024 + col - 2304] = (bf16)f2bf(v);
                else if (col < 4352) MV[row * 1024 + col - 3328] = (bf16)f2bf(v);
                else if (col < 5376) MO[row * 1024 + col - 4352] = (bf16)f2bf(v);
                else if (col < 5384) GATES[row * 8 + col - 5376] = v + bg[col - 5376];
                else if (col < INW) GAB[row * 2048 + col - 5384] = (bf16)f2bf(v);
            }
    }
}


__device__ __forceinline__ float fsig(float x) { return __builtin_amdgcn_rcpf(1.0f + __builtin_amdgcn_exp2f(-1.4426950408889634f * x)); }

__device__ __forceinline__ unsigned pk4_sig_u8(const f32x4 v) { int r = 0;
    r = __builtin_amdgcn_cvt_pk_u8_f32(256.0f * fsig(v[0]) - 0.5f, 0, r); r = __builtin_amdgcn_cvt_pk_u8_f32(256.0f * fsig(v[1]) - 0.5f, 1, r);
    r = __builtin_amdgcn_cvt_pk_u8_f32(256.0f * fsig(v[2]) - 0.5f, 2, r); r = __builtin_amdgcn_cvt_pk_u8_f32(256.0f * fsig(v[3]) - 0.5f, 3, r); return (unsigned)r; }
__device__ __forceinline__ f32x4 unpk4_sig_u8(unsigned w) { return (f32x4){((float)(w & 0xffu) + 0.5f) * (1.0f / 256.0f), ((float)((w >> 8) & 0xffu) + 0.5f) * (1.0f / 256.0f), ((float)((w >> 16) & 0xffu) + 0.5f) * (1.0f / 256.0f), ((float)(w >> 24) + 0.5f) * (1.0f / 256.0f)}; }
struct EpiInproj {
    static constexpr bool PERM = true;
    unsigned char* ws; const float* rope; int nostore; const float* bgates;
    __device__ __forceinline__ bool operator()(const f32x4 (&acc)[2][2][4][2], const g2::UnitMN& u, int wr, int wc, int fr, int fq) const {
        if (nostore == 1) { if (acc[0][0][0][0][0] == 123.456f) ws[0] = 1; return true; }
        const int pn = u.pn; size_t boff; int ld, colt;
        if (pn == 29) {
            if (wc == 0 && fq == 0) { float* GT = (float*)(ws + WS_GATES); const f32x4 b0 = *(const f32x4*)bgates, b1 = *(const f32x4*)(bgates + 4);
#pragma unroll
                for (int ai = 0; ai < 2; ++ai)
#pragma unroll
                    for (int m = 0; m < 4; ++m) { const size_t row = (size_t)(u.pm * 256 + wr * 64 + fr + ai * 128 + m * 16);
                        *(f32x4*)(GT + row * 8) = acc[ai][0][m][0] + b0; *(f32x4*)(GT + row * 8 + 4) = acc[ai][0][m][1] + b1; } }
            return true; }
        if (pn < 9) { boff = pn < 3 ? WS_Q : (pn < 6 ? WS_K : WS_V); ld = 768; colt = (pn % 3) * 256; }
        else if (pn < 13) { boff = WS_MQK; ld = 1024; colt = (pn - 9) * 256; }
        else if (pn < 17) { boff = WS_MV; ld = 1024; colt = (pn - 13) * 256; }
        else if (pn < 21) { boff = WS_MO; ld = 1024; colt = (pn - 17) * 256; }
        else { boff = WS_GAB; ld = 2048; colt = (pn - 21) * 256; }
        bf16* base = (bf16*)(ws + boff);
#if GATES_U8
        if (pn >= 17) {
            unsigned char* b8 = ws + (pn < 21 ? WS_MO : WS_GAB); const int ld8 = pn < 21 ? 1024 : 2048, col8 = (pn < 21 ? (pn - 17) : (pn - 21)) * 256 + wc * 64 + 16 * fq; const int row0g = u.pm * 256 + wr * 64 + fr;
#pragma unroll
            for (int ai = 0; ai < 2; ++ai)
#pragma unroll
                for (int m = 0; m < 4; ++m) { const size_t row = (size_t)(row0g + ai * 128 + m * 16);
                    u32x4 w; w.x = pk4_sig_u8(acc[ai][0][m][0]); w.y = pk4_sig_u8(acc[ai][0][m][1]); w.z = pk4_sig_u8(acc[ai][1][m][0]); w.w = pk4_sig_u8(acc[ai][1][m][1]);
                    __builtin_nontemporal_store(w, (u32x4*)(b8 + row * ld8 + col8)); }
            return true; }
#endif
        const bool do_rope = (pn < 6) && (fq == 0);
        const int row0 = u.pm * 256 + wr * 64 + fr, col0 = colt + wc * 64 + 16 * fq;
#pragma unroll
        for (int ai = 0; ai < 2; ++ai) {
            f32x4 rc[4][4];
            if (do_rope) {
#pragma unroll
                for (int m = 0; m < 4; ++m) { const f32x4* rp = (const f32x4*)(rope + (size_t)(row0 + ai * 128 + m * 16) * 16); rc[m][0] = rp[0]; rc[m][1] = rp[1]; rc[m][2] = rp[2]; rc[m][3] = rp[3]; } }
#pragma unroll
            for (int m = 0; m < 4; ++m) {
                const size_t row = (size_t)(row0 + ai * 128 + m * 16);
                f32x4 a0 = acc[ai][0][m][0], a1 = acc[ai][0][m][1], b0 = acc[ai][1][m][0], b1 = acc[ai][1][m][1];
                if (do_rope) { const f32x4 c0 = rc[m][0], c1 = rc[m][1], s0 = rc[m][2], s1 = rc[m][3];
                    const f32x4 x0 = a0 * c0 - b0 * s0, x1 = a1 * c1 - b1 * s1, y0 = b0 * c0 + a0 * s0, y1 = b1 * c1 + a1 * s1; a0 = x0; a1 = x1; b0 = y0; b1 = y1; }
                u32x4 w0, w1; w0.x = g2::cvt_pk_bf16(a0[0], a0[1]); w0.y = g2::cvt_pk_bf16(a0[2], a0[3]); w0.z = g2::cvt_pk_bf16(a1[0], a1[1]); w0.w = g2::cvt_pk_bf16(a1[2], a1[3]);
                w1.x = g2::cvt_pk_bf16(b0[0], b0[1]); w1.y = g2::cvt_pk_bf16(b0[2], b0[3]); w1.z = g2::cvt_pk_bf16(b1[0], b1[1]); w1.w = g2::cvt_pk_bf16(b1[2], b1[3]);
                __builtin_nontemporal_store(w0, (u32x4*)(base + row * ld + col0)); if (nostore != 2) __builtin_nontemporal_store(w1, (u32x4*)(base + row * ld + col0 + 8));
            } }
        return true;
    }
};
__device__ __forceinline__ void ph_inproj_fast(Frame& F, int nostore = 0) {
#if STAGGER_NS > 0
    {
      const unsigned long long t0 = __builtin_amdgcn_s_memrealtime(); const unsigned long long dl = (unsigned long long)((blockIdx.x >> 3) & 15) * (STAGGER_NS / 10) / 16;
      while (__builtin_amdgcn_s_memrealtime() - t0 < dl) __builtin_amdgcn_s_sleep(4); }
#endif
#if INPROJ_FP8
    { g2::DenseOrder S; S.init(T, 25 * 256, D / 2, F.ws + WS_H8, F.ws + WS_WIN_T8, F.G, (int)blockIdx.x); S.pncut = 9; S.pnskip = 4;
      EpiInproj E{F.ws, (const float*)(F.ws + WS_ROPE), nostore, F.in[I_BGATES]};
      g2::gemm_phase<EpiInproj, g2::DenseOrder, true>(F.lds, S, E, 127 - 5); }
#if GATES_GEMM
    { g2::DenseOrder S; S.init(T, 5 * 256, D, F.outb + OUT_H, F.ws + WS_WIN_T, F.G, (int)blockIdx.x); S.pnoff = 9; S.pncut = 4; S.pnskip = 16;
#else
    { g2::DenseOrder S; S.init(T, 4 * 256, D, F.outb + OUT_H, F.ws + WS_WIN_T, F.G, (int)blockIdx.x); S.pnoff = 9;
#endif
      EpiInproj E{F.ws, (const float*)(F.ws + WS_ROPE), nostore, F.in[I_BGATES]};
      g2::gemm_phase<EpiInproj, g2::DenseOrder>(F.lds, S, E); }
#else
    g2::DenseOrder S; S.init(T, 7424, D, F.outb + OUT_H, F.ws + WS_WIN_T, F.G, (int)blockIdx.x);
    EpiInproj E{F.ws, (const float*)(F.ws + WS_ROPE), nostore, F.in[I_BGATES]};
    g2::gemm_phase<EpiInproj, g2::DenseOrder>(F.lds, S, E);
#endif
}


__device__ __forceinline__ void unpack8(const u32x4 w, float (&o)[8]) {
#pragma unroll
    for (int e = 0; e < 4; ++e) { o[2 * e] = __uint_as_float(w[e] << 16); o[2 * e + 1] = __uint_as_float(w[e] & 0xffff0000u); }
}
struct UnitBr { int pm, pn, sub; };
struct BranchOrder {
    typedef UnitBr Unit;
    g2::DenseOrder d; const char *YA, *YB, *WA, *WB;
    __device__ __forceinline__ bool next(int i, Unit& u) const { g2::UnitMN t; if (!d.next(i >> 1, t)) return false; u.pm = t.pm; u.pn = t.pn; u.sub = i & 1; return true; }
    __device__ __forceinline__ int K(const Unit& u) const { return u.sub ? 1024 : 256; }
    __device__ __forceinline__ const char* a_base(const Unit& u) const { return u.sub ? YB : YA; }
    __device__ __forceinline__ unsigned a_row_off(const Unit& u, int r) const { return (unsigned)(u.pm * 256 + r) * (u.sub ? 2048u : 512u); }
    __device__ __forceinline__ const char* b_base(const Unit& u) const { return u.sub ? WB + (size_t)u.pn * 256 * 2048 : WA + (size_t)u.pn * 256 * 512; }
};
struct EpiBranch {
    static constexpr bool PERM = true;
    const bf16* GAB; bf16* MG;
    __device__ __forceinline__ bool operator()(f32x4 (&acc)[2][2][4][2], const UnitBr& u, int wr, int wc, int fr, int fq) const {
        const int row0 = u.pm * 256 + wr * 64 + fr, col0 = u.pn * 256 + wc * 64 + 16 * fq;
#pragma unroll
        for (int ai = 0; ai < 2; ++ai)
#pragma unroll
            for (int m = 0; m < 4; ++m) { const size_t row = (size_t)(row0 + ai * 128 + m * 16);
                u32x4 wout[2];
#if GATES_U8
                { const unsigned char* g8 = (const unsigned char*)GAB + row * 2048 + col0; const u32x4 gbq = *(const u32x4*)(g8 + 1024);
                  if (u.sub == 0) { const u32x4 gaq = *(const u32x4*)g8;
#pragma unroll
                      for (int bj = 0; bj < 2; ++bj)
#pragma unroll
                          for (int n = 0; n < 2; ++n) { const f32x4 sa = unpk4_sig_u8(gaq[2 * bj + n]), sb = unpk4_sig_u8(gbq[2 * bj + n]);
#pragma unroll
                              for (int e = 0; e < 4; ++e) acc[ai][bj][m][n][e] *= sa[e] * __builtin_amdgcn_rcpf(sb[e]); } }
                  else {
#pragma unroll
                      for (int bj = 0; bj < 2; ++bj) { const f32x4 s0 = unpk4_sig_u8(gbq[2 * bj]), s1 = unpk4_sig_u8(gbq[2 * bj + 1]); const f32x4 v0 = acc[ai][bj][m][0] * s0, v1 = acc[ai][bj][m][1] * s1;
                          wout[bj].x = g2::cvt_pk_bf16(v0[0], v0[1]); wout[bj].y = g2::cvt_pk_bf16(v0[2], v0[3]); wout[bj].z = g2::cvt_pk_bf16(v1[0], v1[1]); wout[bj].w = g2::cvt_pk_bf16(v1[2], v1[3]); } } }
#else
#pragma unroll
                for (int bj = 0; bj < 2; ++bj) { const int col = col0 + 8 * bj;
                    float gb[8]; unpack8(*(const u32x4*)(GAB + row * 2048 + 1024 + col), gb);
                    if (u.sub == 0) { float ga[8]; unpack8(*(const u32x4*)(GAB + row * 2048 + col), ga);
#pragma unroll
                        for (int e = 0; e < 4; ++e) { acc[ai][bj][m][0][e] *= fsig(ga[e]) * (1.0f + __builtin_amdgcn_exp2f(-1.4426950408889634f * gb[e]));
                                                      acc[ai][bj][m][1][e] *= fsig(ga[4 + e]) * (1.0f + __builtin_amdgcn_exp2f(-1.4426950408889634f * gb[4 + e])); } }
                    else { f32x4 v0, v1;
#pragma unroll
                        for (int e = 0; e < 4; ++e) { v0[e] = acc[ai][bj][m][0][e] * fsig(gb[e]); v1[e] = acc[ai][bj][m][1][e] * fsig(gb[4 + e]); }
                        wout[bj].x = g2::cvt_pk_bf16(v0[0], v0[1]); wout[bj].y = g2::cvt_pk_bf16(v0[2], v0[3]); wout[bj].z = g2::cvt_pk_bf16(v1[0], v1[1]); wout[bj].w = g2::cvt_pk_bf16(v1[2], v1[3]); } }
#endif
                if (u.sub != 0) { *(u32x4*)(MG + row * 1024 + col0) = wout[0]; *(u32x4*)(MG + row * 1024 + col0 + 8) = wout[1]; } }
        return u.sub != 0;
    }
};
__device__ __forceinline__ void ph_branch_fast(Frame& F) {
    BranchOrder S; S.d.init(T, 1024, 1024, nullptr, nullptr, F.G, (int)blockIdx.x);
    S.YA = (const char*)(F.outb + OUT_YA); S.YB = (const char*)(F.outb + OUT_YB); S.WA = (const char*)(F.ws + WS_WBA_T); S.WB = (const char*)(F.ws + WS_WBB_T);
    EpiBranch E{(const bf16*)(F.ws + WS_GAB), (bf16*)(F.ws + WS_MERGED)};
    g2::gemm_phase<EpiBranch, BranchOrder>(F.lds, S, E);
}
struct EpiBf16Plain {
    static constexpr bool PERM = true;
    bf16* O; int ld;
    __device__ __forceinline__ bool operator()(const f32x4 (&acc)[2][2][4][2], const g2::UnitMN& u, int wr, int wc, int fr, int fq) const {
        const int row0 = u.pm * 256 + wr * 64 + fr, col0 = u.pn * 256 + wc * 64 + 16 * fq;
#pragma unroll
        for (int ai = 0; ai < 2; ++ai)
#pragma unroll
            for (int m = 0; m < 4; ++m) { bf16* rp = O + (size_t)(row0 + ai * 128 + m * 16) * ld + col0;
#pragma unroll
                for (int bj = 0; bj < 2; ++bj) { const f32x4 v0 = acc[ai][bj][m][0], v1 = acc[ai][bj][m][1];
                    u32x4 w; w.x = g2::cvt_pk_bf16(v0[0], v0[1]); w.y = g2::cvt_pk_bf16(v0[2], v0[3]); w.z = g2::cvt_pk_bf16(v1[0], v1[1]); w.w = g2::cvt_pk_bf16(v1[2], v1[3]);
                    *(u32x4*)(rp + bj * 8) = w; } }
        return true;
    }
};
struct EpiF32Plain {
    static constexpr bool PERM = false;
    float* O; int ld;
    __device__ __forceinline__ bool operator()(const f32x4 (&acc)[2][2][4][2], const g2::UnitMN& u, int wr, int wc, int fr, int fq) const {
        const int row0 = u.pm * 256 + wr * 64 + fr, col0 = u.pn * 256 + wc * 32 + 4 * fq;
#pragma unroll
        for (int ai = 0; ai < 2; ++ai)
#pragma unroll
            for (int m = 0; m < 4; ++m) { float* rp = O + (size_t)(row0 + ai * 128 + m * 16) * ld + col0;
#pragma unroll
                for (int bj = 0; bj < 2; ++bj)
#pragma unroll
                    for (int n = 0; n < 2; ++n) *(f32x4*)(rp + bj * 128 + n * 16) = acc[ai][bj][m][n]; }
        return true;
    }
};
__device__ __forceinline__ void ph_outproj_fast(Frame& F) {
    g2::DenseOrder S; S.init(T, 1024, 1024, F.ws + WS_MERGED, F.ws + WS_WOUT_T, F.G, (int)blockIdx.x);
    EpiBf16Plain E{(bf16*)(F.ws + WS_YMIX), 1024};
    g2::gemm_phase<EpiBf16Plain, g2::DenseOrder>(F.lds, S, E);
}
__device__ __forceinline__ void ph_router_fast(Frame& F);
template <class BlockIter> __device__ __forceinline__ void ph_topk4(Frame& F, const BlockIter& BI);
__device__ __forceinline__ void ph_router_fast(Frame& F) {
    g2::DenseOrder S; S.init(T, 256, 1024, F.ws + WS_H2, F.ws + WS_WR_T, F.G, (int)blockIdx.x);
    EpiF32Plain E{(float*)(F.ws + WS_LOGITS), 256};
    g2::gemm_phase<EpiF32Plain, g2::DenseOrder>(F.lds, S, E);
}
__device__ __forceinline__ void ph_cvt_experts(Frame& F) {
    LAS float* scr = (LAS float*)(F.lds) + F.wave * (64 * 33);
    const int gw = blockIdx.x * NWAVES + F.wave, NGW = F.G * NWAVES;
    for (int it = gw; it < NE * 384; it += NGW) {
        const int e = it / 384, r = it % 384;
        if (r < 256) { const int kb = r >> 4, nb = r & 15, d0 = nb * 32, pn = d0 >> 8, q = d0 & 255; const bool up = q >= 128; const int src = pn * 128 + (q & 127);
            tr_item((up ? F.in[I_WEU] : F.in[I_WEG]) + (size_t)e * 1024 * 256, 256, kb * 64, src, (bf16*)(F.ws + WS_WGU) + (size_t)e * 512 * 1024, 1024, d0, scr, F.lane); }
        else { const int q = r - 256, kb = q >> 5, nb = q & 31;
            tr_item(F.in[I_WED] + (size_t)e * 256 * 1024, 1024, kb * 64, nb * 32, (bf16*)(F.ws + WS_WD) + (size_t)e * 1024 * 256, 256, nb * 32, scr, F.lane); }
    }
}

constexpr int CVT_BATCH = 128, CVT_NBATCH = (NE + 1) * 384 / CVT_BATCH;
__device__ __forceinline__ void cvt_experts8_batch(Frame& F, int batch) {
    LAS float* scr = (LAS float*)(F.lds) + F.wave * (64 * 33);
    for (int it = batch * CVT_BATCH + F.wave; it < (batch + 1) * CVT_BATCH; it += NWAVES) {
        const int e = it / 384, r = it % 384; const bool sh = e == NE;
        if (r < 256) { const int kb = r >> 4, nb = r & 15, d0 = nb * 32, pn = d0 >> 8;
            const int cc = (d0 & 255) + (F.lane & 31); const bool up = (cc >> 3) & 1; const int col = pn * 128 + 8 * (cc >> 4) + (cc & 7);
            const float* pg = sh ? F.in[I_WSG] : F.in[I_WEG] + (size_t)e * 1024 * 256; const float* pu = sh ? F.in[I_WSU] : F.in[I_WEU] + (size_t)e * 1024 * 256;
            const float* W = (up ? pu : pg) + col;
            tr_item8p(W, 256, kb * 64, sh ? F.ws + WS_WSGU8 : F.ws + WS_WGU8 + (size_t)e * 512 * 1024, 1024, d0, 32.0f, scr, F.lane); }
        else { const int q = r - 256, kb = q >> 5, nb = q & 31;
            const float* W = sh ? F.in[I_WSD] : F.in[I_WED] + (size_t)e * 256 * 1024;
            tr_item8(W, 1024, kb * 64, nb * 32, sh ? F.ws + WS_WSD8 : F.ws + WS_WD8 + (size_t)e * 1024 * 256, 256, nb * 32, 16.0f, scr, F.lane); }
    }
}
struct UnitEx { int u, sub, e; };
struct GuOrder {
    typedef UnitEx Unit;
    int NT, nun, G, vcu; const int* UNITEXP; const int* ROWTOK; const char *H2, *WGU, *WSGU;
    __device__ __forceinline__ bool next(int i, Unit& x) const { const int L = i * G + vcu; if (L >= nun) return false; x.u = L >> 1; x.sub = L & 1; x.e = x.u < NT ? UNITEXP[x.u] : -1; return true; }
    __device__ __forceinline__ int K(const Unit&) const { return 1024; }
    __device__ __forceinline__ const char* a_base(const Unit&) const { return H2; }
    __device__ __forceinline__ unsigned a_row_off(const Unit& x, int r) const { return (unsigned)ROWTOK[(unsigned)(x.u * 256 + r)] * 2048u; }
    __device__ __forceinline__ const char* b_base(const Unit& x) const { return (x.e >= 0 ? WGU + (size_t)x.e * (512 * 1024 * 2) : WSGU) + (size_t)x.sub * (256 * 1024 * 2); }
};
struct EpiGu {
    static constexpr bool PERM = true;
    int NT; bf16 *HIDR, *HIDS;
    __device__ __forceinline__ bool operator()(const f32x4 (&acc)[2][2][4][2], const UnitEx& x, int wr, int wc, int fr, int fq) const {
        bf16* base = x.e >= 0 ? HIDR + (size_t)x.u * 256 * 256 : HIDS + (size_t)(x.u - NT) * 256 * 256;
        const int row0 = wr * 64 + fr, col0 = x.sub * 128 + wc * 32 + 8 * fq;
#pragma unroll
        for (int ai = 0; ai < 2; ++ai)
#pragma unroll
            for (int m = 0; m < 4; ++m) { const f32x4 g0 = acc[ai][0][m][0], g1 = acc[ai][0][m][1], u0 = acc[ai][1][m][0], u1 = acc[ai][1][m][1]; f32x4 h0, h1;
#pragma unroll
                for (int e = 0; e < 4; ++e) { h0[e] = g0[e] * fsig(g0[e]) * u0[e]; h1[e] = g1[e] * fsig(g1[e]) * u1[e]; }
                u32x4 w; w.x = g2::cvt_pk_bf16(h0[0], h0[1]); w.y = g2::cvt_pk_bf16(h0[2], h0[3]); w.z = g2::cvt_pk_bf16(h1[0], h1[1]); w.w = g2::cvt_pk_bf16(h1[2], h1[3]);
                *(u32x4*)(base + (size_t)(row0 + ai * 128 + m * 16) * 256 + col0) = w; asm volatile("" ::: "memory"); }
        return true;
    }
};
struct DownOrder {
    typedef UnitEx Unit;
    int NT, nun, G, vcu; const int* UNITEXP; const char *HIDR, *HIDS, *WD, *WSD;
    __device__ __forceinline__ bool next(int i, Unit& x) const { const int L = i * G + vcu; if (L >= nun) return false; x.u = L >> 2; x.sub = L & 3; x.e = x.u < NT ? UNITEXP[x.u] : -1; return true; }
    __device__ __forceinline__ int K(const Unit&) const { return 256; }
    __device__ __forceinline__ const char* a_base(const Unit& x) const { return x.e >= 0 ? HIDR : HIDS; }
    __device__ __forceinline__ unsigned a_row_off(const Unit& x, int r) const { return (unsigned)((x.e >= 0 ? x.u : x.u - NT) * 256 + r) * 512u; }
    __device__ __forceinline__ const char* b_base(const Unit& x) const { return (x.e >= 0 ? WD + (size_t)x.e * (1024 * 256 * 2) : WSD) + (size_t)x.sub * (256 * 256 * 2); }
};
struct EpiDown {
    static constexpr bool PERM = false;
    const int* ROWTOK; const float* ROWW; float* out;
    __device__ __forceinline__ bool operator()(const f32x4 (&acc)[2][2][4][2], const UnitEx& x, int wr, int wc, int fr, int fq) const {
        const int row0 = x.u * 256 + wr * 64 + fr; const unsigned col0 = (unsigned)(x.sub * 256 + wc * 32 + 4 * fq);
#pragma unroll
        for (int ai = 0; ai < 2; ++ai)
#pragma unroll
            for (int m = 0; m < 4; ++m) { const int r = row0 + ai * 128 + m * 16; const unsigned tok = (unsigned)ROWTOK[r]; const float w = ROWW[r];
                const unsigned off = tok * 1024u + col0;
#pragma unroll
                for (int bj = 0; bj < 2; ++bj)
#pragma unroll
                    for (int n = 0; n < 2; ++n)
#pragma unroll
                        for (int e = 0; e < 4; ++e) unsafeAtomicAdd(out + (off + (unsigned)(bj * 128 + n * 16 + e)), acc[ai][bj][m][n][e] * w);
                asm volatile("" ::: "memory"); }
        return true;
    }
};
__device__ __forceinline__ void ph_gu_fast(Frame& F) {
    const int NT = (int)__hip_atomic_load(F.ctl + CW_NT, __ATOMIC_RELAXED, __HIP_MEMORY_SCOPE_AGENT);
    const int bx = blockIdx.x; const int vcu = (F.G % 8 == 0) ? (bx % 8) * (F.G / 8) + bx / 8 : bx;
    GuOrder S{NT, 2 * (NT + T / 256), F.G, vcu, (const int*)(F.ws + WS_UNITEXP), (const int*)(F.ws + WS_ROWTOK), (const char*)(F.ws + WS_H2), (const char*)(F.ws + WS_WGU), (const char*)(F.ws + WS_WSGU_T)};
    EpiGu E{NT, (bf16*)(F.ws + WS_HIDR), (bf16*)(F.ws + WS_HIDS)};
    g2::gemm_phase<EpiGu, GuOrder>(F.lds, S, E);
}
__device__ __forceinline__ void ph_down_fast(Frame& F) {
    const int NT = (int)__hip_atomic_load(F.ctl + CW_NT, __ATOMIC_RELAXED, __HIP_MEMORY_SCOPE_AGENT);
    const int bx = blockIdx.x; const int vcu = (F.G % 8 == 0) ? (bx % 8) * (F.G / 8) + bx / 8 : bx;
    DownOrder S{NT, 4 * (NT + T / 256), F.G, vcu, (const int*)(F.ws + WS_UNITEXP), (const char*)(F.ws + WS_HIDR), (const char*)(F.ws + WS_HIDS), (const char*)(F.ws + WS_WD), (const char*)(F.ws + WS_WSD_T)};
    EpiDown E{(const int*)(F.ws + WS_ROWTOK), (const float*)(F.ws + WS_ROWW), F.out};
    g2::gemm_phase<EpiDown, DownOrder>(F.lds, S, E);
}


__device__ __forceinline__ void ph_rope_naive(Frame& F) {
    bf16* Q = (bf16*)(F.ws + WS_Q); bf16* Kt = (bf16*)(F.ws + WS_K);
    for (int t = blockIdx.x * NWAVES + F.wave; t < T; t += F.G * NWAVES) {
        const float p = (float)F.pos[t];
#pragma unroll
        for (int r = 0; r < 3; ++r) {
            const int it = r * 64 + F.lane;
            const int i = it & 7, head = (it >> 3) % 12, qk = it / 96;
            const float inv = powf(500000.0f, -(float)i / 8.0f);
            const float ang = p * inv; const float cs = cosf(ang), sn = sinf(ang);
            bf16* base = (qk ? Kt : Q) + (size_t)t * 768 + head * 64;
            const float x1 = bf2f(base[i]), x2 = bf2f(base[i + 8]);
            base[i] = (bf16)f2bf(x1 * cs - x2 * sn); base[i + 8] = (bf16)f2bf(x2 * cs + x1 * sn);
        }
    }
}

__device__ __forceinline__ void ph_attn_naive_block(Frame& F, int vb) {
    const bf16* Q = (const bf16*)(F.ws + WS_Q); const bf16* Kt = (const bf16*)(F.ws + WS_K); const bf16* V = (const bf16*)(F.ws + WS_V);
    bf16* YA = (bf16*)(F.outb + OUT_YA);
    const int item = vb * NTHR + F.tid; const int t = item >> 2, j = item & 3; const int b = t / SEQ, s = t % SEQ;
    float acc[64];
#pragma unroll
    for (int d = 0; d < 64; ++d) acc[d] = 0.f;
    float m = -INFINITY, l = 0.f;
    for (int g = 0; g < 3; ++g) {
        const int dil = (g == 0) ? 1 : (g == 1) ? 4 : 16; const int head = g * 4 + j;
        float q[64];
        { const u32x4* qp = (const u32x4*)(Q + (size_t)t * 768 + head * 64);
#pragma unroll
          for (int c = 0; c < 8; ++c) { const u32x4 w = qp[c];
#pragma unroll
              for (int e = 0; e < 4; ++e) { q[c * 8 + 2 * e] = __uint_as_float(w[e] << 16) * 0.125f; q[c * 8 + 2 * e + 1] = __uint_as_float(w[e] & 0xffff0000u) * 0.125f; } } }
        const int lq = s / dil; const int nk = (lq < 128 ? lq : 128) + 1;
        for (int jj = 0; jj < nk; ++jj) {
            const size_t tk = (size_t)b * SEQ + (s - jj * dil);
            const u32x4* kp = (const u32x4*)(Kt + tk * 768 + head * 64);
            float dot = 0.f;
#pragma unroll
            for (int c = 0; c < 8; ++c) { const u32x4 w = kp[c];
#pragma unroll
                for (int e = 0; e < 4; ++e) { dot += q[c * 8 + 2 * e] * __uint_as_float(w[e] << 16); dot += q[c * 8 + 2 * e + 1] * __uint_as_float(w[e] & 0xffff0000u); } }
            const float mn = fmaxf(m, dot); const float corr = expf(m - mn), p = expf(dot - mn);
            l = l * corr + p; m = mn;
            const u32x4* vp = (const u32x4*)(V + tk * 768 + head * 64);
#pragma unroll
            for (int c = 0; c < 8; ++c) { const u32x4 w = vp[c];
#pragma unroll
                for (int e = 0; e < 4; ++e) { acc[c * 8 + 2 * e] = acc[c * 8 + 2 * e] * corr + p * __uint_as_float(w[e] << 16); acc[c * 8 + 2 * e + 1] = acc[c * 8 + 2 * e + 1] * corr + p * __uint_as_float(w[e] & 0xffff0000u); } }
        }
    }
    const float rl = 1.0f / l;
    u32x4* op = (u32x4*)(YA + (size_t)t * 256 + j * 64);
#pragma unroll
    for (int c = 0; c < 8; ++c) { u32x4 w;
#pragma unroll
        for (int e = 0; e < 4; ++e) w[e] = pk2(acc[c * 8 + 2 * e] * rl, acc[c * 8 + 2 * e + 1] * rl);
        op[c] = w; }
}


typedef short v4i16_t __attribute__((ext_vector_type(4)));
typedef short bf16x8_t __attribute__((ext_vector_type(8)));
constexpr int ATT_RS = 144;
constexpr int ATT_ROWS = 272;
constexpr int ATT_UNITS = 48 * 128;
__device__ __forceinline__ void attn_unit_fast(Frame& F, int uidx) {
    const int bj = uidx / 48, r48 = uidx % 48, b = bj >> 2, j = bj & 3, g = r48 >> 4, q16 = r48 & 15;
    const int dil = (g == 0) ? 1 : (g == 1) ? 4 : 16;
    const int rho = (g == 0) ? 0 : (g == 1) ? (q16 >> 2) : q16, n = (g == 0) ? q16 : (g == 1) ? (q16 & 3) : 0;
    const int head = g * 4 + j;
    const bf16* Q = (const bf16*)(F.ws + WS_Q); const bf16* Kg = (const bf16*)(F.ws + WS_K); const bf16* Vg = (const bf16*)(F.ws + WS_V);
    bf16* OG = (bf16*)(F.outb + OUT_OG) + (size_t)g * T * 256; float* LSE = (float*)(F.ws + WS_LSE) + (size_t)g * T * 4;
    LAS unsigned char* Kt = F.lds; LAS unsigned char* Vt = F.lds + ATT_ROWS * ATT_RS;
    const int tid = F.tid, lane = F.lane, w = F.wave, ql = lane & 15, g4 = lane >> 4;
    __syncthreads();
#pragma unroll
    for (int i = 0; i < 4; ++i) { const int p = tid + NTHR * i, row = p >> 3, c = p & 7; const int lk = (n - 1) * 128 + row;
        u32x4 kv = (u32x4){0u, 0u, 0u, 0u}, vv = kv;
        if (lk >= 0) { const size_t off = ((size_t)b * SEQ + (size_t)lk * dil + rho) * 768 + head * 64 + c * 8; kv = *(const u32x4*)(Kg + off); vv = *(const u32x4*)(Vg + off); }
        *(LAS u32x4*)(Kt + row * ATT_RS + c * 16) = kv; *(LAS u32x4*)(Vt + row * ATT_RS + c * 16) = vv; }
    if (tid < 128) { const int row = 256 + (tid >> 3), c = tid & 7; *(LAS u32x4*)(Kt + row * ATT_RS + c * 16) = (u32x4){0u, 0u, 0u, 0u}; *(LAS u32x4*)(Vt + row * ATT_RS + c * 16) = (u32x4){0u, 0u, 0u, 0u}; }
    const int qi = 16 * w + ql; const size_t tq = (size_t)b * SEQ + (size_t)(n * 128 + qi) * dil + rho;
    bf16x8_t Qf[2];
#pragma unroll
    for (int ks = 0; ks < 2; ++ks) Qf[ks] = *(const bf16x8_t*)(Q + tq * 768 + head * 64 + 32 * ks + 8 * g4);
    __syncthreads();
    f32x4 O[4];
#pragma unroll
    for (int dt = 0; dt < 4; ++dt) O[dt] = (f32x4){0.f, 0.f, 0.f, 0.f};
    float m = -INFINITY, lsum = 0.f;
    const float SC = 0.125f * 1.4426950408889634f;
    const int qq = ql >> 2, pp4 = ql & 3;
#pragma unroll 1
    for (int pp = 4; pp >= 0; --pp) {
        const int t0 = w + 2 * pp, t1 = t0 + 1;
        f32x4 S0 = (f32x4){0.f, 0.f, 0.f, 0.f}, S1 = S0;
#pragma unroll
        for (int ks = 0; ks < 2; ++ks) {
            const bf16x8_t k0 = *(const LAS bf16x8_t*)(Kt + (16 * t0 + ql) * ATT_RS + (32 * ks + 8 * g4) * 2);
            const bf16x8_t k1 = *(const LAS bf16x8_t*)(Kt + (16 * t1 + ql) * ATT_RS + (32 * ks + 8 * g4) * 2);
            S0 = __builtin_amdgcn_mfma_f32_16x16x32_bf16(k0, Qf[ks], S0, 0, 0, 0);
            S1 = __builtin_amdgcn_mfma_f32_16x16x32_bf16(k1, Qf[ks], S1, 0, 0, 0);
        }
        float tmax = -INFINITY;
#pragma unroll
        for (int r = 0; r < 4; ++r) {
            const int k0i = 16 * t0 + 4 * g4 + r, k1i = k0i + 16;
            const bool v0 = (k0i >= qi) && (k0i <= qi + 128) && (n > 0 || k0i >= 128), v1 = (k1i >= qi) && (k1i <= qi + 128) && (n > 0 || k1i >= 128);
            S0[r] = v0 ? S0[r] * SC : -INFINITY; S1[r] = v1 ? S1[r] * SC : -INFINITY;
            tmax = fmaxf(tmax, fmaxf(S0[r], S1[r]));
        }
        tmax = fmaxf(tmax, __shfl_xor(tmax, 16)); tmax = fmaxf(tmax, __shfl_xor(tmax, 32));
        const float mn = fmaxf(m, tmax);
        const float corr = __builtin_amdgcn_exp2f(m - mn); m = mn;
        float ps = 0.f; float p0[4], p1[4];
#pragma unroll
        for (int r = 0; r < 4; ++r) { p0[r] = __builtin_amdgcn_exp2f(S0[r] - mn); p1[r] = __builtin_amdgcn_exp2f(S1[r] - mn); ps += p0[r] + p1[r]; }
        lsum = lsum * corr + ps;
        u32x4 pk; pk.x = g2::cvt_pk_bf16(p0[0], p0[1]); pk.y = g2::cvt_pk_bf16(p0[2], p0[3]); pk.z = g2::cvt_pk_bf16(p1[0], p1[1]); pk.w = g2::cvt_pk_bf16(p1[2], p1[3]);
        const bf16x8_t Pf = __builtin_bit_cast(bf16x8_t, pk);
#pragma unroll
        for (int dt = 0; dt < 4; ++dt) {
            O[dt] = O[dt] * corr;
            const v4i16_t lo = __builtin_amdgcn_ds_read_tr16_b64_v4i16((LAS v4i16_t*)(Vt + (16 * t0 + 4 * g4 + qq) * ATT_RS + (16 * dt + 4 * pp4) * 2));
            const v4i16_t hi = __builtin_amdgcn_ds_read_tr16_b64_v4i16((LAS v4i16_t*)(Vt + (16 * t1 + 4 * g4 + qq) * ATT_RS + (16 * dt + 4 * pp4) * 2));
            const bf16x8_t Vf = __builtin_shufflevector(lo, hi, 0, 1, 2, 3, 4, 5, 6, 7);
            O[dt] = __builtin_amdgcn_mfma_f32_16x16x32_bf16(Vf, Pf, O[dt], 0, 0, 0);
        }
    }
    lsum += __shfl_xor(lsum, 16); lsum += __shfl_xor(lsum, 32);
    const float rl = 1.0f / lsum;
#pragma unroll
    for (int dt = 0; dt < 4; ++dt) { u32x2 o; o.x = g2::cvt_pk_bf16(O[dt][0] * rl, O[dt][1] * rl); o.y = g2::cvt_pk_bf16(O[dt][2] * rl, O[dt][3] * rl);
        *(u32x2*)(OG + tq * 256 + j * 64 + 16 * dt + 4 * g4) = o; }
    if (g4 == 0) LSE[tq * 4 + j] = m + __builtin_amdgcn_logf(lsum);
}
struct AttU { int b, j, g, dil, rho, n, head; };
__device__ __forceinline__ AttU att_unit(int uidx) { AttU u; const int bj = uidx / 48, r48 = uidx % 48; u.b = bj >> 2; u.j = bj & 3; u.g = r48 >> 4; const int q16 = r48 & 15;
    u.dil = (u.g == 0) ? 1 : (u.g == 1) ? 4 : 16; u.rho = (u.g == 0) ? 0 : (u.g == 1) ? (q16 >> 2) : q16; u.n = (u.g == 0) ? q16 : (u.g == 1) ? (q16 & 3) : 0; u.head = u.g * 4 + u.j; return u; }
struct AttR { u32x4 kv[4], vv[4]; bf16x8_t q[2]; };
__device__ __forceinline__ void att_load(Frame& F, const AttU& u, AttR& R) {
    const bf16* Q = (const bf16*)(F.ws + WS_Q); const bf16* Kg = (const bf16*)(F.ws + WS_K); const bf16* Vg = (const bf16*)(F.ws + WS_V);
#pragma unroll
    for (int i = 0; i < 4; ++i) { const int p = F.tid + NTHR * i, row = p >> 3, c = p & 7; const int lk = (u.n - 1) * 128 + row;
        R.kv[i] = (u32x4){0u, 0u, 0u, 0u}; R.vv[i] = R.kv[i];
        if (lk >= 0) { const size_t off = ((size_t)u.b * SEQ + (size_t)lk * u.dil + u.rho) * 768 + u.head * 64 + c * 8; R.kv[i] = *(const u32x4*)(Kg + off); R.vv[i] = *(const u32x4*)(Vg + off); } }
    const int qi = 16 * F.wave + (F.lane & 15), g4 = F.lane >> 4; const size_t tq = (size_t)u.b * SEQ + (size_t)(u.n * 128 + qi) * u.dil + u.rho;
#pragma unroll
    for (int ks = 0; ks < 2; ++ks) R.q[ks] = *(const bf16x8_t*)(Q + tq * 768 + u.head * 64 + 32 * ks + 8 * g4);
}
__device__ __forceinline__ void attn_queue_run(Frame& F, unsigned* qc, volatile LAS unsigned* MISC) {
    LAS unsigned char* Kt = F.lds; LAS unsigned char* Vt = F.lds + ATT_ROWS * ATT_RS;
    unsigned nxt = 0u;
    __syncthreads();
    if (F.tid == 0) MISC[0] = atomicAdd(qc, 1u);
    __syncthreads();
    int uidx = (int)MISC[0];
    if (uidx >= ATT_UNITS) return;
    if (F.tid == 0) nxt = atomicAdd(qc, 1u);
    AttR R; AttU u = att_unit(uidx); att_load(F, u, R);
    for (;;) {
        const int tid = F.tid, lane = F.lane, w = F.wave, ql = lane & 15, g4 = lane >> 4;
        const int b = u.b, j = u.j, g = u.g, dil = u.dil, rho = u.rho, n = u.n;
        bf16* OG = (bf16*)(F.outb + OUT_OG) + (size_t)g * T * 256; float* LSE = (float*)(F.ws + WS_LSE) + (size_t)g * T * 4;
        __syncthreads();
#pragma unroll
        for (int i = 0; i < 4; ++i) { const int p = tid + NTHR * i, row = p >> 3, c = p & 7; *(LAS u32x4*)(Kt + row * ATT_RS + c * 16) = R.kv[i]; *(LAS u32x4*)(Vt + row * ATT_RS + c * 16) = R.vv[i]; }
        if (tid < 128) { const int row = 256 + (tid >> 3), c = tid & 7; *(LAS u32x4*)(Kt + row * ATT_RS + c * 16) = (u32x4){0u, 0u, 0u, 0u}; *(LAS u32x4*)(Vt + row * ATT_RS + c * 16) = (u32x4){0u, 0u, 0u, 0u}; }
        bf16x8_t Qf[2]; Qf[0] = R.q[0]; Qf[1] = R.q[1];
        if (tid == 0) MISC[0] = nxt;
        __syncthreads();
        const int un = (int)MISC[0]; const bool more = un < ATT_UNITS;
        AttU u2 = u;
        if (more) { if (tid == 0) nxt = atomicAdd(qc, 1u); u2 = att_unit(un); att_load(F, u2, R); }
        const int qi = 16 * w + ql; const size_t tq = (size_t)b * SEQ + (size_t)(n * 128 + qi) * dil + rho;
    f32x4 O[4];
#pragma unroll
    for (int dt = 0; dt < 4; ++dt) O[dt] = (f32x4){0.f, 0.f, 0.f, 0.f};
    float m = -INFINITY, lsum = 0.f;
    const float SC = 0.125f * 1.4426950408889634f;
    const int qq = ql >> 2, pp4 = ql & 3;
#pragma unroll 1
    for (int pp = 4; pp >= 0; --pp) {
        const int t0 = w + 2 * pp, t1 = t0 + 1;
        f32x4 S0 = (f32x4){0.f, 0.f, 0.f, 0.f}, S1 = S0;
#pragma unroll
        for (int ks = 0; ks < 2; ++ks) {
            const bf16x8_t k0 = *(const LAS bf16x8_t*)(Kt + (16 * t0 + ql) * ATT_RS + (32 * ks + 8 * g4) * 2);
            const bf16x8_t k1 = *(const LAS bf16x8_t*)(Kt + (16 * t1 + ql) * ATT_RS + (32 * ks + 8 * g4) * 2);
            S0 = __builtin_amdgcn_mfma_f32_16x16x32_bf16(k0, Qf[ks], S0, 0, 0, 0);
            S1 = __builtin_amdgcn_mfma_f32_16x16x32_bf16(k1, Qf[ks], S1, 0, 0, 0);
        }
        float tmax = -INFINITY;
#pragma unroll
        for (int r = 0; r < 4; ++r) {
            const int k0i = 16 * t0 + 4 * g4 + r, k1i = k0i + 16;
            const bool v0 = (k0i >= qi) && (k0i <= qi + 128) && (n > 0 || k0i >= 128), v1 = (k1i >= qi) && (k1i <= qi + 128) && (n > 0 || k1i >= 128);
            S0[r] = v0 ? S0[r] * SC : -INFINITY; S1[r] = v1 ? S1[r] * SC : -INFINITY;
            tmax = fmaxf(tmax, fmaxf(S0[r], S1[r]));
        }
        tmax = fmaxf(tmax, __shfl_xor(tmax, 16)); tmax = fmaxf(tmax, __shfl_xor(tmax, 32));
        const float mn = fmaxf(m, tmax);
        const float corr = __builtin_amdgcn_exp2f(m - mn); m = mn;
        float ps = 0.f; float p0[4], p1[4];
#pragma unroll
        for (int r = 0; r < 4; ++r) { p0[r] = __builtin_amdgcn_exp2f(S0[r] - mn); p1[r] = __builtin_amdgcn_exp2f(S1[r] - mn); ps += p0[r] + p1[r]; }
        lsum = lsum * corr + ps;
        u32x4 pk; pk.x = g2::cvt_pk_bf16(p0[0], p0[1]); pk.y = g2::cvt_pk_bf16(p0[2], p0[3]); pk.z = g2::cvt_pk_bf16(p1[0], p1[1]); pk.w = g2::cvt_pk_bf16(p1[2], p1[3]);
        const bf16x8_t Pf = __builtin_bit_cast(bf16x8_t, pk);
#pragma unroll
        for (int dt = 0; dt < 4; ++dt) {
            O[dt] = O[dt] * corr;
            const v4i16_t lo = __builtin_amdgcn_ds_read_tr16_b64_v4i16((LAS v4i16_t*)(Vt + (16 * t0 + 4 * g4 + qq) * ATT_RS + (16 * dt + 4 * pp4) * 2));
            const v4i16_t hi = __builtin_amdgcn_ds_read_tr16_b64_v4i16((LAS v4i16_t*)(Vt + (16 * t1 + 4 * g4 + qq) * ATT_RS + (16 * dt + 4 * pp4) * 2));
            const bf16x8_t Vf = __builtin_shufflevector(lo, hi, 0, 1, 2, 3, 4, 5, 6, 7);
            O[dt] = __builtin_amdgcn_mfma_f32_16x16x32_bf16(Vf, Pf, O[dt], 0, 0, 0);
        }
    }
    lsum += __shfl_xor(lsum, 16); lsum += __shfl_xor(lsum, 32);
    const float rl = 1.0f / lsum;
#pragma unroll
    for (int dt = 0; dt < 4; ++dt) { u32x2 o; o.x = g2::cvt_pk_bf16(O[dt][0] * rl, O[dt][1] * rl); o.y = g2::cvt_pk_bf16(O[dt][2] * rl, O[dt][3] * rl);
        *(u32x2*)(OG + tq * 256 + j * 64 + 16 * dt + 4 * g4) = o; }
    if (g4 == 0) LSE[tq * 4 + j] = m + __builtin_amdgcn_logf(lsum);
        if (!more) break;
        u = u2;
    }
}
__device__ __forceinline__ void ph_attn_combine(Frame& F, int own = -1) {
    const bf16* OG = (const bf16*)(F.outb + OUT_OG); const float* LSE = (const float*)(F.ws + WS_LSE); bf16* YA = (bf16*)(F.outb + OUT_YA);
    const int j = F.lane >> 4, c = (F.lane & 15) * 4;
    const int nit = own >= 0 ? ((T / 256 - own + F.G - 1) / F.G) * 32 : (T - (int)(blockIdx.x * NWAVES + F.wave) + F.G * NWAVES - 1) / (F.G * NWAVES);
    for (int it = 0; it < nit; ++it) { const int t = own >= 0 ? ((own + (it >> 5) * F.G) << 8) + F.wave * 32 + (it & 31) : (int)(blockIdx.x * NWAVES + F.wave) + it * F.G * NWAVES;
        float l[3], o[3][4]; float mx = -INFINITY;
#pragma unroll
        for (int g = 0; g < 3; ++g) { l[g] = LSE[((size_t)g * T + t) * 4 + j]; mx = fmaxf(mx, l[g]);
            const u32x2 w = *(const u32x2*)(OG + ((size_t)g * T + t) * 256 + j * 64 + c);
            o[g][0] = __uint_as_float(w.x << 16); o[g][1] = __uint_as_float(w.x & 0xffff0000u); o[g][2] = __uint_as_float(w.y << 16); o[g][3] = __uint_as_float(w.y & 0xffff0000u); }
        float ws = 0.f, y[4] = {0.f, 0.f, 0.f, 0.f};
#pragma unroll
        for (int g = 0; g < 3; ++g) { const float e = __builtin_amdgcn_exp2f(l[g] - mx); ws += e;
#pragma unroll
            for (int k = 0; k < 4; ++k) y[k] += e * o[g][k]; }
        const float rw = 1.0f / ws;
        u32x2 w; w.x = pk2(y[0] * rw, y[1] * rw); w.y = pk2(y[2] * rw, y[3] * rw);
        *(u32x2*)(YA + (size_t)t * 256 + j * 64 + c) = w;
    }
}

__device__ __forceinline__ void ph_mlstm_naive_unit(Frame& F, int bh) {
    const int b = bh >> 2, h = bh & 3, tid = F.tid, v = tid & 255, dh = tid >> 8;
    LAS float* qs = (LAS float*)F.lds; LAS float* ks = qs + 128; LAS float* red = ks + 128; LAS float* sc = red + 512;
    const bf16* MQK = (const bf16*)(F.ws + WS_MQK); const bf16* MV = (const bf16*)(F.ws + WS_MV); const bf16* MO = (const bf16*)(F.ws + WS_MO);
    const float* GATES = (const float*)(F.ws + WS_GATES); bf16* YB = (bf16*)(F.outb + OUT_YB);
    const float* cw = F.in[I_CONVW]; const float* cbv = F.in[I_CONVB];
    float C[64];
#pragma unroll
    for (int d = 0; d < 64; ++d) C[d] = 0.f;
    float nst = 0.f, m = 0.f;
    const int ch = (tid < 128) ? (h * 128 + tid) : (512 + h * 128 + ((tid - 128) & 127));
    const float w0 = cw[ch], w1 = cw[1024 + ch], w2 = cw[2048 + ch], w3 = cw[3072 + ch], cb = cbv[ch];
    float xh0 = 0.f, xh1 = 0.f, xh2 = 0.f;
    const float gm = F.in[I_GMLSTM][h * 256 + v];
    __syncthreads();
    for (int s = 0; s < SEQ; ++s) {
        const size_t t = (size_t)b * SEQ + s;
        if (tid < 256) {
            const float xc = bf2f(MQK[t * 1024 + ch]);
            float y = cb + w0 * xh0 + w1 * xh1 + w2 * xh2 + w3 * xc; xh0 = xh1; xh1 = xh2; xh2 = xc;
            y = y / (1.0f + expf(-y));
            if (tid < 128) qs[tid] = y; else ks[tid - 128] = y * 0.08838834764831845f;
        }
        const float ig = GATES[t * 8 + h], fg = GATES[t * 8 + 4 + h];
        const float lf = logsigmoidf_(fg); const float mn = fmaxf(lf + m, ig); const float fd = expf(lf + m - mn), iw = expf(ig - mn); m = mn;
        const float vv = bf2f(MV[t * 1024 + h * 256 + v]);
        __syncthreads();
        float part = 0.f; const float ivv = iw * vv;
#pragma unroll
        for (int d4 = 0; d4 < 16; ++d4) { const f32x4 k4 = *(const LAS f32x4*)(ks + dh * 64 + d4 * 4), q4 = *(const LAS f32x4*)(qs + dh * 64 + d4 * 4);
#pragma unroll
            for (int e = 0; e < 4; ++e) { C[d4 * 4 + e] = fd * C[d4 * 4 + e] + ivv * k4[e]; part += C[d4 * 4 + e] * q4[e]; } }
        red[tid] = part;
        float nq = 0.f;
        if (tid < 128) { nst = fd * nst + iw * ks[tid]; nq = nst * qs[tid]; }
        nq = wave_sum(nq);
        if (F.lane == 0 && F.wave < 2) sc[F.wave] = nq;
        __syncthreads();
        const float num = red[v] + red[v + 256]; const float den = sc[0] + sc[1];
        const float hv = num / fmaxf(fabsf(den), expf(-mn));
        float sq = (dh == 0) ? hv * hv : 0.f; sq = wave_sum(sq);
        if (F.lane == 0) sc[2 + F.wave] = sq;
        __syncthreads();
        if (dh == 0) {
            const float ssum = sc[2] + sc[3] + sc[4] + sc[5];
            float y = hv * rsqrtf(ssum * (1.0f / 256.0f) + EPS) * gm;
            y *= sigmoidf_(bf2f(MO[t * 1024 + h * 256 + v]));
            YB[t * 1024 + h * 256 + v] = (bf16)f2bf(y);
        }
    }
    __syncthreads();
}


typedef float f32x16 __attribute__((ext_vector_type(16)));
typedef __bf16 bf16x2_t __attribute__((ext_vector_type(2)));
__device__ __forceinline__ unsigned cvtpk(float lo, float hi) { const f32x2 v = {lo, hi}; const bf16x2_t b = __builtin_convertvector(v, bf16x2_t); return __builtin_bit_cast(unsigned, b); }
__device__ __forceinline__ int crow32(int reg, int h2) { return (reg & 3) + 8 * (reg >> 2) + 4 * h2; }
constexpr int ML_QS = 272, ML_VS = 528, ML_SS = 144;
constexpr int ML_Q = 0, ML_K = 17408, ML_WKT = 34816, ML_WS = 144, ML_V = 53248, ML_SC = 87040, ML_RAW = 96768, ML_TAB = 131584, ML_H = 0;
#define MFMA32(a, b, c) __builtin_amdgcn_mfma_f32_32x32x16_bf16((a), (b), (c), 0, 0, 0)
__device__ __forceinline__ bf16x8_t tr2(LAS unsigned char* p, int rowstride) {
    const v4i16_t lo = __builtin_amdgcn_ds_read_tr16_b64_v4i16((LAS v4i16_t*)p);
    const v4i16_t hi = __builtin_amdgcn_ds_read_tr16_b64_v4i16((LAS v4i16_t*)(p + 4 * rowstride));
    return __builtin_shufflevector(lo, hi, 0, 1, 2, 3, 4, 5, 6, 7);
}
__device__ __forceinline__ void ml_gate_tables(LAS float* gt, float ig, float fg, float& mcar, int lane) {
    float bb = logsigmoidf_(fg);
#pragma unroll
    for (int o = 1; o < 64; o <<= 1) { const float v = __shfl_up(bb, o); if (lane >= o) bb += v; }
    const float a = ig - bb; float mx = a;
#pragma unroll
    for (int o = 1; o < 64; o <<= 1) { const float v = __shfl_up(mx, o); if (lane >= o) mx = fmaxf(mx, v); }
    const float Ml = fmaxf(mcar, mx);
    const float M63 = __shfl(Ml, 63), b63 = __shfl(bb, 63);
    gt[lane] = a; gt[64 + lane] = Ml; gt[128 + lane] = expf(-(bb + Ml)); gt[192 + lane] = expf(mcar - Ml); gt[256 + lane] = expf(a - M63);
    if (lane == 0) gt[320] = expf(mcar - M63);
    mcar = b63 + M63;
}
static_assert(ML_RAW + 67 * 512 <= MISC_OFF && MISC_OFF + 128 <= ML_TAB && ML_TAB + 11264 <= LDS_BYTES, "mLSTM LDS map");
template <bool FIRST>
__device__ __forceinline__ void ml_dma_raw(LAS unsigned char* L, const bf16* MQK, int b, int h, int c, int w, int lane) {
    const int rr = lane >> 5, seg = (lane >> 4) & 1, c16 = lane & 15;
    unsigned vo = (unsigned)(rr * 1024 + (seg ? 512 + h * 128 : h * 128) + c16 * 8) * 2u; asm volatile("" : "+v"(vo));
    const char* base = (const char*)(MQK + ((size_t)b * SEQ + 64 * c) * 1024) - 3 * 2048;
#pragma unroll
    for (int i = 0; i < 5; ++i) { int p = w * 5 + i; p = p > 33 ? 33 : p;
        const char* g = base + (size_t)p * 4096;
        if ((p < 33 || rr == 0) && (!FIRST || p >= 2 || (p == 1 && rr == 1))) __builtin_amdgcn_global_load_lds((const unsigned*)(g + vo), (LAS unsigned*)(L + ML_RAW + p * 1024), 16, 0, 0); }
}
__device__ __forceinline__ void ml_dma_v(LAS unsigned char* L, const bf16* MV, size_t t0, int h, int w, int lane) {
    unsigned vo = (unsigned)lane * 16u; asm volatile("" : "+v"(vo));
    const char* base = (const char*)(MV + (t0 + w * 8) * 1024 + h * 256);
#pragma unroll
    for (int i = 0; i < 8; ++i) { const int row = w * 8 + i;
        if (lane < 32) __builtin_amdgcn_global_load_lds((const unsigned*)(base + (size_t)i * 2048 + vo), (LAS unsigned*)(L + ML_V + row * ML_VS), 16, 0, 0); }
}
#define ML_SYNC() do { asm volatile("s_waitcnt lgkmcnt(0)" ::: "memory"); __builtin_amdgcn_s_barrier(); asm volatile("" ::: "memory"); } while (0)
__device__ __forceinline__ void mlstm_unit_fast(Frame& F, int bh) {
    const int b = bh >> 2, h = bh & 3, tid = F.tid, lane = F.lane, w = F.wave;
    LAS unsigned char* L = F.lds;
    LAS float* tab = (LAS float*)(L + ML_TAB);
    LAS float *td2 = tab + 1024, *trd = tab + 1088, *tn = tab + 1152, *tcw = tab + 1280, *tgm = tab + 2560;
    const bf16* MQK = (const bf16*)(F.ws + WS_MQK); const bf16* MV = (const bf16*)(F.ws + WS_MV); const bf16* MO = (const bf16*)(F.ws + WS_MO);
    const float* GATES = (const float*)(F.ws + WS_GATES); bf16* YB = (bf16*)(F.outb + OUT_YB);
    const int r32 = lane & 31, h2 = lane >> 5, gq = lane >> 4, i16 = lane & 15, q4 = i16 >> 2, p4 = i16 & 3;
    f32x16 Ct[4];
#pragma unroll
    for (int dt = 0; dt < 4; ++dt)
#pragma unroll
        for (int r = 0; r < 16; ++r) Ct[dt][r] = 0.f;
    float mcar = 0.f;
    __syncthreads();
    if (tid < 128) tn[tid] = 0.f;
    const int cg = tid & 31, tq = tid >> 5; const bool isq = cg < 16;
    if (tid < 256) { int chn = (tid < 128) ? (h * 128 + tid) : (512 + h * 128 + (tid - 128)); asm volatile("" : "+v"(chn)); const float* cw = F.in[I_CONVW];
        tcw[tid] = cw[chn]; tcw[256 + tid] = cw[1024 + chn]; tcw[512 + tid] = cw[2048 + chn]; tcw[768 + tid] = cw[3072 + chn]; tcw[1024 + tid] = F.in[I_CONVB][chn];
        int gi = h * 256 + tid; asm volatile("" : "+v"(gi)); tgm[tid] = F.in[I_GMLSTM][gi]; }
    if (tid < 96) *(LAS u32x4*)(L + ML_RAW + tid * 16) = (u32x4){0u, 0u, 0u, 0u};
    ml_dma_raw<true>(L, MQK, b, h, 0, w, lane);
    ml_dma_v(L, MV, (size_t)b * SEQ, h, w, lane);
    float ign = 0.f, fgn = 0.f;
    if (w == 3) { ign = GATES[((size_t)b * SEQ + lane) * 8 + h]; fgn = GATES[((size_t)b * SEQ + lane) * 8 + 4 + h]; ml_gate_tables(tab, ign, fgn, mcar, lane); }
    asm volatile("s_waitcnt vmcnt(0)" ::: "memory");
#pragma unroll 1
    for (int c = 0; c < SEQ / 64; ++c) {
        const size_t t0 = (size_t)b * SEQ + 64 * c;
        const bool more = c + 1 < SEQ / 64;
        LAS float* gt = tab + (c & 1) * 512;
        LAS float *ta = gt, *tM = gt + 64, *temt = gt + 128, *tin = gt + 192, *te = gt + 256, *tsc = gt + 320;
        asm volatile("s_waitcnt vmcnt(12)" ::: "memory");
        ML_SYNC();
        if (w == 3 && more) { ign = GATES[(t0 + 64 + lane) * 8 + h]; fgn = GATES[(t0 + 64 + lane) * 8 + 4 + h]; }
        {
#pragma unroll
          for (int e4 = 0; e4 < 2; ++e4) {
              const f32x4 w0 = *(const LAS f32x4*)(tcw + 8 * cg + 4 * e4), w1 = *(const LAS f32x4*)(tcw + 256 + 8 * cg + 4 * e4), w2 = *(const LAS f32x4*)(tcw + 512 + 8 * cg + 4 * e4),
                          w3 = *(const LAS f32x4*)(tcw + 768 + 8 * cg + 4 * e4), cb = *(const LAS f32x4*)(tcw + 1024 + 8 * cg + 4 * e4);
              f32x4 xr[7];
#pragma unroll
              for (int j = 0; j < 7; ++j) { const u32x2 rw = *(const LAS u32x2*)(L + ML_RAW + (4 * tq + j) * 512 + cg * 16 + e4 * 8); const unsigned lo = rw.x, hi = rw.y;
                  xr[j] = (f32x4){__uint_as_float(lo << 16), __uint_as_float(lo & 0xffff0000u), __uint_as_float(hi << 16), __uint_as_float(hi & 0xffff0000u)}; }
              f32x4 kv[4];
#pragma unroll
              for (int i = 0; i < 4; ++i) { const int sl = 4 * tq + i;
                  f32x4 v = cb + w0 * xr[i] + w1 * xr[i + 1] + w2 * xr[i + 2] + w3 * xr[i + 3];
#pragma unroll
                  for (int e = 0; e < 4; ++e) v[e] = v[e] * fsig(v[e]);
                  if (isq) { u32x2 o; o.x = pk2(v[0], v[1]); o.y = pk2(v[2], v[3]); *(LAS u32x2*)(L + ML_Q + sl * ML_QS + cg * 16 + e4 * 8) = o; }
                  else { const float es = te[sl]; v = v * 0.08838834764831845f;
                      u32x2 o; o.x = pk2(v[0], v[1]); o.y = pk2(v[2], v[3]); *(LAS u32x2*)(L + ML_K + sl * ML_QS + (cg - 16) * 16 + e4 * 8) = o;
                      kv[i] = v * es; } }
              if (!isq) {
#pragma unroll
                  for (int e = 0; e < 4; ++e) { u32x2 o2; o2.x = pk2(kv[0][e], kv[1][e]); o2.y = pk2(kv[2][e], kv[3][e]);
                      *(LAS u32x2*)(L + ML_WKT + (8 * (cg - 16) + 4 * e4 + e) * ML_WS + 8 * tq) = o2; } } } }
        ML_SYNC();
        if (w == 3 && more) ml_gate_tables(tab + ((c + 1) & 1) * 512, ign, fgn, mcar, lane);
        if (more) ml_dma_raw<false>(L, MQK, b, h, c + 1, w, lane);
        if (w < 3) {
            const int lt = w ? 1 : 0, st = (w == 2) ? 1 : 0;
            f32x16 S;
#pragma unroll
            for (int r = 0; r < 16; ++r) S[r] = 0.f;
#pragma unroll
            for (int ks = 0; ks < 8; ++ks) { const bf16x8_t A = *(const LAS bf16x8_t*)(L + ML_Q + (32 * lt + r32) * ML_QS + (16 * ks + 8 * h2) * 2);
                const bf16x8_t B = *(const LAS bf16x8_t*)(L + ML_K + (32 * st + r32) * ML_QS + (16 * ks + 8 * h2) * 2); S = MFMA32(A, B, S);
                if (ks & 1) asm volatile("" ::: "memory"); }
            const int s = 32 * st + r32; const float as = ta[s];
            const LAS float* tMh = tM + 32 * lt + 4 * h2; LAS unsigned char* scp = L + ML_SC + (32 * lt + 4 * h2) * ML_SS + s * 2; const int lb = 32 * lt + 4 * h2;
#pragma unroll
            for (int r = 0; r < 16; ++r) { const int ro = (r & 3) + 8 * (r >> 2);
                float x = as - tMh[ro]; x = (s <= lb + ro) ? x : -INFINITY;
                *(LAS bf16*)(scp + ro * ML_SS) = (bf16)f2bf(S[r] * __expf(x)); }
        } else if (w >= 4) {
            const int idx = tid - 256, l = idx >> 2, part = idx & 3; float acc = 0.f;
#pragma unroll
            for (int i = 0; i < 4; ++i) { float q8[8]; unpack8(*(const LAS u32x4*)(L + ML_Q + l * ML_QS + (32 * part + 8 * i) * 2), q8);
#pragma unroll
                for (int e = 0; e < 8; ++e) acc += tn[32 * part + 8 * i + e] * q8[e]; }
            acc += __shfl_xor(acc, 1); acc += __shfl_xor(acc, 2);
            if (part == 0) td2[l] = acc;
        }
        if (more) asm volatile("s_waitcnt vmcnt(5)" ::: "memory"); else asm volatile("s_waitcnt vmcnt(0)" ::: "memory");
        ML_SYNC();
        if (tid < 64) { const int l = tid; float d1 = 0.f; const int nb = (l < 32) ? 4 : 8;
            for (int i = 0; i < nb; ++i) { float v8[8]; unpack8(*(const LAS u32x4*)(L + ML_SC + l * ML_SS + i * 16), v8);
#pragma unroll
                for (int e = 0; e < 8; ++e) d1 += v8[e]; }
            const float den = d1 + tin[l] * td2[l]; trd[l] = 1.0f / fmaxf(fabsf(den), temt[l]); }
        bf16x8_t Vf[4];
        { v4i16_t t0_, t1_, t2_, t3_, t4_, t5_, t6_, t7_;
          LAS unsigned char* pv = L + ML_V + (8 * h2 + q4) * ML_VS + (32 * w + 16 * (gq & 1) + 4 * p4) * 2;
          static_assert(ML_VS == 528, "offsets below");
          asm volatile("ds_read_b64_tr_b16 %0, %8\n\tds_read_b64_tr_b16 %1, %8 offset:2112\n\tds_read_b64_tr_b16 %2, %8 offset:8448\n\tds_read_b64_tr_b16 %3, %8 offset:10560\n\t"
                       "ds_read_b64_tr_b16 %4, %8 offset:16896\n\tds_read_b64_tr_b16 %5, %8 offset:19008\n\tds_read_b64_tr_b16 %6, %8 offset:25344\n\tds_read_b64_tr_b16 %7, %8 offset:27456\n\t"
                       "s_waitcnt lgkmcnt(0)"
                       : "=&v"(t0_), "=&v"(t1_), "=&v"(t2_), "=&v"(t3_), "=&v"(t4_), "=&v"(t5_), "=&v"(t6_), "=&v"(t7_) : "v"(pv) : "memory");
          Vf[0] = __builtin_shufflevector(t0_, t1_, 0, 1, 2, 3, 4, 5, 6, 7); Vf[1] = __builtin_shufflevector(t2_, t3_, 0, 1, 2, 3, 4, 5, 6, 7);
          Vf[2] = __builtin_shufflevector(t4_, t5_, 0, 1, 2, 3, 4, 5, 6, 7); Vf[3] = __builtin_shufflevector(t6_, t7_, 0, 1, 2, 3, 4, 5, 6, 7); }
        f32x16 N1[2], N2[2];
#pragma unroll
        for (int lt = 0; lt < 2; ++lt)
#pragma unroll
            for (int r = 0; r < 16; ++r) { N1[lt][r] = 0.f; N2[lt][r] = 0.f; }
#pragma unroll
        for (int ks = 0; ks < 2; ++ks) N1[0] = MFMA32(*(const LAS bf16x8_t*)(L + ML_SC + r32 * ML_SS + (16 * ks + 8 * h2) * 2), Vf[ks], N1[0]);
#pragma unroll
        for (int ks = 0; ks < 4; ++ks) N1[1] = MFMA32(*(const LAS bf16x8_t*)(L + ML_SC + (32 + r32) * ML_SS + (16 * ks + 8 * h2) * 2), Vf[ks], N1[1]);
        asm volatile("" ::: "memory");
#pragma unroll
        for (int dt = 0; dt < 4; ++dt)
#pragma unroll
            for (int s2 = 0; s2 < 2; ++s2) {
                u32x4 pk;
#pragma unroll
                for (int e = 0; e < 4; ++e) pk[e] = cvtpk(Ct[dt][8 * s2 + 2 * e], Ct[dt][8 * s2 + 2 * e + 1]);
                const bf16x8_t Bc = __builtin_bit_cast(bf16x8_t, pk);
#pragma unroll
                for (int lt = 0; lt < 2; ++lt) {
                    const u32x2 lo = *(const LAS u32x2*)(L + ML_Q + (32 * lt + r32) * ML_QS + (32 * dt + 16 * s2 + 4 * h2) * 2);
                    const u32x2 hi = *(const LAS u32x2*)(L + ML_Q + (32 * lt + r32) * ML_QS + (32 * dt + 16 * s2 + 8 + 4 * h2) * 2);
                    const u32x4 a4 = (u32x4){lo.x, lo.y, hi.x, hi.y};
                    N2[lt] = MFMA32(__builtin_bit_cast(bf16x8_t, a4), Bc, N2[lt]); }
                asm volatile("" ::: "memory"); }
        { const float decay = tsc[0];
#pragma unroll
          for (int dt = 0; dt < 4; ++dt) {
#pragma unroll
              for (int r = 0; r < 16; ++r) Ct[dt][r] *= decay;
#pragma unroll
              for (int ks = 0; ks < 4; ++ks) Ct[dt] = MFMA32(*(const LAS bf16x8_t*)(L + ML_WKT + (32 * dt + r32) * ML_WS + (16 * ks + 8 * h2) * 2), Vf[ks], Ct[dt]);
              asm volatile("" ::: "memory"); }
          if (tid < 128) { float acc = decay * tn[tid];
#pragma unroll 8
              for (int s = 0; s < 64; ++s) acc += te[s] * bf2f(*(const LAS bf16*)(L + ML_K + s * ML_QS + tid * 2));
              tn[tid] = acc; } }
        ML_SYNC();
        if (more) ml_dma_v(L, MV, t0 + 64, h, w, lane);
#pragma unroll
        for (int lt = 0; lt < 2; ++lt)
#pragma unroll
            for (int r = 0; r < 16; ++r) { const int ro = 32 * lt + (r & 3) + 8 * (r >> 2); const LAS float* tinh = tin + 4 * h2; const LAS float* trdh = trd + 4 * h2;
                const float hv = (N1[lt][r] + tinh[ro] * N2[lt][r]) * trdh[ro];
                *(LAS bf16*)(L + ML_H + (4 * h2) * ML_VS + (32 * w + r32) * 2 + ro * ML_VS) = (bf16)f2bf(hv); }
#if GATES_U8
        u32x4 moreg[2];
        { const unsigned char* mo = (const unsigned char*)MO + (t0 + (tid >> 3)) * 1024 + h * 256 + (tid & 7) * 32; moreg[0] = *(const u32x4*)mo; moreg[1] = *(const u32x4*)(mo + 16); }
#else
        u32x4 moreg[4];
        { const bf16* mo = MO + (t0 + (tid >> 3)) * 1024 + h * 256 + (tid & 7) * 32;
#pragma unroll
          for (int i = 0; i < 4; ++i) moreg[i] = *(const u32x4*)(mo + 8 * i); }
#endif
        ML_SYNC();
        { const int l = tid >> 3, part = tid & 7; float hv[32]; float ss = 0.f;
#pragma unroll
          for (int i = 0; i < 4; ++i) { float t8[8]; unpack8(*(const LAS u32x4*)(L + ML_H + l * ML_VS + part * 64 + i * 16), t8);
#pragma unroll
              for (int e = 0; e < 8; ++e) { hv[8 * i + e] = t8[e]; ss += t8[e] * t8[e]; } }
          ss += __shfl_xor(ss, 1); ss += __shfl_xor(ss, 2); ss += __shfl_xor(ss, 4);
          const float rstd = rsqrtf(ss * (1.0f / 256.0f) + EPS);
          const LAS float* gm = tgm + part * 32; bf16* yb = YB + (t0 + l) * 1024 + h * 256 + part * 32;
#pragma unroll
          for (int i = 0; i < 4; ++i) { const f32x4 g0 = *(const LAS f32x4*)(gm + 8 * i), g1 = *(const LAS f32x4*)(gm + 8 * i + 4);
#if GATES_U8
              const f32x4 sa = unpk4_sig_u8(moreg[i >> 1][2 * (i & 1)]), sb = unpk4_sig_u8(moreg[i >> 1][2 * (i & 1) + 1]);
              float o[8];
#pragma unroll
              for (int e = 0; e < 8; ++e) o[e] = hv[8 * i + e] * rstd * (e < 4 ? g0[e] * sa[e] : g1[e - 4] * sb[e - 4]);
#else
              float m8[8]; unpack8(moreg[i], m8);
              float o[8];
#pragma unroll
              for (int e = 0; e < 8; ++e) o[e] = hv[8 * i + e] * rstd * (e < 4 ? g0[e] : g1[e - 4]) * fsig(m8[e]);
#endif
              u32x4 wv; wv.x = pk2(o[0], o[1]); wv.y = pk2(o[2], o[3]); wv.z = pk2(o[4], o[5]); wv.w = pk2(o[6], o[7]);
              *(u32x4*)(yb + 8 * i) = wv; } }
    }
    __syncthreads();
}

__device__ __forceinline__ void ph_branch_naive(Frame& F) {
    LAS float* As = (LAS float*)F.lds; LAS float* Bs = As + 16 * 132;
    const bf16* YA = (const bf16*)(F.outb + OUT_YA); const bf16* YB = (const bf16*)(F.outb + OUT_YB); const bf16* GAB = (const bf16*)(F.ws + WS_GAB);
    bf16* MG = (bf16*)(F.ws + WS_MERGED);
    const int ty = F.tid >> 5, tx = F.tid & 31;
    for (int vb = blockIdx.x; vb < (T / 128) * 8; vb += F.G) {
        const int tm = vb >> 3, tn = vb & 7, m0 = tm * 128, n0 = tn * 128;
        float a1[8][4], a2[8][4]; ZERO_ACC(a1); ZERO_ACC(a2);
        ARowGlobal ra{YA, (size_t)256, m0, nullptr}; ngemm_acc(As, Bs, ra, F.in[I_WBA], D, 256, n0, D, a1);
        ARowGlobal rb{YB, (size_t)D, m0, nullptr};  ngemm_acc(As, Bs, rb, F.in[I_WBB], D, D, n0, D, a2);
#pragma unroll
        for (int i = 0; i < 8; ++i) { const size_t row = (size_t)(m0 + ty * 8 + i); const int col = n0 + tx * 4;
            const u32x2 ga = *(const u32x2*)(GAB + row * 2048 + col), gb = *(const u32x2*)(GAB + row * 2048 + 1024 + col);
            const float sga[4] = {sigmoidf_(__uint_as_float(ga.x << 16)), sigmoidf_(__uint_as_float(ga.x & 0xffff0000u)), sigmoidf_(__uint_as_float(ga.y << 16)), sigmoidf_(__uint_as_float(ga.y & 0xffff0000u))};
            const float sgb[4] = {sigmoidf_(__uint_as_float(gb.x << 16)), sigmoidf_(__uint_as_float(gb.x & 0xffff0000u)), sigmoidf_(__uint_as_float(gb.y << 16)), sigmoidf_(__uint_as_float(gb.y & 0xffff0000u))};
            float o[4];
#pragma unroll
            for (int j = 0; j < 4; ++j) o[j] = sga[j] * a1[i][j] + sgb[j] * a2[i][j];
            u32x2 w; w.x = pk2(o[0], o[1]); w.y = pk2(o[2], o[3]); *(u32x2*)(MG + row * D + col) = w; }
    }
}

__device__ __forceinline__ void ph_outproj_naive(Frame& F) {
    LAS float* As = (LAS float*)F.lds; LAS float* Bs = As + 16 * 132;
    const bf16* MG = (const bf16*)(F.ws + WS_MERGED); bf16* YM = (bf16*)(F.ws + WS_YMIX);
    const int ty = F.tid >> 5, tx = F.tid & 31;
    for (int vb = blockIdx.x; vb < (T / 128) * 8; vb += F.G) {
        const int tm = vb >> 3, tn = vb & 7, m0 = tm * 128, n0 = tn * 128;
        float a1[8][4]; ZERO_ACC(a1);
        ARowGlobal ra{MG, (size_t)D, m0, nullptr}; ngemm_acc(As, Bs, ra, F.in[I_WOUT], D, D, n0, D, a1);
#pragma unroll
        for (int i = 0; i < 8; ++i) { const size_t row = (size_t)(m0 + ty * 8 + i); const int col = n0 + tx * 4;
            u32x2 w; w.x = pk2(a1[i][0], a1[i][1]); w.y = pk2(a1[i][2], a1[i][3]); *(u32x2*)(YM + row * D + col) = w; }
    }
}

struct X1In { u32x2 ym[4]; f32x4 xv[4]; };
__device__ __forceinline__ void x1_load(Frame& F, int t, X1In& r) {
    const float* x = F.in[I_X]; const bf16* YM = (const bf16*)(F.ws + WS_YMIX);
#pragma unroll
    for (int j = 0; j < 4; ++j) { r.ym[j] = *(const u32x2*)(YM + (size_t)t * D + F.lane * 4 + 256 * j); r.xv[j] = *(const f32x4*)(x + (size_t)t * D + F.lane * 4 + 256 * j); }
}
__device__ __forceinline__ void x1_compute(Frame& F, int t, const X1In& r, f32x4 (&x1)[4]) {
    const float* mod = (const float*)(F.ws + WS_MOD);
    const int b = t / SEQ; const float* gt1 = mod + b * 6144 + 2048; const float* g = F.in[I_GPOSTMIX];
    f32x4 y[4]; float ss = 0.f;
#pragma unroll
    for (int j = 0; j < 4; ++j) { const u32x2 w = r.ym[j];
        y[j][0] = __uint_as_float(w.x << 16); y[j][1] = __uint_as_float(w.x & 0xffff0000u); y[j][2] = __uint_as_float(w.y << 16); y[j][3] = __uint_as_float(w.y & 0xffff0000u);
        ss += y[j][0] * y[j][0] + y[j][1] * y[j][1] + y[j][2] * y[j][2] + y[j][3] * y[j][3]; }
    const float rstd = rsqrtf(wave_sum(ss) * (1.0f / D) + EPS);
#pragma unroll
    for (int j = 0; j < 4; ++j) { const int c = F.lane * 4 + 256 * j; const f32x4 gg = *(const f32x4*)(g + c), gt = *(const f32x4*)(gt1 + c);
#pragma unroll
        for (int e = 0; e < 4; ++e) x1[j][e] = r.xv[j][e] + gt[e] * (y[j][e] * rstd * gg[e]); }
}
__device__ __forceinline__ void x1_row(Frame& F, int t, f32x4 (&x1)[4]) { X1In r; x1_load(F, t, r); x1_compute(F, t, r, x1); }

__device__ __forceinline__ void ph_normmid(Frame& F) {
    const float* mod = (const float*)(F.ws + WS_MOD); const float* g = F.in[I_GPREFFN]; bf16* H2 = (bf16*)(F.ws + WS_H2);
    const int tstep = F.G * NWAVES; int t = blockIdx.x * NWAVES + F.wave;
    X1In rn; if (t < T) x1_load(F, t, rn);
    for (; t < T; t += tstep) {
        const int b = t / SEQ; const float* sh2 = mod + b * 6144 + 3072, *sc2 = mod + b * 6144 + 4096;
        const X1In rc = rn; if (t + tstep < T) x1_load(F, t + tstep, rn);
        f32x4 x1[4]; x1_compute(F, t, rc, x1);
        float ss = 0.f;
#pragma unroll
        for (int j = 0; j < 4; ++j) ss += x1[j][0] * x1[j][0] + x1[j][1] * x1[j][1] + x1[j][2] * x1[j][2] + x1[j][3] * x1[j][3];
        const float rstd = rsqrtf(wave_sum(ss) * (1.0f / D) + EPS);
#pragma unroll
        for (int j = 0; j < 4; ++j) { const int c = F.lane * 4 + 256 * j; const f32x4 gg = *(const f32x4*)(g + c), s2 = *(const f32x4*)(sc2 + c), h2 = *(const f32x4*)(sh2 + c);
            float o[4];
#pragma unroll
            for (int e = 0; e < 4; ++e) o[e] = x1[j][e] * rstd * gg[e] * (1.0f + s2[e]) + h2[e];
            u32x2 w; w.x = pk2(o[0], o[1]); w.y = pk2(o[2], o[3]); *(u32x2*)(H2 + (size_t)t * D + c) = w;
#if MOE_FP8
            *(unsigned*)(F.ws + WS_H2F8 + (size_t)t * D + c) = pk4_fp8(o[0], o[1], o[2], o[3]);
#endif
#if !FAST_MOE2
            *(f32x4*)(F.out + (size_t)t * D + c) = (f32x4){0.f, 0.f, 0.f, 0.f};
#endif
        }
    }
}

__device__ __forceinline__ void ph_normmid_blocks(Frame& F, int vcu) {
    for (int bi = 0; bi * F.G + vcu < T / 256; ++bi) { const int tblk = bi * F.G + vcu;
    const float* mod = (const float*)(F.ws + WS_MOD); const float* g = F.in[I_GPREFFN]; bf16* H2 = (bf16*)(F.ws + WS_H2);
    const int tstep = 1; int t = tblk * 256 + F.wave * 32; const int tend = t + 32;
    X1In rn; x1_load(F, t, rn);
    for (; t < tend; t += tstep) {
        const int b = t / SEQ; const float* sh2 = mod + b * 6144 + 3072, *sc2 = mod + b * 6144 + 4096;
        const X1In rc = rn; if (t + tstep < tend) x1_load(F, t + tstep, rn);
        f32x4 x1[4]; x1_compute(F, t, rc, x1);
        float ss = 0.f;
#pragma unroll
        for (int j = 0; j < 4; ++j) ss += x1[j][0] * x1[j][0] + x1[j][1] * x1[j][1] + x1[j][2] * x1[j][2] + x1[j][3] * x1[j][3];
        const float rstd = rsqrtf(wave_sum(ss) * (1.0f / D) + EPS);
#pragma unroll
        for (int j = 0; j < 4; ++j) { const int c = F.lane * 4 + 256 * j; const f32x4 gg = *(const f32x4*)(g + c), s2 = *(const f32x4*)(sc2 + c), h2 = *(const f32x4*)(sh2 + c);
            float o[4];
#pragma unroll
            for (int e = 0; e < 4; ++e) o[e] = x1[j][e] * rstd * gg[e] * (1.0f + s2[e]) + h2[e];
            u32x2 w; w.x = pk2(o[0], o[1]); w.y = pk2(o[2], o[3]); *(u32x2*)(H2 + (size_t)t * D + c) = w;
            { u32x2 wx; wx.x = pk2(x1[j][0], x1[j][1]); wx.y = pk2(x1[j][2], x1[j][3]); *(u32x2*)((bf16*)(F.ws + WS_YMIX) + (size_t)t * D + c) = wx; }
#if MOE_FP8
            *(unsigned*)(F.ws + WS_H2F8 + (size_t)t * D + c) = pk4_fp8(o[0], o[1], o[2], o[3]);
#endif
#if !FAST_MOE2
            *(f32x4*)(F.out + (size_t)t * D + c) = (f32x4){0.f, 0.f, 0.f, 0.f};
#endif
        }
    }
}
}

constexpr int HALF_T = T / 2;
__device__ __forceinline__ unsigned char* slot_ptr(unsigned char* ws, unsigned char* outb, int half, int k, int t) {
    const size_t tl = (size_t)(t - half * HALF_T);
    if (k < 2) return outb + (size_t)t * 4096 + k * 2048;
#if MOE_FP8
    int ri;
    if (half == 0) { if (k < 4) return outb + (size_t)(t + HALF_T) * 4096 + (k - 2) * 2048; ri = k - 4; } else ri = k - 2;
    const size_t base = (ri == 0) ? 192 : (ri == 1) ? 256 : (ri == 2) ? 448 : (ri == 3) ? 512 : (ri == 4) ? 576 : (ri == 5) ? 640 : 704;
    return ws + base * MiB + tl * 2048;
#else
    if (half == 0) {
        if (k < 4) return outb + (size_t)(t + HALF_T) * 4096 + (k - 2) * 2048;
        if (k < 6) return ws + (192 + 64 * (size_t)(k - 4)) * MiB + tl * 2048;
        return ws + (512 + 64 * (size_t)(k - 6)) * MiB + tl * 2048;
    }
    if (k < 4) return ws + (192 + 64 * (size_t)(k - 2)) * MiB + tl * 2048;
    if (k < 8) return ws + (512 + 64 * (size_t)(k - 4)) * MiB + tl * 2048;
    return ws + 768 * MiB + tl * 2048;
#endif
}
__device__ __forceinline__ void ph_topk2(Frame& F) {
    const float* LG = (const float*)(F.ws + WS_LOGITS); const float* rb = F.in[I_RB];
    int* TOPI = (int*)(F.ws + WS_TOPI); float* TOPW = (float*)(F.ws + WS_TOPW); int* HIST = (int*)(F.ws + WS_HIST);
    LAS float* selw = (LAS float*)F.lds + F.wave * 512; LAS float* gsw = selw + 256;
    LAS unsigned* hist = (LAS unsigned*)(F.lds + 8 * 512 * 4);
    const int lane = F.lane, hf = lane >> 5;
    for (int tb = blockIdx.x; tb < T / 256; tb += F.G) {
        __syncthreads();
        if (F.tid < 256) hist[F.tid] = 0u;
        __syncthreads();
        for (int it = 0; it < 32; ++it) {
            const int t = tb * 256 + F.wave * 32 + it;
            float sc[4], sel[4];
#pragma unroll
            for (int i = 0; i < 4; ++i) { sc[i] = sigmoidf_(LG[(size_t)t * NE + lane + 64 * i]); sel[i] = sc[i] + rb[lane + 64 * i]; selw[lane + 64 * i] = sel[i]; }
            asm volatile("s_waitcnt lgkmcnt(0)" ::: "memory");
            if (lane < 8) { float m1 = -INFINITY, m2 = -INFINITY;
#pragma unroll
                for (int q = 0; q < 8; ++q) { const f32x4 v = *(const LAS f32x4*)(selw + lane * 32 + q * 4);
#pragma unroll
                    for (int e = 0; e < 4; ++e) { const float x = v[e]; const float lo = fminf(m1, x); m1 = fmaxf(m1, x); m2 = fmaxf(m2, lo); } }
                gsw[lane] = m1 + m2; }
            asm volatile("s_waitcnt lgkmcnt(0)" ::: "memory");
            float gs[8];
            { const f32x4 a = *(const LAS f32x4*)gsw, b2 = *(const LAS f32x4*)(gsw + 4); gs[0] = a[0]; gs[1] = a[1]; gs[2] = a[2]; gs[3] = a[3]; gs[4] = b2[0]; gs[5] = b2[1]; gs[6] = b2[2]; gs[7] = b2[3]; }
            bool gsel[8];
#pragma unroll
            for (int a = 0; a < 8; ++a) { int rank = 0;
#pragma unroll
                for (int c = 0; c < 8; ++c) rank += (gs[c] > gs[a] || (gs[c] == gs[a] && c < a)) ? 1 : 0;
                gsel[a] = rank < 4; }
            asm volatile("" ::: "memory");
#pragma unroll
            for (int i = 0; i < 4; ++i) { const bool ok = hf ? gsel[2 * i + 1] : gsel[2 * i]; if (!ok) sel[i] = -INFINITY; selw[lane + 64 * i] = sel[i]; }
            asm volatile("s_waitcnt lgkmcnt(0)" ::: "memory");
            int rk[4] = {0, 0, 0, 0};
#pragma unroll 4
            for (int q = 0; q < 64; ++q) { const f32x4 v = *(const LAS f32x4*)(selw + q * 4);
#pragma unroll
                for (int e = 0; e < 4; ++e) { const float x = v[e]; const int xe = q * 4 + e;
#pragma unroll
                    for (int i = 0; i < 4; ++i) rk[i] += (x > sel[i] || (x == sel[i] && xe < lane + 64 * i)) ? 1 : 0; } }
            asm volatile("" ::: "memory");
            float part = 0.f;
#pragma unroll
            for (int i = 0; i < 4; ++i) { if (sel[i] == -INFINITY) rk[i] = 999; if (rk[i] < TOPK) part += sc[i]; }
            const float wsum = wave_sum(part);
#pragma unroll
            for (int i = 0; i < 4; ++i) if (rk[i] < TOPK) { TOPI[(size_t)t * TOPK + rk[i]] = lane + 64 * i; TOPW[(size_t)t * TOPK + rk[i]] = sc[i] / wsum * 2.5f; __hip_atomic_fetch_add(&hist[lane + 64 * i], 1u, __ATOMIC_RELAXED, __HIP_MEMORY_SCOPE_WORKGROUP); }
        }
        __syncthreads();
        if (F.tid < 256) HIST[tb * 256 + F.tid] = (int)hist[F.tid];
    }
}

__device__ __forceinline__ unsigned mono_key(float v, int e) {
    unsigned u = __float_as_uint(v); u ^= (u & 0x80000000u) ? 0xffffffffu : 0x80000000u; return (u & 0xffffff00u) | (unsigned)(255 - e); }
struct StrideBlocks { int b0, G; __device__ __forceinline__ int block(int i) const { const int tb = b0 + i * G; return tb < T / 256 ? tb : -1; } };
struct RouterBlocks { g2::DenseOrder S; __device__ __forceinline__ int block(int i) const { g2::UnitMN u; return S.next(i, u) ? u.pm : -1; } };
template <class BlockIter>
__device__ __forceinline__ void ph_topk4(Frame& F, const BlockIter& BI) {
    const float* LG = (const float*)(F.ws + WS_LOGITS); const float* rb = F.in[I_RB];
    int* TOPI = (int*)(F.ws + WS_TOPI); float* TOPW = (float*)(F.ws + WS_TOPW); int* HIST = (int*)(F.ws + WS_HIST);
    LAS float* selw = (LAS float*)F.lds + F.wave * 1280; LAS float* gsw = selw + 512; LAS int* gfl = (LAS int*)(selw + 528); LAS int* resI = (LAS int*)(selw + 768); LAS float* resW = selw + 1024;
    LAS unsigned* hist = (LAS unsigned*)(F.lds + 8 * 1280 * 4);
    const int lane = F.lane, hf = lane >> 5;
    float rbv[4];
#pragma unroll
    for (int i = 0; i < 4; ++i) rbv[i] = rb[lane + 64 * i];
#define LWAIT() asm volatile("s_waitcnt lgkmcnt(0)" ::: "memory")
    for (int bi = 0;; ++bi) {
        const int tb = BI.block(bi); if (tb < 0) break;
        __syncthreads();
        if (F.tid < 256) hist[F.tid] = 0u;
        __syncthreads();
        const int tbase = tb * 256 + F.wave * 32;
        float lgn[2][4];
#pragma unroll
        for (int u = 0; u < 2; ++u)
#pragma unroll
            for (int i = 0; i < 4; ++i) lgn[u][i] = LG[(size_t)(tbase + 16 * u) * NE + lane + 64 * i];
#pragma unroll 1
        for (int it = 0; it < 16; ++it) {
            float sc[2][4], sel[2][4];
#pragma unroll
            for (int u = 0; u < 2; ++u)
#pragma unroll
                for (int i = 0; i < 4; ++i) { sc[u][i] = fsig(lgn[u][i]); sel[u][i] = sc[u][i] + rbv[i]; selw[u * 256 + lane + 64 * i] = sel[u][i]; }
            if (it + 1 < 16) {
#pragma unroll
                for (int u = 0; u < 2; ++u)
#pragma unroll
                    for (int i = 0; i < 4; ++i) lgn[u][i] = LG[(size_t)(tbase + 16 * u + it + 1) * NE + lane + 64 * i]; }
            LWAIT();
            if (lane < 16) { float m1 = -INFINITY, m2 = -INFINITY;
#pragma unroll
                for (int q = 0; q < 8; ++q) { const f32x4 v = *(const LAS f32x4*)(selw + lane * 32 + q * 4);
#pragma unroll
                    for (int e = 0; e < 4; ++e) { const float x = v[e]; const float lo = fminf(m1, x); m1 = fmaxf(m1, x); m2 = fmaxf(m2, lo); } }
                gsw[lane] = m1 + m2; }
            LWAIT();
            if (lane < 16) { const LAS float* gp = gsw + (lane & 8); const f32x4 a = *(const LAS f32x4*)gp, b2 = *(const LAS f32x4*)(gp + 4); const float gs[8] = {a[0], a[1], a[2], a[3], b2[0], b2[1], b2[2], b2[3]};
                const int gl = lane & 7; float me = 0.f;
#pragma unroll
                for (int c = 0; c < 8; ++c) me = (gl == c) ? gs[c] : me;
                int rank = 0;
#pragma unroll
                for (int c = 0; c < 8; ++c) rank += (gs[c] > me || (gs[c] == me && c < gl)) ? 1 : 0;
                gfl[lane] = rank < 4 ? 1 : 0; }
            LWAIT();
            unsigned key[2][4];
#pragma unroll
            for (int u = 0; u < 2; ++u) { const u32x4 a = *(const LAS u32x4*)(gfl + 8 * u), b2 = *(const LAS u32x4*)(gfl + 8 * u + 4); const int fl[8] = {(int)a[0], (int)a[1], (int)a[2], (int)a[3], (int)b2[0], (int)b2[1], (int)b2[2], (int)b2[3]};
#pragma unroll
                for (int i = 0; i < 4; ++i) { const int f = hf ? fl[2 * i + 1] : fl[2 * i]; key[u][i] = f ? mono_key(sel[u][i], lane + 64 * i) : 0u; } }
            unsigned prefix[2] = {0u, 0u};
#pragma unroll
            for (int bit = 31; bit >= 0; --bit)
#pragma unroll
                for (int u = 0; u < 2; ++u) { const unsigned cand = prefix[u] | (1u << bit); int cnt = 0;
#pragma unroll
                    for (int i = 0; i < 4; ++i) cnt += __builtin_popcountll(__builtin_amdgcn_ballot_w64(key[u][i] >= cand));
                    prefix[u] = (cnt >= TOPK) ? cand : prefix[u]; }
#pragma unroll
            for (int u = 0; u < 2; ++u) {
                int slot[4]; bool pick[4]; int base = 0; float part = 0.f;
#pragma unroll
                for (int i = 0; i < 4; ++i) { pick[i] = key[u][i] >= prefix[u]; const unsigned long long bm = __builtin_amdgcn_ballot_w64(pick[i]);
                    slot[i] = base + (int)__builtin_amdgcn_mbcnt_hi((unsigned)(bm >> 32), __builtin_amdgcn_mbcnt_lo((unsigned)bm, 0u)); base += __builtin_popcountll(bm);
                    part += pick[i] ? sc[u][i] : 0.f; }
                const float wsum = wave_sum(part);
                const float sc25 = 2.5f / wsum;
#pragma unroll
                for (int i = 0; i < 4; ++i) if (pick[i]) { const int e = lane + 64 * i, ri = (16 * u + it) * TOPK + slot[i]; resI[ri] = e; resW[ri] = sc[u][i] * sc25; __hip_atomic_fetch_add(&hist[e], 1u, __ATOMIC_RELAXED, __HIP_MEMORY_SCOPE_WORKGROUP); } }
        }
        LWAIT();
        *(u32x4*)(TOPI + (size_t)tbase * TOPK + lane * 4) = *(const LAS u32x4*)(resI + lane * 4); *(f32x4*)(TOPW + (size_t)tbase * TOPK + lane * 4) = *(const LAS f32x4*)(resW + lane * 4);
        __syncthreads();
        if (F.tid < 256) HIST[tb * 256 + F.tid] = (int)hist[F.tid];
    }
#undef LWAIT
}

struct UnitBO { int pm, pn, kind; };
struct BOOrder {
    typedef UnitBO Unit;
    int G, vcu; const char *YA, *YB, *MG, *WA, *WB, *WO;
    __device__ __forceinline__ bool next(int i, Unit& u) const { const int rt = i / 12, j = i - rt * 12; u.pm = rt * G + vcu; if (u.pm >= T / 256) return false;
        if (j < 8) { u.pn = j >> 1; u.kind = j & 1; } else { u.pn = j - 8; u.kind = 2; } return true; }
    __device__ __forceinline__ int K(const Unit& u) const { return u.kind == 0 ? 256 : 1024; }
    __device__ __forceinline__ const char* a_base(const Unit& u) const { const char* p = YA; if (u.kind == 1) p = YB; asm volatile("" : "+s"(p)); if (u.kind == 2) p = MG; return p; }
    __device__ __forceinline__ unsigned a_row_off(const Unit& u, int r) const { return (unsigned)(u.pm * 256 + r) * (u.kind == 0 ? 512u : 2048u); }
    __device__ __forceinline__ const char* b_base(const Unit& u) const { const char* p = WA + (size_t)u.pn * 256 * 512; if (u.kind == 1) p = WB + (size_t)u.pn * 256 * 2048; asm volatile("" : "+s"(p)); if (u.kind == 2) p = WO + (size_t)u.pn * 256 * 2048; return p; }
};
struct EpiBO {
    static constexpr bool PERM = true;
    const unsigned char* GAB8; bf16* MG; bf16* YM;
    __device__ __forceinline__ bool operator()(f32x4 (&acc)[2][2][4][2], const UnitBO& u, int wr, int wc, int fr, int fq) const {
        const int row0 = u.pm * 256 + wr * 64 + fr, col0 = u.pn * 256 + wc * 64 + 16 * fq;
        if (u.kind == 0) {
            u32x4 gaq[8], gbq[8];
#pragma unroll
            for (int ai = 0; ai < 2; ++ai)
#pragma unroll
                for (int m = 0; m < 4; ++m) { const unsigned char* g8 = GAB8 + (size_t)(row0 + ai * 128 + m * 16) * 2048 + col0; gaq[ai * 4 + m] = *(const u32x4*)g8; gbq[ai * 4 + m] = *(const u32x4*)(g8 + 1024); }
#pragma unroll
            for (int ai = 0; ai < 2; ++ai)
#pragma unroll
                for (int m = 0; m < 4; ++m)
#pragma unroll
                    for (int bj = 0; bj < 2; ++bj)
#pragma unroll
                        for (int n = 0; n < 2; ++n) { const f32x4 sa = unpk4_sig_u8(gaq[ai * 4 + m][2 * bj + n]), sb = unpk4_sig_u8(gbq[ai * 4 + m][2 * bj + n]);
#pragma unroll
                            for (int e = 0; e < 4; ++e) acc[ai][bj][m][n][e] *= sa[e] * __builtin_amdgcn_rcpf(sb[e]); }
            return false;
        }
        bf16* dbase = YM; if (u.kind == 1) dbase = MG; asm volatile("" : "+s"(dbase));
        u32x4 gbq[8];
        if (u.kind == 1) {
#pragma unroll
            for (int ai = 0; ai < 2; ++ai)
#pragma unroll
                for (int m = 0; m < 4; ++m) gbq[ai * 4 + m] = *(const u32x4*)(GAB8 + (size_t)(row0 + ai * 128 + m * 16) * 2048 + 1024 + col0);
        }
#pragma unroll
        for (int ai = 0; ai < 2; ++ai)
#pragma unroll
            for (int m = 0; m < 4; ++m) { const size_t row = (size_t)(row0 + ai * 128 + m * 16);
                f32x4 s0 = (f32x4){1.f, 1.f, 1.f, 1.f}, s1 = s0, s2 = s0, s3 = s0;
                if (u.kind == 1) { const u32x4 g = gbq[ai * 4 + m]; s0 = unpk4_sig_u8(g[0]); s1 = unpk4_sig_u8(g[1]); s2 = unpk4_sig_u8(g[2]); s3 = unpk4_sig_u8(g[3]); }
                const f32x4 v0 = acc[ai][0][m][0] * s0, v1 = acc[ai][0][m][1] * s1, v2 = acc[ai][1][m][0] * s2, v3 = acc[ai][1][m][1] * s3;
                u32x4 w0, w1; w0.x = g2::cvt_pk_bf16(v0[0], v0[1]); w0.y = g2::cvt_pk_bf16(v0[2], v0[3]); w0.z = g2::cvt_pk_bf16(v1[0], v1[1]); w0.w = g2::cvt_pk_bf16(v1[2], v1[3]);
                w1.x = g2::cvt_pk_bf16(v2[0], v2[1]); w1.y = g2::cvt_pk_bf16(v2[2], v2[3]); w1.z = g2::cvt_pk_bf16(v3[0], v3[1]); w1.w = g2::cvt_pk_bf16(v3[2], v3[3]);
                bf16* dst = dbase + row * 1024 + col0;
                *(u32x4*)dst = w0; *(u32x4*)(dst + 8) = w1; }
        return true;
    }
};
struct OwnBlocks { int vcu, G; __device__ __forceinline__ int block(int i) const { const int tb = i * G + vcu; return tb < T / 256 ? tb : -1; } };
struct OwnRouterOrder {
    typedef g2::UnitMN Unit;
    int G, vcu; const char *H2, *WR;
    __device__ __forceinline__ bool next(int i, Unit& u) const { u.pm = i * G + vcu; u.pn = 0; return u.pm < T / 256; }
    __device__ __forceinline__ int K(const Unit&) const { return 1024; }
    __device__ __forceinline__ const char* a_base(const Unit&) const { return H2; }
    __device__ __forceinline__ unsigned a_row_off(const Unit& u, int r) const { return (unsigned)(u.pm * 256 + r) * 2048u; }
    __device__ __forceinline__ const char* b_base(const Unit&) const { return WR; }
};
__device__ __forceinline__ void ph_normmid_blocks(Frame& F, int vcu);
__device__ __forceinline__ void ph_tokblock(Frame& F) {
    const int bx = blockIdx.x; const int vcu = (F.G % 8 == 0) ? (bx % 8) * (F.G / 8) + bx / 8 : bx;
#if FUSE_ATTN_COMBINE
    ph_attn_combine(F, vcu);
    asm volatile("s_waitcnt vmcnt(0)" ::: "memory"); __syncthreads();
#endif
    { BOOrder S{F.G, vcu, (const char*)(F.outb + OUT_YA), (const char*)(F.outb + OUT_YB), (const char*)(F.ws + WS_MERGED), (const char*)(F.ws + WS_WBA_T), (const char*)(F.ws + WS_WBB_T), (const char*)(F.ws + WS_WOUT_T)};
      EpiBO E{(const unsigned char*)(F.ws + WS_GAB), (bf16*)(F.ws + WS_MERGED), (bf16*)(F.ws + WS_YMIX)};
      g2::gemm_phase<EpiBO, BOOrder>(F.lds, S, E); }
    asm volatile("s_waitcnt vmcnt(0)" ::: "memory"); __syncthreads();
    ph_normmid_blocks(F, vcu);
    asm volatile("s_waitcnt vmcnt(0)" ::: "memory"); __syncthreads();
    { OwnRouterOrder S{F.G, vcu, (const char*)(F.ws + WS_H2), (const char*)(F.ws + WS_WR_T)};
      EpiF32Plain E{(float*)(F.ws + WS_LOGITS), 256};
      g2::gemm_phase<EpiF32Plain, OwnRouterOrder>(F.lds, S, E); }
    asm volatile("s_waitcnt vmcnt(0)" ::: "memory"); __syncthreads();
    ph_topk4(F, OwnBlocks{vcu, F.G});
}
__device__ __forceinline__ void ph_scan2(Frame& F) {
    if (blockIdx.x != 0) return;
    const int* HIST = (const int*)(F.ws + WS_HIST); int* BASEREL = (int*)(F.ws + WS_BASEREL); int* TSG = (int*)(F.ws + WS_TSG); int* TE = (int*)(F.ws + WS_TE);
    unsigned long long* THOFF = (unsigned long long*)(F.ws + WS_THOFF); unsigned long long* DEST = (unsigned long long*)(F.ws + WS_DEST);
    int* ROWTOK = (int*)(F.ws + WS_ROWTOK); float* ROWW = (float*)(F.ws + WS_ROWW);
    LAS int* pre = (LAS int*)F.lds;
    const int e = F.tid;
    int n0 = 0, n1 = 0;
    __syncthreads();
    if (e < NE) {
        for (int tb = 0; tb < 128; ++tb) { const int c = HIST[tb * 256 + e]; BASEREL[tb * 256 + e] = n0; n0 += c; }
        for (int tb = 128; tb < 256; ++tb) { const int c = HIST[tb * 256 + e]; BASEREL[tb * 256 + e] = n1; n1 += c; }
        pre[e] = (n0 + 255) >> 8; pre[256 + e] = (n1 + 255) >> 8;
    }
    __syncthreads();
    if (F.tid == 0) { int a = 0; for (int i = 0; i < NE; ++i) { const int c = pre[i]; pre[i] = a; a += c; } pre[512] = a;
        int b2 = a + 128; for (int i = 0; i < NE; ++i) { const int c = pre[256 + i]; pre[256 + i] = b2; b2 += c; } pre[513] = b2 - (a + 128);
        F.ctl[CW_NT0] = (unsigned)(a + 128); F.ctl[CW_NT] = (unsigned)(b2 + 128); }
    __syncthreads();
    const int R0 = pre[512], R1 = pre[513];
    unsigned char* dump = F.ws + WS_DUMP;
    if (e < NE) {
        const int ts0 = pre[e], ts1 = pre[256 + e], nt0 = (n0 + 255) >> 8, nt1 = (n1 + 255) >> 8;
        TSG[e] = ts0; TSG[256 + e] = ts1;
        for (int u = 0; u < nt0; ++u) { TE[ts0 + u] = e; THOFF[ts0 + u] = (unsigned long long)WS_HIDR + (unsigned long long)(ts0 + u) * (256 * 512); }
        for (int u = 0; u < nt1; ++u) { TE[ts1 + u] = e; THOFF[ts1 + u] = (unsigned long long)WS_HIDR + (unsigned long long)(ts1 + u - 128) * (256 * 512); }
        for (int r = n0; r < nt0 * 256; ++r) { const int p = ts0 * 256 + r; ROWTOK[p] = p & (T - 1); ROWW[p] = 0.f; DEST[p] = (unsigned long long)dump; }
        for (int r = n1; r < nt1 * 256; ++r) { const int p = ts1 * 256 + r; ROWTOK[p] = p & (T - 1); ROWW[p] = 0.f; DEST[p] = (unsigned long long)dump; }
    }
#pragma unroll 1
    for (int half = 0; half < 2; ++half) { const int tb0 = half ? (R0 + 128 + R1) : R0;
        if (F.tid < 128) { TE[tb0 + F.tid] = 256; THOFF[tb0 + F.tid] = (unsigned long long)WS_HIDS + (unsigned long long)(half * HALF_T + F.tid * 256) * 512; }
        for (int i = F.tid; i < HALF_T; i += NTHR) { const int tok = half * HALF_T + i; const int p = tb0 * 256 + i; ROWTOK[p] = tok; ROWW[p] = 1.0f; DEST[p] = (unsigned long long)slot_ptr(F.ws, F.outb, half, 8, tok); } }
}
__device__ __forceinline__ void ph_scatter2(Frame& F) {
    const int* TOPI = (const int*)(F.ws + WS_TOPI); const float* TOPW = (const float*)(F.ws + WS_TOPW); const int* BASEREL = (const int*)(F.ws + WS_BASEREL); const int* TSG = (const int*)(F.ws + WS_TSG);
    int* ROWTOK = (int*)(F.ws + WS_ROWTOK); float* ROWW = (float*)(F.ws + WS_ROWW); unsigned long long* DEST = (unsigned long long*)(F.ws + WS_DEST);
    LAS unsigned* cur = (LAS unsigned*)F.lds;
    for (int tb = blockIdx.x; tb < T / 256; tb += F.G) {
        const int half = tb >> 7;
        __syncthreads();
        if (F.tid < 256) cur[F.tid] = (unsigned)(TSG[half * 256 + F.tid] * 256 + BASEREL[tb * 256 + F.tid]);
        __syncthreads();
#pragma unroll
        for (int i = 0; i < 4; ++i) { const int item = F.tid + NTHR * i; const int t = tb * 256 + (item >> 3), k = item & 7;
            const int e = TOPI[(size_t)t * TOPK + k]; const unsigned p = __hip_atomic_fetch_add(&cur[e], 1u, __ATOMIC_RELAXED, __HIP_MEMORY_SCOPE_WORKGROUP);
            ROWTOK[p] = t; ROWW[p] = TOPW[(size_t)t * TOPK + k]; DEST[p] = (unsigned long long)slot_ptr(F.ws, F.outb, half, k, t); }
    }
}

#if MOE_FP8
constexpr size_t HIDR_OFF = WS_HIDR8, HIDS_OFF = WS_HIDS8; constexpr int HID_ROWB = 256;
#else
constexpr size_t HIDR_OFF = WS_HIDR, HIDS_OFF = WS_HIDS; constexpr int HID_ROWB = 512;
#endif
__device__ __forceinline__ void ph_scatter3(Frame& F) {
    const int* TOPI = (const int*)(F.ws + WS_TOPI); const float* TOPW = (const float*)(F.ws + WS_TOPW); const int* HIST = (const int*)(F.ws + WS_HIST);
    int* TE = (int*)(F.ws + WS_TE); unsigned long long* THOFF = (unsigned long long*)(F.ws + WS_THOFF);
    int* ROWTOK = (int*)(F.ws + WS_ROWTOK); float* ROWW = (float*)(F.ws + WS_ROWW); unsigned long long* DEST = (unsigned long long*)(F.ws + WS_DEST);
    LAS int* pre = (LAS int*)F.lds;
    LAS unsigned* cur = (LAS unsigned*)(F.lds + 4096);
    LAS int* cnt = (LAS int*)(F.lds + 8192);
    unsigned char* dump = F.ws + WS_DUMP;
    for (int tb = blockIdx.x; tb < T / 256; tb += F.G) {
        const int half = tb >> 7; const int e = F.tid;
        int n0 = 0, n1 = 0, mybase = 0;
        __syncthreads();
        if (e < NE) {
#pragma unroll 8
            for (int t2 = 0; t2 < 128; ++t2) { const int c = HIST[t2 * 256 + e]; if (half == 0 && t2 < tb) mybase += c; n0 += c; }
#pragma unroll 8
            for (int t2 = 128; t2 < 256; ++t2) { const int c = HIST[t2 * 256 + e]; if (half == 1 && t2 < tb) mybase += c; n1 += c; }
            pre[e] = (n0 + 255) >> 8; pre[256 + e] = (n1 + 255) >> 8; cnt[e] = n0; cnt[256 + e] = n1;
        }
        __syncthreads();
        if (F.wave == 0) {
            int v[8]; int s0 = 0, s1 = 0;
#pragma unroll
            for (int i = 0; i < 4; ++i) { v[i] = pre[4 * F.lane + i]; v[4 + i] = pre[256 + 4 * F.lane + i]; s0 += v[i]; s1 += v[4 + i]; }
            int i0 = s0, i1 = s1;
#pragma unroll
            for (int o = 1; o < 64; o <<= 1) { const int a0 = __shfl_up(i0, o), a1 = __shfl_up(i1, o); if (F.lane >= o) { i0 += a0; i1 += a1; } }
            const int R0 = __shfl(i0, 63), R1 = __shfl(i1, 63);
            int x0 = i0 - s0, x1 = R0 + 128 + (i1 - s1);
#pragma unroll
            for (int i = 0; i < 4; ++i) { pre[4 * F.lane + i] = x0; x0 += v[i]; pre[256 + 4 * F.lane + i] = x1; x1 += v[4 + i]; }
            if (F.lane == 0) { pre[512] = R0; pre[513] = R1; if (tb == 0) { F.ctl[CW_NT0] = (unsigned)(R0 + 128); F.ctl[CW_NT] = (unsigned)(R0 + R1 + 256); } }
        }
        __syncthreads();
        const int R0 = pre[512], R1 = pre[513];
        if (e < NE) cur[e] = (unsigned)(pre[half * 256 + e] * 256 + mybase);
        { const int ee = tb; const int ts0 = pre[ee], ts1 = pre[256 + ee], c0 = cnt[ee], c1 = cnt[256 + ee], nt0 = (c0 + 255) >> 8, nt1 = (c1 + 255) >> 8;
          if (F.tid < nt0) { TE[ts0 + F.tid] = ee; THOFF[ts0 + F.tid] = (unsigned long long)HIDR_OFF + (unsigned long long)(ts0 + F.tid) * (256 * HID_ROWB); }
          if (F.tid < nt1) { TE[ts1 + F.tid] = ee; THOFF[ts1 + F.tid] = (unsigned long long)HIDR_OFF + (unsigned long long)(ts1 + F.tid - 128) * (256 * HID_ROWB); }
          if (F.tid < 256) { const int r0p = c0 + F.tid; if (r0p < nt0 * 256) { const int p = ts0 * 256 + r0p; ROWTOK[p] = p & (T - 1); ROWW[p] = 0.f; DEST[p] = (unsigned long long)dump; }
                             const int r1p = c1 + F.tid; if (r1p < nt1 * 256) { const int p = ts1 * 256 + r1p; ROWTOK[p] = p & (T - 1); ROWW[p] = 0.f; DEST[p] = (unsigned long long)dump; } } }
        { const int stile = (half ? (R0 + 128 + R1) : R0) + (tb & 127);
          if (F.tid == 0) { TE[stile] = 256; THOFF[stile] = (unsigned long long)HIDS_OFF + (unsigned long long)(tb * 256) * HID_ROWB; }
          if (F.tid < 256) { const int tok = tb * 256 + F.tid; const int p = stile * 256 + F.tid; ROWTOK[p] = tok; ROWW[p] = 1.0f; DEST[p] = (unsigned long long)slot_ptr(F.ws, F.outb, half, 8, tok); } }
        __syncthreads();
#pragma unroll
        for (int i = 0; i < 4; ++i) { const int item = F.tid + NTHR * i; const int t = tb * 256 + (item >> 3), k = item & 7;
            const int ex = TOPI[(size_t)t * TOPK + k]; const unsigned p = __hip_atomic_fetch_add(&cur[ex], 1u, __ATOMIC_RELAXED, __HIP_MEMORY_SCOPE_WORKGROUP);
            ROWTOK[p] = t; ROWW[p] = TOPW[(size_t)t * TOPK + k]; DEST[p] = (unsigned long long)slot_ptr(F.ws, F.outb, half, k, t); }
    }
}
struct UnitEx2 { int u, sub, e; const char* ab; };
struct GuOrder2 {
    typedef UnitEx2 Unit;
    int nun, G, vcu; const int* TE; const int* ROWTOK; const char *H2, *WGU, *WSGU;
    __device__ __forceinline__ bool next(int i, Unit& x) const { const int L = i * G + vcu; if (L >= nun) return false; x.u = L >> 1; x.sub = L & 1; x.e = TE[x.u]; x.ab = nullptr; return true; }
    __device__ __forceinline__ int K(const Unit&) const { return 1024; }
    __device__ __forceinline__ const char* a_base(const Unit&) const { return H2; }
    __device__ __forceinline__ unsigned a_row_off(const Unit& x, int r) const { return (unsigned)ROWTOK[(unsigned)(x.u * 256 + r)] * 2048u; }
    __device__ __forceinline__ const char* b_base(const Unit& x) const { return (x.e < 256 ? WGU + (size_t)x.e * (512 * 1024 * 2) : WSGU) + (size_t)x.sub * (256 * 1024 * 2); }
};
struct EpiGu2 {
    static constexpr bool PERM = true;
    unsigned char* ws; const unsigned long long* THOFF;
    __device__ __forceinline__ bool operator()(const f32x4 (&acc)[2][2][4][2], const UnitEx2& x, int wr, int wc, int fr, int fq) const {
        bf16* base = (bf16*)(ws + THOFF[x.u]);
        const int row0 = wr * 64 + fr, col0 = x.sub * 128 + wc * 32 + 8 * fq;
#pragma unroll
        for (int ai = 0; ai < 2; ++ai)
#pragma unroll
            for (int m = 0; m < 4; ++m) { const f32x4 g0 = acc[ai][0][m][0], g1 = acc[ai][0][m][1], u0 = acc[ai][1][m][0], u1 = acc[ai][1][m][1]; f32x4 h0, h1;
#pragma unroll
                for (int e = 0; e < 4; ++e) { h0[e] = g0[e] * fsig(g0[e]) * u0[e]; h1[e] = g1[e] * fsig(g1[e]) * u1[e]; }
                u32x4 w; w.x = g2::cvt_pk_bf16(h0[0], h0[1]); w.y = g2::cvt_pk_bf16(h0[2], h0[3]); w.z = g2::cvt_pk_bf16(h1[0], h1[1]); w.w = g2::cvt_pk_bf16(h1[2], h1[3]);
                *(u32x4*)(base + (size_t)(row0 + ai * 128 + m * 16) * 256 + col0) = w; asm volatile("" ::: "memory"); }
        return true;
    }
};
struct DownOrder2 {
    typedef UnitEx2 Unit;
    int tlo, nun, G, vcu; const int* TE; const unsigned long long* THOFF; const char *wsb, *WD, *WSD;
    __device__ __forceinline__ bool next(int i, Unit& x) const { const int L = i * G + vcu; if (L >= nun) return false; x.u = tlo + (L >> 2); x.sub = L & 3; x.e = TE[x.u]; x.ab = nullptr; return true; }
    __device__ __forceinline__ int K(const Unit&) const { return 256; }
    __device__ __forceinline__ const char* a_base(const Unit& x) const { return wsb + THOFF[x.u]; }
    __device__ __forceinline__ unsigned a_row_off(const Unit&, int r) const { return (unsigned)r * 512u; }
    __device__ __forceinline__ const char* b_base(const Unit& x) const { return (x.e < 256 ? WD + (size_t)x.e * (1024 * 256 * 2) : WSD) + (size_t)x.sub * (256 * 256 * 2); }
};
struct EpiDown2 {
    static constexpr bool PERM = true;
    const unsigned long long* DEST; const float* ROWW;
    __device__ __forceinline__ bool operator()(const f32x4 (&acc)[2][2][4][2], const UnitEx2& x, int wr, int wc, int fr, int fq) const {
        const int row0 = x.u * 256 + wr * 64 + fr; const int cb = (x.sub * 256 + wc * 32 + 8 * fq) * 2;
#pragma unroll
        for (int ai = 0; ai < 2; ++ai)
#pragma unroll
            for (int m = 0; m < 4; ++m) { const int r = row0 + ai * 128 + m * 16; unsigned char* dp = (unsigned char*)DEST[r] + cb; const float w = ROWW[r];
#pragma unroll
                for (int bj = 0; bj < 2; ++bj) { const f32x4 v0 = acc[ai][bj][m][0] * w, v1 = acc[ai][bj][m][1] * w;
                    u32x4 o; o.x = g2::cvt_pk_bf16(v0[0], v0[1]); o.y = g2::cvt_pk_bf16(v0[2], v0[3]); o.z = g2::cvt_pk_bf16(v1[0], v1[1]); o.w = g2::cvt_pk_bf16(v1[2], v1[3]);
                    *(u32x4*)(dp + bj * 256) = o; }
                asm volatile("" ::: "memory"); }
        return true;
    }
};
__device__ __forceinline__ void ph_gu2(Frame& F) {
    const int NT = (int)__hip_atomic_load(F.ctl + CW_NT, __ATOMIC_RELAXED, __HIP_MEMORY_SCOPE_AGENT);
    const int bx = blockIdx.x; const int vcu = (F.G % 8 == 0) ? (bx % 8) * (F.G / 8) + bx / 8 : bx;
    GuOrder2 S{2 * NT, F.G, vcu, (const int*)(F.ws + WS_TE), (const int*)(F.ws + WS_ROWTOK), (const char*)(F.ws + WS_H2), (const char*)(F.ws + WS_WGU), (const char*)(F.ws + WS_WSGU_T)};
    EpiGu2 E{F.ws, (const unsigned long long*)(F.ws + WS_THOFF)};
    g2::gemm_phase<EpiGu2, GuOrder2>(F.lds, S, E);
}
__device__ __forceinline__ void ph_down2(Frame& F, int half) {
    const int NT = (int)__hip_atomic_load(F.ctl + CW_NT, __ATOMIC_RELAXED, __HIP_MEMORY_SCOPE_AGENT), NT0 = (int)__hip_atomic_load(F.ctl + CW_NT0, __ATOMIC_RELAXED, __HIP_MEMORY_SCOPE_AGENT);
    const int tlo = half ? NT0 : 0, thi = half ? NT : NT0;
    const int bx = blockIdx.x; const int vcu = (F.G % 8 == 0) ? (bx % 8) * (F.G / 8) + bx / 8 : bx;
    DownOrder2 S{tlo, 4 * (thi - tlo), F.G, vcu, (const int*)(F.ws + WS_TE), (const unsigned long long*)(F.ws + WS_THOFF), (const char*)F.ws, (const char*)(F.ws + WS_WD), (const char*)(F.ws + WS_WSD_T)};
    EpiDown2 E{(const unsigned long long*)(F.ws + WS_DEST), (const float*)(F.ws + WS_ROWW)};
    g2::gemm_phase<EpiDown2, DownOrder2>(F.lds, S, E);
}

struct GuOrder8 {
    typedef UnitEx2 Unit;
    int nun, G, vcu; const int* TE; const int* ROWTOK; const char *H2, *WGU, *WSGU;
    __device__ __forceinline__ bool next(int i, Unit& x) const { const int L = i * G + vcu; if (L >= nun) return false; x.u = L >> 1; x.sub = L & 1; x.e = TE[x.u]; x.ab = nullptr; return true; }
    __device__ __forceinline__ int K(const Unit&) const { return 512; }
    __device__ __forceinline__ const char* a_base(const Unit&) const { return H2; }
    __device__ __forceinline__ unsigned a_row_off(const Unit& x, int r) const { return (unsigned)ROWTOK[(unsigned)(x.u * 256 + r)] * 1024u; }
    __device__ __forceinline__ const char* b_base(const Unit& x) const { return (x.e < 256 ? WGU + (size_t)x.e * (512 * 1024) : WSGU) + (size_t)x.sub * (256 * 1024); }
};
struct EpiGu8 {
    static constexpr bool PERM = true;
    unsigned char* ws; const unsigned long long* THOFF;
    __device__ __forceinline__ bool operator()(const f32x4 (&acc)[2][2][4][2], const UnitEx2& x, int wr, int wc, int fr, int fq) const {
        unsigned char* base = ws + THOFF[x.u];
        const int row0 = wr * 64 + fr, col0 = x.sub * 128 + wc * 32 + 8 * fq;
#pragma unroll
        for (int ai = 0; ai < 2; ++ai)
#pragma unroll
            for (int m = 0; m < 4; ++m) { const f32x4 g0 = acc[ai][0][m][0], g1 = acc[ai][0][m][1], u0 = acc[ai][1][m][0], u1 = acc[ai][1][m][1]; f32x4 h0, h1;
#pragma unroll
                for (int e = 0; e < 4; ++e) { h0[e] = g0[e] * fsig(g0[e]) * u0[e]; h1[e] = g1[e] * fsig(g1[e]) * u1[e]; }
                u32x2 w; w.x = pk4_fp8(h0[0], h0[1], h0[2], h0[3]); w.y = pk4_fp8(h1[0], h1[1], h1[2], h1[3]);
                *(u32x2*)(base + (size_t)(row0 + ai * 128 + m * 16) * 256 + col0) = w; asm volatile("" ::: "memory"); }
        return true;
    }
};
struct DownOrder8 {
    typedef UnitEx2 Unit;
    int tlo, nun, G, vcu; const int* TE; const unsigned long long* THOFF; const char *wsb, *WD, *WSD;
    __device__ __forceinline__ bool next(int i, Unit& x) const { const int tl = (i >> 2) * G + vcu; if (4 * tl >= nun) return false; x.u = tlo + tl; x.sub = i & 3; x.e = TE[x.u]; x.ab = wsb + THOFF[x.u]; return true; }
    __device__ __forceinline__ int K(const Unit&) const { return 128; }
    __device__ __forceinline__ const char* a_base(const Unit& x) const { return x.ab; }
    __device__ __forceinline__ unsigned a_row_off(const Unit&, int r) const { return (unsigned)r * 256u; }
    __device__ __forceinline__ const char* b_base(const Unit& x) const { return (x.e < 256 ? WD + (size_t)x.e * (1024 * 256) : WSD) + (size_t)x.sub * (256 * 256); }
};
__device__ __forceinline__ void ph_gu8(Frame& F) {
    const int NT = (int)__hip_atomic_load(F.ctl + CW_NT, __ATOMIC_RELAXED, __HIP_MEMORY_SCOPE_AGENT);
    const int bx = blockIdx.x; const int vcu = (F.G % 8 == 0) ? (bx % 8) * (F.G / 8) + bx / 8 : bx;
    GuOrder8 S{2 * NT, F.G, vcu, (const int*)(F.ws + WS_TE), (const int*)(F.ws + WS_ROWTOK), (const char*)(F.ws + WS_H2F8), (const char*)(F.ws + WS_WGU8), (const char*)(F.ws + WS_WSGU8)};
    EpiGu8 E{F.ws, (const unsigned long long*)(F.ws + WS_THOFF)};
    g2::gemm_phase<EpiGu8, GuOrder8, true>(F.lds, S, E, 127 - 5);
}
__device__ __forceinline__ void ph_down8(Frame& F, int half) {
    const int NT = (int)__hip_atomic_load(F.ctl + CW_NT, __ATOMIC_RELAXED, __HIP_MEMORY_SCOPE_AGENT), NT0 = (int)__hip_atomic_load(F.ctl + CW_NT0, __ATOMIC_RELAXED, __HIP_MEMORY_SCOPE_AGENT);
    const int tlo = half ? NT0 : 0, thi = half ? NT : NT0;
    const int bx = blockIdx.x; const int vcu = (F.G % 8 == 0) ? (bx % 8) * (F.G / 8) + bx / 8 : bx;
    DownOrder8 S{tlo, 4 * (thi - tlo), F.G, vcu, (const int*)(F.ws + WS_TE), (const unsigned long long*)(F.ws + WS_THOFF), (const char*)F.ws, (const char*)(F.ws + WS_WD8), (const char*)(F.ws + WS_WSD8)};
    EpiDown2 E{(const unsigned long long*)(F.ws + WS_DEST), (const float*)(F.ws + WS_ROWW)};
    g2::gemm_phase<EpiDown2, DownOrder8, true>(F.lds, S, E, 127 - 4);
}
__device__ __forceinline__ void ph_combine2(Frame& F, int half) {
    const float* mod = (const float*)(F.ws + WS_MOD); const float* g = F.in[I_GPOSTFFN];
    for (int t = half * HALF_T + blockIdx.x * NWAVES + F.wave; t < (half + 1) * HALF_T; t += F.G * NWAVES) {
        const int b = t / SEQ; const float* gt2 = mod + b * 6144 + 5120;
        float y[16];
#pragma unroll
        for (int i = 0; i < 16; ++i) y[i] = 0.f;
#pragma unroll
        for (int k = 0; k < 9; ++k) { const unsigned char* sp = slot_ptr(F.ws, F.outb, half, k, t);
#pragma unroll
            for (int j = 0; j < 4; ++j) { const u32x2 w = *(const u32x2*)(sp + (F.lane * 4 + 256 * j) * 2);
                y[4 * j + 0] += __uint_as_float(w.x << 16); y[4 * j + 1] += __uint_as_float(w.x & 0xffff0000u); y[4 * j + 2] += __uint_as_float(w.y << 16); y[4 * j + 3] += __uint_as_float(w.y & 0xffff0000u); } }
        f32x4 x1[4]; x1_row(F, t, x1);
        float ss = 0.f;
#pragma unroll
        for (int i = 0; i < 16; ++i) ss += y[i] * y[i];
        const float rstd = rsqrtf(wave_sum(ss) * (1.0f / D) + EPS);
#pragma unroll
        for (int j = 0; j < 4; ++j) { const int c = F.lane * 4 + 256 * j; const f32x4 gg = *(const f32x4*)(g + c), gt = *(const f32x4*)(gt2 + c);
            f32x4 o;
#pragma unroll
            for (int e = 0; e < 4; ++e) o[e] = x1[j][e] + gt[e] * (y[4 * j + e] * rstd * gg[e]);
            *(f32x4*)(F.out + (size_t)t * D + c) = o; }
    }
}


constexpr float SLOT_SC = 16.0f;
__device__ __forceinline__ unsigned char* slot8_ptr(unsigned char* ws, unsigned char* outb, int k, int t) {
    if (k < 4) return outb + (size_t)t * 4096 + k * 1024;
    const int ri = k - 4; const size_t base = (ri == 0) ? 192 : (ri == 1) ? 256 : (ri == 2) ? 320 : (ri == 3) ? 384 : 736;
    return ws + base * MiB + (size_t)t * 1024;
}
constexpr size_t YS_A = 192 * MiB, YS_B = 736 * MiB; constexpr int YS_NA = 262144;
__device__ __forceinline__ unsigned char* ys_row(unsigned char* ws, int p) { return ws + (p < YS_NA ? YS_A + (size_t)p * 1024 : YS_B + (size_t)(p - YS_NA) * 1024); }
static_assert(YS_NA % 256 == 0 && YS_A + (size_t)YS_NA * 1024 <= WS_HIDS8 && YS_B + (size_t)(T * 8 + 256 * 255 - YS_NA) * 1024 <= WS_NEED, "dense MoE output map");
__device__ __forceinline__ void ph_scatter4(Frame& F) {
    const int* TOPI = (const int*)(F.ws + WS_TOPI); const float* TOPW = (const float*)(F.ws + WS_TOPW); const int* HIST = (const int*)(F.ws + WS_HIST);
    int* TE = (int*)(F.ws + WS_TE); unsigned long long* THOFF = (unsigned long long*)(F.ws + WS_THOFF);
    int* ROWTOK = (int*)(F.ws + WS_ROWTOK); float* ROWW = (float*)(F.ws + WS_ROWW); int* POS = (int*)(F.ws + WS_DEST);
    LAS int* pre = (LAS int*)F.lds;
    LAS unsigned* cur = (LAS unsigned*)(F.lds + 4096);
    LAS int* cnt = (LAS int*)(F.lds + 8192);
    for (int tb = blockIdx.x; tb < T / 256; tb += F.G) {
        const int e = F.tid; int n0 = 0, mybase = 0;
        __syncthreads();
        if (e < NE) {
#pragma unroll 8
            for (int t2 = 0; t2 < 256; ++t2) { const int c = HIST[t2 * 256 + e]; if (t2 < tb) mybase += c; n0 += c; }
            pre[e] = (n0 + 255) >> 8; cnt[e] = n0;
        }
        __syncthreads();
        if (F.wave == 0) { int v[4]; int s0 = 0;
#pragma unroll
            for (int i = 0; i < 4; ++i) { v[i] = pre[4 * F.lane + i]; s0 += v[i]; }
            int i0 = s0;
#pragma unroll
            for (int o = 1; o < 64; o <<= 1) { const int a0 = __shfl_up(i0, o); if (F.lane >= o) i0 += a0; }
            const int R = __shfl(i0, 63); int x0 = i0 - s0;
#pragma unroll
            for (int i = 0; i < 4; ++i) { pre[4 * F.lane + i] = x0; x0 += v[i]; }
            if (F.lane == 0) { pre[512] = R; if (tb == 0) { F.ctl[CW_NT0] = (unsigned)R; F.ctl[CW_NT] = (unsigned)(R + 256); } } }
        __syncthreads();
        const int R = pre[512];
        if (e < NE) cur[e] = (unsigned)(pre[e] * 256 + mybase);
        { const int ee = tb; const int ts0 = pre[ee], c0 = cnt[ee], nt0 = (c0 + 255) >> 8;
          if (F.tid < nt0) { TE[ts0 + F.tid] = ee; THOFF[ts0 + F.tid] = (unsigned long long)HIDR_OFF + (unsigned long long)(ts0 + F.tid) * (256 * HID_ROWB); }
          if (F.tid < 256) { const int r0p = c0 + F.tid; if (r0p < nt0 * 256) { const int p = ts0 * 256 + r0p; ROWTOK[p] = p & (T - 1); ROWW[p] = 0.f; } } }
        { const int stile = R + tb;
          if (F.tid == 0) { TE[stile] = 256; THOFF[stile] = (unsigned long long)HIDS_OFF + (unsigned long long)(tb * 256) * HID_ROWB; }
          if (F.tid < 256) { const int tok = tb * 256 + F.tid; const int p = stile * 256 + F.tid; ROWTOK[p] = tok; ROWW[p] = 1.0f; } }
        __syncthreads();
#pragma unroll
        for (int i = 0; i < 4; ++i) { const int item = F.tid + NTHR * i; const int t = tb * 256 + (item >> 3), k = item & 7;
            const int ex = TOPI[(size_t)t * TOPK + k]; const unsigned p = __hip_atomic_fetch_add(&cur[ex], 1u, __ATOMIC_RELAXED, __HIP_MEMORY_SCOPE_WORKGROUP);
            ROWTOK[p] = t; ROWW[p] = TOPW[(size_t)t * TOPK + k]; POS[(size_t)t * TOPK + k] = (int)p; }
    }
}
struct EpiDown8 {
    static constexpr bool PERM = true;
    unsigned char* ws; unsigned char* outb; const float* ROWW; int R; int dbg; unsigned char* dbgbase;
    __device__ __forceinline__ bool operator()(const f32x4 (&acc)[2][2][4][2], const UnitEx2& x, int wr, int wc, int fr, int fq) const {
        const int rl = wr * 64 + fr; const int cb = x.sub * 256 + wc * 64 + 16 * fq;
        const bool sh = x.e == 256;
        unsigned char* base = sh ? outb + (size_t)(x.u - R) * (256 * 4096) : ys_row(ws, x.u * 256); const int pitch = sh ? 4096 : 1024;
        if (dbg == 2) base = dbgbase + (size_t)((x.u * 256) & 65535) * 1024;
        float wv[8];
#pragma unroll
        for (int q = 0; q < 8; ++q) wv[q] = ROWW[x.u * 256 + rl + (q >> 2) * 128 + (q & 3) * 16];
#pragma unroll
        for (int ai = 0; ai < 2; ++ai)
#pragma unroll
            for (int m = 0; m < 4; ++m) { const int i = rl + ai * 128 + m * 16; unsigned char* dp = base + (size_t)i * (dbg == 2 ? 1024 : pitch) + cb; const float w = wv[ai * 4 + m] * SLOT_SC;
                if (dbg == 1) { if (acc[ai][0][m][0][0] == 123.456f) dp[0] = 1; continue; }
                const f32x4 a0 = acc[ai][0][m][0] * w, a1 = acc[ai][0][m][1] * w, b0 = acc[ai][1][m][0] * w, b1 = acc[ai][1][m][1] * w;
                u32x4 o; o.x = pk4_fp8(a0[0], a0[1], a0[2], a0[3]); o.y = pk4_fp8(a1[0], a1[1], a1[2], a1[3]); o.z = pk4_fp8(b0[0], b0[1], b0[2], b0[3]); o.w = pk4_fp8(b1[0], b1[1], b1[2], b1[3]);
                *(u32x4*)dp = o;
                asm volatile("" ::: "memory"); }
        return true;
    }
};
__device__ __forceinline__ void ph_down9(Frame& F, int dbg = 0) {
    const int NT = (int)__hip_atomic_load(F.ctl + CW_NT, __ATOMIC_RELAXED, __HIP_MEMORY_SCOPE_AGENT);
    const int bx = blockIdx.x; const int vcu = (F.G % 8 == 0) ? (bx % 8) * (F.G / 8) + bx / 8 : bx;
    DownOrder8 S{0, 4 * NT, F.G, vcu, (const int*)(F.ws + WS_TE), (const unsigned long long*)(F.ws + WS_THOFF), (const char*)F.ws, (const char*)(F.ws + WS_WD8), (const char*)(F.ws + WS_WSD8)};
    const int R = (int)__hip_atomic_load(F.ctl + CW_NT0, __ATOMIC_RELAXED, __HIP_MEMORY_SCOPE_AGENT);
    EpiDown8 E{F.ws, F.outb, (const float*)(F.ws + WS_ROWW), R, dbg, F.ws + 640 * MiB};
    g2::gemm_phase<EpiDown8, DownOrder8, true, DOWN_ALIGN>(F.lds, S, E, 127 - 4);
}
struct X1B { u32x2 xm[4]; };
__device__ __forceinline__ void x1b_load(Frame& F, int t, X1B& r) {
    const bf16* XM = (const bf16*)(F.ws + WS_YMIX);
#pragma unroll
    for (int j = 0; j < 4; ++j) r.xm[j] = *(const u32x2*)(XM + (size_t)t * D + F.lane * 4 + 256 * j);
}
__device__ __forceinline__ void ph_combine9(Frame& F) {
    const float* mod = (const float*)(F.ws + WS_MOD); const float* g = F.in[I_GPOSTFFN];
    const int* POS = (const int*)(F.ws + WS_DEST);
#define C9_TOK(qq) ((int)((blockIdx.x + ((qq) >> 5) * F.G) << 8) + F.wave + 8 * ((qq) & 31))
#define C9_POS(tt) (((tt) < T) ? POS[(size_t)(tt) * TOPK + (F.lane & 7)] : 0)
#define C9_LOAD(SN, tt, pp) do { _Pragma("unroll") for (int k = 0; k < 9; ++k) { \
        const unsigned char* sp = (k < 8) ? ys_row(F.ws, __builtin_amdgcn_readlane((pp), k)) : F.outb + (size_t)(tt) * 4096; \
        _Pragma("unroll") for (int j = 0; j < 4; ++j) SN[k][j] = *(const int*)(sp + F.lane * 4 + 256 * j); } } while (0)
#define C9_STEP(SN, tt, tn1, tnx, pnx) do { \
        float y[16]; \
        _Pragma("unroll") for (int i = 0; i < 16; ++i) y[i] = 0.f; \
        _Pragma("unroll") for (int k = 0; k < 9; ++k) _Pragma("unroll") for (int j = 0; j < 4; ++j) { const int w = SN[k][j]; \
            y[4 * j + 0] += __builtin_amdgcn_cvt_f32_fp8(w, 0); y[4 * j + 1] += __builtin_amdgcn_cvt_f32_fp8(w, 1); y[4 * j + 2] += __builtin_amdgcn_cvt_f32_fp8(w, 2); y[4 * j + 3] += __builtin_amdgcn_cvt_f32_fp8(w, 3); } \
        const X1B rc = rn; \
        if ((tn1) < T) x1b_load(F, (tn1), rn); \
        if ((tnx) < T) C9_LOAD(SN, (tnx), (pnx)); \
        const int b = (tt) / SEQ; const float* gt2 = mod + b * 6144 + 5120; \
        f32x4 x1[4]; \
        _Pragma("unroll") for (int j = 0; j < 4; ++j) { const u32x2 w = rc.xm[j]; x1[j] = (f32x4){__uint_as_float(w.x << 16), __uint_as_float(w.x & 0xffff0000u), __uint_as_float(w.y << 16), __uint_as_float(w.y & 0xffff0000u)}; } \
        float ss = 0.f; \
        _Pragma("unroll") for (int i = 0; i < 16; ++i) ss += y[i] * y[i]; \
        const float rstd = rsqrtf(wave_sum(ss) * (1.0f / (D * SLOT_SC * SLOT_SC)) + EPS);            \
        _Pragma("unroll") for (int j = 0; j < 4; ++j) { const int c = F.lane * 4 + 256 * j; const f32x4 gg = *(const f32x4*)(g + c), gt = *(const f32x4*)(gt2 + c); \
            f32x4 o; \
            _Pragma("unroll") for (int e = 0; e < 4; ++e) o[e] = x1[j][e] + gt[e] * (y[4 * j + e] * (1.0f / SLOT_SC) * rstd * gg[e]); \
            *(f32x4*)(F.out + (size_t)(tt) * D + c) = o; } } while (0)
    X1B rn; int sA[9][4], sB[9][4];
    int q = 0, t0 = C9_TOK(0), t1 = C9_TOK(1);
    { const int p0 = C9_POS(t0), p1 = C9_POS(t1);
      if (t0 < T) { x1b_load(F, t0, rn); C9_LOAD(sA, t0, p0); }
      if (t1 < T) C9_LOAD(sB, t1, p1); }
    int p2 = C9_POS(C9_TOK(2)), p3 = C9_POS(C9_TOK(3));
    for (; t0 < T; q += 2) {
        { int ln = F.lane; asm volatile("" : "+v"(ln)); F.lane = ln; }
        const int t2 = C9_TOK(q + 2), t3 = C9_TOK(q + 3);
        const int p4 = C9_POS(C9_TOK(q + 4)), p5 = C9_POS(C9_TOK(q + 5));
        C9_STEP(sA, t0, t1, t2, p2);
        if (t1 < T) C9_STEP(sB, t1, t2, t3, p3);
        t0 = t2; t1 = t3; p2 = p4; p3 = p5;
    }
#undef C9_STEP
#undef C9_LOAD
#undef C9_POS
#undef C9_TOK
}
__device__ __forceinline__ void ph_router_naive(Frame& F) {
    LAS float* As = (LAS float*)F.lds; LAS float* Bs = As + 16 * 132;
    const bf16* H2 = (const bf16*)(F.ws + WS_H2); float* LG = (float*)(F.ws + WS_LOGITS);
    const int ty = F.tid >> 5, tx = F.tid & 31;
    for (int vb = blockIdx.x; vb < (T / 128) * 2; vb += F.G) {
        const int tm = vb >> 1, tn = vb & 1, m0 = tm * 128, n0 = tn * 128;
        float a1[8][4]; ZERO_ACC(a1);
        ARowGlobal ra{H2, (size_t)D, m0, nullptr}; ngemm_acc(As, Bs, ra, F.in[I_RW], NE, D, n0, NE, a1);
#pragma unroll
        for (int i = 0; i < 8; ++i) { const size_t row = (size_t)(m0 + ty * 8 + i); const int col = n0 + tx * 4;
            *(f32x4*)(LG + row * NE + col) = (f32x4){a1[i][0], a1[i][1], a1[i][2], a1[i][3]}; }
    }
}

__device__ __forceinline__ float half_max(float v) {
#pragma unroll
    for (int o = 1; o < 32; o <<= 1) v = fmaxf(v, __shfl_xor(v, o));
    return v;
}
__device__ __forceinline__ void ph_topk(Frame& F) {
    const float* LG = (const float*)(F.ws + WS_LOGITS); const float* rb = F.in[I_RB];
    int* TOPI = (int*)(F.ws + WS_TOPI); float* TOPW = (float*)(F.ws + WS_TOPW); unsigned* counts = F.ctl + CW_COUNTS;
    const int lane = F.lane, hf = lane >> 5;
    for (int t = blockIdx.x * NWAVES + F.wave; t < T; t += F.G * NWAVES) {
        float sc[4], sel[4];
#pragma unroll
        for (int i = 0; i < 4; ++i) { sc[i] = sigmoidf_(LG[(size_t)t * NE + lane + 64 * i]); sel[i] = sc[i] + rb[lane + 64 * i]; }
        float gs[8];
#pragma unroll
        for (int i = 0; i < 4; ++i) {
            const float m1 = half_max(sel[i]);
            const unsigned long long bal = __ballot(sel[i] == m1); const unsigned hb = hf ? (unsigned)(bal >> 32) : (unsigned)bal;
            const int first = __ffs(hb) - 1;
            const float v2 = ((lane & 31) == first) ? -INFINITY : sel[i];
            const float m2 = half_max(v2);
            const float g = m1 + m2;
            const float go = __shfl_xor(g, 32);
            gs[2 * i] = hf ? go : g; gs[2 * i + 1] = hf ? g : go;
        }
        bool gsel[8];
#pragma unroll
        for (int a = 0; a < 8; ++a) { int rank = 0;
#pragma unroll
            for (int c = 0; c < 8; ++c) rank += (gs[c] > gs[a] || (gs[c] == gs[a] && c < a)) ? 1 : 0;
            gsel[a] = rank < 4; }
#pragma unroll
        for (int i = 0; i < 4; ++i) { const bool ok = hf ? gsel[2 * i + 1] : gsel[2 * i]; if (!ok) sel[i] = -INFINITY; }
        int myidx = 0; float myw = 0.f; float wsum = 0.f;
#pragma unroll
        for (int k = 0; k < TOPK; ++k) {
            float bv = sel[0]; int bi = lane;
#pragma unroll
            for (int i = 1; i < 4; ++i) if (sel[i] > bv) { bv = sel[i]; bi = lane + 64 * i; }
#pragma unroll
            for (int o = 1; o < 64; o <<= 1) { const float ov = __shfl_xor(bv, o); const int oi = __shfl_xor(bi, o); if (ov > bv || (ov == bv && oi < bi)) { bv = ov; bi = oi; } }
            const int ol = bi & 63, oi = bi >> 6;
            float s = (oi == 0) ? sc[0] : (oi == 1) ? sc[1] : (oi == 2) ? sc[2] : sc[3];
            s = __shfl(s, ol);
            if (lane == ol) { if (oi == 0) sel[0] = -INFINITY; else if (oi == 1) sel[1] = -INFINITY; else if (oi == 2) sel[2] = -INFINITY; else sel[3] = -INFINITY; }
            wsum += s;
            if (lane == k) { myidx = bi; myw = s; }
        }
        if (lane < TOPK) { TOPI[(size_t)t * TOPK + lane] = myidx; TOPW[(size_t)t * TOPK + lane] = myw / wsum * 2.5f; atomicAdd(&counts[myidx], 1u); }
    }
}


__device__ __forceinline__ void ph_topk_serial(Frame& F) {
    const float* LG = (const float*)(F.ws + WS_LOGITS); const float* rb = F.in[I_RB];
    int* TOPI = (int*)(F.ws + WS_TOPI); float* TOPW = (float*)(F.ws + WS_TOPW); unsigned* counts = F.ctl + CW_COUNTS;
    LAS float* sel = (LAS float*)F.lds + F.wave * 1024; LAS float* scr = sel + 256; LAS float* gsc = scr + 256; LAS int* gok = (LAS int*)(gsc + 8); LAS int* bi = gok + 8; LAS float* bw = (LAS float*)(bi + 8);
    for (int t = blockIdx.x * NWAVES + F.wave; t < T; t += F.G * NWAVES) {
        for (int i = 0; i < 4; ++i) { const int e = F.lane + 64 * i; const float s = sigmoidf_(LG[(size_t)t * NE + e]); scr[e] = s; sel[e] = s + rb[e]; }
        __builtin_amdgcn_s_waitcnt(0);
        if (F.lane == 0) {
            for (int g = 0; g < 8; ++g) { float m1 = -INFINITY, m2 = -INFINITY; for (int q = 0; q < 32; ++q) { const float v = sel[g * 32 + q]; if (v > m1) { m2 = m1; m1 = v; } else if (v > m2) m2 = v; } gsc[g] = m1 + m2; gok[g] = 0; }
            for (int k = 0; k < 4; ++k) { int best = -1; float bv = -INFINITY; for (int g = 0; g < 8; ++g) if (!gok[g] && gsc[g] > bv) { bv = gsc[g]; best = g; } gok[best] = 1; }
            for (int e = 0; e < 256; ++e) if (!gok[e >> 5]) sel[e] = -INFINITY;
            float ws = 0.f;
            for (int k = 0; k < 8; ++k) { int best = 0; float bv = -INFINITY; for (int e = 0; e < 256; ++e) if (sel[e] > bv) { bv = sel[e]; best = e; } sel[best] = -INFINITY; bi[k] = best; bw[k] = scr[best]; ws += scr[best]; }
            for (int k = 0; k < 8; ++k) { TOPI[(size_t)t * 8 + k] = bi[k]; TOPW[(size_t)t * 8 + k] = bw[k] / ws * 2.5f; atomicAdd(&counts[bi[k]], 1u); }
        }
        __builtin_amdgcn_s_waitcnt(0);
    }
}

__device__ __forceinline__ void ph_scan(Frame& F) {
    if (blockIdx.x != 0) return;
    LAS int* pre = (LAS int*)F.lds;
    unsigned* counts = F.ctl + CW_COUNTS; int* ROWTOK = (int*)(F.ws + WS_ROWTOK); float* ROWW = (float*)(F.ws + WS_ROWW);
    int* UNITEXP = (int*)(F.ws + WS_UNITEXP); int* EXPTILE0 = (int*)(F.ws + WS_EXPTILE0);
    __syncthreads();
    int n = 0, nt = 0;
    if (F.tid < NE) { n = (int)counts[F.tid]; nt = (n + 255) >> 8; pre[F.tid] = nt; }
    __syncthreads();
    if (F.tid == 0) { int s = 0; for (int e = 0; e < NE; ++e) { const int c = pre[e]; pre[e] = s; s += c; } F.ctl[CW_NT] = (unsigned)s; }
    __syncthreads();
    if (F.tid < NE) {
        const int t0 = pre[F.tid]; EXPTILE0[F.tid] = t0;
        for (int u = 0; u < nt; ++u) UNITEXP[t0 + u] = F.tid;
        for (int r = n; r < nt * 256; ++r) { ROWTOK[t0 * 256 + r] = (t0 * 256 + r) & (T - 1); ROWW[t0 * 256 + r] = 0.f; }
    }
    __syncthreads();
    { const int NTv = (int)F.ctl[CW_NT];
      for (int i = F.tid; i < T; i += NTHR) { ROWTOK[NTv * 256 + i] = i; ROWW[NTv * 256 + i] = 1.0f; } }
}

__device__ __forceinline__ void ph_scatter(Frame& F) {
    const int* TOPI = (const int*)(F.ws + WS_TOPI); const float* TOPW = (const float*)(F.ws + WS_TOPW);
    int* ROWTOK = (int*)(F.ws + WS_ROWTOK); float* ROWW = (float*)(F.ws + WS_ROWW); const int* EXPTILE0 = (const int*)(F.ws + WS_EXPTILE0);
    unsigned* cursor = F.ctl + CW_CURSOR;
    for (int i = blockIdx.x * NTHR + F.tid; i < T * TOPK; i += F.G * NTHR) {
        const int e = TOPI[i]; const unsigned p = atomicAdd(&cursor[e], 1u);
        const size_t r = (size_t)EXPTILE0[e] * 256 + p;
        ROWTOK[r] = i >> 3; ROWW[r] = TOPW[i];
    }
}

__device__ __forceinline__ void ph_experts_naive(Frame& F) {
    LAS float* As = (LAS float*)F.lds; LAS float* Bs = As + 16 * 132; LAS bf16* hid = (LAS bf16*)(F.lds + 32768);
    const bf16* H2 = (const bf16*)(F.ws + WS_H2);
    const int* ROWTOK = (const int*)(F.ws + WS_ROWTOK); const float* ROWW = (const float*)(F.ws + WS_ROWW); const int* UNITEXP = (const int*)(F.ws + WS_UNITEXP);
    const int NT = (int)__hip_atomic_load(F.ctl + CW_NT, __ATOMIC_RELAXED, __HIP_MEMORY_SCOPE_AGENT);
    const int ty = F.tid >> 5, tx = F.tid & 31;
    const int nvb = 2 * NT + T / 128;
    for (int vb = blockIdx.x; vb < nvb; vb += F.G) {
        const bool shared = vb >= 2 * NT;
        const float *Wg, *Wu, *Wd; int r0; const int* gather;
        if (shared) { Wg = F.in[I_WSG]; Wu = F.in[I_WSU]; Wd = F.in[I_WSD]; r0 = (vb - 2 * NT) * 128; gather = nullptr; }
        else { const int u = vb >> 1; const int e = UNITEXP[u]; Wg = F.in[I_WEG] + (size_t)e * 1024 * 256; Wu = F.in[I_WEU] + (size_t)e * 1024 * 256; Wd = F.in[I_WED] + (size_t)e * 256 * 1024;
               r0 = u * 256 + (vb & 1) * 128; gather = ROWTOK; }
        ARowGlobal ra{H2, (size_t)D, r0, gather};
        for (int nh = 0; nh < 2; ++nh) {
            float ag[8][4], au[8][4]; ZERO_ACC(ag); ZERO_ACC(au);
            ngemm_acc(As, Bs, ra, Wg, 256, D, nh * 128, 256, ag);
            ngemm_acc(As, Bs, ra, Wu, 256, D, nh * 128, 256, au);
#pragma unroll
            for (int i = 0; i < 8; ++i) { float o[4];
#pragma unroll
                for (int j = 0; j < 4; ++j) { const float g = ag[i][j]; o[j] = g / (1.0f + expf(-g)) * au[i][j]; }
                u32x2 w; w.x = pk2(o[0], o[1]); w.y = pk2(o[2], o[3]); *(LAS u32x2*)(hid + (ty * 8 + i) * 256 + nh * 128 + tx * 4) = w; }
        }
        __syncthreads();
        ARowLds rl{hid};
        for (int nc = 0; nc < 8; ++nc) {
            float ad[8][4]; ZERO_ACC(ad);
            ngemm_acc(As, Bs, rl, Wd, D, 256, nc * 128, D, ad);
#pragma unroll
            for (int i = 0; i < 8; ++i) { const int r = r0 + ty * 8 + i; const int tok = shared ? r : ROWTOK[r]; const float w = shared ? 1.0f : ROWW[r];
                if (w != 0.f) {
#pragma unroll
                    for (int j = 0; j < 4; ++j) unsafeAtomicAdd(F.out + (size_t)tok * D + nc * 128 + tx * 4 + j, ad[i][j] * w); } }
        }
        __syncthreads();
    }
}


__device__ __forceinline__ void ph_experts_brute(Frame& F) {
    LAS float* hs = (LAS float*)F.lds;
    LAS float* hid = hs + 1024;
    LAS float* pg = hid + 256;
    const bf16* H2 = (const bf16*)(F.ws + WS_H2); const int* TOPI = (const int*)(F.ws + WS_TOPI); const float* TOPW = (const float*)(F.ws + WS_TOPW);
    const int tid = F.tid, j = tid & 255, kh = tid >> 8;
    for (int t = blockIdx.x; t < T; t += F.G) {
        __syncthreads();
        hs[tid] = bf2f(H2[(size_t)t * D + tid]); hs[tid + 512] = bf2f(H2[(size_t)t * D + tid + 512]);
        float o0 = 0.f, o1 = 0.f;
        __syncthreads();
        for (int k9 = 0; k9 < 9; ++k9) {
            const float *Wg, *Wu, *Wd; float w;
            if (k9 == 8) { Wg = F.in[I_WSG]; Wu = F.in[I_WSU]; Wd = F.in[I_WSD]; w = 1.0f; }
            else { const int e = TOPI[(size_t)t * 8 + k9]; w = TOPW[(size_t)t * 8 + k9]; Wg = F.in[I_WEG] + (size_t)e * 1024 * 256; Wu = F.in[I_WEU] + (size_t)e * 1024 * 256; Wd = F.in[I_WED] + (size_t)e * 256 * 1024; }
            float g = 0.f, u = 0.f;
            for (int k = kh * 512; k < kh * 512 + 512; ++k) { const float hv = hs[k]; g += hv * Wg[(size_t)k * 256 + j]; u += hv * Wu[(size_t)k * 256 + j]; }
            pg[tid] = g; pg[512 + tid] = u;
            __syncthreads();
            if (tid < 256) { const float gg = pg[tid] + pg[tid + 256], uu = pg[512 + tid] + pg[512 + tid + 256]; hid[tid] = gg / (1.0f + expf(-gg)) * uu * w; }
            __syncthreads();
            for (int q = 0; q < 256; ++q) { const float hv = hid[q]; o0 += hv * Wd[(size_t)q * 1024 + tid]; o1 += hv * Wd[(size_t)q * 1024 + tid + 512]; }
        }
        F.out[(size_t)t * D + tid] = o0; F.out[(size_t)t * D + tid + 512] = o1;
    }
}

__device__ __forceinline__ void ph_final(Frame& F) {
    const float* mod = (const float*)(F.ws + WS_MOD); const float* g = F.in[I_GPOSTFFN];
    for (int t = blockIdx.x * NWAVES + F.wave; t < T; t += F.G * NWAVES) {
        const int b = t / SEQ; const float* gt2 = mod + b * 6144 + 5120;
        f32x4 x1[4]; x1_row(F, t, x1);
        f32x4 y[4]; float ss = 0.f;
#pragma unroll
        for (int j = 0; j < 4; ++j) { y[j] = *(const f32x4*)(F.out + (size_t)t * D + F.lane * 4 + 256 * j); ss += y[j][0] * y[j][0] + y[j][1] * y[j][1] + y[j][2] * y[j][2] + y[j][3] * y[j][3]; }
        const float rstd = rsqrtf(wave_sum(ss) * (1.0f / D) + EPS);
#pragma unroll
        for (int j = 0; j < 4; ++j) { const int c = F.lane * 4 + 256 * j; const f32x4 gg = *(const f32x4*)(g + c), gt = *(const f32x4*)(gt2 + c);
            f32x4 o;
#pragma unroll
            for (int e = 0; e < 4; ++e) o[e] = x1[j][e] + DBG_MOE_SCALE * gt[e] * (y[j][e] * rstd * gg[e]);
#if DBG_STAMP_A >= 0
            { const float dl = (float)(F.ctl[CW_STAMP + DBG_STAMP_B] - F.ctl[CW_STAMP + DBG_STAMP_A]) * 1e-6f; const f32x4 xv = *(const f32x4*)(F.in[I_X] + (size_t)t * D + c); o = o + xv * dl; }
#endif
            *(f32x4*)(F.out + (size_t)t * D + c) = o; }
    }
}

enum { PH_MOD = 0, PH_NORM1, PH_INPROJ, PH_ROPE, PH_MIX, PH_BRANCH, PH_OUTPROJ, PH_NORMMID, PH_ROUTER, PH_TOPK, PH_SCAN, PH_SCATTER, PH_EXPERTS, PH_FINAL, N_PHASES };

__global__ void __launch_bounds__(NTHR, 2) mk_fwd(Args args) {
    extern __shared__ __attribute__((aligned(16))) unsigned char lds_raw[];
    Frame F;
    F.lds = (LAS unsigned char*)lds_raw;
    F.tid = threadIdx.x; F.lane = F.tid & 63; F.wave = __builtin_amdgcn_readfirstlane(F.tid >> 6); F.G = gridDim.x;
#pragma unroll
    for (int i = 0; i < N_IN; ++i) F.in[i] = args.in[i];
    F.pos = (const int*)args.in[I_POS];
    F.out = args.out; F.outb = (unsigned char*)args.out; F.ws = args.ws; F.ctl = (unsigned*)(args.ws + WS_CTL);
    volatile LAS unsigned* MISC = (volatile LAS unsigned*)(F.lds + MISC_OFF);
    if (F.tid < 32) MISC[F.tid] = 0u;
    __syncthreads();
    const int lo = args.ph_lo, hi = args.ph_hi;
#define STAMP(id) do { if (DBG_STAMP_A >= 0 && blockIdx.x == 0 && threadIdx.x == 0) F.ctl[CW_STAMP + (id)] = (unsigned)wall_clock64(); } while (0)
#define REFRESH() do { int _t = threadIdx.x; asm volatile("" : "+v"(_t)); F.tid = _t; F.lane = _t & 63; F.wave = __builtin_amdgcn_readfirstlane(_t >> 6); } while (0)
    XcdBarrier bar; bar.bar = F.ctl + CW_BAR; bar.x = 0; bar.st = nullptr;
    if (hi - lo > 1) bar = xcd_barrier_post(F.ctl + CW_BAR, MISC + 8);
#ifndef PH_MASK
#define PH_MASK 0xFFFFFFu
#endif
#define IN(k) ((((PH_MASK) >> (k)) & 1u) && lo <= (k) && (k) < hi)
#define SEAM(k) do { if (IN(k) && IN((k) + 1)) xcd_barrier(bar); } while (0)

    STAMP(0);
    if (IN(PH_MOD)) { REFRESH(); ph_mod(F); ph_cvt_small(F); if (DUP == 0) { __syncthreads(); ph_mod(F); ph_cvt_small(F); } } SEAM(PH_MOD); STAMP(1);
    if (IN(PH_NORM1)) { REFRESH(); ph_norm1(F); if (DUP == 1) ph_norm1(F); if (DUP == 30) { int md = 1; asm volatile("" : "+s"(md)); ph_norm1(F, md); } } SEAM(PH_NORM1); STAMP(2);
#if FAST_INPROJ
    if (IN(PH_INPROJ)) { REFRESH(); ph_inproj_fast(F); if (DUP == 2) ph_inproj_fast(F); if (DUP == 20 || DUP == 21 || DUP == 22) { int ns = (DUP == 20) ? 1 : (DUP == 21) ? 2 : 0; asm volatile("" : "+s"(ns)); ph_inproj_fast(F, ns); } }
    SEAM(PH_INPROJ); STAMP(3);
#else
    if (IN(PH_INPROJ)) { REFRESH(); ph_inproj_naive(F); }
    SEAM(PH_INPROJ);
    if (IN(PH_ROPE)) { REFRESH(); ph_rope_naive(F); }
    SEAM(PH_ROPE);
#endif
    if (IN(PH_MIX)) { REFRESH();
#if FAST_ATTN
#if FAST_MLSTM
        if (blockIdx.x < 128) { int nrep = (DUP == 3) ? 2 : 1; asm volatile("" : "+s"(nrep));
#pragma unroll 1
            for (int rep = 0; rep < nrep; ++rep) mlstm_unit_fast(F, blockIdx.x); }
#else
        if (blockIdx.x < 128) ph_mlstm_naive_unit(F, blockIdx.x);
#endif
        { int first = (blockIdx.x >= 128 && (int)((blockIdx.x >> 3) & 3) < MIX_CVT_FIRST) ? 1 : 0; first = __builtin_amdgcn_readfirstlane(first);
#if MOE_FP8
          if (first) for (;;) {
              __syncthreads();
              if (F.tid == 0) MISC[0] = atomicAdd(F.ctl + CW_CVTQ, 1u);
              __syncthreads();
              const int bt = (int)MISC[0];
              if (bt >= CVT_NBATCH) break;
              cvt_experts8_batch(F, bt);
          }
#endif
#if ATTN_PIPE
          attn_queue_run(F, F.ctl + CW_ATTQ, MISC);
#else
          for (;;) {
              __syncthreads();
              if (F.tid == 0) MISC[0] = atomicAdd(F.ctl + CW_ATTQ, 1u);
              __syncthreads();
              const int uidx = (int)MISC[0];
              if (uidx >= ATT_UNITS) break;
              attn_unit_fast(F, uidx);
          }
#endif
#if MOE_FP8
          for (;;) {
              __syncthreads();
              if (F.tid == 0) MISC[0] = atomicAdd(F.ctl + CW_CVTQ, 1u);
              __syncthreads();
              const int bt = (int)MISC[0];
              if (bt >= CVT_NBATCH) break;
              cvt_experts8_batch(F, bt);
          }
#endif
        }
#else
        for (int vb = blockIdx.x; vb < 128 + 512; vb += F.G) { if (vb < 128) ph_mlstm_naive_unit(F, vb); else ph_attn_naive_block(F, vb - 128); }
#endif
    } SEAM(PH_MIX); STAMP(4);
#if FAST_ATTN
#if !(FUSE_ATTN_COMBINE && FUSE_TOKBLOCK)
    if (IN(PH_MIX)) { REFRESH(); ph_attn_combine(F); if (DUP == 13) ph_attn_combine(F); xcd_barrier(bar); }
#endif
#endif
    STAMP(5);
#if FUSE_TOKBLOCK
    if (IN(PH_BRANCH)) { REFRESH(); ph_tokblock(F); }
#else
#if FAST_BRANCH
    if (IN(PH_BRANCH)) { REFRESH(); ph_branch_fast(F); if (DUP == 4) ph_branch_fast(F); }
    SEAM(PH_BRANCH); STAMP(6);
    if (IN(PH_OUTPROJ)) { REFRESH(); ph_outproj_fast(F); if (DUP == 5) ph_outproj_fast(F); }
    SEAM(PH_OUTPROJ); STAMP(7);
#else
    if (IN(PH_BRANCH)) { REFRESH(); ph_branch_naive(F); }
    SEAM(PH_BRANCH);
    if (IN(PH_OUTPROJ)) { REFRESH(); ph_outproj_naive(F); }
    SEAM(PH_OUTPROJ);
#endif
    if (IN(PH_NORMMID)) { REFRESH(); ph_normmid(F);
#if FAST_EXPERTS
#if MOE_FP8
        if (DUP == 6) ph_normmid(F);
#else
        ph_cvt_experts(F); if (DUP == 6) { ph_normmid(F); ph_cvt_experts(F); }
#endif
#endif
    }
    SEAM(PH_NORMMID); STAMP(8);
#if FAST_ROUTER
    if (IN(PH_ROUTER)) { REFRESH(); ph_router_fast(F); if (DUP == 7) ph_router_fast(F);
#if FUSE_ROUTER_TOPK
        asm volatile("s_waitcnt vmcnt(0)" ::: "memory"); __syncthreads();
        REFRESH(); { RouterBlocks RB; RB.S.init(T, 256, 1024, nullptr, nullptr, F.G, (int)blockIdx.x); ph_topk4(F, RB); }
#endif
    }
#else
    if (IN(PH_ROUTER)) { REFRESH(); ph_router_naive(F); }
#endif
#if !FUSE_ROUTER_TOPK
    SEAM(PH_ROUTER);
#endif
    STAMP(9);
#endif
    #if FAST_MOE2
#if FAST_TOPK4
    if (IN(PH_TOPK) && !FUSE_ROUTER_TOPK && !FUSE_TOKBLOCK) { REFRESH(); ph_topk4(F, StrideBlocks{(int)blockIdx.x, F.G}); }
#else
    if (IN(PH_TOPK)) { REFRESH(); ph_topk2(F); if (DUP == 8) ph_topk2(F); }
#endif
    SEAM(PH_TOPK); STAMP(10);
#if SLOT8
    if (IN(PH_SCATTER)) { REFRESH(); ph_scatter4(F); if (DUP == 9) ph_scatter4(F); } SEAM(PH_SCATTER); STAMP(12);
    if (IN(PH_EXPERTS)) { REFRESH(); ph_gu8(F); if (DUP == 10) ph_gu8(F); xcd_barrier(bar); STAMP(13); REFRESH(); ph_down9(F); if (DUP == 11) ph_down9(F); if (DUP == 40 || DUP == 41) { int dm = (DUP == 40) ? 1 : 2; asm volatile("" : "+s"(dm)); ph_down9(F, dm); } }
    SEAM(PH_EXPERTS); STAMP(14);
    if (IN(PH_FINAL)) { REFRESH(); ph_combine9(F); if (DUP == 12) { __syncthreads(); ph_combine9(F); } }
#else
    if (IN(PH_SCATTER)) { REFRESH(); ph_scatter3(F); } SEAM(PH_SCATTER); STAMP(12);
#if MOE_FP8
    if (IN(PH_EXPERTS)) { REFRESH(); ph_gu8(F); if (DUP == 10) ph_gu8(F); xcd_barrier(bar); STAMP(13); REFRESH(); ph_down8(F, 0); if (DUP == 11) ph_down8(F, 0); xcd_barrier(bar); REFRESH(); ph_combine2(F, 0); xcd_barrier(bar); REFRESH(); ph_down8(F, 1); }
#else
    if (IN(PH_EXPERTS)) { REFRESH(); ph_gu2(F); if (DUP == 10) ph_gu2(F); xcd_barrier(bar); STAMP(13); REFRESH(); ph_down2(F, 0); if (DUP == 11) ph_down2(F, 0); xcd_barrier(bar); REFRESH(); ph_combine2(F, 0); xcd_barrier(bar); REFRESH(); ph_down2(F, 1); }
#endif
    SEAM(PH_EXPERTS); STAMP(14);
    if (IN(PH_FINAL)) { REFRESH(); ph_combine2(F, 1); if (DUP == 12) { __syncthreads(); } }
#endif
#else
#if DBG_TOPK_SERIAL
    if (IN(PH_TOPK)) { REFRESH(); ph_topk_serial(F); }
#else
    if (IN(PH_TOPK)) { REFRESH(); ph_topk(F); }
#endif
    SEAM(PH_TOPK); STAMP(10);
    if (IN(PH_SCAN)) { REFRESH(); ph_scan(F); } SEAM(PH_SCAN); STAMP(11);
    if (IN(PH_SCATTER)) { REFRESH(); ph_scatter(F); } SEAM(PH_SCATTER); STAMP(12);
#if DBG_BRUTE
    if (IN(PH_EXPERTS)) { REFRESH(); ph_experts_brute(F); }
#elif FAST_EXPERTS
    if (IN(PH_EXPERTS)) { REFRESH(); ph_gu_fast(F); xcd_barrier(bar); STAMP(13); REFRESH(); ph_down_fast(F); }
#else
    if (IN(PH_EXPERTS)) { REFRESH(); ph_experts_naive(F); }
#endif
    SEAM(PH_EXPERTS); STAMP(14);
    if (IN(PH_FINAL)) { REFRESH(); ph_final(F); }
#endif
#undef IN
#undef SEAM
}

extern "C" void kernel_launch(void* const* d_in, const int* in_sizes, int n_in, void* d_out, int out_size, void* d_ws, size_t ws_size, hipStream_t stream) {
    static int grid = 0;
    if (grid == 0) {
        if (n_in != N_IN || out_size != T * D || ws_size < WS_NEED) { fprintf(stderr, "kernel_launch: unexpected shapes (n_in %d, out %d, ws %zu); nothing launched\n", n_in, out_size, ws_size); grid = -1; return; }
        int dev = 0, cus = 0, per_cu = 0;
        if (hipGetDevice(&dev) != hipSuccess || hipDeviceGetAttribute(&cus, hipDeviceAttributeMultiprocessorCount, dev) != hipSuccess) { grid = -1; return; }
        if (hipFuncSetAttribute((const void*)mk_fwd, hipFuncAttributeMaxDynamicSharedMemorySize, LDS_BYTES) != hipSuccess) { fprintf(stderr, "kernel_launch: hipFuncSetAttribute failed\n"); grid = -1; return; }
        if (hipOccupancyMaxActiveBlocksPerMultiprocessor(&per_cu, (const void*)mk_fwd, NTHR, LDS_BYTES) != hipSuccess || per_cu < 1) fprintf(stderr, "kernel_launch: occupancy query reports %d\n", per_cu);
        (void)hipGetLastError();
        grid = cus;
    }
    if (grid < 0) return;
    if (hipMemsetAsync((char*)d_ws + WS_CTL, 0, CTL_ZERO_BYTES, stream) != hipSuccess) return;
    Args a{};
    for (int i = 0; i < N_IN; ++i) a.in[i] = (const float*)d_in[i];
    a.out = (float*)d_out; a.ws = (unsigned char*)d_ws;
#if MK_SPLIT
    for (int p = 0; p < N_PHASES; ++p) { a.ph_lo = p; a.ph_hi = p + 1; hipLaunchKernelGGL(mk_fwd, dim3(grid), dim3(NTHR), LDS_BYTES, stream, a); }
#elif defined(MK_CUTS)
    { const int cuts[] = MK_CUTS; const int nc = sizeof(cuts) / sizeof(int);
      for (int i = 0; i + 1 < nc; ++i) { a.ph_lo = cuts[i]; a.ph_hi = cuts[i + 1];
          if (i) hipMemsetAsync((char*)d_ws + WS_CTL + CW_BAR * 4, 0, XCD_BAR_WORDS * 4, stream);
          hipLaunchKernelGGL(mk_fwd, dim3(grid), dim3(NTHR), LDS_BYTES, stream, a); } }
#else
    a.ph_lo = 0; a.ph_hi = N_PHASES;
    hipLaunchKernelGGL(mk_fwd, dim3(grid), dim3(NTHR), LDS_BYTES, stream, a);
#endif
}
```

```cpp
#include <hip/hip_runtime.h>
#include <cstdio>
#include <cstdint>

#define GAS __attribute__((address_space(1)))
#define LAS __attribute__((address_space(3)))
typedef unsigned short bf16;
typedef float f32x4 __attribute__((ext_vector_type(4)));
typedef float f32x2 __attribute__((ext_vector_type(2)));
typedef unsigned u32x4 __attribute__((ext_vector_type(4)));
typedef unsigned u32x2 __attribute__((ext_vector_type(2)));

#ifndef DBG_MOE_SCALE
#define DBG_MOE_SCALE 1.0f
#endif
#ifndef DBG_BRUTE
#define DBG_BRUTE 0
#endif
#ifndef DBG_TOPK_SERIAL
#define DBG_TOPK_SERIAL 1
#endif

#ifndef FAST_INPROJ
#define FAST_INPROJ 1
#endif
#ifndef FAST_BRANCH
#define FAST_BRANCH 1
#endif
#ifndef FAST_ROUTER
#define FAST_ROUTER 1
#endif
#ifndef FAST_EXPERTS
#define FAST_EXPERTS 1
#endif
#ifndef FAST_ATTN
#define FAST_ATTN 1
#endif
#ifndef FAST_MLSTM
#define FAST_MLSTM 1
#endif
#ifndef DBG_STAMP_A
#define DBG_STAMP_A -1
#endif
#ifndef DBG_STAMP_B
#define DBG_STAMP_B 0
#endif
#ifndef FAST_MOE2
#define FAST_MOE2 1
#endif
#ifndef DUP
#define DUP -1
#ifndef ATTN_PIPE
#define ATTN_PIPE 1
#endif
#ifndef FUSE_ATTN_COMBINE
#define FUSE_ATTN_COMBINE 1
#endif
#ifndef MIX_CVT_FIRST
#define MIX_CVT_FIRST 3
#endif
#endif
#ifndef FAST_TOPK4
#define FAST_TOPK4 1
#endif
#ifndef MOE_FP8
#define MOE_FP8 1
#endif
#ifndef STAGGER_NS
#define STAGGER_NS 0
#endif
#ifndef INPROJ_FP8
#define INPROJ_FP8 1
#endif
#ifndef SLOT8
#define SLOT8 1
#endif
#ifndef GATES_GEMM
#define GATES_GEMM 1
#endif
#ifndef GATES_U8
#define GATES_U8 1
#endif
#ifndef DOWN_ALIGN
#define DOWN_ALIGN true
#endif
#ifndef FUSE_ROUTER_TOPK
#define FUSE_ROUTER_TOPK 1
#endif
#ifndef FUSE_TOKBLOCK
#define FUSE_TOKBLOCK 1
#endif
#ifndef MK_SPLIT
#define MK_SPLIT 0
#endif

constexpr int D = 1024, NB = 32, SEQ = 2048, T = NB * SEQ;
constexpr int INW = 7432;
constexpr int NE = 256, TOPK = 8;
constexpr int NTHR = 512, NWAVES = 8;
constexpr float EPS = 1e-6f;

enum { I_X = 0, I_C, I_POS, I_WADA, I_BADA, I_GPREMIX, I_GPOSTMIX, I_GPREFFN, I_GPOSTFFN, I_WIN, I_CONVW, I_CONVB, I_BGATES, I_GMLSTM,
       I_WBA, I_WBB, I_WOUT, I_RW, I_RB, I_WEG, I_WEU, I_WED, I_WSG, I_WSU, I_WSD, N_IN };

constexpr size_t MiB = 1u << 20;
constexpr size_t WS_CTL = 0, CTL_ZERO_BYTES = 1 * MiB;
constexpr size_t WS_MOD = 1 * MiB;
constexpr size_t WS_GATES = 2 * MiB;
constexpr size_t WS_TOPI = 4 * MiB;
constexpr size_t WS_TOPW = 6 * MiB;
constexpr size_t WS_ROWTOK = 8 * MiB;
constexpr size_t WS_ROWW = 12 * MiB;
constexpr size_t WS_UNITEXP = 16 * MiB;
constexpr size_t WS_EXPTILE0 = 16 * MiB + 65536;
constexpr size_t WS_HIST = 17 * MiB;
constexpr size_t WS_BASEREL = 17 * MiB + 262144;
constexpr size_t WS_TSG = 17 * MiB + 524288;
constexpr size_t WS_TE = 17 * MiB + 528384;
constexpr size_t WS_THOFF = 17 * MiB + 544768;
constexpr size_t WS_DEST = 52 * MiB;
constexpr size_t WS_DUMP = 18 * MiB;
constexpr size_t WS_ROPE = 20 * MiB;
constexpr size_t WS_W8T = 24 * MiB;
constexpr size_t WS_WIN_T = 25 * MiB;
constexpr size_t WS_WBA_T = 40 * MiB;
constexpr size_t WS_WBB_T = 41 * MiB;
constexpr size_t WS_WOUT_T = 43 * MiB;
constexpr size_t WS_WR_T = 45 * MiB;
constexpr size_t WS_WSGU_T = 46 * MiB;
constexpr size_t WS_WSD_T = 47 * MiB;
constexpr size_t WS_LSE = 48 * MiB;
constexpr size_t WS_Q = 64 * MiB, WS_K = 160 * MiB, WS_V = 256 * MiB;
constexpr size_t WS_MQK = 352 * MiB, WS_MV = 480 * MiB, WS_MO = 608 * MiB;
constexpr size_t WS_GAB = 736 * MiB;
constexpr size_t WS_MERGED = 192 * MiB;
constexpr size_t WS_YMIX = 64 * MiB;
constexpr size_t WS_H2 = 192 * MiB;
constexpr size_t WS_LOGITS = 384 * MiB;
constexpr size_t WS_WD = 384 * MiB;
constexpr size_t WS_WGU = 512 * MiB;
constexpr size_t WS_HIDS = 320 * MiB;
constexpr size_t WS_HIDR = 768 * MiB;
constexpr size_t WS_NEED = 1064 * MiB;
constexpr size_t WS_H8 = 992 * MiB;
constexpr size_t WS_WIN_T8 = 1056 * MiB;
constexpr size_t WS_H2F8 = 320 * MiB;
constexpr size_t WS_WD8 = 672 * MiB;
constexpr size_t WS_WGU8 = 864 * MiB;
constexpr size_t WS_WSGU8 = 46 * MiB;
constexpr size_t WS_WSD8 = 47 * MiB;
constexpr size_t WS_HIDS8 = 448 * MiB;
constexpr size_t WS_HIDR8 = 480 * MiB;
constexpr size_t OUT_H = 0;
constexpr size_t OUT_YA = 0;
constexpr size_t OUT_YB = 128 * MiB;
constexpr size_t OUT_OG = 32 * MiB;

constexpr int CW_BAR = 4096;
constexpr int CW_STAMP = 8192;
constexpr int CW_CVTQ = 12800;
constexpr int CW_ATTQ = 12288;
constexpr int CW_COUNTS = 16384, CW_CURSOR = 16384 + 256, CW_NT = 16384 + 512, CW_NT0 = 16384 + 576;

constexpr int LDS_BYTES = 147456;
constexpr int MISC_OFF = 131072 + 320;

__device__ __forceinline__ float bf2f(bf16 b) { return __uint_as_float(((unsigned)b) << 16); }
__device__ __forceinline__ unsigned f2bf(float f) { unsigned u = __float_as_uint(f); return (u + 0x7fffu + ((u >> 16) & 1u)) >> 16; }
__device__ __forceinline__ unsigned pk2(float lo, float hi) { return f2bf(lo) | (f2bf(hi) << 16); }
__device__ __forceinline__ float wave_sum(float v) {
#pragma unroll
    for (int o = 1; o < 64; o <<= 1) v += __shfl_xor(v, o);
    return v;
}
__device__ __forceinline__ float sigmoidf_(float x) { return 1.0f / (1.0f + expf(-x)); }
__device__ __forceinline__ float logsigmoidf_(float x) { return fminf(x, 0.f) - log1pf(expf(-fabsf(x))); }

#define XB_TMO      128
#define XB_XCNT(j)  (256  + 64 * (j))
#define XB_XSUB(j)  (1280 + 64 * (j))
#define XB_XGEN(j)  (2304 + 64 * (j))
#define XB_TOP      3328
#define XB_TOPGEN   3392
#define XCD_BAR_WORDS 3456
#define XB_SPIN_CAP (1u << 23)

__device__ __forceinline__ unsigned xb_ld(unsigned* p)              { return __hip_atomic_load(p, __ATOMIC_RELAXED, __HIP_MEMORY_SCOPE_AGENT); }
__device__ __forceinline__ unsigned xb_add(unsigned* p, unsigned v) { return __hip_atomic_fetch_add(p, v, __ATOMIC_RELAXED, __HIP_MEMORY_SCOPE_AGENT); }
__device__ __forceinline__ unsigned xb_xcc_id() { return (unsigned)__builtin_amdgcn_s_getreg((3 << 11) | 20) & 0xFu; }
#define XB_SPIN(cond, bar) do { unsigned _sp = 0; while (cond) { __builtin_amdgcn_s_sleep(1); \
    if ((++_sp & 255u) == 0u) { if (xb_ld(&(bar)[XB_TMO])) break; if (_sp > XB_SPIN_CAP) { atomicAdd(&(bar)[XB_TMO], 1u); break; } } } } while (0)

struct XcdBarrier { unsigned* bar; unsigned x; volatile LAS unsigned* st; };

__device__ __forceinline__ XcdBarrier xcd_barrier_post(unsigned* bar, volatile LAS unsigned* st) {
    XcdBarrier b; b.bar = bar; b.x = xb_xcc_id(); b.st = st;
    if (threadIdx.x == 0) (void)xb_add(&bar[XB_XCNT(b.x)], 1u);
    return b;
}
__device__ __forceinline__ void xcd_barrier_complete(unsigned* bar, unsigned x, unsigned& nloc, unsigned& nx) {
    const unsigned G = gridDim.x * gridDim.y * gridDim.z;
    unsigned sum, cnt, mine, sp = 0u;
    for (;;) {
        sum = 0u; cnt = 0u; mine = 0u;
#pragma unroll
        for (unsigned j = 0; j < 16; ++j) { const unsigned c = xb_ld(&bar[XB_XCNT(j)]); sum += c; cnt += (c > 0u) ? 1u : 0u; mine = (j == x) ? c : mine; }
        if (sum == G) break;
        __builtin_amdgcn_s_sleep(1);
        if ((++sp & 255u) == 0u) { if (xb_ld(&bar[XB_TMO])) break; if (sp > XB_SPIN_CAP) { atomicAdd(&bar[XB_TMO], 1u); break; } }
    }
    nloc = mine > 0u ? mine : 1u; nx = cnt > 0u ? cnt : 1u;
}
__device__ __forceinline__ void xcd_barrier(const XcdBarrier& b) {
    asm volatile("s_waitcnt vmcnt(0)" ::: "memory");
    __syncthreads();
    if (threadIdx.x == 0) {
        unsigned* bar = b.bar;
        __builtin_amdgcn_s_waitcnt(0);
        unsigned nloc = b.st[0], nx = b.st[1];
        if (nloc == 0u) { xcd_barrier_complete(bar, b.x, nloc, nx); b.st[0] = nloc; b.st[1] = nx; }
        const unsigned old = xb_add(&bar[XB_XSUB(b.x)], 1u);
        const unsigned gen = old / nloc;
        if (old + 1u == (gen + 1u) * nloc) {
            __builtin_amdgcn_fence(__ATOMIC_RELEASE, "agent");
            asm volatile("s_waitcnt vmcnt(0)" ::: "memory");
            const unsigned og = xb_add(&bar[XB_TOP], 1u);
            const unsigned tg = og / nx;
            if (og + 1u == (tg + 1u) * nx) xb_add(&bar[XB_TOPGEN], 1u);
            else XB_SPIN(xb_ld(&bar[XB_TOPGEN]) == tg, bar);
            __builtin_amdgcn_fence(__ATOMIC_ACQUIRE, "agent");
            xb_add(&bar[XB_XGEN(b.x)], 1u);
            asm volatile("s_waitcnt vmcnt(0)" ::: "memory");
        } else {
            XB_SPIN(xb_ld(&bar[XB_XGEN(b.x)]) == gen, bar);
            __builtin_amdgcn_fence(__ATOMIC_ACQUIRE, "agent");
            asm volatile("s_waitcnt vmcnt(0)" ::: "memory");
        }
    }
    __syncthreads();
}

struct Args { const float* in[N_IN]; float* out; unsigned char* ws; int ph_lo, ph_hi; };

struct Frame {
    LAS unsigned char* lds;
    unsigned* ctl;
    int tid, lane, wave, G;
    const float* in[N_IN];
    const int* pos;
    float* out; unsigned char* outb; unsigned char* ws;
};

struct ARowGlobal {
    const bf16* base; size_t ld; int m0; const int* gather;
    __device__ __forceinline__ void load4(int r, int k, float (&o)[4]) const {
        const size_t row = gather ? (size_t)gather[m0 + r] : (size_t)(m0 + r);
        const u32x2 v = *(const u32x2*)(base + row * ld + k);
        o[0] = __uint_as_float(v.x << 16); o[1] = __uint_as_float(v.x & 0xffff0000u); o[2] = __uint_as_float(v.y << 16); o[3] = __uint_as_float(v.y & 0xffff0000u);
    }
};
struct ARowLds {
    const LAS bf16* base;
    __device__ __forceinline__ void load4(int r, int k, float (&o)[4]) const {
        const u32x2 v = *(const LAS u32x2*)(base + r * 256 + k);
        o[0] = __uint_as_float(v.x << 16); o[1] = __uint_as_float(v.x & 0xffff0000u); o[2] = __uint_as_float(v.y << 16); o[3] = __uint_as_float(v.y & 0xffff0000u);
    }
};
template <class ARow>
__device__ __forceinline__ void ngemm_acc(LAS float* As, LAS float* Bs, const ARow& arow, const float* __restrict__ W, int ldw, int K, int n0, int Nvalid, float (&acc)[8][4]) {
    const int tid = threadIdx.x, ty = tid >> 5, tx = tid & 31;
    const int ar = tid >> 2, ak = (tid & 3) * 4;
    const int bk = tid >> 5, bn = (tid & 31) * 4;
    for (int k0 = 0; k0 < K; k0 += 16) {
        float a4[4]; arow.load4(ar, k0 + ak, a4);
        f32x4 b4 = (f32x4){0.f, 0.f, 0.f, 0.f};
        if (n0 + bn < Nvalid) b4 = *(const f32x4*)(W + (size_t)(k0 + bk) * ldw + n0 + bn);
        __syncthreads();
        As[(ak + 0) * 132 + ar] = a4[0]; As[(ak + 1) * 132 + ar] = a4[1]; As[(ak + 2) * 132 + ar] = a4[2]; As[(ak + 3) * 132 + ar] = a4[3];
        *(LAS f32x4*)(Bs + bk * 132 + bn) = b4;
        __syncthreads();
#pragma unroll 4
        for (int kk = 0; kk < 16; ++kk) {
            const f32x4 a0 = *(const LAS f32x4*)(As + kk * 132 + ty * 8), a1 = *(const LAS f32x4*)(As + kk * 132 + ty * 8 + 4);
            const f32x4 b = *(const LAS f32x4*)(Bs + kk * 132 + tx * 4);
#pragma unroll
            for (int j = 0; j < 4; ++j) {
                acc[0][j] += a0[0] * b[j]; acc[1][j] += a0[1] * b[j]; acc[2][j] += a0[2] * b[j]; acc[3][j] += a0[3] * b[j];
                acc[4][j] += a1[0] * b[j]; acc[5][j] += a1[1] * b[j]; acc[6][j] += a1[2] * b[j]; acc[7][j] += a1[3] * b[j];
            }
        }
    }
    __syncthreads();
}
#define ZERO_ACC(a) do { _Pragma("unroll") for (int _i = 0; _i < 8; ++_i) _Pragma("unroll") for (int _j = 0; _j < 4; ++_j) a[_i][_j] = 0.f; } while (0)


namespace g2 {
typedef short bf16x8 __attribute__((ext_vector_type(8)));
typedef int v4i_t __attribute__((ext_vector_type(4)));
typedef int v8i_t __attribute__((ext_vector_type(8)));
constexpr int BM = 256, BK = 64, HALF = 128, HTB = HALF * BK * 2, STAGE_BYTES = 8 * HTB, NXCD = 8, WGM = 8;
__host__ __device__ __forceinline__ int lds_byte(int r, int c) { const int st = (r >> 4) * 2 + (c >> 5), rr = r & 15, cc = c & 31, ob = rr * 64 + cc * 2; return st * 1024 + (ob ^ (((ob >> 9) & 1) << 5)); }
__host__ __device__ __forceinline__ void stage_rc(int b, int& R, int& C) { const int st = b / 1024, sb = b % 1024, swz = sb ^ (((sb >> 9) & 1) << 5); R = (st >> 1) * 16 + swz / 64; C = (st & 1) * 32 + (swz % 64) / 2; }
__host__ __device__ __forceinline__ int perm32(int rho) { const int n = rho >> 4, i = rho & 15; return 8 * (i >> 2) + 4 * n + (i & 3); }
__device__ __forceinline__ unsigned cvt_pk_bf16(float lo, float hi) { unsigned r; asm volatile("v_cvt_pk_bf16_f32 %0, %1, %2" : "=v"(r) : "v"(lo), "v"(hi)); return r; }

struct UnitMN { int pm, pn; };
struct DenseOrder {
    typedef UnitMN Unit;
    int nM, nN, nwg, G, c, Kk, pnoff, pncut, pnskip;
    const char* A; const char* Bt;
    __device__ void init(int M, int N, int K, const void* A_, const void* Bt_, int G_, int c_) { nM = M / BM; nN = N / BM; nwg = nM * nN; G = G_; c = c_; Kk = K; A = (const char*)A_; Bt = (const char*)Bt_; pnoff = 0; pncut = 1 << 20; pnskip = 0; }
    __device__ __forceinline__ bool next(int i, Unit& u) const {
        const long L = (long)i * G + c; if (L >= nwg) return false;
        int wgid = (int)L; { const int q = nwg / NXCD, r = nwg % NXCD, xcd = wgid % NXCD, off = wgid / NXCD; wgid = (xcd < r ? xcd * (q + 1) : r * (q + 1) + (xcd - r) * q) + off; }
        const int nig = WGM * nN, gid = wgid / nig, fm = gid * WGM, gsz = (nM - fm) < WGM ? (nM - fm) : WGM;
        u.pm = fm + ((wgid % nig) % gsz); u.pn = (wgid % nig) / gsz; if (u.pn >= pncut) u.pn += pnskip; u.pn += pnoff; return true;
    }
    __device__ __forceinline__ int K(const Unit&) const { return Kk; }
    __device__ __forceinline__ const char* a_base(const Unit&) const { return A; }
    __device__ __forceinline__ unsigned a_row_off(const Unit& u, int r) const { return (unsigned)(u.pm * BM + r) * (unsigned)(Kk * 2); }
    __device__ __forceinline__ const char* b_base(const Unit& u) const { return Bt + (size_t)u.pn * BM * Kk * 2; }
};

template <class Epi, class Sched, bool F8 = false, bool ALIGN_EPI = true>
__device__ __forceinline__ void gemm_phase(LAS unsigned char* lds, const Sched& S, const Epi& E, int f8_scale_b = 127) {
    const int tid = threadIdx.x, wid = __builtin_amdgcn_readfirstlane(tid >> 6), lane = tid & 63, wr = wid >> 2, wc = wid & 3, fr = lane & 15, fq = lane >> 4;
#define G2_RC(i, R, Rb, C2) int R, Rb; unsigned C2; { int _R, _C; stage_rc(tid * 16 + (i) * 8192, _R, _C); R = _R; Rb = Epi::PERM ? (64 * (_R >> 5) + 16 * ((_R & 15) >> 2) + 4 * ((_R & 31) >> 4) + (_R & 3)) : _R; C2 = (unsigned)_C * 2u; }
    const size_t kstep = (size_t)(BK * 2);
    const unsigned ldsw = (unsigned)wid * 1024u;
    const int aoff = lds_byte(wr * 64 + fr, fq * 8), boff = lds_byte(wc * 32 + fr, fq * 8);
#define G2_SA(b, h) (((b) * 2 + (h)) * HTB)
#define G2_SB(b, h) ((4 + (b) * 2 + (h)) * HTB)
#define G2_STAGE(bufoff, gbase, voff) do { _Pragma("unroll") for (int _i = 0; _i < 2; ++_i) \
        __builtin_amdgcn_global_load_lds((const unsigned*)((const char*)(gbase) + (voff)[_i]), (LAS unsigned*)(lds + (bufoff) + ldsw + _i * 8192), 16, 0, 0); } while (0)
#define G2_LDA(dst, b, h) do { _Pragma("unroll") for (int m = 0; m < 4; ++m) { const v4i_t _lo = *(const LAS v4i_t*)(lds + G2_SA(b, h) + aoff + m * 2048), _hi = *(const LAS v4i_t*)(lds + G2_SA(b, h) + aoff + m * 2048 + 1024); \
        dst[m] = __builtin_shufflevector(_lo, _hi, 0, 1, 2, 3, 4, 5, 6, 7); } } while (0)
#define G2_LDB(dst, b, h) do { _Pragma("unroll") for (int n = 0; n < 2; ++n) { const v4i_t _lo = *(const LAS v4i_t*)(lds + G2_SB(b, h) + boff + n * 2048), _hi = *(const LAS v4i_t*)(lds + G2_SB(b, h) + boff + n * 2048 + 1024); \
        dst[n] = __builtin_shufflevector(_lo, _hi, 0, 1, 2, 3, 4, 5, 6, 7); } } while (0)
#define G2_MMA(ai, bj, At, Bt) do { __builtin_amdgcn_s_setprio(1); _Pragma("unroll") for (int m = 0; m < 4; ++m) _Pragma("unroll") for (int n = 0; n < 2; ++n) { \
        if constexpr (F8) asm volatile("v_mfma_scale_f32_16x16x128_f8f6f4 %0, %1, %2, %0, %3, %4 op_sel_hi:[0,0,0]" : "+v"(acc[ai][bj][m][n]) : "v"(Bt[n]), "v"(At[m]), "v"(f8_sb), "v"(f8_sa)); \
        else { acc[ai][bj][m][n] = __builtin_amdgcn_mfma_f32_16x16x32_bf16(__builtin_bit_cast(bf16x8, __builtin_shufflevector(Bt[n], Bt[n], 0, 1, 2, 3)), __builtin_bit_cast(bf16x8, __builtin_shufflevector(At[m], At[m], 0, 1, 2, 3)), acc[ai][bj][m][n], 0, 0, 0); \
               acc[ai][bj][m][n] = __builtin_amdgcn_mfma_f32_16x16x32_bf16(__builtin_bit_cast(bf16x8, __builtin_shufflevector(Bt[n], Bt[n], 4, 5, 6, 7)), __builtin_bit_cast(bf16x8, __builtin_shufflevector(At[m], At[m], 4, 5, 6, 7)), acc[ai][bj][m][n], 0, 0, 0); } } \
        __builtin_amdgcn_s_setprio(0); } while (0)
#define G2_WAIT_V(n) asm volatile("s_waitcnt vmcnt(" #n ")" ::: "memory")
#define G2_WAIT_L(n) asm volatile("s_waitcnt lgkmcnt(" #n ")" ::: "memory")
#define G2_BAR __builtin_amdgcn_s_barrier()
#define G2_SCHED __builtin_amdgcn_sched_barrier(0)
    const int f8_sb = f8_scale_b, f8_sa = 127;
    typename Sched::Unit cur, nxt; int ui = 0;
    if (!S.next(0, cur)) return;
    f32x4 acc[2][2][4][2];
#pragma unroll
    for (int a = 0; a < 2; ++a)
#pragma unroll
        for (int b = 0; b < 2; ++b)
#pragma unroll
            for (int m = 0; m < 4; ++m)
#pragma unroll
                for (int n = 0; n < 2; ++n) acc[a][b][m][n] = (f32x4){0.f, 0.f, 0.f, 0.f};
    v8i_t At[4], B0[2], B1[2];
    unsigned vA0[2], vA1[2], vN0[2], vN1[2], vBc[2], vBN[2];
    int Kc = S.K(cur); asm volatile("" : "+s"(Kc)); int nt = Kc / BK;
    constexpr int HROWS = Epi::PERM ? 8 : HALF;
    size_t hc = (size_t)HROWS * Kc * 2, hN = hc;
#pragma unroll
    for (int i = 0; i < 2; ++i) { G2_RC(i, R, Rb, C2); vA0[i] = S.a_row_off(cur, R) + C2; vA1[i] = S.a_row_off(cur, HALF + R) + C2; vN0[i] = vA0[i]; vN1[i] = vA1[i];
        vBc[i] = (unsigned)(Rb * Kc) * 2u + C2; vBN[i] = vBc[i]; }
    const char* cA = S.a_base(cur);
    const char* cB = S.b_base(cur);
    G2_STAGE(G2_SB(0, 0), cB, vBc); G2_STAGE(G2_SB(0, 1), cB + hc, vBc); G2_STAGE(G2_SA(0, 0), cA, vA0); G2_STAGE(G2_SA(0, 1), cA, vA1);
    if (wr == 1) G2_BAR;
    G2_WAIT_V(2); G2_BAR;
    G2_STAGE(G2_SB(1, 0), cB + kstep, vBc); G2_STAGE(G2_SA(1, 0), cA + kstep, vA0); G2_STAGE(G2_SB(1, 1), cB + hc + kstep, vBc);
    G2_WAIT_V(6); G2_BAR;
    bool has_next = S.next(1, nxt);
    typename Sched::Unit nn;
    for (;;) {
        const bool has_nn = has_next ? S.next(ui + 2, nn) : false;
        const char* nA = has_next ? S.a_base(nxt) : cA; const char* nB = has_next ? S.b_base(nxt) : cB;
        int Kn = has_next ? S.K(nxt) : Kc; asm volatile("" : "+s"(Kn));
        unsigned vP0[2], vP1[2];
        if (has_next) {
#pragma unroll
            for (int i = 0; i < 2; ++i) { G2_RC(i, R, Rb, C2); (void)Rb; vP0[i] = S.a_row_off(nxt, R) + C2; vP1[i] = S.a_row_off(nxt, HALF + R) + C2; } }
        for (int t = 0; t < nt; t += 2) {
            const bool last = (t == nt - 2);
            const char* a1 = cA + (size_t)(t + 1) * kstep;
            const char* a2 = last ? nA : cA + (size_t)(t + 2) * kstep; const char* b2 = last ? nB : cB + (size_t)(t + 2) * kstep;
            const char* a3 = a2 + kstep; const char* b3 = b2 + kstep;
            if (last && has_next) { hN = (size_t)HROWS * Kn * 2;
#pragma unroll
                for (int i = 0; i < 2; ++i) { G2_RC(i, R, Rb, C2); (void)R; vN0[i] = vP0[i]; vN1[i] = vP1[i]; vBN[i] = (unsigned)(Rb * Kn) * 2u + C2; } }
            G2_LDB(B0, 0, 0); G2_LDB(B1, 0, 1); G2_SCHED; G2_LDA(At, 0, 0); G2_STAGE(G2_SA(1, 1), a1, vA1);
            G2_WAIT_V(8); G2_WAIT_L(0); G2_BAR; G2_MMA(0, 0, At, B0); G2_MMA(0, 1, At, B1); G2_BAR; G2_SCHED;
            G2_LDA(At, 0, 1); G2_STAGE(G2_SB(0, 0), b2, vBN); G2_STAGE(G2_SB(0, 1), b2 + hN, vBN); G2_STAGE(G2_SA(0, 0), a2, vN0);
            G2_WAIT_V(8); G2_WAIT_L(0); G2_BAR; G2_MMA(1, 0, At, B0); G2_MMA(1, 1, At, B1); G2_BAR; G2_SCHED;
            G2_LDB(B0, 1, 0); G2_LDB(B1, 1, 1); G2_SCHED; G2_LDA(At, 1, 0); G2_STAGE(G2_SA(0, 1), a2, vN1);
            G2_WAIT_V(8); G2_WAIT_L(0); G2_BAR; G2_MMA(0, 0, At, B0); G2_MMA(0, 1, At, B1); G2_BAR; G2_SCHED;
            G2_LDA(At, 1, 1); G2_STAGE(G2_SB(1, 0), b3, vBN); G2_STAGE(G2_SB(1, 1), b3 + hN, vBN); G2_STAGE(G2_SA(1, 0), a3, vN0);
            G2_WAIT_V(8); G2_WAIT_L(0); G2_BAR; G2_MMA(1, 0, At, B0); G2_MMA(1, 1, At, B1); G2_BAR; G2_SCHED;
        }
        if constexpr (ALIGN_EPI) { if (wr == 0) G2_BAR; }
        int t2 = threadIdx.x; asm volatile("" : "+v"(t2));
        const bool zero = E(acc, cur, wr, wc, t2 & 15, (t2 & 63) >> 4);
        if (!has_next) break;
        if (zero) {
#pragma unroll
        for (int a = 0; a < 2; ++a)
#pragma unroll
            for (int b = 0; b < 2; ++b)
#pragma unroll
                for (int m = 0; m < 4; ++m)
#pragma unroll
                    for (int n = 0; n < 2; ++n) acc[a][b][m][n] = (f32x4){0.f, 0.f, 0.f, 0.f};
        }
        cur = nxt; nxt = nn; has_next = has_nn; cA = nA; cB = nB; Kc = Kn; nt = Kc / BK; hc = hN; ++ui;
#pragma unroll
        for (int i = 0; i < 2; ++i) { vA0[i] = vN0[i]; vA1[i] = vN1[i]; vBc[i] = vBN[i]; }
        if constexpr (ALIGN_EPI) { if (wr == 1) G2_BAR; }
    }
    G2_WAIT_V(0);
    if constexpr (!ALIGN_EPI) { if (wr == 0) G2_BAR; }
    G2_BAR;
#undef G2_RC
#undef G2_SA
#undef G2_SB
#undef G2_STAGE
#undef G2_LDA
#undef G2_LDB
#undef G2_MMA
#undef G2_WAIT_V
#undef G2_WAIT_L
#undef G2_BAR
#undef G2_SCHED
}
}

__device__ __forceinline__ void tr_item(const float* __restrict__ W, int ldw, int k0, int n0src, bf16* WT, int Kd, int drow0, LAS float* scr, int lane) {
#pragma unroll 8
    for (int i = 0; i < 32; ++i) { const int kk = 2 * i + (lane >> 5); scr[kk * 33 + (lane & 31)] = W[(size_t)(k0 + kk) * ldw + n0src + (lane & 31)]; }
    asm volatile("s_waitcnt lgkmcnt(0)" ::: "memory");
    const int c = lane & 7;
#pragma unroll
    for (int j = 0; j < 4; ++j) { const int n = (lane >> 3) + 8 * j; const LAS float* sp = scr + (8 * c) * 33 + n;
        u32x4 o; o.x = pk2(sp[0 * 33], sp[1 * 33]); o.y = pk2(sp[2 * 33], sp[3 * 33]); o.z = pk2(sp[4 * 33], sp[5 * 33]); o.w = pk2(sp[6 * 33], sp[7 * 33]);
        *(u32x4*)(WT + (size_t)(drow0 + n) * Kd + k0 + 8 * c) = o; }
    asm volatile("s_waitcnt lgkmcnt(0)" ::: "memory");
}


__device__ __forceinline__ unsigned pk4_fp8(float a, float b, float c, float d) { int r = __builtin_amdgcn_cvt_pk_fp8_f32(a, b, 0, false); r = __builtin_amdgcn_cvt_pk_fp8_f32(c, d, r, true); return (unsigned)r; }
__device__ __forceinline__ void tr_item8p(const float* __restrict__ Wcol  , int ldw, int k0, unsigned char* WT, int Kd, int drow0, float sc, LAS float* scr, int lane) {
#pragma unroll 8
    for (int i = 0; i < 32; ++i) { const int kk = 2 * i + (lane >> 5); scr[kk * 33 + (lane & 31)] = Wcol[(size_t)(k0 + kk) * ldw] * sc; }
    asm volatile("s_waitcnt lgkmcnt(0)" ::: "memory");
    const int c = lane & 7;
#pragma unroll
    for (int j = 0; j < 4; ++j) { const int n = (lane >> 3) + 8 * j; const LAS float* sp = scr + (8 * c) * 33 + n;
        u32x2 o; o.x = pk4_fp8(sp[0 * 33], sp[1 * 33], sp[2 * 33], sp[3 * 33]); o.y = pk4_fp8(sp[4 * 33], sp[5 * 33], sp[6 * 33], sp[7 * 33]);
        *(u32x2*)(WT + (size_t)(drow0 + n) * Kd + k0 + 8 * c) = o; }
    asm volatile("s_waitcnt lgkmcnt(0)" ::: "memory");
}
__device__ __forceinline__ void tr_item8(const float* __restrict__ W, int ldw, int k0, int n0src, unsigned char* WT, int Kd, int drow0, float sc, LAS float* scr, int lane) {
    tr_item8p(W + n0src + (lane & 31), ldw, k0, WT, Kd, drow0, sc, scr, lane);
}
__device__ __forceinline__ void ph_cvt_small(Frame& F) {
    LAS float* scr = (LAS float*)(F.lds) + F.wave * (64 * 33);
    const int gw = blockIdx.x * NWAVES + F.wave, NGW = F.G * NWAVES;
    constexpr int I_IN = 16 * 232, I_BA = 4 * 32, I_BB = 16 * 32, I_OUT = 16 * 32, I_R = 16 * 8, I_SGU = 16 * 16, I_SD = 4 * 32;
    constexpr int NIT = I_IN + I_BA + I_BB + I_OUT + I_R + I_SGU + I_SD;
    for (int it = gw; it < NIT + 1; it += NGW) {
        int r = it;
        if (r < I_IN) { const int kb = r / 232, nb = r % 232, d0 = nb * 32; tr_item(F.in[I_WIN], INW, kb * 64, d0 < 5376 ? d0 : d0 + 8, (bf16*)(F.ws + WS_WIN_T), 1024, d0, scr, F.lane);
#if INPROJ_FP8
            tr_item8(F.in[I_WIN], INW, kb * 64, d0 < 5376 ? d0 : d0 + 8, F.ws + WS_WIN_T8, 1024, d0, 32.0f, scr, F.lane);
#endif
            continue; } r -= I_IN;
        if (r < I_BA) { const int kb = r / 32, nb = r % 32; tr_item(F.in[I_WBA], 1024, kb * 64, nb * 32, (bf16*)(F.ws + WS_WBA_T), 256, nb * 32, scr, F.lane); continue; } r -= I_BA;
        if (r < I_BB) { const int kb = r / 32, nb = r % 32; tr_item(F.in[I_WBB], 1024, kb * 64, nb * 32, (bf16*)(F.ws + WS_WBB_T), 1024, nb * 32, scr, F.lane); continue; } r -= I_BB;
        if (r < I_OUT) { const int kb = r / 32, nb = r % 32; tr_item(F.in[I_WOUT], 1024, kb * 64, nb * 32, (bf16*)(F.ws + WS_WOUT_T), 1024, nb * 32, scr, F.lane); continue; } r -= I_OUT;
        if (r < I_R) { const int kb = r / 8, nb = r % 8; tr_item(F.in[I_RW], 256, kb * 64, nb * 32, (bf16*)(F.ws + WS_WR_T), 1024, nb * 32, scr, F.lane); continue; } r -= I_R;
        if (r < I_SGU) { const int kb = r / 16, nb = r % 16, d0 = nb * 32, pn = d0 >> 8, q = d0 & 255; const bool up = q >= 128; const int src = pn * 128 + (q & 127);
            tr_item(up ? F.in[I_WSU] : F.in[I_WSG], 256, kb * 64, src, (bf16*)(F.ws + WS_WSGU_T), 1024, d0, scr, F.lane); continue; } r -= I_SGU;
        if (r < I_SD) { const int kb = r / 32, nb = r % 32; tr_item(F.in[I_WSD], 1024, kb * 64, nb * 32, (bf16*)(F.ws + WS_WSD_T), 256, nb * 32, scr, F.lane); continue; } r -= I_SD;
        { float* W8T = (float*)(F.ws + WS_W8T); const float* W = F.in[I_WIN];
          for (int i = F.lane; i < 8 * 1024; i += 64) { const int k = i >> 3, g = i & 7; W8T[i] = W[(size_t)k * INW + 5376 + g]; } }
    }
#if GATES_GEMM
    { bf16* WT = (bf16*)(F.ws + WS_WIN_T) + (size_t)7424 * 1024; const float* W = F.in[I_WIN];
      for (int i = blockIdx.x * NTHR + F.tid; i < 256 * 1024 / 8; i += F.G * NTHR) { const int rr = i >> 7, k0 = (i & 127) * 8; u32x4 o = (u32x4){0u, 0u, 0u, 0u};
          if (rr < 8) { float v[8];
#pragma unroll
              for (int e = 0; e < 8; ++e) v[e] = W[(size_t)(k0 + e) * INW + 5376 + rr];
              o.x = pk2(v[0], v[1]); o.y = pk2(v[2], v[3]); o.z = pk2(v[4], v[5]); o.w = pk2(v[6], v[7]); }
          *(u32x4*)(WT + (size_t)rr * 1024 + k0) = o; } }
#endif
}

__device__ __forceinline__ void ph_mod(Frame& F) {
    LAS float* scT = (LAS float*)F.lds;
    const float* c = F.in[I_C]; const float* W = F.in[I_WADA]; const float* bias = F.in[I_BADA];
    float* mod = (float*)(F.ws + WS_MOD);
    bool filled = false;
    for (int vb = blockIdx.x; vb < 96; vb += F.G) {
        __syncthreads();
        if (!filled) { for (int i = F.tid; i < 32 * 1024; i += NTHR) { const int b = i >> 10, k = i & 1023; const float v = c[i]; scT[k * 32 + b] = v / (1.0f + expf(-v)); } filled = true; }
        __syncthreads();
        const int n = vb * 64 + F.lane;
        float acc[32];
#pragma unroll
        for (int b = 0; b < 32; ++b) acc[b] = 0.f;
#pragma unroll 4
        for (int kk = 0; kk < 128; ++kk) { const int k = F.wave * 128 + kk;
            const float w = W[(size_t)k * 6144 + n];
#pragma unroll
            for (int b4 = 0; b4 < 8; ++b4) { const f32x4 sv = *(const LAS f32x4*)(scT + k * 32 + b4 * 4);
                acc[b4 * 4 + 0] += sv[0] * w; acc[b4 * 4 + 1] += sv[1] * w; acc[b4 * 4 + 2] += sv[2] * w; acc[b4 * 4 + 3] += sv[3] * w; } }
        __syncthreads();
        LAS float* part = (LAS float*)F.lds;
#pragma unroll
        for (int b = 0; b < 32; ++b) part[(F.wave * 32 + b) * 64 + F.lane] = acc[b];
        filled = false;
        __syncthreads();
        for (int i = F.tid; i < 32 * 64; i += NTHR) { const int b = i >> 6, col = i & 63; float sum = bias[vb * 64 + col];
#pragma unroll
            for (int w8 = 0; w8 < 8; ++w8) sum += part[(w8 * 32 + b) * 64 + col];
            mod[b * 6144 + vb * 64 + col] = sum; }
    }
}

__device__ __forceinline__ float wave_sum8(const float (&v)[8], int lane) {
    float a[4], b2[2], c;
#pragma unroll
    for (int i = 0; i < 4; ++i) { const float keep = (lane & 1) ? v[2 * i + 1] : v[2 * i], give = (lane & 1) ? v[2 * i] : v[2 * i + 1]; a[i] = keep + __shfl_xor(give, 1); }
#pragma unroll
    for (int i = 0; i < 2; ++i) { const float keep = (lane & 2) ? a[2 * i + 1] : a[2 * i], give = (lane & 2) ? a[2 * i] : a[2 * i + 1]; b2[i] = keep + __shfl_xor(give, 2); }
    { const float keep = (lane & 4) ? b2[1] : b2[0], give = (lane & 4) ? b2[0] : b2[1]; c = keep + __shfl_xor(give, 4); }
    c += __shfl_xor(c, 8); c += __shfl_xor(c, 16); c += __shfl_xor(c, 32);
    return c;
}
__device__ __forceinline__ void ph_norm1(Frame& F, int mode = 0) {
    const float* x = F.in[I_X]; const float* g = F.in[I_GPREMIX]; const float* mod = (const float*)(F.ws + WS_MOD);
    bf16* H = (bf16*)(F.outb + OUT_H);
    const float* W8T = (const float*)(F.ws + WS_W8T); float* GATES = (float*)(F.ws + WS_GATES); float* ROPE = (float*)(F.ws + WS_ROPE); const float* bg = F.in[I_BGATES];
    const float inv = powf(500000.0f, -(float)(F.lane & 7) / 8.0f); const float bgl = bg[F.lane & 7];
    for (int ci = blockIdx.x * NWAVES + F.wave; ci < T / 32; ci += F.G * NWAVES) {
        const int tb = ci * 32, b = tb / SEQ; const float* sh = mod + b * 6144, *scl = sh + 1024;
        f32x4 gs[4], h1[4];
#pragma unroll
        for (int j = 0; j < 4; ++j) { const int c = F.lane * 4 + 256 * j; const f32x4 gg = *(const f32x4*)(g + c), s1 = *(const f32x4*)(scl + c); h1[j] = *(const f32x4*)(sh + c); gs[j] = gg * (s1 + 1.0f); }
        f32x4 vn[4];
#pragma unroll
        for (int j = 0; j < 4; ++j) vn[j] = *(const f32x4*)(x + (size_t)tb * D + F.lane * 4 + 256 * j);
#pragma unroll 1
        for (int i = 0; i < 32; ++i) {
            const int t = tb + i;
            asm volatile("" ::: "memory");
            f32x4 v[4]; float ss = 0.f;
#pragma unroll
            for (int j = 0; j < 4; ++j) { v[j] = vn[j]; ss += v[j][0] * v[j][0] + v[j][1] * v[j][1] + v[j][2] * v[j][2] + v[j][3] * v[j][3]; }
            if (i + 1 < 32) {
#pragma unroll
                for (int j = 0; j < 4; ++j) vn[j] = *(const f32x4*)(x + (size_t)(t + 1) * D + F.lane * 4 + 256 * j); }
            const float rstd = rsqrtf(wave_sum(ss) * (1.0f / D) + EPS);
            float gacc[8];
#pragma unroll
            for (int gi = 0; gi < 8; ++gi) gacc[gi] = 0.f;
#pragma unroll
            for (int j = 0; j < 4; ++j) { const int c = F.lane * 4 + 256 * j;
                const f32x4 o = v[j] * rstd * gs[j] + h1[j];
                u32x2 w; w.x = pk2(o[0], o[1]); w.y = pk2(o[2], o[3]); *(u32x2*)(H + (size_t)t * D + c) = w;
#if INPROJ_FP8
                *(unsigned*)(F.ws + WS_H8 + (size_t)t * D + c) = pk4_fp8(o[0], o[1], o[2], o[3]);
#endif
                if (mode != 1 && !GATES_GEMM)
#pragma unroll
                for (int e = 0; e < 4; ++e) { const f32x4 wa = *(const f32x4*)(W8T + (size_t)(c + e) * 8), wb = *(const f32x4*)(W8T + (size_t)(c + e) * 8 + 4);
                    gacc[0] += o[e] * wa[0]; gacc[1] += o[e] * wa[1]; gacc[2] += o[e] * wa[2]; gacc[3] += o[e] * wa[3]; gacc[4] += o[e] * wb[0]; gacc[5] += o[e] * wb[1]; gacc[6] += o[e] * wb[2]; gacc[7] += o[e] * wb[3]; }
                asm volatile("" ::: "memory"); }
#if GATES_GEMM
            const float gsum = 0.f;
#else
            if (mode == 1) continue;
            const float gsum = wave_sum8(gacc, F.lane);
#endif
            const float ang = (float)F.pos[t] * inv; const float kk = rintf(ang * 0.15915494309189535f);
            float rv = fmaf(ang, 0.15915494309189535f, -kk); rv = fmaf(ang, 6.4206383e-9f, rv);
            if (F.lane < 8) { if (!GATES_GEMM) GATES[(size_t)t * 8 + F.lane] = gsum + bgl; ROPE[(size_t)t * 16 + F.lane] = __builtin_amdgcn_cosf(rv); ROPE[(size_t)t * 16 + 8 + F.lane] = __builtin_amdgcn_sinf(rv); }
        }
    }
}

__device__ __forceinline__ void ph_inproj_naive(Frame& F) {
    LAS float* As = (LAS float*)F.lds; LAS float* Bs = As + 16 * 132;
    const bf16* H = (const bf16*)(F.outb + OUT_H); const float* W = F.in[I_WIN]; const float* bg = F.in[I_BGATES];
    bf16* Q = (bf16*)(F.ws + WS_Q); bf16* Kt = (bf16*)(F.ws + WS_K); bf16* V = (bf16*)(F.ws + WS_V); bf16* MQK = (bf16*)(F.ws + WS_MQK); bf16* MV = (bf16*)(F.ws + WS_MV);
    bf16* MO = (bf16*)(F.ws + WS_MO); bf16* GAB = (bf16*)(F.ws + WS_GAB); float* GATES = (float*)(F.ws + WS_GATES);
    constexpr int NTN = (INW + 127) / 128;
    const int ty = F.tid >> 5, tx = F.tid & 31;
    for (int vb = blockIdx.x; vb < (T / 128) * NTN; vb += F.G) {
        const int tm = vb / NTN, tn = vb % NTN, m0 = tm * 128, n0 = tn * 128;
        float acc[8][4]; ZERO_ACC(acc);
        ARowGlobal ar{H, (size_t)D, m0, nullptr};
        ngemm_acc(As, Bs, ar, W, INW, D, n0, INW, acc);
#pragma unroll
        for (int i = 0; i < 8; ++i)
#pragma unroll
            for (int j = 0; j < 4; ++j) {
                const size_t row = (size_t)(m0 + ty * 8 + i); const int col = n0 + tx * 4 + j; const float v = acc[i][j];
                if (col < 768) Q[row * 768 + col] = (bf16)f2bf(v);
                else if (col < 1536) Kt[row * 768 + col - 768] = (bf16)f2bf(v);
                else if (col < 2304) V[row * 768 + col - 1536] = (bf16)f2bf(v);
                else if (col < 3328) MQK[row * 1024 + col - 2304] = (bf16)f2bf(v);
                else if (col < 4352) MV[row * 1024 + col - 3328] = (bf16)f2bf(v);
                else if (col < 5376) MO[row * 1024 + col - 4352] = (bf16)f2bf(v);
                else if (col < 5384) GATES[row * 8 + col - 5376] = v + bg[col - 5376];
                else if (col < INW) GAB[row * 2048 + col - 5384] = (bf16)f2bf(v);
            }
    }
}


__device__ __forceinline__ float fsig(float x) { return __builtin_amdgcn_rcpf(1.0f + __builtin_amdgcn_exp2f(-1.4426950408889634f * x)); }

__device__ __forceinline__ unsigned pk4_sig_u8(const f32x4 v) { int r = 0;
    r = __builtin_amdgcn_cvt_pk_u8_f32(256.0f * fsig(v[0]) - 0.5f, 0, r); r = __builtin_amdgcn_cvt_pk_u8_f32(256.0f * fsig(v[1]) - 0.5f, 1, r);
    r = __builtin_amdgcn_cvt_pk_u8_f32(256.0f * fsig(v[2]) - 0.5f, 2, r); r = __builtin_amdgcn_cvt_pk_u8_f32(256.0f * fsig(v[3]) - 0.5f, 3, r); return (unsigned)r; }
__device__ __forceinline__ f32x4 unpk4_sig_u8(unsigned w) { return (f32x4){((float)(w & 0xffu) + 0.5f) * (1.0f / 256.0f), ((float)((w >> 8) & 0xffu) + 0.5f) * (1.0f / 256.0f), ((float)((w >> 16) & 0xffu) + 0.5f) * (1.0f / 256.0f), ((float)(w >> 24) + 0.5f) * (1.0f / 256.0f)}; }
struct EpiInproj {
    static constexpr bool PERM = true;
    unsigned char* ws; const float* rope; int nostore; const float* bgates;
    __device__ __forceinline__ bool operator()(const f32x4 (&acc)[2][2][4][2], const g2::UnitMN& u, int wr, int wc, int fr, int fq) const {
        if (nostore == 1) { if (acc[0][0][0][0][0] == 123.456f) ws[0] = 1; return true; }
        const int pn = u.pn; size_t boff; int ld, colt;
        if (pn == 29) {
            if (wc == 0 && fq == 0) { float* GT = (float*)(ws + WS_GATES); const f32x4 b0 = *(const f32x4*)bgates, b1 = *(const f32x4*)(bgates + 4);
#pragma unroll
                for (int ai = 0; ai < 2; ++ai)
#pragma unroll
                    for (int m = 0; m < 4; ++m) { const size_t row = (size_t)(u.pm * 256 + wr * 64 + fr + ai * 128 + m * 16);
                        *(f32x4*)(GT + row * 8) = acc[ai][0][m][0] + b0; *(f32x4*)(GT + row * 8 + 4) = acc[ai][0][m][1] + b1; } }
            return true; }
        if (pn < 9) { boff = pn < 3 ? WS_Q : (pn < 6 ? WS_K : WS_V); ld = 768; colt = (pn % 3) * 256; }
        else if (pn < 13) { boff = WS_MQK; ld = 1024; colt = (pn - 9) * 256; }
        else if (pn < 17) { boff = WS_MV; ld = 1024; colt = (pn - 13) * 256; }
        else if (pn < 21) { boff = WS_MO; ld = 1024; colt = (pn - 17) * 256; }
        else { boff = WS_GAB; ld = 2048; colt = (pn - 21) * 256; }
        bf16* base = (bf16*)(ws + boff);
#if GATES_U8
        if (pn >= 17) {
            unsigned char* b8 = ws + (pn < 21 ? WS_MO : WS_GAB); const int ld8 = pn < 21 ? 1024 : 2048, col8 = (pn < 21 ? (pn - 17) : (pn - 21)) * 256 + wc * 64 + 16 * fq; const int row0g = u.pm * 256 + wr * 64 + fr;
#pragma unroll
            for (int ai = 0; ai < 2; ++ai)
#pragma unroll
                for (int m = 0; m < 4; ++m) { const size_t row = (size_t)(row0g + ai * 128 + m * 16);
                    u32x4 w; w.x = pk4_sig_u8(acc[ai][0][m][0]); w.y = pk4_sig_u8(acc[ai][0][m][1]); w.z = pk4_sig_u8(acc[ai][1][m][0]); w.w = pk4_sig_u8(acc[ai][1][m][1]);
                    __builtin_nontemporal_store(w, (u32x4*)(b8 + row * ld8 + col8)); }
            return true; }
#endif
        const bool do_rope = (pn < 6) && (fq == 0);
        const int row0 = u.pm * 256 + wr * 64 + fr, col0 = colt + wc * 64 + 16 * fq;
#pragma unroll
        for (int ai = 0; ai < 2; ++ai) {
            f32x4 rc[4][4];
            if (do_rope) {
#pragma unroll
                for (int m = 0; m < 4; ++m) { const f32x4* rp = (const f32x4*)(rope + (size_t)(row0 + ai * 128 + m * 16) * 16); rc[m][0] = rp[0]; rc[m][1] = rp[1]; rc[m][2] = rp[2]; rc[m][3] = rp[3]; } }
#pragma unroll
            for (int m = 0; m < 4; ++m) {
                const size_t row = (size_t)(row0 + ai * 128 + m * 16);
                f32x4 a0 = acc[ai][0][m][0], a1 = acc[ai][0][m][1], b0 = acc[ai][1][m][0], b1 = acc[ai][1][m][1];
                if (do_rope) { const f32x4 c0 = rc[m][0], c1 = rc[m][1], s0 = rc[m][2], s1 = rc[m][3];
                    const f32x4 x0 = a0 * c0 - b0 * s0, x1 = a1 * c1 - b1 * s1, y0 = b0 * c0 + a0 * s0, y1 = b1 * c1 + a1 * s1; a0 = x0; a1 = x1; b0 = y0; b1 = y1; }
                u32x4 w0, w1; w0.x = g2::cvt_pk_bf16(a0[0], a0[1]); w0.y = g2::cvt_pk_bf16(a0[2], a0[3]); w0.z = g2::cvt_pk_bf16(a1[0], a1[1]); w0.w = g2::cvt_pk_bf16(a1[2], a1[3]);
                w1.x = g2::cvt_pk_bf16(b0[0], b0[1]); w1.y = g2::cvt_pk_bf16(b0[2], b0[3]); w1.z = g2::cvt_pk_bf16(b1[0], b1[1]); w1.w = g2::cvt_pk_bf16(b1[2], b1[3]);
                __builtin_nontemporal_store(w0, (u32x4*)(base + row * ld + col0)); if (nostore != 2) __builtin_nontemporal_store(w1, (u32x4*)(base + row * ld + col0 + 8));
            } }
        return true;
    }
};
__device__ __forceinline__ void ph_inproj_fast(Frame& F, int nostore = 0) {
#if STAGGER_NS > 0
    {
      const unsigned long long t0 = __builtin_amdgcn_s_memrealtime(); const unsigned long long dl = (unsigned long long)((blockIdx.x >> 3) & 15) * (STAGGER_NS / 10) / 16;
      while (__builtin_amdgcn_s_memrealtime() - t0 < dl) __builtin_amdgcn_s_sleep(4); }
#endif
#if INPROJ_FP8
    { g2::DenseOrder S; S.init(T, 25 * 256, D / 2, F.ws + WS_H8, F.ws + WS_WIN_T8, F.G, (int)blockIdx.x); S.pncut = 9; S.pnskip = 4;
      EpiInproj E{F.ws, (const float*)(F.ws + WS_ROPE), nostore, F.in[I_BGATES]};
      g2::gemm_phase<EpiInproj, g2::DenseOrder, true>(F.lds, S, E, 127 - 5); }
#if GATES_GEMM
    { g2::DenseOrder S; S.init(T, 5 * 256, D, F.outb + OUT_H, F.ws + WS_WIN_T, F.G, (int)blockIdx.x); S.pnoff = 9; S.pncut = 4; S.pnskip = 16;
#else
    { g2::DenseOrder S; S.init(T, 4 * 256, D, F.outb + OUT_H, F.ws + WS_WIN_T, F.G, (int)blockIdx.x); S.pnoff = 9;
#endif
      EpiInproj E{F.ws, (const float*)(F.ws + WS_ROPE), nostore, F.in[I_BGATES]};
      g2::gemm_phase<EpiInproj, g2::DenseOrder>(F.lds, S, E); }
#else
    g2::DenseOrder S; S.init(T, 7424, D, F.outb + OUT_H, F.ws + WS_WIN_T, F.G, (int)blockIdx.x);
    EpiInproj E{F.ws, (const float*)(F.ws + WS_ROPE), nostore, F.in[I_BGATES]};
    g2::gemm_phase<EpiInproj, g2::DenseOrder>(F.lds, S, E);
#endif
}


__device__ __forceinline__ void unpack8(const u32x4 w, float (&o)[8]) {
#pragma unroll
    for (int e = 0; e < 4; ++e) { o[2 * e] = __uint_as_float(w[e] << 16); o[2 * e + 1] = __uint_as_float(w[e] & 0xffff0000u); }
}
struct UnitBr { int pm, pn, sub; };
struct BranchOrder {
    typedef UnitBr Unit;
    g2::DenseOrder d; const char *YA, *YB, *WA, *WB;
    __device__ __forceinline__ bool next(int i, Unit& u) const { g2::UnitMN t; if (!d.next(i >> 1, t)) return false; u.pm = t.pm; u.pn = t.pn; u.sub = i & 1; return true; }
    __device__ __forceinline__ int K(const Unit& u) const { return u.sub ? 1024 : 256; }
    __device__ __forceinline__ const char* a_base(const Unit& u) const { return u.sub ? YB : YA; }
    __device__ __forceinline__ unsigned a_row_off(const Unit& u, int r) const { return (unsigned)(u.pm * 256 + r) * (u.sub ? 2048u : 512u); }
    __device__ __forceinline__ const char* b_base(const Unit& u) const { return u.sub ? WB + (size_t)u.pn * 256 * 2048 : WA + (size_t)u.pn * 256 * 512; }
};
struct EpiBranch {
    static constexpr bool PERM = true;
    const bf16* GAB; bf16* MG;
    __device__ __forceinline__ bool operator()(f32x4 (&acc)[2][2][4][2], const UnitBr& u, int wr, int wc, int fr, int fq) const {
        const int row0 = u.pm * 256 + wr * 64 + fr, col0 = u.pn * 256 + wc * 64 + 16 * fq;
#pragma unroll
        for (int ai = 0; ai < 2; ++ai)
#pragma unroll
            for (int m = 0; m < 4; ++m) { const size_t row = (size_t)(row0 + ai * 128 + m * 16);
                u32x4 wout[2];
#if GATES_U8
                { const unsigned char* g8 = (const unsigned char*)GAB + row * 2048 + col0; const u32x4 gbq = *(const u32x4*)(g8 + 1024);
                  if (u.sub == 0) { const u32x4 gaq = *(const u32x4*)g8;
#pragma unroll
                      for (int bj = 0; bj < 2; ++bj)
#pragma unroll
                          for (int n = 0; n < 2; ++n) { const f32x4 sa = unpk4_sig_u8(gaq[2 * bj + n]), sb = unpk4_sig_u8(gbq[2 * bj + n]);
#pragma unroll
                              for (int e = 0; e < 4; ++e) acc[ai][bj][m][n][e] *= sa[e] * __builtin_amdgcn_rcpf(sb[e]); } }
                  else {
#pragma unroll
                      for (int bj = 0; bj < 2; ++bj) { const f32x4 s0 = unpk4_sig_u8(gbq[2 * bj]), s1 = unpk4_sig_u8(gbq[2 * bj + 1]); const f32x4 v0 = acc[ai][bj][m][0] * s0, v1 = acc[ai][bj][m][1] * s1;
                          wout[bj].x = g2::cvt_pk_bf16(v0[0], v0[1]); wout[bj].y = g2::cvt_pk_bf16(v0[2], v0[3]); wout[bj].z = g2::cvt_pk_bf16(v1[0], v1[1]); wout[bj].w = g2::cvt_pk_bf16(v1[2], v1[3]); } } }
#else
#pragma unroll
                for (int bj = 0; bj < 2; ++bj) { const int col = col0 + 8 * bj;
                    float gb[8]; unpack8(*(const u32x4*)(GAB + row * 2048 + 1024 + col), gb);
                    if (u.sub == 0) { float ga[8]; unpack8(*(const u32x4*)(GAB + row * 2048 + col), ga);
#pragma unroll
                        for (int e = 0; e < 4; ++e) { acc[ai][bj][m][0][e] *= fsig(ga[e]) * (1.0f + __builtin_amdgcn_exp2f(-1.4426950408889634f * gb[e]));
                                                      acc[ai][bj][m][1][e] *= fsig(ga[4 + e]) * (1.0f + __builtin_amdgcn_exp2f(-1.4426950408889634f * gb[4 + e])); } }
                    else { f32x4 v0, v1;
#pragma unroll
                        for (int e = 0; e < 4; ++e) { v0[e] = acc[ai][bj][m][0][e] * fsig(gb[e]); v1[e] = acc[ai][bj][m][1][e] * fsig(gb[4 + e]); }
                        wout[bj].x = g2::cvt_pk_bf16(v0[0], v0[1]); wout[bj].y = g2::cvt_pk_bf16(v0[2], v0[3]); wout[bj].z = g2::cvt_pk_bf16(v1[0], v1[1]); wout[bj].w = g2::cvt_pk_bf16(v1[2], v1[3]); } }
#endif
                if (u.sub != 0) { *(u32x4*)(MG + row * 1024 + col0) = wout[0]; *(u32x4*)(MG + row * 1024 + col0 + 8) = wout[1]; } }
        return u.sub != 0;
    }
};
__device__ __forceinline__ void ph_branch_fast(Frame& F) {
    BranchOrder S; S.d.init(T, 1024, 1024, nullptr, nullptr, F.G, (int)blockIdx.x);
    S.YA = (const char*)(F.outb + OUT_YA); S.YB = (const char*)(F.outb + OUT_YB); S.WA = (const char*)(F.ws + WS_WBA_T); S.WB = (const char*)(F.ws + WS_WBB_T);
    EpiBranch E{(const bf16*)(F.ws + WS_GAB), (bf16*)(F.ws + WS_MERGED)};
    g2::gemm_phase<EpiBranch, BranchOrder>(F.lds, S, E);
}
struct EpiBf16Plain {
    static constexpr bool PERM = true;
    bf16* O; int ld;
    __device__ __forceinline__ bool operator()(const f32x4 (&acc)[2][2][4][2], const g2::UnitMN& u, int wr, int wc, int fr, int fq) const {
        const int row0 = u.pm * 256 + wr * 64 + fr, col0 = u.pn * 256 + wc * 64 + 16 * fq;
#pragma unroll
        for (int ai = 0; ai < 2; ++ai)
#pragma unroll
            for (int m = 0; m < 4; ++m) { bf16* rp = O + (size_t)(row0 + ai * 128 + m * 16) * ld + col0;
#pragma unroll
                for (int bj = 0; bj < 2; ++bj) { const f32x4 v0 = acc[ai][bj][m][0], v1 = acc[ai][bj][m][1];
                    u32x4 w; w.x = g2::cvt_pk_bf16(v0[0], v0[1]); w.y = g2::cvt_pk_bf16(v0[2], v0[3]); w.z = g2::cvt_pk_bf16(v1[0], v1[1]); w.w = g2::cvt_pk_bf16(v1[2], v1[3]);
                    *(u32x4*)(rp + bj * 8) = w; } }
        return true;
    }
};
struct EpiF32Plain {
    static constexpr bool PERM = false;
    float* O; int ld;
    __device__ __forceinline__ bool operator()(const f32x4 (&acc)[2][2][4][2], const g2::UnitMN& u, int wr, int wc, int fr, int fq) const {
        const int row0 = u.pm * 256 + wr * 64 + fr, col0 = u.pn * 256 + wc * 32 + 4 * fq;
#pragma unroll
        for (int ai = 0; ai < 2; ++ai)
#pragma unroll
            for (int m = 0; m < 4; ++m) { float* rp = O + (size_t)(row0 + ai * 128 + m * 16) * ld + col0;
#pragma unroll
                for (int bj = 0; bj < 2; ++bj)
#pragma unroll
                    for (int n = 0; n < 2; ++n) *(f32x4*)(rp + bj * 128 + n * 16) = acc[ai][bj][m][n]; }
        return true;
    }
};
__device__ __forceinline__ void ph_outproj_fast(Frame& F) {
    g2::DenseOrder S; S.init(T, 1024, 1024, F.ws + WS_MERGED, F.ws + WS_WOUT_T, F.G, (int)blockIdx.x);
    EpiBf16Plain E{(bf16*)(F.ws + WS_YMIX), 1024};
    g2::gemm_phase<EpiBf16Plain, g2::DenseOrder>(F.lds, S, E);
}
__device__ __forceinline__ void ph_router_fast(Frame& F);
template <class BlockIter> __device__ __forceinline__ void ph_topk4(Frame& F, const BlockIter& BI);
__device__ __forceinline__ void ph_router_fast(Frame& F) {
    g2::DenseOrder S; S.init(T, 256, 1024, F.ws + WS_H2, F.ws + WS_WR_T, F.G, (int)blockIdx.x);
    EpiF32Plain E{(float*)(F.ws + WS_LOGITS), 256};
    g2::gemm_phase<EpiF32Plain, g2::DenseOrder>(F.lds, S, E);
}
__device__ __forceinline__ void ph_cvt_experts(Frame& F) {
    LAS float* scr = (LAS float*)(F.lds) + F.wave * (64 * 33);
    const int gw = blockIdx.x * NWAVES + F.wave, NGW = F.G * NWAVES;
    for (int it = gw; it < NE * 384; it += NGW) {
        const int e = it / 384, r = it % 384;
        if (r < 256) { const int kb = r >> 4, nb = r & 15, d0 = nb * 32, pn = d0 >> 8, q = d0 & 255; const bool up = q >= 128; const int src = pn * 128 + (q & 127);
            tr_item((up ? F.in[I_WEU] : F.in[I_WEG]) + (size_t)e * 1024 * 256, 256, kb * 64, src, (bf16*)(F.ws + WS_WGU) + (size_t)e * 512 * 1024, 1024, d0, scr, F.lane); }
        else { const int q = r - 256, kb = q >> 5, nb = q & 31;
            tr_item(F.in[I_WED] + (size_t)e * 256 * 1024, 1024, kb * 64, nb * 32, (bf16*)(F.ws + WS_WD) + (size_t)e * 1024 * 256, 256, nb * 32, scr, F.lane); }
    }
}

constexpr int CVT_BATCH = 128, CVT_NBATCH = (NE + 1) * 384 / CVT_BATCH;
struct CvtD { const float* Wq; int ldw, k0; unsigned char* WT; int Kd, drow0; float sc; };
__device__ __forceinline__ CvtD cvt_desc(Frame& F, int it) {
    CvtD d; const int e = it / 384, r = it % 384; const bool sh = e == NE;
    if (r < 256) { const int kb = r >> 4, nb = r & 15, d0 = nb * 32, pn = d0 >> 8;
        const int cc = (d0 & 255) + 4 * (F.lane & 7); const bool up = (cc >> 3) & 1; const int col = pn * 128 + 8 * (cc >> 4) + (cc & 7);
        const float* pg = sh ? F.in[I_WSG] : F.in[I_WEG] + (size_t)e * 1024 * 256; const float* pu = sh ? F.in[I_WSU] : F.in[I_WEU] + (size_t)e * 1024 * 256;
        d.Wq = (up ? pu : pg) + col; d.ldw = 256; d.k0 = kb * 64; d.WT = sh ? F.ws + WS_WSGU8 : F.ws + WS_WGU8 + (size_t)e * 512 * 1024; d.Kd = 1024; d.drow0 = d0; d.sc = 32.0f; }
    else { const int q = r - 256, kb = q >> 5, nb = q & 31;
        const float* W = sh ? F.in[I_WSD] : F.in[I_WED] + (size_t)e * 256 * 1024;
        d.Wq = W + nb * 32 + 4 * (F.lane & 7); d.ldw = 1024; d.k0 = kb * 64; d.WT = sh ? F.ws + WS_WSD8 : F.ws + WS_WD8 + (size_t)e * 1024 * 256; d.Kd = 256; d.drow0 = nb * 32; d.sc = 16.0f; }
    return d;
}
struct CvtR { f32x4 v[8]; };
__device__ __forceinline__ void cvt_load(const CvtD& d, CvtR& R, int lane) {
    const int kg = lane >> 3;
#pragma unroll
    for (int i = 0; i < 8; ++i) R.v[i] = *(const f32x4*)(d.Wq + (size_t)(d.k0 + kg + 8 * i) * d.ldw);
}
__device__ __forceinline__ void cvt_store(const CvtD& d, const CvtR& R, LAS float* scr, int lane) {
    const int kg = lane >> 3, q4 = (lane & 7) * 4;
#pragma unroll
    for (int i = 0; i < 8; ++i) { const f32x4 v = R.v[i] * d.sc; LAS float* p = scr + (kg + 8 * i) * 33 + q4; p[0] = v[0]; p[1] = v[1]; p[2] = v[2]; p[3] = v[3]; }
    asm volatile("s_waitcnt lgkmcnt(0)" ::: "memory");
    const int c = lane & 7;
#pragma unroll
    for (int j = 0; j < 4; ++j) { const int n = (lane >> 3) + 8 * j; const LAS float* sp = scr + (8 * c) * 33 + n;
        u32x2 o; o.x = pk4_fp8(sp[0 * 33], sp[1 * 33], sp[2 * 33], sp[3 * 33]); o.y = pk4_fp8(sp[4 * 33], sp[5 * 33], sp[6 * 33], sp[7 * 33]);
        *(u32x2*)(d.WT + (size_t)(d.drow0 + n) * d.Kd + d.k0 + 8 * c) = o; }
    asm volatile("s_waitcnt lgkmcnt(0)" ::: "memory");
}
__device__ __forceinline__ void cvt_experts8_batch(Frame& F, int batch) {
    LAS float* scr = (LAS float*)(F.lds) + F.wave * (64 * 33);
    const int it0 = batch * CVT_BATCH + F.wave;
    CvtD d = cvt_desc(F, it0); CvtR R; cvt_load(d, R, F.lane);
#pragma unroll 1
    for (int k = 0; k < CVT_BATCH / NWAVES; ++k) {
        const CvtD dc = d; const CvtR Rc = R;
        if (k + 1 < CVT_BATCH / NWAVES) { d = cvt_desc(F, it0 + NWAVES * (k + 1)); cvt_load(d, R, F.lane); }
        cvt_store(dc, Rc, scr, F.lane);
    }
}
struct UnitEx { int u, sub, e; };
struct GuOrder {
    typedef UnitEx Unit;
    int NT, nun, G, vcu; const int* UNITEXP; const int* ROWTOK; const char *H2, *WGU, *WSGU;
    __device__ __forceinline__ bool next(int i, Unit& x) const { const int L = i * G + vcu; if (L >= nun) return false; x.u = L >> 1; x.sub = L & 1; x.e = x.u < NT ? UNITEXP[x.u] : -1; return true; }
    __device__ __forceinline__ int K(const Unit&) const { return 1024; }
    __device__ __forceinline__ const char* a_base(const Unit&) const { return H2; }
    __device__ __forceinline__ unsigned a_row_off(const Unit& x, int r) const { return (unsigned)ROWTOK[(unsigned)(x.u * 256 + r)] * 2048u; }
    __device__ __forceinline__ const char* b_base(const Unit& x) const { return (x.e >= 0 ? WGU + (size_t)x.e * (512 * 1024 * 2) : WSGU) + (size_t)x.sub * (256 * 1024 * 2); }
};
struct EpiGu {
    static constexpr bool PERM = true;
    int NT; bf16 *HIDR, *HIDS;
    __device__ __forceinline__ bool operator()(const f32x4 (&acc)[2][2][4][2], const UnitEx& x, int wr, int wc, int fr, int fq) const {
        bf16* base = x.e >= 0 ? HIDR + (size_t)x.u * 256 * 256 : HIDS + (size_t)(x.u - NT) * 256 * 256;
        const int row0 = wr * 64 + fr, col0 = x.sub * 128 + wc * 32 + 8 * fq;
#pragma unroll
        for (int ai = 0; ai < 2; ++ai)
#pragma unroll
            for (int m = 0; m < 4; ++m) { const f32x4 g0 = acc[ai][0][m][0], g1 = acc[ai][0][m][1], u0 = acc[ai][1][m][0], u1 = acc[ai][1][m][1]; f32x4 h0, h1;
#pragma unroll
                for (int e = 0; e < 4; ++e) { h0[e] = g0[e] * fsig(g0[e]) * u0[e]; h1[e] = g1[e] * fsig(g1[e]) * u1[e]; }
                u32x4 w; w.x = g2::cvt_pk_bf16(h0[0], h0[1]); w.y = g2::cvt_pk_bf16(h0[2], h0[3]); w.z = g2::cvt_pk_bf16(h1[0], h1[1]); w.w = g2::cvt_pk_bf16(h1[2], h1[3]);
                *(u32x4*)(base + (size_t)(row0 + ai * 128 + m * 16) * 256 + col0) = w; asm volatile("" ::: "memory"); }
        return true;
    }
};
struct DownOrder {
    typedef UnitEx Unit;
    int NT, nun, G, vcu; const int* UNITEXP; const char *HIDR, *HIDS, *WD, *WSD;
    __device__ __forceinline__ bool next(int i, Unit& x) const { const int L = i * G + vcu; if (L >= nun) return false; x.u = L >> 2; x.sub = L & 3; x.e = x.u < NT ? UNITEXP[x.u] : -1; return true; }
    __device__ __forceinline__ int K(const Unit&) const { return 256; }
    __device__ __forceinline__ const char* a_base(const Unit& x) const { return x.e >= 0 ? HIDR : HIDS; }
    __device__ __forceinline__ unsigned a_row_off(const Unit& x, int r) const { return (unsigned)((x.e >= 0 ? x.u : x.u - NT) * 256 + r) * 512u; }
    __device__ __forceinline__ const char* b_base(const Unit& x) const { return (x.e >= 0 ? WD + (size_t)x.e * (1024 * 256 * 2) : WSD) + (size_t)x.sub * (256 * 256 * 2); }
};
struct EpiDown {
    static constexpr bool PERM = false;
    const int* ROWTOK; const float* ROWW; float* out;
    __device__ __forceinline__ bool operator()(const f32x4 (&acc)[2][2][4][2], const UnitEx& x, int wr, int wc, int fr, int fq) const {
        const int row0 = x.u * 256 + wr * 64 + fr; const unsigned col0 = (unsigned)(x.sub * 256 + wc * 32 + 4 * fq);
#pragma unroll
        for (int ai = 0; ai < 2; ++ai)
#pragma unroll
            for (int m = 0; m < 4; ++m) { const int r = row0 + ai * 128 + m * 16; const unsigned tok = (unsigned)ROWTOK[r]; const float w = ROWW[r];
                const unsigned off = tok * 1024u + col0;
#pragma unroll
                for (int bj = 0; bj < 2; ++bj)
#pragma unroll
                    for (int n = 0; n < 2; ++n)
#pragma unroll
                        for (int e = 0; e < 4; ++e) unsafeAtomicAdd(out + (off + (unsigned)(bj * 128 + n * 16 + e)), acc[ai][bj][m][n][e] * w);
                asm volatile("" ::: "memory"); }
        return true;
    }
};
__device__ __forceinline__ void ph_gu_fast(Frame& F) {
    const int NT = (int)__hip_atomic_load(F.ctl + CW_NT, __ATOMIC_RELAXED, __HIP_MEMORY_SCOPE_AGENT);
    const int bx = blockIdx.x; const int vcu = (F.G % 8 == 0) ? (bx % 8) * (F.G / 8) + bx / 8 : bx;
    GuOrder S{NT, 2 * (NT + T / 256), F.G, vcu, (const int*)(F.ws + WS_UNITEXP), (const int*)(F.ws + WS_ROWTOK), (const char*)(F.ws + WS_H2), (const char*)(F.ws + WS_WGU), (const char*)(F.ws + WS_WSGU_T)};
    EpiGu E{NT, (bf16*)(F.ws + WS_HIDR), (bf16*)(F.ws + WS_HIDS)};
    g2::gemm_phase<EpiGu, GuOrder>(F.lds, S, E);
}
__device__ __forceinline__ void ph_down_fast(Frame& F) {
    const int NT = (int)__hip_atomic_load(F.ctl + CW_NT, __ATOMIC_RELAXED, __HIP_MEMORY_SCOPE_AGENT);
    const int bx = blockIdx.x; const int vcu = (F.G % 8 == 0) ? (bx % 8) * (F.G / 8) + bx / 8 : bx;
    DownOrder S{NT, 4 * (NT + T / 256), F.G, vcu, (const int*)(F.ws + WS_UNITEXP), (const char*)(F.ws + WS_HIDR), (const char*)(F.ws + WS_HIDS), (const char*)(F.ws + WS_WD), (const char*)(F.ws + WS_WSD_T)};
    EpiDown E{(const int*)(F.ws + WS_ROWTOK), (const float*)(F.ws + WS_ROWW), F.out};
    g2::gemm_phase<EpiDown, DownOrder>(F.lds, S, E);
}


__device__ __forceinline__ void ph_rope_naive(Frame& F) {
    bf16* Q = (bf16*)(F.ws + WS_Q); bf16* Kt = (bf16*)(F.ws + WS_K);
    for (int t = blockIdx.x * NWAVES + F.wave; t < T; t += F.G * NWAVES) {
        const float p = (float)F.pos[t];
#pragma unroll
        for (int r = 0; r < 3; ++r) {
            const int it = r * 64 + F.lane;
            const int i = it & 7, head = (it >> 3) % 12, qk = it / 96;
            const float inv = powf(500000.0f, -(float)i / 8.0f);
            const float ang = p * inv; const float cs = cosf(ang), sn = sinf(ang);
            bf16* base = (qk ? Kt : Q) + (size_t)t * 768 + head * 64;
            const float x1 = bf2f(base[i]), x2 = bf2f(base[i + 8]);
            base[i] = (bf16)f2bf(x1 * cs - x2 * sn); base[i + 8] = (bf16)f2bf(x2 * cs + x1 * sn);
        }
    }
}

__device__ __forceinline__ void ph_attn_naive_block(Frame& F, int vb) {
    const bf16* Q = (const bf16*)(F.ws + WS_Q); const bf16* Kt = (const bf16*)(F.ws + WS_K); const bf16* V = (const bf16*)(F.ws + WS_V);
    bf16* YA = (bf16*)(F.outb + OUT_YA);
    const int item = vb * NTHR + F.tid; const int t = item >> 2, j = item & 3; const int b = t / SEQ, s = t % SEQ;
    float acc[64];
#pragma unroll
    for (int d = 0; d < 64; ++d) acc[d] = 0.f;
    float m = -INFINITY, l = 0.f;
    for (int g = 0; g < 3; ++g) {
        const int dil = (g == 0) ? 1 : (g == 1) ? 4 : 16; const int head = g * 4 + j;
        float q[64];
        { const u32x4* qp = (const u32x4*)(Q + (size_t)t * 768 + head * 64);
#pragma unroll
          for (int c = 0; c < 8; ++c) { const u32x4 w = qp[c];
#pragma unroll
              for (int e = 0; e < 4; ++e) { q[c * 8 + 2 * e] = __uint_as_float(w[e] << 16) * 0.125f; q[c * 8 + 2 * e + 1] = __uint_as_float(w[e] & 0xffff0000u) * 0.125f; } } }
        const int lq = s / dil; const int nk = (lq < 128 ? lq : 128) + 1;
        for (int jj = 0; jj < nk; ++jj) {
            const size_t tk = (size_t)b * SEQ + (s - jj * dil);
            const u32x4* kp = (const u32x4*)(Kt + tk * 768 + head * 64);
            float dot = 0.f;
#pragma unroll
            for (int c = 0; c < 8; ++c) { const u32x4 w = kp[c];
#pragma unroll
                for (int e = 0; e < 4; ++e) { dot += q[c * 8 + 2 * e] * __uint_as_float(w[e] << 16); dot += q[c * 8 + 2 * e + 1] * __uint_as_float(w[e] & 0xffff0000u); } }
            const float mn = fmaxf(m, dot); const float corr = expf(m - mn), p = expf(dot - mn);
            l = l * corr + p; m = mn;
            const u32x4* vp = (const u32x4*)(V + tk * 768 + head * 64);
#pragma unroll
            for (int c = 0; c < 8; ++c) { const u32x4 w = vp[c];
#pragma unroll
                for (int e = 0; e < 4; ++e) { acc[c * 8 + 2 * e] = acc[c * 8 + 2 * e] * corr + p * __uint_as_float(w[e] << 16); acc[c * 8 + 2 * e + 1] = acc[c * 8 + 2 * e + 1] * corr + p * __uint_as_float(w[e] & 0xffff0000u); } }
        }
    }
    const float rl = 1.0f / l;
    u32x4* op = (u32x4*)(YA + (size_t)t * 256 + j * 64);
#pragma unroll
    for (int c = 0; c < 8; ++c) { u32x4 w;
#pragma unroll
        for (int e = 0; e < 4; ++e) w[e] = pk2(acc[c * 8 + 2 * e] * rl, acc[c * 8 + 2 * e + 1] * rl);
        op[c] = w; }
}


typedef short v4i16_t __attribute__((ext_vector_type(4)));
typedef short bf16x8_t __attribute__((ext_vector_type(8)));
constexpr int ATT_RS = 144;
constexpr int ATT_ROWS = 272;
constexpr int ATT_UNITS = 48 * 128;
__device__ __forceinline__ void attn_unit_fast(Frame& F, int uidx) {
    const int bj = uidx / 48, r48 = uidx % 48, b = bj >> 2, j = bj & 3, g = r48 >> 4, q16 = r48 & 15;
    const int dil = (g == 0) ? 1 : (g == 1) ? 4 : 16;
    const int rho = (g == 0) ? 0 : (g == 1) ? (q16 >> 2) : q16, n = (g == 0) ? q16 : (g == 1) ? (q16 & 3) : 0;
    const int head = g * 4 + j;
    const bf16* Q = (const bf16*)(F.ws + WS_Q); const bf16* Kg = (const bf16*)(F.ws + WS_K); const bf16* Vg = (const bf16*)(F.ws + WS_V);
    bf16* OG = (bf16*)(F.outb + OUT_OG) + (size_t)g * T * 256; float* LSE = (float*)(F.ws + WS_LSE) + (size_t)g * T * 4;
    LAS unsigned char* Kt = F.lds; LAS unsigned char* Vt = F.lds + ATT_ROWS * ATT_RS;
    const int tid = F.tid, lane = F.lane, w = F.wave, ql = lane & 15, g4 = lane >> 4;
    __syncthreads();
#pragma unroll
    for (int i = 0; i < 4; ++i) { const int p = tid + NTHR * i, row = p >> 3, c = p & 7; const int lk = (n - 1) * 128 + row;
        u32x4 kv = (u32x4){0u, 0u, 0u, 0u}, vv = kv;
        if (lk >= 0) { const size_t off = ((size_t)b * SEQ + (size_t)lk * dil + rho) * 768 + head * 64 + c * 8; kv = *(const u32x4*)(Kg + off); vv = *(const u32x4*)(Vg + off); }
        *(LAS u32x4*)(Kt + row * ATT_RS + c * 16) = kv; *(LAS u32x4*)(Vt + row * ATT_RS + c * 16) = vv; }
    if (tid < 128) { const int row = 256 + (tid >> 3), c = tid & 7; *(LAS u32x4*)(Kt + row * ATT_RS + c * 16) = (u32x4){0u, 0u, 0u, 0u}; *(LAS u32x4*)(Vt + row * ATT_RS + c * 16) = (u32x4){0u, 0u, 0u, 0u}; }
    const int qi = 16 * w + ql; const size_t tq = (size_t)b * SEQ + (size_t)(n * 128 + qi) * dil + rho;
    bf16x8_t Qf[2];
#pragma unroll
    for (int ks = 0; ks < 2; ++ks) Qf[ks] = *(const bf16x8_t*)(Q + tq * 768 + head * 64 + 32 * ks + 8 * g4);
    __syncthreads();
    f32x4 O[4];
#pragma unroll
    for (int dt = 0; dt < 4; ++dt) O[dt] = (f32x4){0.f, 0.f, 0.f, 0.f};
    float m = -INFINITY, lsum = 0.f;
    const float SC = 0.125f * 1.4426950408889634f;
    const int qq = ql >> 2, pp4 = ql & 3;
#pragma unroll 1
    for (int pp = 4; pp >= 0; --pp) {
        const int t0 = w + 2 * pp, t1 = t0 + 1;
        f32x4 S0 = (f32x4){0.f, 0.f, 0.f, 0.f}, S1 = S0;
#pragma unroll
        for (int ks = 0; ks < 2; ++ks) {
            const bf16x8_t k0 = *(const LAS bf16x8_t*)(Kt + (16 * t0 + ql) * ATT_RS + (32 * ks + 8 * g4) * 2);
            const bf16x8_t k1 = *(const LAS bf16x8_t*)(Kt + (16 * t1 + ql) * ATT_RS + (32 * ks + 8 * g4) * 2);
            S0 = __builtin_amdgcn_mfma_f32_16x16x32_bf16(k0, Qf[ks], S0, 0, 0, 0);
            S1 = __builtin_amdgcn_mfma_f32_16x16x32_bf16(k1, Qf[ks], S1, 0, 0, 0);
        }
        float tmax = -INFINITY;
#pragma unroll
        for (int r = 0; r < 4; ++r) {
            const int k0i = 16 * t0 + 4 * g4 + r, k1i = k0i + 16;
            const bool v0 = (k0i >= qi) && (k0i <= qi + 128) && (n > 0 || k0i >= 128), v1 = (k1i >= qi) && (k1i <= qi + 128) && (n > 0 || k1i >= 128);
            S0[r] = v0 ? S0[r] * SC : -INFINITY; S1[r] = v1 ? S1[r] * SC : -INFINITY;
            tmax = fmaxf(tmax, fmaxf(S0[r], S1[r]));
        }
        tmax = fmaxf(tmax, __shfl_xor(tmax, 16)); tmax = fmaxf(tmax, __shfl_xor(tmax, 32));
        const float mn = fmaxf(m, tmax);
        const float corr = __builtin_amdgcn_exp2f(m - mn); m = mn;
        float ps = 0.f; float p0[4], p1[4];
#pragma unroll
        for (int r = 0; r < 4; ++r) { p0[r] = __builtin_amdgcn_exp2f(S0[r] - mn); p1[r] = __builtin_amdgcn_exp2f(S1[r] - mn); ps += p0[r] + p1[r]; }
        lsum = lsum * corr + ps;
        u32x4 pk; pk.x = g2::cvt_pk_bf16(p0[0], p0[1]); pk.y = g2::cvt_pk_bf16(p0[2], p0[3]); pk.z = g2::cvt_pk_bf16(p1[0], p1[1]); pk.w = g2::cvt_pk_bf16(p1[2], p1[3]);
        const bf16x8_t Pf = __builtin_bit_cast(bf16x8_t, pk);
#pragma unroll
        for (int dt = 0; dt < 4; ++dt) {
            O[dt] = O[dt] * corr;
            const v4i16_t lo = __builtin_amdgcn_ds_read_tr16_b64_v4i16((LAS v4i16_t*)(Vt + (16 * t0 + 4 * g4 + qq) * ATT_RS + (16 * dt + 4 * pp4) * 2));
            const v4i16_t hi = __builtin_amdgcn_ds_read_tr16_b64_v4i16((LAS v4i16_t*)(Vt + (16 * t1 + 4 * g4 + qq) * ATT_RS + (16 * dt + 4 * pp4) * 2));
            const bf16x8_t Vf = __builtin_shufflevector(lo, hi, 0, 1, 2, 3, 4, 5, 6, 7);
            O[dt] = __builtin_amdgcn_mfma_f32_16x16x32_bf16(Vf, Pf, O[dt], 0, 0, 0);
        }
    }
    lsum += __shfl_xor(lsum, 16); lsum += __shfl_xor(lsum, 32);
    const float rl = 1.0f / lsum;
#pragma unroll
    for (int dt = 0; dt < 4; ++dt) { u32x2 o; o.x = g2::cvt_pk_bf16(O[dt][0] * rl, O[dt][1] * rl); o.y = g2::cvt_pk_bf16(O[dt][2] * rl, O[dt][3] * rl);
        *(u32x2*)(OG + tq * 256 + j * 64 + 16 * dt + 4 * g4) = o; }
    if (g4 == 0) LSE[tq * 4 + j] = m + __builtin_amdgcn_logf(lsum);
}
struct AttU { int b, j, g, dil, rho, n, head; };
__device__ __forceinline__ AttU att_unit(int uidx) { AttU u; const int bj = uidx / 48, r48 = uidx % 48; u.b = bj >> 2; u.j = bj & 3; u.g = r48 >> 4; const int q16 = r48 & 15;
    u.dil = (u.g == 0) ? 1 : (u.g == 1) ? 4 : 16; u.rho = (u.g == 0) ? 0 : (u.g == 1) ? (q16 >> 2) : q16; u.n = (u.g == 0) ? q16 : (u.g == 1) ? (q16 & 3) : 0; u.head = u.g * 4 + u.j; return u; }
struct AttR { u32x4 kv[4], vv[4]; bf16x8_t q[2]; };
__device__ __forceinline__ void att_load(Frame& F, const AttU& u, AttR& R) {
    const bf16* Q = (const bf16*)(F.ws + WS_Q); const bf16* Kg = (const bf16*)(F.ws + WS_K); const bf16* Vg = (const bf16*)(F.ws + WS_V);
#pragma unroll
    for (int i = 0; i < 4; ++i) { const int p = F.tid + NTHR * i, row = p >> 3, c = p & 7; const int lk = (u.n - 1) * 128 + row;
        R.kv[i] = (u32x4){0u, 0u, 0u, 0u}; R.vv[i] = R.kv[i];
        if (lk >= 0) { const size_t off = ((size_t)u.b * SEQ + (size_t)lk * u.dil + u.rho) * 768 + u.head * 64 + c * 8; R.kv[i] = *(const u32x4*)(Kg + off); R.vv[i] = *(const u32x4*)(Vg + off); } }
    const int qi = 16 * F.wave + (F.lane & 15), g4 = F.lane >> 4; const size_t tq = (size_t)u.b * SEQ + (size_t)(u.n * 128 + qi) * u.dil + u.rho;
#pragma unroll
    for (int ks = 0; ks < 2; ++ks) R.q[ks] = *(const bf16x8_t*)(Q + tq * 768 + u.head * 64 + 32 * ks + 8 * g4);
}
__device__ __forceinline__ void attn_queue_run(Frame& F, unsigned* qc, volatile LAS unsigned* MISC) {
    LAS unsigned char* Kt = F.lds; LAS unsigned char* Vt = F.lds + ATT_ROWS * ATT_RS;
    unsigned nxt = 0u;
    __syncthreads();
    if (F.tid == 0) MISC[0] = atomicAdd(qc, 1u);
    __syncthreads();
    int uidx = (int)MISC[0];
    if (uidx >= ATT_UNITS) return;
    if (F.tid == 0) nxt = atomicAdd(qc, 1u);
    AttR R; AttU u = att_unit(uidx); att_load(F, u, R);
    for (;;) {
        const int tid = F.tid, lane = F.lane, w = F.wave, ql = lane & 15, g4 = lane >> 4;
        const int b = u.b, j = u.j, g = u.g, dil = u.dil, rho = u.rho, n = u.n;
        bf16* OG = (bf16*)(F.outb + OUT_OG) + (size_t)g * T * 256; float* LSE = (float*)(F.ws + WS_LSE) + (size_t)g * T * 4;
        __syncthreads();
#pragma unroll
        for (int i = 0; i < 4; ++i) { const int p = tid + NTHR * i, row = p >> 3, c = p & 7; *(LAS u32x4*)(Kt + row * ATT_RS + c * 16) = R.kv[i]; *(LAS u32x4*)(Vt + row * ATT_RS + c * 16) = R.vv[i]; }
        if (tid < 128) { const int row = 256 + (tid >> 3), c = tid & 7; *(LAS u32x4*)(Kt + row * ATT_RS + c * 16) = (u32x4){0u, 0u, 0u, 0u}; *(LAS u32x4*)(Vt + row * ATT_RS + c * 16) = (u32x4){0u, 0u, 0u, 0u}; }
        bf16x8_t Qf[2]; Qf[0] = R.q[0]; Qf[1] = R.q[1];
        if (tid == 0) MISC[0] = nxt;
        __syncthreads();
        const int un = (int)MISC[0]; const bool more = un < ATT_UNITS;
        AttU u2 = u;
        if (more) { if (tid == 0) nxt = atomicAdd(qc, 1u); u2 = att_unit(un); att_load(F, u2, R); }
        const int qi = 16 * w + ql; const size_t tq = (size_t)b * SEQ + (size_t)(n * 128 + qi) * dil + rho;
    f32x4 O[4];
#pragma unroll
    for (int dt = 0; dt < 4; ++dt) O[dt] = (f32x4){0.f, 0.f, 0.f, 0.f};
    float m = -INFINITY, lsum = 0.f;
    const float SC = 0.125f * 1.4426950408889634f;
    const int qq = ql >> 2, pp4 = ql & 3;
#pragma unroll 1
    for (int pp = 4; pp >= 0; --pp) {
        const int t0 = w + 2 * pp, t1 = t0 + 1;
        f32x4 S0 = (f32x4){0.f, 0.f, 0.f, 0.f}, S1 = S0;
#pragma unroll
        for (int ks = 0; ks < 2; ++ks) {
            const bf16x8_t k0 = *(const LAS bf16x8_t*)(Kt + (16 * t0 + ql) * ATT_RS + (32 * ks + 8 * g4) * 2);
            const bf16x8_t k1 = *(const LAS bf16x8_t*)(Kt + (16 * t1 + ql) * ATT_RS + (32 * ks + 8 * g4) * 2);
            S0 = __builtin_amdgcn_mfma_f32_16x16x32_bf16(k0, Qf[ks], S0, 0, 0, 0);
            S1 = __builtin_amdgcn_mfma_f32_16x16x32_bf16(k1, Qf[ks], S1, 0, 0, 0);
        }
        float tmax = -INFINITY;
#pragma unroll
        for (int r = 0; r < 4; ++r) {
            const int k0i = 16 * t0 + 4 * g4 + r, k1i = k0i + 16;
            const bool v0 = (k0i >= qi) && (k0i <= qi + 128) && (n > 0 || k0i >= 128), v1 = (k1i >= qi) && (k1i <= qi + 128) && (n > 0 || k1i >= 128);
            S0[r] = v0 ? S0[r] * SC : -INFINITY; S1[r] = v1 ? S1[r] * SC : -INFINITY;
            tmax = fmaxf(tmax, fmaxf(S0[r], S1[r]));
        }
        tmax = fmaxf(tmax, __shfl_xor(tmax, 16)); tmax = fmaxf(tmax, __shfl_xor(tmax, 32));
        const float mn = fmaxf(m, tmax);
        const float corr = __builtin_amdgcn_exp2f(m - mn); m = mn;
        float ps = 0.f; float p0[4], p1[4];
#pragma unroll
        for (int r = 0; r < 4; ++r) { p0[r] = __builtin_amdgcn_exp2f(S0[r] - mn); p1[r] = __builtin_amdgcn_exp2f(S1[r] - mn); ps += p0[r] + p1[r]; }
        lsum = lsum * corr + ps;
        u32x4 pk; pk.x = g2::cvt_pk_bf16(p0[0], p0[1]); pk.y = g2::cvt_pk_bf16(p0[2], p0[3]); pk.z = g2::cvt_pk_bf16(p1[0], p1[1]); pk.w = g2::cvt_pk_bf16(p1[2], p1[3]);
        const bf16x8_t Pf = __builtin_bit_cast(bf16x8_t, pk);
#pragma unroll
        for (int dt = 0; dt < 4; ++dt) {
            O[dt] = O[dt] * corr;
            const v4i16_t lo = __builtin_amdgcn_ds_read_tr16_b64_v4i16((LAS v4i16_t*)(Vt + (16 * t0 + 4 * g4 + qq) * ATT_RS + (16 * dt + 4 * pp4) * 2));
            const v4i16_t hi = __builtin_amdgcn_ds_read_tr16_b64_v4i16((LAS v4i16_t*)(Vt + (16 * t1 + 4 * g4 + qq) * ATT_RS + (16 * dt + 4 * pp4) * 2));
            const bf16x8_t Vf = __builtin_shufflevector(lo, hi, 0, 1, 2, 3, 4, 5, 6, 7);
            O[dt] = __builtin_amdgcn_mfma_f32_16x16x32_bf16(Vf, Pf, O[dt], 0, 0, 0);
        }
    }
    lsum += __shfl_xor(lsum, 16); lsum += __shfl_xor(lsum, 32);
    const float rl = 1.0f / lsum;
#pragma unroll
    for (int dt = 0; dt < 4; ++dt) { u32x2 o; o.x = g2::cvt_pk_bf16(O[dt][0] * rl, O[dt][1] * rl); o.y = g2::cvt_pk_bf16(O[dt][2] * rl, O[dt][3] * rl);
        *(u32x2*)(OG + tq * 256 + j * 64 + 16 * dt + 4 * g4) = o; }
    if (g4 == 0) LSE[tq * 4 + j] = m + __builtin_amdgcn_logf(lsum);
        if (!more) break;
        u = u2;
    }
}
__device__ __forceinline__ void ph_attn_combine(Frame& F, int own = -1) {
    const bf16* OG = (const bf16*)(F.outb + OUT_OG); const float* LSE = (const float*)(F.ws + WS_LSE); bf16* YA = (bf16*)(F.outb + OUT_YA);
    const int j = F.lane >> 4, c = (F.lane & 15) * 4;
    const int nit = own >= 0 ? ((T / 256 - own + F.G - 1) / F.G) * 32 : (T - (int)(blockIdx.x * NWAVES + F.wave) + F.G * NWAVES - 1) / (F.G * NWAVES);
    for (int it = 0; it < nit; ++it) { const int t = own >= 0 ? ((own + (it >> 5) * F.G) << 8) + F.wave * 32 + (it & 31) : (int)(blockIdx.x * NWAVES + F.wave) + it * F.G * NWAVES;
        float l[3], o[3][4]; float mx = -INFINITY;
#pragma unroll
        for (int g = 0; g < 3; ++g) { l[g] = LSE[((size_t)g * T + t) * 4 + j]; mx = fmaxf(mx, l[g]);
            const u32x2 w = *(const u32x2*)(OG + ((size_t)g * T + t) * 256 + j * 64 + c);
            o[g][0] = __uint_as_float(w.x << 16); o[g][1] = __uint_as_float(w.x & 0xffff0000u); o[g][2] = __uint_as_float(w.y << 16); o[g][3] = __uint_as_float(w.y & 0xffff0000u); }
        float ws = 0.f, y[4] = {0.f, 0.f, 0.f, 0.f};
#pragma unroll
        for (int g = 0; g < 3; ++g) { const float e = __builtin_amdgcn_exp2f(l[g] - mx); ws += e;
#pragma unroll
            for (int k = 0; k < 4; ++k) y[k] += e * o[g][k]; }
        const float rw = 1.0f / ws;
        u32x2 w; w.x = pk2(y[0] * rw, y[1] * rw); w.y = pk2(y[2] * rw, y[3] * rw);
        *(u32x2*)(YA + (size_t)t * 256 + j * 64 + c) = w;
    }
}

__device__ __forceinline__ void ph_mlstm_naive_unit(Frame& F, int bh) {
    const int b = bh >> 2, h = bh & 3, tid = F.tid, v = tid & 255, dh = tid >> 8;
    LAS float* qs = (LAS float*)F.lds; LAS float* ks = qs + 128; LAS float* red = ks + 128; LAS float* sc = red + 512;
    const bf16* MQK = (const bf16*)(F.ws + WS_MQK); const bf16* MV = (const bf16*)(F.ws + WS_MV); const bf16* MO = (const bf16*)(F.ws + WS_MO);
    const float* GATES = (const float*)(F.ws + WS_GATES); bf16* YB = (bf16*)(F.outb + OUT_YB);
    const float* cw = F.in[I_CONVW]; const float* cbv = F.in[I_CONVB];
    float C[64];
#pragma unroll
    for (int d = 0; d < 64; ++d) C[d] = 0.f;
    float nst = 0.f, m = 0.f;
    const int ch = (tid < 128) ? (h * 128 + tid) : (512 + h * 128 + ((tid - 128) & 127));
    const float w0 = cw[ch], w1 = cw[1024 + ch], w2 = cw[2048 + ch], w3 = cw[3072 + ch], cb = cbv[ch];
    float xh0 = 0.f, xh1 = 0.f, xh2 = 0.f;
    const float gm = F.in[I_GMLSTM][h * 256 + v];
    __syncthreads();
    for (int s = 0; s < SEQ; ++s) {
        const size_t t = (size_t)b * SEQ + s;
        if (tid < 256) {
            const float xc = bf2f(MQK[t * 1024 + ch]);
            float y = cb + w0 * xh0 + w1 * xh1 + w2 * xh2 + w3 * xc; xh0 = xh1; xh1 = xh2; xh2 = xc;
            y = y / (1.0f + expf(-y));
            if (tid < 128) qs[tid] = y; else ks[tid - 128] = y * 0.08838834764831845f;
        }
        const float ig = GATES[t * 8 + h], fg = GATES[t * 8 + 4 + h];
        const float lf = logsigmoidf_(fg); const float mn = fmaxf(lf + m, ig); const float fd = expf(lf + m - mn), iw = expf(ig - mn); m = mn;
        const float vv = bf2f(MV[t * 1024 + h * 256 + v]);
        __syncthreads();
        float part = 0.f; const float ivv = iw * vv;
#pragma unroll
        for (int d4 = 0; d4 < 16; ++d4) { const f32x4 k4 = *(const LAS f32x4*)(ks + dh * 64 + d4 * 4), q4 = *(const LAS f32x4*)(qs + dh * 64 + d4 * 4);
#pragma unroll
            for (int e = 0; e < 4; ++e) { C[d4 * 4 + e] = fd * C[d4 * 4 + e] + ivv * k4[e]; part += C[d4 * 4 + e] * q4[e]; } }
        red[tid] = part;
        float nq = 0.f;
        if (tid < 128) { nst = fd * nst + iw * ks[tid]; nq = nst * qs[tid]; }
        nq = wave_sum(nq);
        if (F.lane == 0 && F.wave < 2) sc[F.wave] = nq;
        __syncthreads();
        const float num = red[v] + red[v + 256]; const float den = sc[0] + sc[1];
        const float hv = num / fmaxf(fabsf(den), expf(-mn));
        float sq = (dh == 0) ? hv * hv : 0.f; sq = wave_sum(sq);
        if (F.lane == 0) sc[2 + F.wave] = sq;
        __syncthreads();
        if (dh == 0) {
            const float ssum = sc[2] + sc[3] + sc[4] + sc[5];
            float y = hv * rsqrtf(ssum * (1.0f / 256.0f) + EPS) * gm;
            y *= sigmoidf_(bf2f(MO[t * 1024 + h * 256 + v]));
            YB[t * 1024 + h * 256 + v] = (bf16)f2bf(y);
        }
    }
    __syncthreads();
}


typedef float f32x16 __attribute__((ext_vector_type(16)));
typedef __bf16 bf16x2_t __attribute__((ext_vector_type(2)));
__device__ __forceinline__ unsigned cvtpk(float lo, float hi) { const f32x2 v = {lo, hi}; const bf16x2_t b = __builtin_convertvector(v, bf16x2_t); return __builtin_bit_cast(unsigned, b); }
__device__ __forceinline__ int crow32(int reg, int h2) { return (reg & 3) + 8 * (reg >> 2) + 4 * h2; }
constexpr int ML_QS = 272, ML_VS = 528, ML_SS = 144;
constexpr int ML_Q = 0, ML_K = 17408, ML_WKT = 34816, ML_WS = 144, ML_V = 53248, ML_SC = 87040, ML_RAW = 96768, ML_TAB = 131584, ML_H = 0;
#define MFMA32(a, b, c) __builtin_amdgcn_mfma_f32_32x32x16_bf16((a), (b), (c), 0, 0, 0)
__device__ __forceinline__ bf16x8_t tr2(LAS unsigned char* p, int rowstride) {
    const v4i16_t lo = __builtin_amdgcn_ds_read_tr16_b64_v4i16((LAS v4i16_t*)p);
    const v4i16_t hi = __builtin_amdgcn_ds_read_tr16_b64_v4i16((LAS v4i16_t*)(p + 4 * rowstride));
    return __builtin_shufflevector(lo, hi, 0, 1, 2, 3, 4, 5, 6, 7);
}
__device__ __forceinline__ void ml_gate_tables(LAS float* gt, float ig, float fg, float& mcar, int lane) {
    float bb = logsigmoidf_(fg);
#pragma unroll
    for (int o = 1; o < 64; o <<= 1) { const float v = __shfl_up(bb, o); if (lane >= o) bb += v; }
    const float a = ig - bb; float mx = a;
#pragma unroll
    for (int o = 1; o < 64; o <<= 1) { const float v = __shfl_up(mx, o); if (lane >= o) mx = fmaxf(mx, v); }
    const float Ml = fmaxf(mcar, mx);
    const float M63 = __shfl(Ml, 63), b63 = __shfl(bb, 63);
    gt[lane] = a; gt[64 + lane] = Ml; gt[128 + lane] = expf(-(bb + Ml)); gt[192 + lane] = expf(mcar - Ml); gt[256 + lane] = expf(a - M63);
    if (lane == 0) gt[320] = expf(mcar - M63);
    mcar = b63 + M63;
}
static_assert(ML_RAW + 67 * 512 <= MISC_OFF && MISC_OFF + 128 <= ML_TAB && ML_TAB + 11264 <= LDS_BYTES, "mLSTM LDS map");
template <bool FIRST>
__device__ __forceinline__ void ml_dma_raw(LAS unsigned char* L, const bf16* MQK, int b, int h, int c, int w, int lane) {
    const int rr = lane >> 5, seg = (lane >> 4) & 1, c16 = lane & 15;
    unsigned vo = (unsigned)(rr * 1024 + (seg ? 512 + h * 128 : h * 128) + c16 * 8) * 2u; asm volatile("" : "+v"(vo));
    const char* base = (const char*)(MQK + ((size_t)b * SEQ + 64 * c) * 1024) - 3 * 2048;
#pragma unroll
    for (int i = 0; i < 5; ++i) { int p = w * 5 + i; p = p > 33 ? 33 : p;
        const char* g = base + (size_t)p * 4096;
        if ((p < 33 || rr == 0) && (!FIRST || p >= 2 || (p == 1 && rr == 1))) __builtin_amdgcn_global_load_lds((const unsigned*)(g + vo), (LAS unsigned*)(L + ML_RAW + p * 1024), 16, 0, 0); }
}
__device__ __forceinline__ void ml_dma_v(LAS unsigned char* L, const bf16* MV, size_t t0, int h, int w, int lane) {
    unsigned vo = (unsigned)lane * 16u; asm volatile("" : "+v"(vo));
    const char* base = (const char*)(MV + (t0 + w * 8) * 1024 + h * 256);
#pragma unroll
    for (int i = 0; i < 8; ++i) { const int row = w * 8 + i;
        if (lane < 32) __builtin_amdgcn_global_load_lds((const unsigned*)(base + (size_t)i * 2048 + vo), (LAS unsigned*)(L + ML_V + row * ML_VS), 16, 0, 0); }
}
#define ML_SYNC() do { asm volatile("s_waitcnt lgkmcnt(0)" ::: "memory"); __builtin_amdgcn_s_barrier(); asm volatile("" ::: "memory"); } while (0)
__device__ __forceinline__ void mlstm_unit_fast(Frame& F, int bh) {
    const int b = bh >> 2, h = bh & 3, tid = F.tid, lane = F.lane, w = F.wave;
    LAS unsigned char* L = F.lds;
    LAS float* tab = (LAS float*)(L + ML_TAB);
    LAS float *td2 = tab + 1024, *trd = tab + 1088, *tn = tab + 1152, *tcw = tab + 1280, *tgm = tab + 2560;
    const bf16* MQK = (const bf16*)(F.ws + WS_MQK); const bf16* MV = (const bf16*)(F.ws + WS_MV); const bf16* MO = (const bf16*)(F.ws + WS_MO);
    const float* GATES = (const float*)(F.ws + WS_GATES); bf16* YB = (bf16*)(F.outb + OUT_YB);
    const int r32 = lane & 31, h2 = lane >> 5, gq = lane >> 4, i16 = lane & 15, q4 = i16 >> 2, p4 = i16 & 3;
    f32x16 Ct[4];
#pragma unroll
    for (int dt = 0; dt < 4; ++dt)
#pragma unroll
        for (int r = 0; r < 16; ++r) Ct[dt][r] = 0.f;
    float mcar = 0.f;
    __syncthreads();
    if (tid < 128) tn[tid] = 0.f;
    const int cg = tid & 31, tq = tid >> 5; const bool isq = cg < 16;
    if (tid < 256) { int chn = (tid < 128) ? (h * 128 + tid) : (512 + h * 128 + (tid - 128)); asm volatile("" : "+v"(chn)); const float* cw = F.in[I_CONVW];
        tcw[tid] = cw[chn]; tcw[256 + tid] = cw[1024 + chn]; tcw[512 + tid] = cw[2048 + chn]; tcw[768 + tid] = cw[3072 + chn]; tcw[1024 + tid] = F.in[I_CONVB][chn];
        int gi = h * 256 + tid; asm volatile("" : "+v"(gi)); tgm[tid] = F.in[I_GMLSTM][gi]; }
    if (tid < 96) *(LAS u32x4*)(L + ML_RAW + tid * 16) = (u32x4){0u, 0u, 0u, 0u};
    ml_dma_raw<true>(L, MQK, b, h, 0, w, lane);
    ml_dma_v(L, MV, (size_t)b * SEQ, h, w, lane);
    float ign = 0.f, fgn = 0.f;
    if (w == 3) { ign = GATES[((size_t)b * SEQ + lane) * 8 + h]; fgn = GATES[((size_t)b * SEQ + lane) * 8 + 4 + h]; ml_gate_tables(tab, ign, fgn, mcar, lane); }
    asm volatile("s_waitcnt vmcnt(0)" ::: "memory");
#pragma unroll 1
    for (int c = 0; c < SEQ / 64; ++c) {
        const size_t t0 = (size_t)b * SEQ + 64 * c;
        const bool more = c + 1 < SEQ / 64;
        LAS float* gt = tab + (c & 1) * 512;
        LAS float *ta = gt, *tM = gt + 64, *temt = gt + 128, *tin = gt + 192, *te = gt + 256, *tsc = gt + 320;
        asm volatile("s_waitcnt vmcnt(12)" ::: "memory");
        ML_SYNC();
        if (w == 3 && more) { ign = GATES[(t0 + 64 + lane) * 8 + h]; fgn = GATES[(t0 + 64 + lane) * 8 + 4 + h]; }
        {
#pragma unroll
          for (int e4 = 0; e4 < 2; ++e4) {
              const f32x4 w0 = *(const LAS f32x4*)(tcw + 8 * cg + 4 * e4), w1 = *(const LAS f32x4*)(tcw + 256 + 8 * cg + 4 * e4), w2 = *(const LAS f32x4*)(tcw + 512 + 8 * cg + 4 * e4),
                          w3 = *(const LAS f32x4*)(tcw + 768 + 8 * cg + 4 * e4), cb = *(const LAS f32x4*)(tcw + 1024 + 8 * cg + 4 * e4);
              f32x4 xr[7];
#pragma unroll
              for (int j = 0; j < 7; ++j) { const u32x2 rw = *(const LAS u32x2*)(L + ML_RAW + (4 * tq + j) * 512 + cg * 16 + e4 * 8); const unsigned lo = rw.x, hi = rw.y;
                  xr[j] = (f32x4){__uint_as_float(lo << 16), __uint_as_float(lo & 0xffff0000u), __uint_as_float(hi << 16), __uint_as_float(hi & 0xffff0000u)}; }
              f32x4 kv[4];
#pragma unroll
              for (int i = 0; i < 4; ++i) { const int sl = 4 * tq + i;
                  f32x4 v = cb + w0 * xr[i] + w1 * xr[i + 1] + w2 * xr[i + 2] + w3 * xr[i + 3];
#pragma unroll
                  for (int e = 0; e < 4; ++e) v[e] = v[e] * fsig(v[e]);
                  if (isq) { u32x2 o; o.x = pk2(v[0], v[1]); o.y = pk2(v[2], v[3]); *(LAS u32x2*)(L + ML_Q + sl * ML_QS + cg * 16 + e4 * 8) = o; }
                  else { const float es = te[sl]; v = v * 0.08838834764831845f;
                      u32x2 o; o.x = pk2(v[0], v[1]); o.y = pk2(v[2], v[3]); *(LAS u32x2*)(L + ML_K + sl * ML_QS + (cg - 16) * 16 + e4 * 8) = o;
                      kv[i] = v * es; } }
              if (!isq) {
#pragma unroll
                  for (int e = 0; e < 4; ++e) { u32x2 o2; o2.x = pk2(kv[0][e], kv[1][e]); o2.y = pk2(kv[2][e], kv[3][e]);
                      *(LAS u32x2*)(L + ML_WKT + (8 * (cg - 16) + 4 * e4 + e) * ML_WS + 8 * tq) = o2; } } } }
        ML_SYNC();
        if (w == 3 && more) ml_gate_tables(tab + ((c + 1) & 1) * 512, ign, fgn, mcar, lane);
        if (more) ml_dma_raw<false>(L, MQK, b, h, c + 1, w, lane);
        if (w < 3) {
            const int lt = w ? 1 : 0, st = (w == 2) ? 1 : 0;
            f32x16 S;
#pragma unroll
            for (int r = 0; r < 16; ++r) S[r] = 0.f;
#pragma unroll
            for (int ks = 0; ks < 8; ++ks) { const bf16x8_t A = *(const LAS bf16x8_t*)(L + ML_Q + (32 * lt + r32) * ML_QS + (16 * ks + 8 * h2) * 2);
                const bf16x8_t B = *(const LAS bf16x8_t*)(L + ML_K + (32 * st + r32) * ML_QS + (16 * ks + 8 * h2) * 2); S = MFMA32(A, B, S);
                if (ks & 1) asm volatile("" ::: "memory"); }
            const int s = 32 * st + r32; const float as = ta[s];
            const LAS float* tMh = tM + 32 * lt + 4 * h2; LAS unsigned char* scp = L + ML_SC + (32 * lt + 4 * h2) * ML_SS + s * 2; const int lb = 32 * lt + 4 * h2;
#pragma unroll
            for (int r = 0; r < 16; ++r) { const int ro = (r & 3) + 8 * (r >> 2);
                float x = as - tMh[ro]; x = (s <= lb + ro) ? x : -INFINITY;
                *(LAS bf16*)(scp + ro * ML_SS) = (bf16)f2bf(S[r] * __expf(x)); }
        } else if (w >= 4) {
            const int idx = tid - 256, l = idx >> 2, part = idx & 3; float acc = 0.f;
#pragma unroll
            for (int i = 0; i < 4; ++i) { float q8[8]; unpack8(*(const LAS u32x4*)(L + ML_Q + l * ML_QS + (32 * part + 8 * i) * 2), q8);
#pragma unroll
                for (int e = 0; e < 8; ++e) acc += tn[32 * part + 8 * i + e] * q8[e]; }
            acc += __shfl_xor(acc, 1); acc += __shfl_xor(acc, 2);
            if (part == 0) td2[l] = acc;
        }
        if (more) asm volatile("s_waitcnt vmcnt(5)" ::: "memory"); else asm volatile("s_waitcnt vmcnt(0)" ::: "memory");
        ML_SYNC();
        if (tid < 64) { const int l = tid; float d1 = 0.f; const int nb = (l < 32) ? 4 : 8;
            for (int i = 0; i < nb; ++i) { float v8[8]; unpack8(*(const LAS u32x4*)(L + ML_SC + l * ML_SS + i * 16), v8);
#pragma unroll
                for (int e = 0; e < 8; ++e) d1 += v8[e]; }
            const float den = d1 + tin[l] * td2[l]; trd[l] = 1.0f / fmaxf(fabsf(den), temt[l]); }
        bf16x8_t Vf[4];
        { v4i16_t t0_, t1_, t2_, t3_, t4_, t5_, t6_, t7_;
          LAS unsigned char* pv = L + ML_V + (8 * h2 + q4) * ML_VS + (32 * w + 16 * (gq & 1) + 4 * p4) * 2;
          static_assert(ML_VS == 528, "offsets below");
          asm volatile("ds_read_b64_tr_b16 %0, %8\n\tds_read_b64_tr_b16 %1, %8 offset:2112\n\tds_read_b64_tr_b16 %2, %8 offset:8448\n\tds_read_b64_tr_b16 %3, %8 offset:10560\n\t"
                       "ds_read_b64_tr_b16 %4, %8 offset:16896\n\tds_read_b64_tr_b16 %5, %8 offset:19008\n\tds_read_b64_tr_b16 %6, %8 offset:25344\n\tds_read_b64_tr_b16 %7, %8 offset:27456\n\t"
                       "s_waitcnt lgkmcnt(0)"
                       : "=&v"(t0_), "=&v"(t1_), "=&v"(t2_), "=&v"(t3_), "=&v"(t4_), "=&v"(t5_), "=&v"(t6_), "=&v"(t7_) : "v"(pv) : "memory");
          Vf[0] = __builtin_shufflevector(t0_, t1_, 0, 1, 2, 3, 4, 5, 6, 7); Vf[1] = __builtin_shufflevector(t2_, t3_, 0, 1, 2, 3, 4, 5, 6, 7);
          Vf[2] = __builtin_shufflevector(t4_, t5_, 0, 1, 2, 3, 4, 5, 6, 7); Vf[3] = __builtin_shufflevector(t6_, t7_, 0, 1, 2, 3, 4, 5, 6, 7); }
        f32x16 N1[2], N2[2];
#pragma unroll
        for (int lt = 0; lt < 2; ++lt)
#pragma unroll
            for (int r = 0; r < 16; ++r) { N1[lt][r] = 0.f; N2[lt][r] = 0.f; }
#pragma unroll
        for (int ks = 0; ks < 2; ++ks) N1[0] = MFMA32(*(const LAS bf16x8_t*)(L + ML_SC + r32 * ML_SS + (16 * ks + 8 * h2) * 2), Vf[ks], N1[0]);
#pragma unroll
        for (int ks = 0; ks < 4; ++ks) N1[1] = MFMA32(*(const LAS bf16x8_t*)(L + ML_SC + (32 + r32) * ML_SS + (16 * ks + 8 * h2) * 2), Vf[ks], N1[1]);
        asm volatile("" ::: "memory");
#pragma unroll
        for (int dt = 0; dt < 4; ++dt)
#pragma unroll
            for (int s2 = 0; s2 < 2; ++s2) {
                u32x4 pk;
#pragma unroll
                for (int e = 0; e < 4; ++e) pk[e] = cvtpk(Ct[dt][8 * s2 + 2 * e], Ct[dt][8 * s2 + 2 * e + 1]);
                const bf16x8_t Bc = __builtin_bit_cast(bf16x8_t, pk);
#pragma unroll
                for (int lt = 0; lt < 2; ++lt) {
                    const u32x2 lo = *(const LAS u32x2*)(L + ML_Q + (32 * lt + r32) * ML_QS + (32 * dt + 16 * s2 + 4 * h2) * 2);
                    const u32x2 hi = *(const LAS u32x2*)(L + ML_Q + (32 * lt + r32) * ML_QS + (32 * dt + 16 * s2 + 8 + 4 * h2) * 2);
                    const u32x4 a4 = (u32x4){lo.x, lo.y, hi.x, hi.y};
                    N2[lt] = MFMA32(__builtin_bit_cast(bf16x8_t, a4), Bc, N2[lt]); }
                asm volatile("" ::: "memory"); }
        { const float decay = tsc[0];
#pragma unroll
          for (int dt = 0; dt < 4; ++dt) {
#pragma unroll
              for (int r = 0; r < 16; ++r) Ct[dt][r] *= decay;
#pragma unroll
              for (int ks = 0; ks < 4; ++ks) Ct[dt] = MFMA32(*(const LAS bf16x8_t*)(L + ML_WKT + (32 * dt + r32) * ML_WS + (16 * ks + 8 * h2) * 2), Vf[ks], Ct[dt]);
              asm volatile("" ::: "memory"); }
          if (tid < 128) { float acc = decay * tn[tid];
#pragma unroll 8
              for (int s = 0; s < 64; ++s) acc += te[s] * bf2f(*(const LAS bf16*)(L + ML_K + s * ML_QS + tid * 2));
              tn[tid] = acc; } }
        ML_SYNC();
        if (more) ml_dma_v(L, MV, t0 + 64, h, w, lane);
#pragma unroll
        for (int lt = 0; lt < 2; ++lt)
#pragma unroll
            for (int r = 0; r < 16; ++r) { const int ro = 32 * lt + (r & 3) + 8 * (r >> 2); const LAS float* tinh = tin + 4 * h2; const LAS float* trdh = trd + 4 * h2;
                const float hv = (N1[lt][r] + tinh[ro] * N2[lt][r]) * trdh[ro];
                *(LAS bf16*)(L + ML_H + (4 * h2) * ML_VS + (32 * w + r32) * 2 + ro * ML_VS) = (bf16)f2bf(hv); }
#if GATES_U8
        u32x4 moreg[2];
        { const unsigned char* mo = (const unsigned char*)MO + (t0 + (tid >> 3)) * 1024 + h * 256 + (tid & 7) * 32; moreg[0] = *(const u32x4*)mo; moreg[1] = *(const u32x4*)(mo + 16); }
#else
        u32x4 moreg[4];
        { const bf16* mo = MO + (t0 + (tid >> 3)) * 1024 + h * 256 + (tid & 7) * 32;
#pragma unroll
          for (int i = 0; i < 4; ++i) moreg[i] = *(const u32x4*)(mo + 8 * i); }
#endif
        ML_SYNC();
        { const int l = tid >> 3, part = tid & 7; float hv[32]; float ss = 0.f;
#pragma unroll
          for (int i = 0; i < 4; ++i) { float t8[8]; unpack8(*(const LAS u32x4*)(L + ML_H + l * ML_VS + part * 64 + i * 16), t8);
#pragma unroll
              for (int e = 0; e < 8; ++e) { hv[8 * i + e] = t8[e]; ss += t8[e] * t8[e]; } }
          ss += __shfl_xor(ss, 1); ss += __shfl_xor(ss, 2); ss += __shfl_xor(ss, 4);
          const float rstd = rsqrtf(ss * (1.0f / 256.0f) + EPS);
          const LAS float* gm = tgm + part * 32; bf16* yb = YB + (t0 + l) * 1024 + h * 256 + part * 32;
#pragma unroll
          for (int i = 0; i < 4; ++i) { const f32x4 g0 = *(const LAS f32x4*)(gm + 8 * i), g1 = *(const LAS f32x4*)(gm + 8 * i + 4);
#if GATES_U8
              const f32x4 sa = unpk4_sig_u8(moreg[i >> 1][2 * (i & 1)]), sb = unpk4_sig_u8(moreg[i >> 1][2 * (i & 1) + 1]);
              float o[8];
#pragma unroll
              for (int e = 0; e < 8; ++e) o[e] = hv[8 * i + e] * rstd * (e < 4 ? g0[e] * sa[e] : g1[e - 4] * sb[e - 4]);
#else
              float m8[8]; unpack8(moreg[i], m8);
              float o[8];
#pragma unroll
              for (int e = 0; e < 8; ++e) o[e] = hv[8 * i + e] * rstd * (e < 4 ? g0[e] : g1[e - 4]) * fsig(m8[e]);
#endif
              u32x4 wv; wv.x = pk2(o[0], o[1]); wv.y = pk2(o[2], o[3]); wv.z = pk2(o[4], o[5]); wv.w = pk2(o[6], o[7]);
              *(u32x4*)(yb + 8 * i) = wv; } }
    }
    __syncthreads();
}

__device__ __forceinline__ void ph_branch_naive(Frame& F) {
    LAS float* As = (LAS float*)F.lds; LAS float* Bs = As + 16 * 132;
    const bf16* YA = (const bf16*)(F.outb + OUT_YA); const bf16* YB = (const bf16*)(F.outb + OUT_YB); const bf16* GAB = (const bf16*)(F.ws + WS_GAB);
    bf16* MG = (bf16*)(F.ws + WS_MERGED);
    const int ty = F.tid >> 5, tx = F.tid & 31;
    for (int vb = blockIdx.x; vb < (T / 128) * 8; vb += F.G) {
        const int tm = vb >> 3, tn = vb & 7, m0 = tm * 128, n0 = tn * 128;
        float a1[8][4], a2[8][4]; ZERO_ACC(a1); ZERO_ACC(a2);
        ARowGlobal ra{YA, (size_t)256, m0, nullptr}; ngemm_acc(As, Bs, ra, F.in[I_WBA], D, 256, n0, D, a1);
        ARowGlobal rb{YB, (size_t)D, m0, nullptr};  ngemm_acc(As, Bs, rb, F.in[I_WBB], D, D, n0, D, a2);
#pragma unroll
        for (int i = 0; i < 8; ++i) { const size_t row = (size_t)(m0 + ty * 8 + i); const int col = n0 + tx * 4;
            const u32x2 ga = *(const u32x2*)(GAB + row * 2048 + col), gb = *(const u32x2*)(GAB + row * 2048 + 1024 + col);
            const float sga[4] = {sigmoidf_(__uint_as_float(ga.x << 16)), sigmoidf_(__uint_as_float(ga.x & 0xffff0000u)), sigmoidf_(__uint_as_float(ga.y << 16)), sigmoidf_(__uint_as_float(ga.y & 0xffff0000u))};
            const float sgb[4] = {sigmoidf_(__uint_as_float(gb.x << 16)), sigmoidf_(__uint_as_float(gb.x & 0xffff0000u)), sigmoidf_(__uint_as_float(gb.y << 16)), sigmoidf_(__uint_as_float(gb.y & 0xffff0000u))};
            float o[4];
#pragma unroll
            for (int j = 0; j < 4; ++j) o[j] = sga[j] * a1[i][j] + sgb[j] * a2[i][j];
            u32x2 w; w.x = pk2(o[0], o[1]); w.y = pk2(o[2], o[3]); *(u32x2*)(MG + row * D + col) = w; }
    }
}

__device__ __forceinline__ void ph_outproj_naive(Frame& F) {
    LAS float* As = (LAS float*)F.lds; LAS float* Bs = As + 16 * 132;
    const bf16* MG = (const bf16*)(F.ws + WS_MERGED); bf16* YM = (bf16*)(F.ws + WS_YMIX);
    const int ty = F.tid >> 5, tx = F.tid & 31;
    for (int vb = blockIdx.x; vb < (T / 128) * 8; vb += F.G) {
        const int tm = vb >> 3, tn = vb & 7, m0 = tm * 128, n0 = tn * 128;
        float a1[8][4]; ZERO_ACC(a1);
        ARowGlobal ra{MG, (size_t)D, m0, nullptr}; ngemm_acc(As, Bs, ra, F.in[I_WOUT], D, D, n0, D, a1);
#pragma unroll
        for (int i = 0; i < 8; ++i) { const size_t row = (size_t)(m0 + ty * 8 + i); const int col = n0 + tx * 4;
            u32x2 w; w.x = pk2(a1[i][0], a1[i][1]); w.y = pk2(a1[i][2], a1[i][3]); *(u32x2*)(YM + row * D + col) = w; }
    }
}

struct X1In { u32x2 ym[4]; f32x4 xv[4]; };
__device__ __forceinline__ void x1_load(Frame& F, int t, X1In& r) {
    const float* x = F.in[I_X]; const bf16* YM = (const bf16*)(F.ws + WS_YMIX);
#pragma unroll
    for (int j = 0; j < 4; ++j) { r.ym[j] = *(const u32x2*)(YM + (size_t)t * D + F.lane * 4 + 256 * j); r.xv[j] = *(const f32x4*)(x + (size_t)t * D + F.lane * 4 + 256 * j); }
}
__device__ __forceinline__ void x1_compute(Frame& F, int t, const X1In& r, f32x4 (&x1)[4]) {
    const float* mod = (const float*)(F.ws + WS_MOD);
    const int b = t / SEQ; const float* gt1 = mod + b * 6144 + 2048; const float* g = F.in[I_GPOSTMIX];
    f32x4 y[4]; float ss = 0.f;
#pragma unroll
    for (int j = 0; j < 4; ++j) { const u32x2 w = r.ym[j];
        y[j][0] = __uint_as_float(w.x << 16); y[j][1] = __uint_as_float(w.x & 0xffff0000u); y[j][2] = __uint_as_float(w.y << 16); y[j][3] = __uint_as_float(w.y & 0xffff0000u);
        ss += y[j][0] * y[j][0] + y[j][1] * y[j][1] + y[j][2] * y[j][2] + y[j][3] * y[j][3]; }
    const float rstd = rsqrtf(wave_sum(ss) * (1.0f / D) + EPS);
#pragma unroll
    for (int j = 0; j < 4; ++j) { const int c = F.lane * 4 + 256 * j; const f32x4 gg = *(const f32x4*)(g + c), gt = *(const f32x4*)(gt1 + c);
#pragma unroll
        for (int e = 0; e < 4; ++e) x1[j][e] = r.xv[j][e] + gt[e] * (y[j][e] * rstd * gg[e]); }
}
__device__ __forceinline__ void x1_row(Frame& F, int t, f32x4 (&x1)[4]) { X1In r; x1_load(F, t, r); x1_compute(F, t, r, x1); }

__device__ __forceinline__ void ph_normmid(Frame& F) {
    const float* mod = (const float*)(F.ws + WS_MOD); const float* g = F.in[I_GPREFFN]; bf16* H2 = (bf16*)(F.ws + WS_H2);
    const int tstep = F.G * NWAVES; int t = blockIdx.x * NWAVES + F.wave;
    X1In rn; if (t < T) x1_load(F, t, rn);
    for (; t < T; t += tstep) {
        const int b = t / SEQ; const float* sh2 = mod + b * 6144 + 3072, *sc2 = mod + b * 6144 + 4096;
        const X1In rc = rn; if (t + tstep < T) x1_load(F, t + tstep, rn);
        f32x4 x1[4]; x1_compute(F, t, rc, x1);
        float ss = 0.f;
#pragma unroll
        for (int j = 0; j < 4; ++j) ss += x1[j][0] * x1[j][0] + x1[j][1] * x1[j][1] + x1[j][2] * x1[j][2] + x1[j][3] * x1[j][3];
        const float rstd = rsqrtf(wave_sum(ss) * (1.0f / D) + EPS);
#pragma unroll
        for (int j = 0; j < 4; ++j) { const int c = F.lane * 4 + 256 * j; const f32x4 gg = *(const f32x4*)(g + c), s2 = *(const f32x4*)(sc2 + c), h2 = *(const f32x4*)(sh2 + c);
            float o[4];
#pragma unroll
            for (int e = 0; e < 4; ++e) o[e] = x1[j][e] * rstd * gg[e] * (1.0f + s2[e]) + h2[e];
            u32x2 w; w.x = pk2(o[0], o[1]); w.y = pk2(o[2], o[3]); *(u32x2*)(H2 + (size_t)t * D + c) = w;
#if MOE_FP8
            *(unsigned*)(F.ws + WS_H2F8 + (size_t)t * D + c) = pk4_fp8(o[0], o[1], o[2], o[3]);
#endif
#if !FAST_MOE2
            *(f32x4*)(F.out + (size_t)t * D + c) = (f32x4){0.f, 0.f, 0.f, 0.f};
#endif
        }
    }
}

__device__ __forceinline__ void ph_normmid_blocks(Frame& F, int vcu) {
    for (int bi = 0; bi * F.G + vcu < T / 256; ++bi) { const int tblk = bi * F.G + vcu;
    const float* mod = (const float*)(F.ws + WS_MOD); const float* g = F.in[I_GPREFFN]; bf16* H2 = (bf16*)(F.ws + WS_H2);
    const int tstep = 1; int t = tblk * 256 + F.wave * 32; const int tend = t + 32;
    X1In rn; x1_load(F, t, rn);
    for (; t < tend; t += tstep) {
        const int b = t / SEQ; const float* sh2 = mod + b * 6144 + 3072, *sc2 = mod + b * 6144 + 4096;
        const X1In rc = rn; if (t + tstep < tend) x1_load(F, t + tstep, rn);
        f32x4 x1[4]; x1_compute(F, t, rc, x1);
        float ss = 0.f;
#pragma unroll
        for (int j = 0; j < 4; ++j) ss += x1[j][0] * x1[j][0] + x1[j][1] * x1[j][1] + x1[j][2] * x1[j][2] + x1[j][3] * x1[j][3];
        const float rstd = rsqrtf(wave_sum(ss) * (1.0f / D) + EPS);
#pragma unroll
        for (int j = 0; j < 4; ++j) { const int c = F.lane * 4 + 256 * j; const f32x4 gg = *(const f32x4*)(g + c), s2 = *(const f32x4*)(sc2 + c), h2 = *(const f32x4*)(sh2 + c);
            float o[4];
#pragma unroll
            for (int e = 0; e < 4; ++e) o[e] = x1[j][e] * rstd * gg[e] * (1.0f + s2[e]) + h2[e];
            u32x2 w; w.x = pk2(o[0], o[1]); w.y = pk2(o[2], o[3]); *(u32x2*)(H2 + (size_t)t * D + c) = w;
            { u32x2 wx; wx.x = pk2(x1[j][0], x1[j][1]); wx.y = pk2(x1[j][2], x1[j][3]); *(u32x2*)((bf16*)(F.ws + WS_YMIX) + (size_t)t * D + c) = wx; }
#if MOE_FP8
            *(unsigned*)(F.ws + WS_H2F8 + (size_t)t * D + c) = pk4_fp8(o[0], o[1], o[2], o[3]);
#endif
#if !FAST_MOE2
            *(f32x4*)(F.out + (size_t)t * D + c) = (f32x4){0.f, 0.f, 0.f, 0.f};
#endif
        }
    }
}
}

constexpr int HALF_T = T / 2;
__device__ __forceinline__ unsigned char* slot_ptr(unsigned char* ws, unsigned char* outb, int half, int k, int t) {
    const size_t tl = (size_t)(t - half * HALF_T);
    if (k < 2) return outb + (size_t)t * 4096 + k * 2048;
#if MOE_FP8
    int ri;
    if (half == 0) { if (k < 4) return outb + (size_t)(t + HALF_T) * 4096 + (k - 2) * 2048; ri = k - 4; } else ri = k - 2;
    const size_t base = (ri == 0) ? 192 : (ri == 1) ? 256 : (ri == 2) ? 448 : (ri == 3) ? 512 : (ri == 4) ? 576 : (ri == 5) ? 640 : 704;
    return ws + base * MiB + tl * 2048;
#else
    if (half == 0) {
        if (k < 4) return outb + (size_t)(t + HALF_T) * 4096 + (k - 2) * 2048;
        if (k < 6) return ws + (192 + 64 * (size_t)(k - 4)) * MiB + tl * 2048;
        return ws + (512 + 64 * (size_t)(k - 6)) * MiB + tl * 2048;
    }
    if (k < 4) return ws + (192 + 64 * (size_t)(k - 2)) * MiB + tl * 2048;
    if (k < 8) return ws + (512 + 64 * (size_t)(k - 4)) * MiB + tl * 2048;
    return ws + 768 * MiB + tl * 2048;
#endif
}
__device__ __forceinline__ void ph_topk2(Frame& F) {
    const float* LG = (const float*)(F.ws + WS_LOGITS); const float* rb = F.in[I_RB];
    int* TOPI = (int*)(F.ws + WS_TOPI); float* TOPW = (float*)(F.ws + WS_TOPW); int* HIST = (int*)(F.ws + WS_HIST);
    LAS float* selw = (LAS float*)F.lds + F.wave * 512; LAS float* gsw = selw + 256;
    LAS unsigned* hist = (LAS unsigned*)(F.lds + 8 * 512 * 4);
    const int lane = F.lane, hf = lane >> 5;
    for (int tb = blockIdx.x; tb < T / 256; tb += F.G) {
        __syncthreads();
        if (F.tid < 256) hist[F.tid] = 0u;
        __syncthreads();
        for (int it = 0; it < 32; ++it) {
            const int t = tb * 256 + F.wave * 32 + it;
            float sc[4], sel[4];
#pragma unroll
            for (int i = 0; i < 4; ++i) { sc[i] = sigmoidf_(LG[(size_t)t * NE + lane + 64 * i]); sel[i] = sc[i] + rb[lane + 64 * i]; selw[lane + 64 * i] = sel[i]; }
            asm volatile("s_waitcnt lgkmcnt(0)" ::: "memory");
            if (lane < 8) { float m1 = -INFINITY, m2 = -INFINITY;
#pragma unroll
                for (int q = 0; q < 8; ++q) { const f32x4 v = *(const LAS f32x4*)(selw + lane * 32 + q * 4);
#pragma unroll
                    for (int e = 0; e < 4; ++e) { const float x = v[e]; const float lo = fminf(m1, x); m1 = fmaxf(m1, x); m2 = fmaxf(m2, lo); } }
                gsw[lane] = m1 + m2; }
            asm volatile("s_waitcnt lgkmcnt(0)" ::: "memory");
            float gs[8];
            { const f32x4 a = *(const LAS f32x4*)gsw, b2 = *(const LAS f32x4*)(gsw + 4); gs[0] = a[0]; gs[1] = a[1]; gs[2] = a[2]; gs[3] = a[3]; gs[4] = b2[0]; gs[5] = b2[1]; gs[6] = b2[2]; gs[7] = b2[3]; }
            bool gsel[8];
#pragma unroll
            for (int a = 0; a < 8; ++a) { int rank = 0;
#pragma unroll
                for (int c = 0; c < 8; ++c) rank += (gs[c] > gs[a] || (gs[c] == gs[a] && c < a)) ? 1 : 0;
                gsel[a] = rank < 4; }
            asm volatile("" ::: "memory");
#pragma unroll
            for (int i = 0; i < 4; ++i) { const bool ok = hf ? gsel[2 * i + 1] : gsel[2 * i]; if (!ok) sel[i] = -INFINITY; selw[lane + 64 * i] = sel[i]; }
            asm volatile("s_waitcnt lgkmcnt(0)" ::: "memory");
            int rk[4] = {0, 0, 0, 0};
#pragma unroll 4
            for (int q = 0; q < 64; ++q) { const f32x4 v = *(const LAS f32x4*)(selw + q * 4);
#pragma unroll
                for (int e = 0; e < 4; ++e) { const float x = v[e]; const int xe = q * 4 + e;
#pragma unroll
                    for (int i = 0; i < 4; ++i) rk[i] += (x > sel[i] || (x == sel[i] && xe < lane + 64 * i)) ? 1 : 0; } }
            asm volatile("" ::: "memory");
            float part = 0.f;
#pragma unroll
            for (int i = 0; i < 4; ++i) { if (sel[i] == -INFINITY) rk[i] = 999; if (rk[i] < TOPK) part += sc[i]; }
            const float wsum = wave_sum(part);
#pragma unroll
            for (int i = 0; i < 4; ++i) if (rk[i] < TOPK) { TOPI[(size_t)t * TOPK + rk[i]] = lane + 64 * i; TOPW[(size_t)t * TOPK + rk[i]] = sc[i] / wsum * 2.5f; __hip_atomic_fetch_add(&hist[lane + 64 * i], 1u, __ATOMIC_RELAXED, __HIP_MEMORY_SCOPE_WORKGROUP); }
        }
        __syncthreads();
        if (F.tid < 256) HIST[tb * 256 + F.tid] = (int)hist[F.tid];
    }
}

__device__ __forceinline__ unsigned mono_key(float v, int e) {
    unsigned u = __float_as_uint(v); u ^= (u & 0x80000000u) ? 0xffffffffu : 0x80000000u; return (u & 0xffffff00u) | (unsigned)(255 - e); }
struct StrideBlocks { int b0, G; __device__ __forceinline__ int block(int i) const { const int tb = b0 + i * G; return tb < T / 256 ? tb : -1; } };
struct RouterBlocks { g2::DenseOrder S; __device__ __forceinline__ int block(int i) const { g2::UnitMN u; return S.next(i, u) ? u.pm : -1; } };
template <class BlockIter>
__device__ __forceinline__ void ph_topk4(Frame& F, const BlockIter& BI) {
    const float* LG = (const float*)(F.ws + WS_LOGITS); const float* rb = F.in[I_RB];
    int* TOPI = (int*)(F.ws + WS_TOPI); float* TOPW = (float*)(F.ws + WS_TOPW); int* HIST = (int*)(F.ws + WS_HIST);
    LAS float* selw = (LAS float*)F.lds + F.wave * 1280; LAS float* gsw = selw + 512; LAS int* gfl = (LAS int*)(selw + 528); LAS int* resI = (LAS int*)(selw + 768); LAS float* resW = selw + 1024;
    LAS unsigned* hist = (LAS unsigned*)(F.lds + 8 * 1280 * 4);
    const int lane = F.lane, hf = lane >> 5;
    float rbv[4];
#pragma unroll
    for (int i = 0; i < 4; ++i) rbv[i] = rb[lane + 64 * i];
#define LWAIT() asm volatile("s_waitcnt lgkmcnt(0)" ::: "memory")
    for (int bi = 0;; ++bi) {
        const int tb = BI.block(bi); if (tb < 0) break;
        __syncthreads();
        if (F.tid < 256) hist[F.tid] = 0u;
        __syncthreads();
        const int tbase = tb * 256 + F.wave * 32;
        float lgn[2][4];
#pragma unroll
        for (int u = 0; u < 2; ++u)
#pragma unroll
            for (int i = 0; i < 4; ++i) lgn[u][i] = LG[(size_t)(tbase + 16 * u) * NE + lane + 64 * i];
#pragma unroll 1
        for (int it = 0; it < 16; ++it) {
            float sc[2][4], sel[2][4];
#pragma unroll
            for (int u = 0; u < 2; ++u)
#pragma unroll
                for (int i = 0; i < 4; ++i) { sc[u][i] = fsig(lgn[u][i]); sel[u][i] = sc[u][i] + rbv[i]; selw[u * 256 + lane + 64 * i] = sel[u][i]; }
            if (it + 1 < 16) {
#pragma unroll
                for (int u = 0; u < 2; ++u)
#pragma unroll
                    for (int i = 0; i < 4; ++i) lgn[u][i] = LG[(size_t)(tbase + 16 * u + it + 1) * NE + lane + 64 * i]; }
            LWAIT();
            if (lane < 16) { float m1 = -INFINITY, m2 = -INFINITY;
#pragma unroll
                for (int q = 0; q < 8; ++q) { const f32x4 v = *(const LAS f32x4*)(selw + lane * 32 + q * 4);
#pragma unroll
                    for (int e = 0; e < 4; ++e) { const float x = v[e]; const float lo = fminf(m1, x); m1 = fmaxf(m1, x); m2 = fmaxf(m2, lo); } }
                gsw[lane] = m1 + m2; }
            LWAIT();
            if (lane < 16) { const LAS float* gp = gsw + (lane & 8); const f32x4 a = *(const LAS f32x4*)gp, b2 = *(const LAS f32x4*)(gp + 4); const float gs[8] = {a[0], a[1], a[2], a[3], b2[0], b2[1], b2[2], b2[3]};
                const int gl = lane & 7; float me = 0.f;
#pragma unroll
                for (int c = 0; c < 8; ++c) me = (gl == c) ? gs[c] : me;
                int rank = 0;
#pragma unroll
                for (int c = 0; c < 8; ++c) rank += (gs[c] > me || (gs[c] == me && c < gl)) ? 1 : 0;
                gfl[lane] = rank < 4 ? 1 : 0; }
            LWAIT();
            unsigned key[2][4];
#pragma unroll
            for (int u = 0; u < 2; ++u) { const u32x4 a = *(const LAS u32x4*)(gfl + 8 * u), b2 = *(const LAS u32x4*)(gfl + 8 * u + 4); const int fl[8] = {(int)a[0], (int)a[1], (int)a[2], (int)a[3], (int)b2[0], (int)b2[1], (int)b2[2], (int)b2[3]};
#pragma unroll
                for (int i = 0; i < 4; ++i) { const int f = hf ? fl[2 * i + 1] : fl[2 * i]; key[u][i] = f ? mono_key(sel[u][i], lane + 64 * i) : 0u; } }
            unsigned prefix[2] = {0u, 0u};
#pragma unroll
            for (int bit = 31; bit >= 0; --bit)
#pragma unroll
                for (int u = 0; u < 2; ++u) { const unsigned cand = prefix[u] | (1u << bit); int cnt = 0;
#pragma unroll
                    for (int i = 0; i < 4; ++i) cnt += __builtin_popcountll(__builtin_amdgcn_ballot_w64(key[u][i] >= cand));
                    prefix[u] = (cnt >= TOPK) ? cand : prefix[u]; }
#pragma unroll
            for (int u = 0; u < 2; ++u) {
                int slot[4]; bool pick[4]; int base = 0; float part = 0.f;
#pragma unroll
                for (int i = 0; i < 4; ++i) { pick[i] = key[u][i] >= prefix[u]; const unsigned long long bm = __builtin_amdgcn_ballot_w64(pick[i]);
                    slot[i] = base + (int)__builtin_amdgcn_mbcnt_hi((unsigned)(bm >> 32), __builtin_amdgcn_mbcnt_lo((unsigned)bm, 0u)); base += __builtin_popcountll(bm);
                    part += pick[i] ? sc[u][i] : 0.f; }
                const float wsum = wave_sum(part);
                const float sc25 = 2.5f / wsum;
#pragma unroll
                for (int i = 0; i < 4; ++i) if (pick[i]) { const int e = lane + 64 * i, ri = (16 * u + it) * TOPK + slot[i]; resI[ri] = e; resW[ri] = sc[u][i] * sc25; __hip_atomic_fetch_add(&hist[e], 1u, __ATOMIC_RELAXED, __HIP_MEMORY_SCOPE_WORKGROUP); } }
        }
        LWAIT();
        *(u32x4*)(TOPI + (size_t)tbase * TOPK + lane * 4) = *(const LAS u32x4*)(resI + lane * 4); *(f32x4*)(TOPW + (size_t)tbase * TOPK + lane * 4) = *(const LAS f32x4*)(resW + lane * 4);
        __syncthreads();
        if (F.tid < 256) HIST[tb * 256 + F.tid] = (int)hist[F.tid];
    }
#undef LWAIT
}

struct UnitBO { int pm, pn, kind; };
struct BOOrder {
    typedef UnitBO Unit;
    int G, vcu; const char *YA, *YB, *MG, *WA, *WB, *WO;
    __device__ __forceinline__ bool next(int i, Unit& u) const { const int rt = i / 12, j = i - rt * 12; u.pm = rt * G + vcu; if (u.pm >= T / 256) return false;
        if (j < 8) { u.pn = j >> 1; u.kind = j & 1; } else { u.pn = j - 8; u.kind = 2; } return true; }
    __device__ __forceinline__ int K(const Unit& u) const { return u.kind == 0 ? 256 : 1024; }
    __device__ __forceinline__ const char* a_base(const Unit& u) const { const char* p = YA; if (u.kind == 1) p = YB; asm volatile("" : "+s"(p)); if (u.kind == 2) p = MG; return p; }
    __device__ __forceinline__ unsigned a_row_off(const Unit& u, int r) const { return (unsigned)(u.pm * 256 + r) * (u.kind == 0 ? 512u : 2048u); }
    __device__ __forceinline__ const char* b_base(const Unit& u) const { const char* p = WA + (size_t)u.pn * 256 * 512; if (u.kind == 1) p = WB + (size_t)u.pn * 256 * 2048; asm volatile("" : "+s"(p)); if (u.kind == 2) p = WO + (size_t)u.pn * 256 * 2048; return p; }
};
struct EpiBO {
    static constexpr bool PERM = true;
    const unsigned char* GAB8; bf16* MG; bf16* YM;
    __device__ __forceinline__ bool operator()(f32x4 (&acc)[2][2][4][2], const UnitBO& u, int wr, int wc, int fr, int fq) const {
        const int row0 = u.pm * 256 + wr * 64 + fr, col0 = u.pn * 256 + wc * 64 + 16 * fq;
        if (u.kind == 0) {
            u32x4 gaq[8], gbq[8];
#pragma unroll
            for (int ai = 0; ai < 2; ++ai)
#pragma unroll
                for (int m = 0; m < 4; ++m) { const unsigned char* g8 = GAB8 + (size_t)(row0 + ai * 128 + m * 16) * 2048 + col0; gaq[ai * 4 + m] = *(const u32x4*)g8; gbq[ai * 4 + m] = *(const u32x4*)(g8 + 1024); }
#pragma unroll
            for (int ai = 0; ai < 2; ++ai)
#pragma unroll
                for (int m = 0; m < 4; ++m)
#pragma unroll
                    for (int bj = 0; bj < 2; ++bj)
#pragma unroll
                        for (int n = 0; n < 2; ++n) { const f32x4 sa = unpk4_sig_u8(gaq[ai * 4 + m][2 * bj + n]), sb = unpk4_sig_u8(gbq[ai * 4 + m][2 * bj + n]);
#pragma unroll
                            for (int e = 0; e < 4; ++e) acc[ai][bj][m][n][e] *= sa[e] * __builtin_amdgcn_rcpf(sb[e]); }
            return false;
        }
        bf16* dbase = YM; if (u.kind == 1) dbase = MG; asm volatile("" : "+s"(dbase));
        u32x4 gbq[8];
        if (u.kind == 1) {
#pragma unroll
            for (int ai = 0; ai < 2; ++ai)
#pragma unroll
                for (int m = 0; m < 4; ++m) gbq[ai * 4 + m] = *(const u32x4*)(GAB8 + (size_t)(row0 + ai * 128 + m * 16) * 2048 + 1024 + col0);
        }
#pragma unroll
        for (int ai = 0; ai < 2; ++ai)
#pragma unroll
            for (int m = 0; m < 4; ++m) { const size_t row = (size_t)(row0 + ai * 128 + m * 16);
                f32x4 s0 = (f32x4){1.f, 1.f, 1.f, 1.f}, s1 = s0, s2 = s0, s3 = s0;
                if (u.kind == 1) { const u32x4 g = gbq[ai * 4 + m]; s0 = unpk4_sig_u8(g[0]); s1 = unpk4_sig_u8(g[1]); s2 = unpk4_sig_u8(g[2]); s3 = unpk4_sig_u8(g[3]); }
                const f32x4 v0 = acc[ai][0][m][0] * s0, v1 = acc[ai][0][m][1] * s1, v2 = acc[ai][1][m][0] * s2, v3 = acc[ai][1][m][1] * s3;
                u32x4 w0, w1; w0.x = g2::cvt_pk_bf16(v0[0], v0[1]); w0.y = g2::cvt_pk_bf16(v0[2], v0[3]); w0.z = g2::cvt_pk_bf16(v1[0], v1[1]); w0.w = g2::cvt_pk_bf16(v1[2], v1[3]);
                w1.x = g2::cvt_pk_bf16(v2[0], v2[1]); w1.y = g2::cvt_pk_bf16(v2[2], v2[3]); w1.z = g2::cvt_pk_bf16(v3[0], v3[1]); w1.w = g2::cvt_pk_bf16(v3[2], v3[3]);
                bf16* dst = dbase + row * 1024 + col0;
                *(u32x4*)dst = w0; *(u32x4*)(dst + 8) = w1; }
        return true;
    }
};
struct OwnBlocks { int vcu, G; __device__ __forceinline__ int block(int i) const { const int tb = i * G + vcu; return tb < T / 256 ? tb : -1; } };
struct OwnRouterOrder {
    typedef g2::UnitMN Unit;
    int G, vcu; const char *H2, *WR;
    __device__ __forceinline__ bool next(int i, Unit& u) const { u.pm = i * G + vcu; u.pn = 0; return u.pm < T / 256; }
    __device__ __forceinline__ int K(const Unit&) const { return 1024; }
    __device__ __forceinline__ const char* a_base(const Unit&) const { return H2; }
    __device__ __forceinline__ unsigned a_row_off(const Unit& u, int r) const { return (unsigned)(u.pm * 256 + r) * 2048u; }
    __device__ __forceinline__ const char* b_base(const Unit&) const { return WR; }
};
__device__ __forceinline__ void ph_normmid_blocks(Frame& F, int vcu);
__device__ __forceinline__ void ph_tokblock(Frame& F) {
    const int bx = blockIdx.x; const int vcu = (F.G % 8 == 0) ? (bx % 8) * (F.G / 8) + bx / 8 : bx;
#if FUSE_ATTN_COMBINE
    ph_attn_combine(F, vcu);
    asm volatile("s_waitcnt vmcnt(0)" ::: "memory"); __syncthreads();
#endif
    { BOOrder S{F.G, vcu, (const char*)(F.outb + OUT_YA), (const char*)(F.outb + OUT_YB), (const char*)(F.ws + WS_MERGED), (const char*)(F.ws + WS_WBA_T), (const char*)(F.ws + WS_WBB_T), (const char*)(F.ws + WS_WOUT_T)};
      EpiBO E{(const unsigned char*)(F.ws + WS_GAB), (bf16*)(F.ws + WS_MERGED), (bf16*)(F.ws + WS_YMIX)};
      g2::gemm_phase<EpiBO, BOOrder>(F.lds, S, E); }
    asm volatile("s_waitcnt vmcnt(0)" ::: "memory"); __syncthreads();
    ph_normmid_blocks(F, vcu);
    asm volatile("s_waitcnt vmcnt(0)" ::: "memory"); __syncthreads();
    { OwnRouterOrder S{F.G, vcu, (const char*)(F.ws + WS_H2), (const char*)(F.ws + WS_WR_T)};
      EpiF32Plain E{(float*)(F.ws + WS_LOGITS), 256};
      g2::gemm_phase<EpiF32Plain, OwnRouterOrder>(F.lds, S, E); }
    asm volatile("s_waitcnt vmcnt(0)" ::: "memory"); __syncthreads();
    ph_topk4(F, OwnBlocks{vcu, F.G});
}
__device__ __forceinline__ void ph_scan2(Frame& F) {
    if (blockIdx.x != 0) return;
    const int* HIST = (const int*)(F.ws + WS_HIST); int* BASEREL = (int*)(F.ws + WS_BASEREL); int* TSG = (int*)(F.ws + WS_TSG); int* TE = (int*)(F.ws + WS_TE);
    unsigned long long* THOFF = (unsigned long long*)(F.ws + WS_THOFF); unsigned long long* DEST = (unsigned long long*)(F.ws + WS_DEST);
    int* ROWTOK = (int*)(F.ws + WS_ROWTOK); float* ROWW = (float*)(F.ws + WS_ROWW);
    LAS int* pre = (LAS int*)F.lds;
    const int e = F.tid;
    int n0 = 0, n1 = 0;
    __syncthreads();
    if (e < NE) {
        for (int tb = 0; tb < 128; ++tb) { const int c = HIST[tb * 256 + e]; BASEREL[tb * 256 + e] = n0; n0 += c; }
        for (int tb = 128; tb < 256; ++tb) { const int c = HIST[tb * 256 + e]; BASEREL[tb * 256 + e] = n1; n1 += c; }
        pre[e] = (n0 + 255) >> 8; pre[256 + e] = (n1 + 255) >> 8;
    }
    __syncthreads();
    if (F.tid == 0) { int a = 0; for (int i = 0; i < NE; ++i) { const int c = pre[i]; pre[i] = a; a += c; } pre[512] = a;
        int b2 = a + 128; for (int i = 0; i < NE; ++i) { const int c = pre[256 + i]; pre[256 + i] = b2; b2 += c; } pre[513] = b2 - (a + 128);
        F.ctl[CW_NT0] = (unsigned)(a + 128); F.ctl[CW_NT] = (unsigned)(b2 + 128); }
    __syncthreads();
    const int R0 = pre[512], R1 = pre[513];
    unsigned char* dump = F.ws + WS_DUMP;
    if (e < NE) {
        const int ts0 = pre[e], ts1 = pre[256 + e], nt0 = (n0 + 255) >> 8, nt1 = (n1 + 255) >> 8;
        TSG[e] = ts0; TSG[256 + e] = ts1;
        for (int u = 0; u < nt0; ++u) { TE[ts0 + u] = e; THOFF[ts0 + u] = (unsigned long long)WS_HIDR + (unsigned long long)(ts0 + u) * (256 * 512); }
        for (int u = 0; u < nt1; ++u) { TE[ts1 + u] = e; THOFF[ts1 + u] = (unsigned long long)WS_HIDR + (unsigned long long)(ts1 + u - 128) * (256 * 512); }
        for (int r = n0; r < nt0 * 256; ++r) { const int p = ts0 * 256 + r; ROWTOK[p] = p & (T - 1); ROWW[p] = 0.f; DEST[p] = (unsigned long long)dump; }
        for (int r = n1; r < nt1 * 256; ++r) { const int p = ts1 * 256 + r; ROWTOK[p] = p & (T - 1); ROWW[p] = 0.f; DEST[p] = (unsigned long long)dump; }
    }
#pragma unroll 1
    for (int half = 0; half < 2; ++half) { const int tb0 = half ? (R0 + 128 + R1) : R0;
        if (F.tid < 128) { TE[tb0 + F.tid] = 256; THOFF[tb0 + F.tid] = (unsigned long long)WS_HIDS + (unsigned long long)(half * HALF_T + F.tid * 256) * 512; }
        for (int i = F.tid; i < HALF_T; i += NTHR) { const int tok = half * HALF_T + i; const int p = tb0 * 256 + i; ROWTOK[p] = tok; ROWW[p] = 1.0f; DEST[p] = (unsigned long long)slot_ptr(F.ws, F.outb, half, 8, tok); } }
}
__device__ __forceinline__ void ph_scatter2(Frame& F) {
    const int* TOPI = (const int*)(F.ws + WS_TOPI); const float* TOPW = (const float*)(F.ws + WS_TOPW); const int* BASEREL = (const int*)(F.ws + WS_BASEREL); const int* TSG = (const int*)(F.ws + WS_TSG);
    int* ROWTOK = (int*)(F.ws + WS_ROWTOK); float* ROWW = (float*)(F.ws + WS_ROWW); unsigned long long* DEST = (unsigned long long*)(F.ws + WS_DEST);
    LAS unsigned* cur = (LAS unsigned*)F.lds;
    for (int tb = blockIdx.x; tb < T / 256; tb += F.G) {
        const int half = tb >> 7;
        __syncthreads();
        if (F.tid < 256) cur[F.tid] = (unsigned)(TSG[half * 256 + F.tid] * 256 + BASEREL[tb * 256 + F.tid]);
        __syncthreads();
#pragma unroll
        for (int i = 0; i < 4; ++i) { const int item = F.tid + NTHR * i; const int t = tb * 256 + (item >> 3), k = item & 7;
            const int e = TOPI[(size_t)t * TOPK + k]; const unsigned p = __hip_atomic_fetch_add(&cur[e], 1u, __ATOMIC_RELAXED, __HIP_MEMORY_SCOPE_WORKGROUP);
            ROWTOK[p] = t; ROWW[p] = TOPW[(size_t)t * TOPK + k]; DEST[p] = (unsigned long long)slot_ptr(F.ws, F.outb, half, k, t); }
    }
}

#if MOE_FP8
constexpr size_t HIDR_OFF = WS_HIDR8, HIDS_OFF = WS_HIDS8; constexpr int HID_ROWB = 256;
#else
constexpr size_t HIDR_OFF = WS_HIDR, HIDS_OFF = WS_HIDS; constexpr int HID_ROWB = 512;
#endif
__device__ __forceinline__ void ph_scatter3(Frame& F) {
    const int* TOPI = (const int*)(F.ws + WS_TOPI); const float* TOPW = (const float*)(F.ws + WS_TOPW); const int* HIST = (const int*)(F.ws + WS_HIST);
    int* TE = (int*)(F.ws + WS_TE); unsigned long long* THOFF = (unsigned long long*)(F.ws + WS_THOFF);
    int* ROWTOK = (int*)(F.ws + WS_ROWTOK); float* ROWW = (float*)(F.ws + WS_ROWW); unsigned long long* DEST = (unsigned long long*)(F.ws + WS_DEST);
    LAS int* pre = (LAS int*)F.lds;
    LAS unsigned* cur = (LAS unsigned*)(F.lds + 4096);
    LAS int* cnt = (LAS int*)(F.lds + 8192);
    unsigned char* dump = F.ws + WS_DUMP;
    for (int tb = blockIdx.x; tb < T / 256; tb += F.G) {
        const int half = tb >> 7; const int e = F.tid;
        int n0 = 0, n1 = 0, mybase = 0;
        __syncthreads();
        if (e < NE) {
#pragma unroll 8
            for (int t2 = 0; t2 < 128; ++t2) { const int c = HIST[t2 * 256 + e]; if (half == 0 && t2 < tb) mybase += c; n0 += c; }
#pragma unroll 8
            for (int t2 = 128; t2 < 256; ++t2) { const int c = HIST[t2 * 256 + e]; if (half == 1 && t2 < tb) mybase += c; n1 += c; }
            pre[e] = (n0 + 255) >> 8; pre[256 + e] = (n1 + 255) >> 8; cnt[e] = n0; cnt[256 + e] = n1;
        }
        __syncthreads();
        if (F.wave == 0) {
            int v[8]; int s0 = 0, s1 = 0;
#pragma unroll
            for (int i = 0; i < 4; ++i) { v[i] = pre[4 * F.lane + i]; v[4 + i] = pre[256 + 4 * F.lane + i]; s0 += v[i]; s1 += v[4 + i]; }
            int i0 = s0, i1 = s1;
#pragma unroll
            for (int o = 1; o < 64; o <<= 1) { const int a0 = __shfl_up(i0, o), a1 = __shfl_up(i1, o); if (F.lane >= o) { i0 += a0; i1 += a1; } }
            const int R0 = __shfl(i0, 63), R1 = __shfl(i1, 63);
            int x0 = i0 - s0, x1 = R0 + 128 + (i1 - s1);
#pragma unroll
            for (int i = 0; i < 4; ++i) { pre[4 * F.lane + i] = x0; x0 += v[i]; pre[256 + 4 * F.lane + i] = x1; x1 += v[4 + i]; }
            if (F.lane == 0) { pre[512] = R0; pre[513] = R1; if (tb == 0) { F.ctl[CW_NT0] = (unsigned)(R0 + 128); F.ctl[CW_NT] = (unsigned)(R0 + R1 + 256); } }
        }
        __syncthreads();
        const int R0 = pre[512], R1 = pre[513];
        if (e < NE) cur[e] = (unsigned)(pre[half * 256 + e] * 256 + mybase);
        { const int ee = tb; const int ts0 = pre[ee], ts1 = pre[256 + ee], c0 = cnt[ee], c1 = cnt[256 + ee], nt0 = (c0 + 255) >> 8, nt1 = (c1 + 255) >> 8;
          if (F.tid < nt0) { TE[ts0 + F.tid] = ee; THOFF[ts0 + F.tid] = (unsigned long long)HIDR_OFF + (unsigned long long)(ts0 + F.tid) * (256 * HID_ROWB); }
          if (F.tid < nt1) { TE[ts1 + F.tid] = ee; THOFF[ts1 + F.tid] = (unsigned long long)HIDR_OFF + (unsigned long long)(ts1 + F.tid - 128) * (256 * HID_ROWB); }
          if (F.tid < 256) { const int r0p = c0 + F.tid; if (r0p < nt0 * 256) { const int p = ts0 * 256 + r0p; ROWTOK[p] = p & (T - 1); ROWW[p] = 0.f; DEST[p] = (unsigned long long)dump; }
                             const int r1p = c1 + F.tid; if (r1p < nt1 * 256) { const int p = ts1 * 256 + r1p; ROWTOK[p] = p & (T - 1); ROWW[p] = 0.f; DEST[p] = (unsigned long long)dump; } } }
        { const int stile = (half ? (R0 + 128 + R1) : R0) + (tb & 127);
          if (F.tid == 0) { TE[stile] = 256; THOFF[stile] = (unsigned long long)HIDS_OFF + (unsigned long long)(tb * 256) * HID_ROWB; }
          if (F.tid < 256) { const int tok = tb * 256 + F.tid; const int p = stile * 256 + F.tid; ROWTOK[p] = tok; ROWW[p] = 1.0f; DEST[p] = (unsigned long long)slot_ptr(F.ws, F.outb, half, 8, tok); } }
        __syncthreads();
#pragma unroll
        for (int i = 0; i < 4; ++i) { const int item = F.tid + NTHR * i; const int t = tb * 256 + (item >> 3), k = item & 7;
            const int ex = TOPI[(size_t)t * TOPK + k]; const unsigned p = __hip_atomic_fetch_add(&cur[ex], 1u, __ATOMIC_RELAXED, __HIP_MEMORY_SCOPE_WORKGROUP);
            ROWTOK[p] = t; ROWW[p] = TOPW[(size_t)t * TOPK + k]; DEST[p] = (unsigned long long)slot_ptr(F.ws, F.outb, half, k, t); }
    }
}
struct UnitEx2 { int u, sub, e; const char* ab; };
struct GuOrder2 {
    typedef UnitEx2 Unit;
    int nun, G, vcu; const int* TE; const int* ROWTOK; const char *H2, *WGU, *WSGU;
    __device__ __forceinline__ bool next(int i, Unit& x) const { const int L = i * G + vcu; if (L >= nun) return false; x.u = L >> 1; x.sub = L & 1; x.e = TE[x.u]; x.ab = nullptr; return true; }
    __device__ __forceinline__ int K(const Unit&) const { return 1024; }
    __device__ __forceinline__ const char* a_base(const Unit&) const { return H2; }
    __device__ __forceinline__ unsigned a_row_off(const Unit& x, int r) const { return (unsigned)ROWTOK[(unsigned)(x.u * 256 + r)] * 2048u; }
    __device__ __forceinline__ const char* b_base(const Unit& x) const { return (x.e < 256 ? WGU + (size_t)x.e * (512 * 1024 * 2) : WSGU) + (size_t)x.sub * (256 * 1024 * 2); }
};
struct EpiGu2 {
    static constexpr bool PERM = true;
    unsigned char* ws; const unsigned long long* THOFF;
    __device__ __forceinline__ bool operator()(const f32x4 (&acc)[2][2][4][2], const UnitEx2& x, int wr, int wc, int fr, int fq) const {
        bf16* base = (bf16*)(ws + THOFF[x.u]);
        const int row0 = wr * 64 + fr, col0 = x.sub * 128 + wc * 32 + 8 * fq;
#pragma unroll
        for (int ai = 0; ai < 2; ++ai)
#pragma unroll
            for (int m = 0; m < 4; ++m) { const f32x4 g0 = acc[ai][0][m][0], g1 = acc[ai][0][m][1], u0 = acc[ai][1][m][0], u1 = acc[ai][1][m][1]; f32x4 h0, h1;
#pragma unroll
                for (int e = 0; e < 4; ++e) { h0[e] = g0[e] * fsig(g0[e]) * u0[e]; h1[e] = g1[e] * fsig(g1[e]) * u1[e]; }
                u32x4 w; w.x = g2::cvt_pk_bf16(h0[0], h0[1]); w.y = g2::cvt_pk_bf16(h0[2], h0[3]); w.z = g2::cvt_pk_bf16(h1[0], h1[1]); w.w = g2::cvt_pk_bf16(h1[2], h1[3]);
                *(u32x4*)(base + (size_t)(row0 + ai * 128 + m * 16) * 256 + col0) = w; asm volatile("" ::: "memory"); }
        return true;
    }
};
struct DownOrder2 {
    typedef UnitEx2 Unit;
    int tlo, nun, G, vcu; const int* TE; const unsigned long long* THOFF; const char *wsb, *WD, *WSD;
    __device__ __forceinline__ bool next(int i, Unit& x) const { const int L = i * G + vcu; if (L >= nun) return false; x.u = tlo + (L >> 2); x.sub = L & 3; x.e = TE[x.u]; x.ab = nullptr; return true; }
    __device__ __forceinline__ int K(const Unit&) const { return 256; }
    __device__ __forceinline__ const char* a_base(const Unit& x) const { return wsb + THOFF[x.u]; }
    __device__ __forceinline__ unsigned a_row_off(const Unit&, int r) const { return (unsigned)r * 512u; }
    __device__ __forceinline__ const char* b_base(const Unit& x) const { return (x.e < 256 ? WD + (size_t)x.e * (1024 * 256 * 2) : WSD) + (size_t)x.sub * (256 * 256 * 2); }
};
struct EpiDown2 {
    static constexpr bool PERM = true;
    const unsigned long long* DEST; const float* ROWW;
    __device__ __forceinline__ bool operator()(const f32x4 (&acc)[2][2][4][2], const UnitEx2& x, int wr, int wc, int fr, int fq) const {
        const int row0 = x.u * 256 + wr * 64 + fr; const int cb = (x.sub * 256 + wc * 32 + 8 * fq) * 2;
#pragma unroll
        for (int ai = 0; ai < 2; ++ai)
#pragma unroll
            for (int m = 0; m < 4; ++m) { const int r = row0 + ai * 128 + m * 16; unsigned char* dp = (unsigned char*)DEST[r] + cb; const float w = ROWW[r];
#pragma unroll
                for (int bj = 0; bj < 2; ++bj) { const f32x4 v0 = acc[ai][bj][m][0] * w, v1 = acc[ai][bj][m][1] * w;
                    u32x4 o; o.x = g2::cvt_pk_bf16(v0[0], v0[1]); o.y = g2::cvt_pk_bf16(v0[2], v0[3]); o.z = g2::cvt_pk_bf16(v1[0], v1[1]); o.w = g2::cvt_pk_bf16(v1[2], v1[3]);
                    *(u32x4*)(dp + bj * 256) = o; }
                asm volatile("" ::: "memory"); }
        return true;
    }
};
__device__ __forceinline__ void ph_gu2(Frame& F) {
    const int NT = (int)__hip_atomic_load(F.ctl + CW_NT, __ATOMIC_RELAXED, __HIP_MEMORY_SCOPE_AGENT);
    const int bx = blockIdx.x; const int vcu = (F.G % 8 == 0) ? (bx % 8) * (F.G / 8) + bx / 8 : bx;
    GuOrder2 S{2 * NT, F.G, vcu, (const int*)(F.ws + WS_TE), (const int*)(F.ws + WS_ROWTOK), (const char*)(F.ws + WS_H2), (const char*)(F.ws + WS_WGU), (const char*)(F.ws + WS_WSGU_T)};
    EpiGu2 E{F.ws, (const unsigned long long*)(F.ws + WS_THOFF)};
    g2::gemm_phase<EpiGu2, GuOrder2>(F.lds, S, E);
}
__device__ __forceinline__ void ph_down2(Frame& F, int half) {
    const int NT = (int)__hip_atomic_load(F.ctl + CW_NT, __ATOMIC_RELAXED, __HIP_MEMORY_SCOPE_AGENT), NT0 = (int)__hip_atomic_load(F.ctl + CW_NT0, __ATOMIC_RELAXED, __HIP_MEMORY_SCOPE_AGENT);
    const int tlo = half ? NT0 : 0, thi = half ? NT : NT0;
    const int bx = blockIdx.x; const int vcu = (F.G % 8 == 0) ? (bx % 8) * (F.G / 8) + bx / 8 : bx;
    DownOrder2 S{tlo, 4 * (thi - tlo), F.G, vcu, (const int*)(F.ws + WS_TE), (const unsigned long long*)(F.ws + WS_THOFF), (const char*)F.ws, (const char*)(F.ws + WS_WD), (const char*)(F.ws + WS_WSD_T)};
    EpiDown2 E{(const unsigned long long*)(F.ws + WS_DEST), (const float*)(F.ws + WS_ROWW)};
    g2::gemm_phase<EpiDown2, DownOrder2>(F.lds, S, E);
}

struct GuOrder8 {
    typedef UnitEx2 Unit;
    int nun, G, vcu; const int* TE; const int* ROWTOK; const char *H2, *WGU, *WSGU;
    __device__ __forceinline__ bool next(int i, Unit& x) const { const int L = i * G + vcu; if (L >= nun) return false; x.u = L >> 1; x.sub = L & 1; x.e = TE[x.u]; x.ab = nullptr; return true; }
    __device__ __forceinline__ int K(const Unit&) const { return 512; }
    __device__ __forceinline__ const char* a_base(const Unit&) const { return H2; }
    __device__ __forceinline__ unsigned a_row_off(const Unit& x, int r) const { return (unsigned)ROWTOK[(unsigned)(x.u * 256 + r)] * 1024u; }
    __device__ __forceinline__ const char* b_base(const Unit& x) const { return (x.e < 256 ? WGU + (size_t)x.e * (512 * 1024) : WSGU) + (size_t)x.sub * (256 * 1024); }
};
struct EpiGu8 {
    static constexpr bool PERM = true;
    unsigned char* ws; const unsigned long long* THOFF;
    __device__ __forceinline__ bool operator()(const f32x4 (&acc)[2][2][4][2], const UnitEx2& x, int wr, int wc, int fr, int fq) const {
        unsigned char* base = ws + THOFF[x.u];
        const int row0 = wr * 64 + fr, col0 = x.sub * 128 + wc * 32 + 8 * fq;
#pragma unroll
        for (int ai = 0; ai < 2; ++ai)
#pragma unroll
            for (int m = 0; m < 4; ++m) { const f32x4 g0 = acc[ai][0][m][0], g1 = acc[ai][0][m][1], u0 = acc[ai][1][m][0], u1 = acc[ai][1][m][1]; f32x4 h0, h1;
#pragma unroll
                for (int e = 0; e < 4; ++e) { h0[e] = g0[e] * fsig(g0[e]) * u0[e]; h1[e] = g1[e] * fsig(g1[e]) * u1[e]; }
                u32x2 w; w.x = pk4_fp8(h0[0], h0[1], h0[2], h0[3]); w.y = pk4_fp8(h1[0], h1[1], h1[2], h1[3]);
                *(u32x2*)(base + (size_t)(row0 + ai * 128 + m * 16) * 256 + col0) = w; asm volatile("" ::: "memory"); }
        return true;
    }
};
struct DownOrder8 {
    typedef UnitEx2 Unit;
    int tlo, nun, G, vcu; const int* TE; const unsigned long long* THOFF; const char *wsb, *WD, *WSD;
    __device__ __forceinline__ bool next(int i, Unit& x) const { const int tl = (i >> 2) * G + vcu; if (4 * tl >= nun) return false; x.u = tlo + tl; x.sub = i & 3; x.e = TE[x.u]; x.ab = wsb + THOFF[x.u]; return true; }
    __device__ __forceinline__ int K(const Unit&) const { return 128; }
    __device__ __forceinline__ const char* a_base(const Unit& x) const { return x.ab; }
    __device__ __forceinline__ unsigned a_row_off(const Unit&, int r) const { return (unsigned)r * 256u; }
    __device__ __forceinline__ const char* b_base(const Unit& x) const { return (x.e < 256 ? WD + (size_t)x.e * (1024 * 256) : WSD) + (size_t)x.sub * (256 * 256); }
};
__device__ __forceinline__ void ph_gu8(Frame& F) {
    const int NT = (int)__hip_atomic_load(F.ctl + CW_NT, __ATOMIC_RELAXED, __HIP_MEMORY_SCOPE_AGENT);
    const int bx = blockIdx.x; const int vcu = (F.G % 8 == 0) ? (bx % 8) * (F.G / 8) + bx / 8 : bx;
    GuOrder8 S{2 * NT, F.G, vcu, (const int*)(F.ws + WS_TE), (const int*)(F.ws + WS_ROWTOK), (const char*)(F.ws + WS_H2F8), (const char*)(F.ws + WS_WGU8), (const char*)(F.ws + WS_WSGU8)};
    EpiGu8 E{F.ws, (const unsigned long long*)(F.ws + WS_THOFF)};
    g2::gemm_phase<EpiGu8, GuOrder8, true>(F.lds, S, E, 127 - 5);
}
__device__ __forceinline__ void ph_down8(Frame& F, int half) {
    const int NT = (int)__hip_atomic_load(F.ctl + CW_NT, __ATOMIC_RELAXED, __HIP_MEMORY_SCOPE_AGENT), NT0 = (int)__hip_atomic_load(F.ctl + CW_NT0, __ATOMIC_RELAXED, __HIP_MEMORY_SCOPE_AGENT);
    const int tlo = half ? NT0 : 0, thi = half ? NT : NT0;
    const int bx = blockIdx.x; const int vcu = (F.G % 8 == 0) ? (bx % 8) * (F.G / 8) + bx / 8 : bx;
    DownOrder8 S{tlo, 4 * (thi - tlo), F.G, vcu, (const int*)(F.ws + WS_TE), (const unsigned long long*)(F.ws + WS_THOFF), (const char*)F.ws, (const char*)(F.ws + WS_WD8), (const char*)(F.ws + WS_WSD8)};
    EpiDown2 E{(const unsigned long long*)(F.ws + WS_DEST), (const float*)(F.ws + WS_ROWW)};
    g2::gemm_phase<EpiDown2, DownOrder8, true>(F.lds, S, E, 127 - 4);
}
__device__ __forceinline__ void ph_combine2(Frame& F, int half) {
    const float* mod = (const float*)(F.ws + WS_MOD); const float* g = F.in[I_GPOSTFFN];
    for (int t = half * HALF_T + blockIdx.x * NWAVES + F.wave; t < (half + 1) * HALF_T; t += F.G * NWAVES) {
        const int b = t / SEQ; const float* gt2 = mod + b * 6144 + 5120;
        float y[16];
#pragma unroll
        for (int i = 0; i < 16; ++i) y[i] = 0.f;
#pragma unroll
        for (int k = 0; k < 9; ++k) { const unsigned char* sp = slot_ptr(F.ws, F.outb, half, k, t);
#pragma unroll
            for (int j = 0; j < 4; ++j) { const u32x2 w = *(const u32x2*)(sp + (F.lane * 4 + 256 * j) * 2);
                y[4 * j + 0] += __uint_as_float(w.x << 16); y[4 * j + 1] += __uint_as_float(w.x & 0xffff0000u); y[4 * j + 2] += __uint_as_float(w.y << 16); y[4 * j + 3] += __uint_as_float(w.y & 0xffff0000u); } }
        f32x4 x1[4]; x1_row(F, t, x1);
        float ss = 0.f;
#pragma unroll
        for (int i = 0; i < 16; ++i) ss += y[i] * y[i];
        const float rstd = rsqrtf(wave_sum(ss) * (1.0f / D) + EPS);
#pragma unroll
        for (int j = 0; j < 4; ++j) { const int c = F.lane * 4 + 256 * j; const f32x4 gg = *(const f32x4*)(g + c), gt = *(const f32x4*)(gt2 + c);
            f32x4 o;
#pragma unroll
            for (int e = 0; e < 4; ++e) o[e] = x1[j][e] + gt[e] * (y[4 * j + e] * rstd * gg[e]);
            *(f32x4*)(F.out + (size_t)t * D + c) = o; }
    }
}


constexpr float SLOT_SC = 16.0f;
__device__ __forceinline__ unsigned char* slot8_ptr(unsigned char* ws, unsigned char* outb, int k, int t) {
    if (k < 4) return outb + (size_t)t * 4096 + k * 1024;
    const int ri = k - 4; const size_t base = (ri == 0) ? 192 : (ri == 1) ? 256 : (ri == 2) ? 320 : (ri == 3) ? 384 : 736;
    return ws + base * MiB + (size_t)t * 1024;
}
constexpr size_t YS_A = 192 * MiB, YS_B = 736 * MiB; constexpr int YS_NA = 262144;
__device__ __forceinline__ unsigned char* ys_row(unsigned char* ws, int p) { return ws + (p < YS_NA ? YS_A + (size_t)p * 1024 : YS_B + (size_t)(p - YS_NA) * 1024); }
static_assert(YS_NA % 256 == 0 && YS_A + (size_t)YS_NA * 1024 <= WS_HIDS8 && YS_B + (size_t)(T * 8 + 256 * 255 - YS_NA) * 1024 <= WS_NEED, "dense MoE output map");
__device__ __forceinline__ void ph_scatter4(Frame& F) {
    const int* TOPI = (const int*)(F.ws + WS_TOPI); const float* TOPW = (const float*)(F.ws + WS_TOPW); const int* HIST = (const int*)(F.ws + WS_HIST);
    int* TE = (int*)(F.ws + WS_TE); unsigned long long* THOFF = (unsigned long long*)(F.ws + WS_THOFF);
    int* ROWTOK = (int*)(F.ws + WS_ROWTOK); float* ROWW = (float*)(F.ws + WS_ROWW); int* POS = (int*)(F.ws + WS_DEST);
    LAS int* pre = (LAS int*)F.lds;
    LAS unsigned* cur = (LAS unsigned*)(F.lds + 4096);
    LAS int* cnt = (LAS int*)(F.lds + 8192);
    for (int tb = blockIdx.x; tb < T / 256; tb += F.G) {
        const int e = F.tid; int n0 = 0, mybase = 0;
        __syncthreads();
        if (e < NE) {
#pragma unroll 8
            for (int t2 = 0; t2 < 256; ++t2) { const int c = HIST[t2 * 256 + e]; if (t2 < tb) mybase += c; n0 += c; }
            pre[e] = (n0 + 255) >> 8; cnt[e] = n0;
        }
        __syncthreads();
        if (F.wave == 0) { int v[4]; int s0 = 0;
#pragma unroll
            for (int i = 0; i < 4; ++i) { v[i] = pre[4 * F.lane + i]; s0 += v[i]; }
            int i0 = s0;
#pragma unroll
            for (int o = 1; o < 64; o <<= 1) { const int a0 = __shfl_up(i0, o); if (F.lane >= o) i0 += a0; }
            const int R = __shfl(i0, 63); int x0 = i0 - s0;
#pragma unroll
            for (int i = 0; i < 4; ++i) { pre[4 * F.lane + i] = x0; x0 += v[i]; }
            if (F.lane == 0) { pre[512] = R; if (tb == 0) { F.ctl[CW_NT0] = (unsigned)R; F.ctl[CW_NT] = (unsigned)(R + 256); } } }
        __syncthreads();
        const int R = pre[512];
        if (e < NE) cur[e] = (unsigned)(pre[e] * 256 + mybase);
        { const int ee = tb; const int ts0 = pre[ee], c0 = cnt[ee], nt0 = (c0 + 255) >> 8;
          if (F.tid < nt0) { TE[ts0 + F.tid] = ee; THOFF[ts0 + F.tid] = (unsigned long long)HIDR_OFF + (unsigned long long)(ts0 + F.tid) * (256 * HID_ROWB); }
          if (F.tid < 256) { const int r0p = c0 + F.tid; if (r0p < nt0 * 256) { const int p = ts0 * 256 + r0p; ROWTOK[p] = p & (T - 1); ROWW[p] = 0.f; } } }
        { const int stile = R + tb;
          if (F.tid == 0) { TE[stile] = 256; THOFF[stile] = (unsigned long long)HIDS_OFF + (unsigned long long)(tb * 256) * HID_ROWB; }
          if (F.tid < 256) { const int tok = tb * 256 + F.tid; const int p = stile * 256 + F.tid; ROWTOK[p] = tok; ROWW[p] = 1.0f; } }
        __syncthreads();
#pragma unroll
        for (int i = 0; i < 4; ++i) { const int item = F.tid + NTHR * i; const int t = tb * 256 + (item >> 3), k = item & 7;
            const int ex = TOPI[(size_t)t * TOPK + k]; const unsigned p = __hip_atomic_fetch_add(&cur[ex], 1u, __ATOMIC_RELAXED, __HIP_MEMORY_SCOPE_WORKGROUP);
            ROWTOK[p] = t; ROWW[p] = TOPW[(size_t)t * TOPK + k]; POS[(size_t)t * TOPK + k] = (int)p; }
    }
}
struct EpiDown8 {
    static constexpr bool PERM = true;
    unsigned char* ws; unsigned char* outb; const float* ROWW; int R; int dbg; unsigned char* dbgbase;
    __device__ __forceinline__ bool operator()(const f32x4 (&acc)[2][2][4][2], const UnitEx2& x, int wr, int wc, int fr, int fq) const {
        const int rl = wr * 64 + fr; const int cb = x.sub * 256 + wc * 64 + 16 * fq;
        const bool sh = x.e == 256;
        unsigned char* base = sh ? outb + (size_t)(x.u - R) * (256 * 4096) : ys_row(ws, x.u * 256); const int pitch = sh ? 4096 : 1024;
        if (dbg == 2) base = dbgbase + (size_t)((x.u * 256) & 65535) * 1024;
        float wv[8];
#pragma unroll
        for (int q = 0; q < 8; ++q) wv[q] = ROWW[x.u * 256 + rl + (q >> 2) * 128 + (q & 3) * 16];
#pragma unroll
        for (int ai = 0; ai < 2; ++ai)
#pragma unroll
            for (int m = 0; m < 4; ++m) { const int i = rl + ai * 128 + m * 16; unsigned char* dp = base + (size_t)i * (dbg == 2 ? 1024 : pitch) + cb; const float w = wv[ai * 4 + m] * SLOT_SC;
                if (dbg == 1) { if (acc[ai][0][m][0][0] == 123.456f) dp[0] = 1; continue; }
                const f32x4 a0 = acc[ai][0][m][0] * w, a1 = acc[ai][0][m][1] * w, b0 = acc[ai][1][m][0] * w, b1 = acc[ai][1][m][1] * w;
                u32x4 o; o.x = pk4_fp8(a0[0], a0[1], a0[2], a0[3]); o.y = pk4_fp8(a1[0], a1[1], a1[2], a1[3]); o.z = pk4_fp8(b0[0], b0[1], b0[2], b0[3]); o.w = pk4_fp8(b1[0], b1[1], b1[2], b1[3]);
                *(u32x4*)dp = o;
                asm volatile("" ::: "memory"); }
        return true;
    }
};
__device__ __forceinline__ void ph_down9(Frame& F, int dbg = 0) {
    const int NT = (int)__hip_atomic_load(F.ctl + CW_NT, __ATOMIC_RELAXED, __HIP_MEMORY_SCOPE_AGENT);
    const int bx = blockIdx.x; const int vcu = (F.G % 8 == 0) ? (bx % 8) * (F.G / 8) + bx / 8 : bx;
    DownOrder8 S{0, 4 * NT, F.G, vcu, (const int*)(F.ws + WS_TE), (const unsigned long long*)(F.ws + WS_THOFF), (const char*)F.ws, (const char*)(F.ws + WS_WD8), (const char*)(F.ws + WS_WSD8)};
    const int R = (int)__hip_atomic_load(F.ctl + CW_NT0, __ATOMIC_RELAXED, __HIP_MEMORY_SCOPE_AGENT);
    EpiDown8 E{F.ws, F.outb, (const float*)(F.ws + WS_ROWW), R, dbg, F.ws + 640 * MiB};
    g2::gemm_phase<EpiDown8, DownOrder8, true, DOWN_ALIGN>(F.lds, S, E, 127 - 4);
}
struct X1B { u32x2 xm[4]; };
__device__ __forceinline__ void x1b_load(Frame& F, int t, X1B& r) {
    const bf16* XM = (const bf16*)(F.ws + WS_YMIX);
#pragma unroll
    for (int j = 0; j < 4; ++j) r.xm[j] = *(const u32x2*)(XM + (size_t)t * D + F.lane * 4 + 256 * j);
}
__device__ __forceinline__ void ph_combine9(Frame& F) {
    const float* mod = (const float*)(F.ws + WS_MOD); const float* g = F.in[I_GPOSTFFN];
    const int* POS = (const int*)(F.ws + WS_DEST);
#define C9_TOK(qq) ((int)((blockIdx.x + ((qq) >> 5) * F.G) << 8) + F.wave + 8 * ((qq) & 31))
#define C9_POS(tt) (((tt) < T) ? POS[(size_t)(tt) * TOPK + (F.lane & 7)] : 0)
#define C9_LOAD(SN, tt, pp) do { _Pragma("unroll") for (int k = 0; k < 9; ++k) { \
        const unsigned char* sp = (k < 8) ? ys_row(F.ws, __builtin_amdgcn_readlane((pp), k)) : F.outb + (size_t)(tt) * 4096; \
        _Pragma("unroll") for (int j = 0; j < 4; ++j) SN[k][j] = *(const int*)(sp + F.lane * 4 + 256 * j); } } while (0)
#define C9_STEP(SN, tt, tn1, tnx, pnx) do { \
        float y[16]; \
        _Pragma("unroll") for (int i = 0; i < 16; ++i) y[i] = 0.f; \
        _Pragma("unroll") for (int k = 0; k < 9; ++k) _Pragma("unroll") for (int j = 0; j < 4; ++j) { const int w = SN[k][j]; \
            y[4 * j + 0] += __builtin_amdgcn_cvt_f32_fp8(w, 0); y[4 * j + 1] += __builtin_amdgcn_cvt_f32_fp8(w, 1); y[4 * j + 2] += __builtin_amdgcn_cvt_f32_fp8(w, 2); y[4 * j + 3] += __builtin_amdgcn_cvt_f32_fp8(w, 3); } \
        const X1B rc = rn; \
        if ((tn1) < T) x1b_load(F, (tn1), rn); \
        if ((tnx) < T) C9_LOAD(SN, (tnx), (pnx)); \
        const int b = (tt) / SEQ; const float* gt2 = mod + b * 6144 + 5120; \
        f32x4 x1[4]; \
        _Pragma("unroll") for (int j = 0; j < 4; ++j) { const u32x2 w = rc.xm[j]; x1[j] = (f32x4){__uint_as_float(w.x << 16), __uint_as_float(w.x & 0xffff0000u), __uint_as_float(w.y << 16), __uint_as_float(w.y & 0xffff0000u)}; } \
        float ss = 0.f; \
        _Pragma("unroll") for (int i = 0; i < 16; ++i) ss += y[i] * y[i]; \
        const float rstd = rsqrtf(wave_sum(ss) * (1.0f / (D * SLOT_SC * SLOT_SC)) + EPS);            \
        _Pragma("unroll") for (int j = 0; j < 4; ++j) { const int c = F.lane * 4 + 256 * j; const f32x4 gg = *(const f32x4*)(g + c), gt = *(const f32x4*)(gt2 + c); \
            f32x4 o; \
            _Pragma("unroll") for (int e = 0; e < 4; ++e) o[e] = x1[j][e] + gt[e] * (y[4 * j + e] * (1.0f / SLOT_SC) * rstd * gg[e]); \
            *(f32x4*)(F.out + (size_t)(tt) * D + c) = o; } } while (0)
    X1B rn; int sA[9][4], sB[9][4];
    int q = 0, t0 = C9_TOK(0), t1 = C9_TOK(1);
    { const int p0 = C9_POS(t0), p1 = C9_POS(t1);
      if (t0 < T) { x1b_load(F, t0, rn); C9_LOAD(sA, t0, p0); }
      if (t1 < T) C9_LOAD(sB, t1, p1); }
    int p2 = C9_POS(C9_TOK(2)), p3 = C9_POS(C9_TOK(3));
    for (; t0 < T; q += 2) {
        { int ln = F.lane; asm volatile("" : "+v"(ln)); F.lane = ln; }
        const int t2 = C9_TOK(q + 2), t3 = C9_TOK(q + 3);
        const int p4 = C9_POS(C9_TOK(q + 4)), p5 = C9_POS(C9_TOK(q + 5));
        C9_STEP(sA, t0, t1, t2, p2);
        if (t1 < T) C9_STEP(sB, t1, t2, t3, p3);
        t0 = t2; t1 = t3; p2 = p4; p3 = p5;
    }
#undef C9_STEP
#undef C9_LOAD
#undef C9_POS
#undef C9_TOK
}
__device__ __forceinline__ void ph_router_naive(Frame& F) {
    LAS float* As = (LAS float*)F.lds; LAS float* Bs = As + 16 * 132;
    const bf16* H2 = (const bf16*)(F.ws + WS_H2); float* LG = (float*)(F.ws + WS_LOGITS);
    const int ty = F.tid >> 5, tx = F.tid & 31;
    for (int vb = blockIdx.x; vb < (T / 128) * 2; vb += F.G) {
        const int tm = vb >> 1, tn = vb & 1, m0 = tm * 128, n0 = tn * 128;
        float a1[8][4]; ZERO_ACC(a1);
        ARowGlobal ra{H2, (size_t)D, m0, nullptr}; ngemm_acc(As, Bs, ra, F.in[I_RW], NE, D, n0, NE, a1);
#pragma unroll
        for (int i = 0; i < 8; ++i) { const size_t row = (size_t)(m0 + ty * 8 + i); const int col = n0 + tx * 4;
            *(f32x4*)(LG + row * NE + col) = (f32x4){a1[i][0], a1[i][1], a1[i][2], a1[i][3]}; }
    }
}

__device__ __forceinline__ float half_max(float v) {
#pragma unroll
    for (int o = 1; o < 32; o <<= 1) v = fmaxf(v, __shfl_xor(v, o));
    return v;
}
__device__ __forceinline__ void ph_topk(Frame& F) {
    const float* LG = (const float*)(F.ws + WS_LOGITS); const float* rb = F.in[I_RB];
    int* TOPI = (int*)(F.ws + WS_TOPI); float* TOPW = (float*)(F.ws + WS_TOPW); unsigned* counts = F.ctl + CW_COUNTS;
    const int lane = F.lane, hf = lane >> 5;
    for (int t = blockIdx.x * NWAVES + F.wave; t < T; t += F.G * NWAVES) {
        float sc[4], sel[4];
#pragma unroll
        for (int i = 0; i < 4; ++i) { sc[i] = sigmoidf_(LG[(size_t)t * NE + lane + 64 * i]); sel[i] = sc[i] + rb[lane + 64 * i]; }
        float gs[8];
#pragma unroll
        for (int i = 0; i < 4; ++i) {
            const float m1 = half_max(sel[i]);
            const unsigned long long bal = __ballot(sel[i] == m1); const unsigned hb = hf ? (unsigned)(bal >> 32) : (unsigned)bal;
            const int first = __ffs(hb) - 1;
            const float v2 = ((lane & 31) == first) ? -INFINITY : sel[i];
            const float m2 = half_max(v2);
            const float g = m1 + m2;
            const float go = __shfl_xor(g, 32);
            gs[2 * i] = hf ? go : g; gs[2 * i + 1] = hf ? g : go;
        }
        bool gsel[8];
#pragma unroll
        for (int a = 0; a < 8; ++a) { int rank = 0;
#pragma unroll
            for (int c = 0; c < 8; ++c) rank += (gs[c] > gs[a] || (gs[c] == gs[a] && c < a)) ? 1 : 0;
            gsel[a] = rank < 4; }
#pragma unroll
        for (int i = 0; i < 4; ++i) { const bool ok = hf ? gsel[2 * i + 1] : gsel[2 * i]; if (!ok) sel[i] = -INFINITY; }
        int myidx = 0; float myw = 0.f; float wsum = 0.f;
#pragma unroll
        for (int k = 0; k < TOPK; ++k) {
            float bv = sel[0]; int bi = lane;
#pragma unroll
            for (int i = 1; i < 4; ++i) if (sel[i] > bv) { bv = sel[i]; bi = lane + 64 * i; }
#pragma unroll
            for (int o = 1; o < 64; o <<= 1) { const float ov = __shfl_xor(bv, o); const int oi = __shfl_xor(bi, o); if (ov > bv || (ov == bv && oi < bi)) { bv = ov; bi = oi; } }
            const int ol = bi & 63, oi = bi >> 6;
            float s = (oi == 0) ? sc[0] : (oi == 1) ? sc[1] : (oi == 2) ? sc[2] : sc[3];
            s = __shfl(s, ol);
            if (lane == ol) { if (oi == 0) sel[0] = -INFINITY; else if (oi == 1) sel[1] = -INFINITY; else if (oi == 2) sel[2] = -INFINITY; else sel[3] = -INFINITY; }
            wsum += s;
            if (lane == k) { myidx = bi; myw = s; }
        }
        if (lane < TOPK) { TOPI[(size_t)t * TOPK + lane] = myidx; TOPW[(size_t)t * TOPK + lane] = myw / wsum * 2.5f; atomicAdd(&counts[myidx], 1u); }
    }
}


__device__ __forceinline__ void ph_topk_serial(Frame& F) {
    const float* LG = (const float*)(F.ws + WS_LOGITS); const float* rb = F.in[I_RB];
    int* TOPI = (int*)(F.ws + WS_TOPI); float* TOPW = (float*)(F.ws + WS_TOPW); unsigned* counts = F.ctl + CW_COUNTS;
    LAS float* sel = (LAS float*)F.lds + F.wave * 1024; LAS float* scr = sel + 256; LAS float* gsc = scr + 256; LAS int* gok = (LAS int*)(gsc + 8); LAS int* bi = gok + 8; LAS float* bw = (LAS float*)(bi + 8);
    for (int t = blockIdx.x * NWAVES + F.wave; t < T; t += F.G * NWAVES) {
        for (int i = 0; i < 4; ++i) { const int e = F.lane + 64 * i; const float s = sigmoidf_(LG[(size_t)t * NE + e]); scr[e] = s; sel[e] = s + rb[e]; }
        __builtin_amdgcn_s_waitcnt(0);
        if (F.lane == 0) {
            for (int g = 0; g < 8; ++g) { float m1 = -INFINITY, m2 = -INFINITY; for (int q = 0; q < 32; ++q) { const float v = sel[g * 32 + q]; if (v > m1) { m2 = m1; m1 = v; } else if (v > m2) m2 = v; } gsc[g] = m1 + m2; gok[g] = 0; }
            for (int k = 0; k < 4; ++k) { int best = -1; float bv = -INFINITY; for (int g = 0; g < 8; ++g) if (!gok[g] && gsc[g] > bv) { bv = gsc[g]; best = g; } gok[best] = 1; }
            for (int e = 0; e < 256; ++e) if (!gok[e >> 5]) sel[e] = -INFINITY;
            float ws = 0.f;
            for (int k = 0; k < 8; ++k) { int best = 0; float bv = -INFINITY; for (int e = 0; e < 256; ++e) if (sel[e] > bv) { bv = sel[e]; best = e; } sel[best] = -INFINITY; bi[k] = best; bw[k] = scr[best]; ws += scr[best]; }
            for (int k = 0; k < 8; ++k) { TOPI[(size_t)t * 8 + k] = bi[k]; TOPW[(size_t)t * 8 + k] = bw[k] / ws * 2.5f; atomicAdd(&counts[bi[k]], 1u); }
        }
        __builtin_amdgcn_s_waitcnt(0);
    }
}

__device__ __forceinline__ void ph_scan(Frame& F) {
    if (blockIdx.x != 0) return;
    LAS int* pre = (LAS int*)F.lds;
    unsigned* counts = F.ctl + CW_COUNTS; int* ROWTOK = (int*)(F.ws + WS_ROWTOK); float* ROWW = (float*)(F.ws + WS_ROWW);
    int* UNITEXP = (int*)(F.ws + WS_UNITEXP); int* EXPTILE0 = (int*)(F.ws + WS_EXPTILE0);
    __syncthreads();
    int n = 0, nt = 0;
    if (F.tid < NE) { n = (int)counts[F.tid]; nt = (n + 255) >> 8; pre[F.tid] = nt; }
    __syncthreads();
    if (F.tid == 0) { int s = 0; for (int e = 0; e < NE; ++e) { const int c = pre[e]; pre[e] = s; s += c; } F.ctl[CW_NT] = (unsigned)s; }
    __syncthreads();
    if (F.tid < NE) {
        const int t0 = pre[F.tid]; EXPTILE0[F.tid] = t0;
        for (int u = 0; u < nt; ++u) UNITEXP[t0 + u] = F.tid;
        for (int r = n; r < nt * 256; ++r) { ROWTOK[t0 * 256 + r] = (t0 * 256 + r) & (T - 1); ROWW[t0 * 256 + r] = 0.f; }
    }
    __syncthreads();
    { const int NTv = (int)F.ctl[CW_NT];
      for (int i = F.tid; i < T; i += NTHR) { ROWTOK[NTv * 256 + i] = i; ROWW[NTv * 256 + i] = 1.0f; } }
}

__device__ __forceinline__ void ph_scatter(Frame& F) {
    const int* TOPI = (const int*)(F.ws + WS_TOPI); const float* TOPW = (const float*)(F.ws + WS_TOPW);
    int* ROWTOK = (int*)(F.ws + WS_ROWTOK); float* ROWW = (float*)(F.ws + WS_ROWW); const int* EXPTILE0 = (const int*)(F.ws + WS_EXPTILE0);
    unsigned* cursor = F.ctl + CW_CURSOR;
    for (int i = blockIdx.x * NTHR + F.tid; i < T * TOPK; i += F.G * NTHR) {
        const int e = TOPI[i]; const unsigned p = atomicAdd(&cursor[e], 1u);
        const size_t r = (size_t)EXPTILE0[e] * 256 + p;
        ROWTOK[r] = i >> 3; ROWW[r] = TOPW[i];
    }
}

__device__ __forceinline__ void ph_experts_naive(Frame& F) {
    LAS float* As = (LAS float*)F.lds; LAS float* Bs = As + 16 * 132; LAS bf16* hid = (LAS bf16*)(F.lds + 32768);
    const bf16* H2 = (const bf16*)(F.ws + WS_H2);
    const int* ROWTOK = (const int*)(F.ws + WS_ROWTOK); const float* ROWW = (const float*)(F.ws + WS_ROWW); const int* UNITEXP = (const int*)(F.ws + WS_UNITEXP);
    const int NT = (int)__hip_atomic_load(F.ctl + CW_NT, __ATOMIC_RELAXED, __HIP_MEMORY_SCOPE_AGENT);
    const int ty = F.tid >> 5, tx = F.tid & 31;
    const int nvb = 2 * NT + T / 128;
    for (int vb = blockIdx.x; vb < nvb; vb += F.G) {
        const bool shared = vb >= 2 * NT;
        const float *Wg, *Wu, *Wd; int r0; const int* gather;
        if (shared) { Wg = F.in[I_WSG]; Wu = F.in[I_WSU]; Wd = F.in[I_WSD]; r0 = (vb - 2 * NT) * 128; gather = nullptr; }
        else { const int u = vb >> 1; const int e = UNITEXP[u]; Wg = F.in[I_WEG] + (size_t)e * 1024 * 256; Wu = F.in[I_WEU] + (size_t)e * 1024 * 256; Wd = F.in[I_WED] + (size_t)e * 256 * 1024;
               r0 = u * 256 + (vb & 1) * 128; gather = ROWTOK; }
        ARowGlobal ra{H2, (size_t)D, r0, gather};
        for (int nh = 0; nh < 2; ++nh) {
            float ag[8][4], au[8][4]; ZERO_ACC(ag); ZERO_ACC(au);
            ngemm_acc(As, Bs, ra, Wg, 256, D, nh * 128, 256, ag);
            ngemm_acc(As, Bs, ra, Wu, 256, D, nh * 128, 256, au);
#pragma unroll
            for (int i = 0; i < 8; ++i) { float o[4];
#pragma unroll
                for (int j = 0; j < 4; ++j) { const float g = ag[i][j]; o[j] = g / (1.0f + expf(-g)) * au[i][j]; }
                u32x2 w; w.x = pk2(o[0], o[1]); w.y = pk2(o[2], o[3]); *(LAS u32x2*)(hid + (ty * 8 + i) * 256 + nh * 128 + tx * 4) = w; }
        }
        __syncthreads();
        ARowLds rl{hid};
        for (int nc = 0; nc < 8; ++nc) {
            float ad[8][4]; ZERO_ACC(ad);
            ngemm_acc(As, Bs, rl, Wd, D, 256, nc * 128, D, ad);
#pragma unroll
            for (int i = 0; i < 8; ++i) { const int r = r0 + ty * 8 + i; const int tok = shared ? r : ROWTOK[r]; const float w = shared ? 1.0f : ROWW[r];
                if (w != 0.f) {
#pragma unroll
                    for (int j = 0; j < 4; ++j) unsafeAtomicAdd(F.out + (size_t)tok * D + nc * 128 + tx * 4 + j, ad[i][j] * w); } }
        }
        __syncthreads();
    }
}


__device__ __forceinline__ void ph_experts_brute(Frame& F) {
    LAS float* hs = (LAS float*)F.lds;
    LAS float* hid = hs + 1024;
    LAS float* pg = hid + 256;
    const bf16* H2 = (const bf16*)(F.ws + WS_H2); const int* TOPI = (const int*)(F.ws + WS_TOPI); const float* TOPW = (const float*)(F.ws + WS_TOPW);
    const int tid = F.tid, j = tid & 255, kh = tid >> 8;
    for (int t = blockIdx.x; t < T; t += F.G) {
        __syncthreads();
        hs[tid] = bf2f(H2[(size_t)t * D + tid]); hs[tid + 512] = bf2f(H2[(size_t)t * D + tid + 512]);
        float o0 = 0.f, o1 = 0.f;
        __syncthreads();
        for (int k9 = 0; k9 < 9; ++k9) {
            const float *Wg, *Wu, *Wd; float w;
            if (k9 == 8) { Wg = F.in[I_WSG]; Wu = F.in[I_WSU]; Wd = F.in[I_WSD]; w = 1.0f; }
            else { const int e = TOPI[(size_t)t * 8 + k9]; w = TOPW[(size_t)t * 8 + k9]; Wg = F.in[I_WEG] + (size_t)e * 1024 * 256; Wu = F.in[I_WEU] + (size_t)e * 1024 * 256; Wd = F.in[I_WED] + (size_t)e * 256 * 1024; }
            float g = 0.f, u = 0.f;
            for (int k = kh * 512; k < kh * 512 + 512; ++k) { const float hv = hs[k]; g += hv * Wg[(size_t)k * 256 + j]; u += hv * Wu[(size_t)k * 256 + j]; }
            pg[tid] = g; pg[512 + tid] = u;
            __syncthreads();
            if (tid < 256) { const float gg = pg[tid] + pg[tid + 256], uu = pg[512 + tid] + pg[512 + tid + 256]; hid[tid] = gg / (1.0f + expf(-gg)) * uu * w; }
            __syncthreads();
            for (int q = 0; q < 256; ++q) { const float hv = hid[q]; o0 += hv * Wd[(size_t)q * 1024 + tid]; o1 += hv * Wd[(size_t)q * 1024 + tid + 512]; }
        }
        F.out[(size_t)t * D + tid] = o0; F.out[(size_t)t * D + tid + 512] = o1;
    }
}

__device__ __forceinline__ void ph_final(Frame& F) {
    const float* mod = (const float*)(F.ws + WS_MOD); const float* g = F.in[I_GPOSTFFN];
    for (int t = blockIdx.x * NWAVES + F.wave; t < T; t += F.G * NWAVES) {
        const int b = t / SEQ; const float* gt2 = mod + b * 6144 + 5120;
        f32x4 x1[4]; x1_row(F, t, x1);
        f32x4 y[4]; float ss = 0.f;
#pragma unroll
        for (int j = 0; j < 4; ++j) { y[j] = *(const f32x4*)(F.out + (size_t)t * D + F.lane * 4 + 256 * j); ss += y[j][0] * y[j][0] + y[j][1] * y[j][1] + y[j][2] * y[j][2] + y[j][3] * y[j][3]; }
        const float rstd = rsqrtf(wave_sum(ss) * (1.0f / D) + EPS);
#pragma unroll
        for (int j = 0; j < 4; ++j) { const int c = F.lane * 4 + 256 * j; const f32x4 gg = *(const f32x4*)(g + c), gt = *(const f32x4*)(gt2 + c);
            f32x4 o;
#pragma unroll
            for (int e = 0; e < 4; ++e) o[e] = x1[j][e] + DBG_MOE_SCALE * gt[e] * (y[j][e] * rstd * gg[e]);
#if DBG_STAMP_A >= 0
            { const float dl = (float)(F.ctl[CW_STAMP + DBG_STAMP_B] - F.ctl[CW_STAMP + DBG_STAMP_A]) * 1e-6f; const f32x4 xv = *(const f32x4*)(F.in[I_X] + (size_t)t * D + c); o = o + xv * dl; }
#endif
            *(f32x4*)(F.out + (size_t)t * D + c) = o; }
    }
}

enum { PH_MOD = 0, PH_NORM1, PH_INPROJ, PH_ROPE, PH_MIX, PH_BRANCH, PH_OUTPROJ, PH_NORMMID, PH_ROUTER, PH_TOPK, PH_SCAN, PH_SCATTER, PH_EXPERTS, PH_FINAL, N_PHASES };

__global__ void __launch_bounds__(NTHR, 2) mk_fwd(Args args) {
    extern __shared__ __attribute__((aligned(16))) unsigned char lds_raw[];
    Frame F;
    F.lds = (LAS unsigned char*)lds_raw;
    F.tid = threadIdx.x; F.lane = F.tid & 63; F.wave = __builtin_amdgcn_readfirstlane(F.tid >> 6); F.G = gridDim.x;
#pragma unroll
    for (int i = 0; i < N_IN; ++i) F.in[i] = args.in[i];
    F.pos = (const int*)args.in[I_POS];
    F.out = args.out; F.outb = (unsigned char*)args.out; F.ws = args.ws; F.ctl = (unsigned*)(args.ws + WS_CTL);
    volatile LAS unsigned* MISC = (volatile LAS unsigned*)(F.lds + MISC_OFF);
    if (F.tid < 32) MISC[F.tid] = 0u;
    __syncthreads();
    const int lo = args.ph_lo, hi = args.ph_hi;
#define STAMP(id) do { if (DBG_STAMP_A >= 0 && blockIdx.x == 0 && threadIdx.x == 0) F.ctl[CW_STAMP + (id)] = (unsigned)wall_clock64(); } while (0)
#define REFRESH() do { int _t = threadIdx.x; asm volatile("" : "+v"(_t)); F.tid = _t; F.lane = _t & 63; F.wave = __builtin_amdgcn_readfirstlane(_t >> 6); } while (0)
    XcdBarrier bar; bar.bar = F.ctl + CW_BAR; bar.x = 0; bar.st = nullptr;
    if (hi - lo > 1) bar = xcd_barrier_post(F.ctl + CW_BAR, MISC + 8);
#ifndef PH_MASK
#define PH_MASK 0xFFFFFFu
#endif
#define IN(k) ((((PH_MASK) >> (k)) & 1u) && lo <= (k) && (k) < hi)
#define SEAM(k) do { if (IN(k) && IN((k) + 1)) xcd_barrier(bar); } while (0)

    STAMP(0);
    if (IN(PH_MOD)) { REFRESH(); ph_mod(F); ph_cvt_small(F); if (DUP == 0) { __syncthreads(); ph_mod(F); ph_cvt_small(F); } } SEAM(PH_MOD); STAMP(1);
    if (IN(PH_NORM1)) { REFRESH(); ph_norm1(F); if (DUP == 1) ph_norm1(F); if (DUP == 30) { int md = 1; asm volatile("" : "+s"(md)); ph_norm1(F, md); } } SEAM(PH_NORM1); STAMP(2);
#if FAST_INPROJ
    if (IN(PH_INPROJ)) { REFRESH(); ph_inproj_fast(F); if (DUP == 2) ph_inproj_fast(F); if (DUP == 20 || DUP == 21 || DUP == 22) { int ns = (DUP == 20) ? 1 : (DUP == 21) ? 2 : 0; asm volatile("" : "+s"(ns)); ph_inproj_fast(F, ns); } }
    SEAM(PH_INPROJ); STAMP(3);
#else
    if (IN(PH_INPROJ)) { REFRESH(); ph_inproj_naive(F); }
    SEAM(PH_INPROJ);
    if (IN(PH_ROPE)) { REFRESH(); ph_rope_naive(F); }
    SEAM(PH_ROPE);
#endif
    if (IN(PH_MIX)) { REFRESH();
#if FAST_ATTN
#if FAST_MLSTM
        if (blockIdx.x < 128) { int nrep = (DUP == 3) ? 2 : 1; asm volatile("" : "+s"(nrep));
#pragma unroll 1
            for (int rep = 0; rep < nrep; ++rep) mlstm_unit_fast(F, blockIdx.x); }
#else
        if (blockIdx.x < 128) ph_mlstm_naive_unit(F, blockIdx.x);
#endif
        { int first = (blockIdx.x >= 128 && (int)((blockIdx.x >> 3) & 3) < MIX_CVT_FIRST) ? 1 : 0; first = __builtin_amdgcn_readfirstlane(first);
#if MOE_FP8
          if (first) for (;;) {
              __syncthreads();
              if (F.tid == 0) MISC[0] = atomicAdd(F.ctl + CW_CVTQ, 1u);
              __syncthreads();
              const int bt = (int)MISC[0];
              if (bt >= CVT_NBATCH) break;
              cvt_experts8_batch(F, bt);
          }
#endif
#if ATTN_PIPE
          attn_queue_run(F, F.ctl + CW_ATTQ, MISC);
#else
          for (;;) {
              __syncthreads();
              if (F.tid == 0) MISC[0] = atomicAdd(F.ctl + CW_ATTQ, 1u);
              __syncthreads();
              const int uidx = (int)MISC[0];
              if (uidx >= ATT_UNITS) break;
              attn_unit_fast(F, uidx);
          }
#endif
#if MOE_FP8
          for (;;) {
              __syncthreads();
              if (F.tid == 0) MISC[0] = atomicAdd(F.ctl + CW_CVTQ, 1u);
              __syncthreads();
              const int bt = (int)MISC[0];
              if (bt >= CVT_NBATCH) break;
              cvt_experts8_batch(F, bt);
          }
#endif
        }
#else
        for (int vb = blockIdx.x; vb < 128 + 512; vb += F.G) { if (vb < 128) ph_mlstm_naive_unit(F, vb); else ph_attn_naive_block(F, vb - 128); }
#endif
    } SEAM(PH_MIX); STAMP(4);
#if FAST_ATTN
#if !(FUSE_ATTN_COMBINE && FUSE_TOKBLOCK)
    if (IN(PH_MIX)) { REFRESH(); ph_attn_combine(F); if (DUP == 13) ph_attn_combine(F); xcd_barrier(bar); }
#endif
#endif
    STAMP(5);
#if FUSE_TOKBLOCK
    if (IN(PH_BRANCH)) { REFRESH(); ph_tokblock(F); }
#else
#if FAST_BRANCH
    if (IN(PH_BRANCH)) { REFRESH(); ph_branch_fast(F); if (DUP == 4) ph_branch_fast(F); }
    SEAM(PH_BRANCH); STAMP(6);
    if (IN(PH_OUTPROJ)) { REFRESH(); ph_outproj_fast(F); if (DUP == 5) ph_outproj_fast(F); }
    SEAM(PH_OUTPROJ); STAMP(7);
#else
    if (IN(PH_BRANCH)) { REFRESH(); ph_branch_naive(F); }
    SEAM(PH_BRANCH);
    if (IN(PH_OUTPROJ)) { REFRESH(); ph_outproj_naive(F); }
    SEAM(PH_OUTPROJ);
#endif
    if (IN(PH_NORMMID)) { REFRESH(); ph_normmid(F);
#if FAST_EXPERTS
#if MOE_FP8
        if (DUP == 6) ph_normmid(F);
#else
        ph_cvt_experts(F); if (DUP == 6) { ph_normmid(F); ph_cvt_experts(F); }
#endif
#endif
    }
    SEAM(PH_NORMMID); STAMP(8);
#if FAST_ROUTER
    if (IN(PH_ROUTER)) { REFRESH(); ph_router_fast(F); if (DUP == 7) ph_router_fast(F);
#if FUSE_ROUTER_TOPK
        asm volatile("s_waitcnt vmcnt(0)" ::: "memory"); __syncthreads();
        REFRESH(); { RouterBlocks RB; RB.S.init(T, 256, 1024, nullptr, nullptr, F.G, (int)blockIdx.x); ph_topk4(F, RB); }
#endif
    }
#else
    if (IN(PH_ROUTER)) { REFRESH(); ph_router_naive(F); }
#endif
#if !FUSE_ROUTER_TOPK
    SEAM(PH_ROUTER);
#endif
    STAMP(9);
#endif
    #if FAST_MOE2
#if FAST_TOPK4
    if (IN(PH_TOPK) && !FUSE_ROUTER_TOPK && !FUSE_TOKBLOCK) { REFRESH(); ph_topk4(F, StrideBlocks{(int)blockIdx.x, F.G}); }
#else
    if (IN(PH_TOPK)) { REFRESH(); ph_topk2(F); if (DUP == 8) ph_topk2(F); }
#endif
    SEAM(PH_TOPK); STAMP(10);
#if SLOT8
    if (IN(PH_SCATTER)) { REFRESH(); ph_scatter4(F); if (DUP == 9) ph_scatter4(F); } SEAM(PH_SCATTER); STAMP(12);
    if (IN(PH_EXPERTS)) { REFRESH(); ph_gu8(F); if (DUP == 10) ph_gu8(F); xcd_barrier(bar); STAMP(13); REFRESH(); ph_down9(F); if (DUP == 11) ph_down9(F); if (DUP == 40 || DUP == 41) { int dm = (DUP == 40) ? 1 : 2; asm volatile("" : "+s"(dm)); ph_down9(F, dm); } }
    SEAM(PH_EXPERTS); STAMP(14);
    if (IN(PH_FINAL)) { REFRESH(); ph_combine9(F); if (DUP == 12) { __syncthreads(); ph_combine9(F); } }
#else
    if (IN(PH_SCATTER)) { REFRESH(); ph_scatter3(F); } SEAM(PH_SCATTER); STAMP(12);
#if MOE_FP8
    if (IN(PH_EXPERTS)) { REFRESH(); ph_gu8(F); if (DUP == 10) ph_gu8(F); xcd_barrier(bar); STAMP(13); REFRESH(); ph_down8(F, 0); if (DUP == 11) ph_down8(F, 0); xcd_barrier(bar); REFRESH(); ph_combine2(F, 0); xcd_barrier(bar); REFRESH(); ph_down8(F, 1); }
#else
    if (IN(PH_EXPERTS)) { REFRESH(); ph_gu2(F); if (DUP == 10) ph_gu2(F); xcd_barrier(bar); STAMP(13); REFRESH(); ph_down2(F, 0); if (DUP == 11) ph_down2(F, 0); xcd_barrier(bar); REFRESH(); ph_combine2(F, 0); xcd_barrier(bar); REFRESH(); ph_down2(F, 1); }
#endif
    SEAM(PH_EXPERTS); STAMP(14);
    if (IN(PH_FINAL)) { REFRESH(); ph_combine2(F, 1); if (DUP == 12) { __syncthreads(); } }
#endif
#else
#if DBG_TOPK_SERIAL
    if (IN(PH_TOPK)) { REFRESH(); ph_topk_serial(F); }
#else
    if (IN(PH_TOPK)) { REFRESH(); ph_topk(F); }
#endif
    SEAM(PH_TOPK); STAMP(10);
    if (IN(PH_SCAN)) { REFRESH(); ph_scan(F); } SEAM(PH_SCAN); STAMP(11);
    if (IN(PH_SCATTER)) { REFRESH(); ph_scatter(F); } SEAM(PH_SCATTER); STAMP(12);
#if DBG_BRUTE
    if (IN(PH_EXPERTS)) { REFRESH(); ph_experts_brute(F); }
#elif FAST_EXPERTS
    if (IN(PH_EXPERTS)) { REFRESH(); ph_gu_fast(F); xcd_barrier(bar); STAMP(13); REFRESH(); ph_down_fast(F); }
#else
    if (IN(PH_EXPERTS)) { REFRESH(); ph_experts_naive(F); }
#endif
    SEAM(PH_EXPERTS); STAMP(14);
    if (IN(PH_FINAL)) { REFRESH(); ph_final(F); }
#endif
#undef IN
#undef SEAM
}

extern "C" void kernel_launch(void* const* d_in, const int* in_sizes, int n_in, void* d_out, int out_size, void* d_ws, size_t ws_size, hipStream_t stream) {
    static int grid = 0;
    if (grid == 0) {
        if (n_in != N_IN || out_size != T * D || ws_size < WS_NEED) { fprintf(stderr, "kernel_launch: unexpected shapes (n_in %d, out %d, ws %zu); nothing launched\n", n_in, out_size, ws_size); grid = -1; return; }
        int dev = 0, cus = 0, per_cu = 0;
        if (hipGetDevice(&dev) != hipSuccess || hipDeviceGetAttribute(&cus, hipDeviceAttributeMultiprocessorCount, dev) != hipSuccess) { grid = -1; return; }
        if (hipFuncSetAttribute((const void*)mk_fwd, hipFuncAttributeMaxDynamicSharedMemorySize, LDS_BYTES) != hipSuccess) { fprintf(stderr, "kernel_launch: hipFuncSetAttribute failed\n"); grid = -1; return; }
        if (hipOccupancyMaxActiveBlocksPerMultiprocessor(&per_cu, (const void*)mk_fwd, NTHR, LDS_BYTES) != hipSuccess || per_cu < 1) fprintf(stderr, "kernel_launch: occupancy query reports %d\n", per_cu);
        (void)hipGetLastError();
        grid = cus;
    }
    if (grid < 0) return;
    if (hipMemsetAsync((char*)d_ws + WS_CTL, 0, CTL_ZERO_BYTES, stream) != hipSuccess) return;
    Args a{};
    for (int i = 0; i < N_IN; ++i) a.in[i] = (const float*)d_in[i];
    a.out = (float*)d_out; a.ws = (unsigned char*)d_ws;
#if MK_SPLIT
    for (int p = 0; p < N_PHASES; ++p) { a.ph_lo = p; a.ph_hi = p + 1; hipLaunchKernelGGL(mk_fwd, dim3(grid), dim3(NTHR), LDS_BYTES, stream, a); }
#elif defined(MK_CUTS)
    { const int cuts[] = MK_CUTS; const int nc = sizeof(cuts) / sizeof(int);
      for (int i = 0; i + 1 < nc; ++i) { a.ph_lo = cuts[i]; a.ph_hi = cuts[i + 1];
          if (i) hipMemsetAsync((char*)d_ws + WS_CTL + CW_BAR * 4, 0, XCD_BAR_WORDS * 4, stream);
          hipLaunchKernelGGL(mk_fwd, dim3(grid), dim3(NTHR), LDS_BYTES, stream, a); } }
#else
    a.ph_lo = 0; a.ph_hi = N_PHASES;
    hipLaunchKernelGGL(mk_fwd, dim3(grid), dim3(NTHR), LDS_BYTES, stream, a);
#endif
}
```

```cpp
#include <hip/hip_runtime.h>
#include <cstdio>
#include <cstdint>

#define GAS __attribute__((address_space(1)))
#define LAS __attribute__((address_space(3)))
typedef unsigned short bf16;
typedef float f32x4 __attribute__((ext_vector_type(4)));
typedef float f32x2 __attribute__((ext_vector_type(2)));
typedef unsigned u32x4 __attribute__((ext_vector_type(4)));
typedef unsigned u32x2 __attribute__((ext_vector_type(2)));

#ifndef DBG_MOE_SCALE
#define DBG_MOE_SCALE 1.0f
#endif
#ifndef DBG_BRUTE
#define DBG_BRUTE 0
#endif
#ifndef DBG_TOPK_SERIAL
#define DBG_TOPK_SERIAL 1
#endif

#ifndef FAST_INPROJ
#define FAST_INPROJ 1
#endif
#ifndef FAST_BRANCH
#define FAST_BRANCH 1
#endif
#ifndef FAST_ROUTER
#define FAST_ROUTER 1
#endif
#ifndef FAST_EXPERTS
#define FAST_EXPERTS 1
#endif
#ifndef FAST_ATTN
#define FAST_ATTN 1
#endif
#ifndef FAST_MLSTM
#define FAST_MLSTM 1
#endif
#ifndef DBG_STAMP_A
#define DBG_STAMP_A -1
#endif
#ifndef DBG_STAMP_B
#define DBG_STAMP_B 0
#endif
#ifndef FAST_MOE2
#define FAST_MOE2 1
#endif
#ifndef DUP
#define DUP -1
#ifndef ATTN_PIPE
#define ATTN_PIPE 1
#endif
#ifndef FUSE_ATTN_COMBINE
#define FUSE_ATTN_COMBINE 1
#endif
#ifndef MIX_CVT_FIRST
#define MIX_CVT_FIRST 3
#endif
#endif
#ifndef FAST_TOPK4
#define FAST_TOPK4 1
#endif
#ifndef MOE_FP8
#define MOE_FP8 1
#endif
#ifndef STAGGER_NS
#define STAGGER_NS 0
#endif
#ifndef INPROJ_FP8
#define INPROJ_FP8 1
#endif
#ifndef SLOT8
#define SLOT8 1
#endif
#ifndef GATES_GEMM
#define GATES_GEMM 1
#endif
#ifndef GATES_U8
#define GATES_U8 1
#endif
#ifndef DOWN_ALIGN
#define DOWN_ALIGN true
#endif
#ifndef FUSE_ROUTER_TOPK
#define FUSE_ROUTER_TOPK 1
#endif
#ifndef FUSE_TOKBLOCK
#define FUSE_TOKBLOCK 1
#endif
#ifndef MK_SPLIT
#define MK_SPLIT 0
#endif

constexpr int D = 1024, NB = 32, SEQ = 2048, T = NB * SEQ;
constexpr int INW = 7432;
constexpr int NE = 256, TOPK = 8;
constexpr int NTHR = 512, NWAVES = 8;
constexpr float EPS = 1e-6f;

enum { I_X = 0, I_C, I_POS, I_WADA, I_BADA, I_GPREMIX, I_GPOSTMIX, I_GPREFFN, I_GPOSTFFN, I_WIN, I_CONVW, I_CONVB, I_BGATES, I_GMLSTM,
       I_WBA, I_WBB, I_WOUT, I_RW, I_RB, I_WEG, I_WEU, I_WED, I_WSG, I_WSU, I_WSD, N_IN };

constexpr size_t MiB = 1u << 20;
constexpr size_t WS_CTL = 0, CTL_ZERO_BYTES = 1 * MiB;
constexpr size_t WS_MOD = 1 * MiB;
constexpr size_t WS_GATES = 2 * MiB;
constexpr size_t WS_TOPI = 4 * MiB;
constexpr size_t WS_TOPW = 6 * MiB;
constexpr size_t WS_ROWTOK = 8 * MiB;
constexpr size_t WS_ROWW = 12 * MiB;
constexpr size_t WS_UNITEXP = 16 * MiB;
constexpr size_t WS_EXPTILE0 = 16 * MiB + 65536;
constexpr size_t WS_HIST = 17 * MiB;
constexpr size_t WS_BASEREL = 17 * MiB + 262144;
constexpr size_t WS_TSG = 17 * MiB + 524288;
constexpr size_t WS_TE = 17 * MiB + 528384;
constexpr size_t WS_THOFF = 17 * MiB + 544768;
constexpr size_t WS_DEST = 52 * MiB;
constexpr size_t WS_DUMP = 18 * MiB;
constexpr size_t WS_ROPE = 20 * MiB;
constexpr size_t WS_W8T = 24 * MiB;
constexpr size_t WS_WIN_T = 25 * MiB;
constexpr size_t WS_WBA_T = 40 * MiB;
constexpr size_t WS_WBB_T = 41 * MiB;
constexpr size_t WS_WOUT_T = 43 * MiB;
constexpr size_t WS_WR_T = 45 * MiB;
constexpr size_t WS_WSGU_T = 46 * MiB;
constexpr size_t WS_WSD_T = 47 * MiB;
constexpr size_t WS_LSE = 48 * MiB;
constexpr size_t WS_Q = 64 * MiB, WS_K = 160 * MiB, WS_V = 256 * MiB;
constexpr size_t WS_MQK = 352 * MiB, WS_MV = 480 * MiB, WS_MO = 608 * MiB;
constexpr size_t WS_GAB = 736 * MiB;
constexpr size_t WS_MERGED = 192 * MiB;
constexpr size_t WS_YMIX = 64 * MiB;
constexpr size_t WS_H2 = 192 * MiB;
constexpr size_t WS_LOGITS = 384 * MiB;
constexpr size_t WS_WD = 384 * MiB;
constexpr size_t WS_WGU = 512 * MiB;
constexpr size_t WS_HIDS = 320 * MiB;
constexpr size_t WS_HIDR = 768 * MiB;
constexpr size_t WS_NEED = 1064 * MiB;
constexpr size_t WS_H8 = 992 * MiB;
constexpr size_t WS_WIN_T8 = 1056 * MiB;
constexpr size_t WS_H2F8 = 320 * MiB;
constexpr size_t WS_WD8 = 672 * MiB;
constexpr size_t WS_WGU8 = 864 * MiB;
constexpr size_t WS_WSGU8 = 46 * MiB;
constexpr size_t WS_WSD8 = 47 * MiB;
constexpr size_t WS_HIDS8 = 448 * MiB;
constexpr size_t WS_HIDR8 = 480 * MiB;
constexpr size_t OUT_H = 0;
constexpr size_t OUT_YA = 0;
constexpr size_t OUT_YB = 128 * MiB;
constexpr size_t OUT_OG = 32 * MiB;

constexpr int CW_BAR = 4096;
constexpr int CW_STAMP = 8192;
constexpr int CW_CVTQ = 12800;
constexpr int CW_ATTQ = 12288;
constexpr int CW_COUNTS = 16384, CW_CURSOR = 16384 + 256, CW_NT = 16384 + 512, CW_NT0 = 16384 + 576;

constexpr int LDS_BYTES = 147456;
constexpr int MISC_OFF = 131072 + 320;

__device__ __forceinline__ float bf2f(bf16 b) { return __uint_as_float(((unsigned)b) << 16); }
__device__ __forceinline__ unsigned f2bf(float f) { unsigned u = __float_as_uint(f); return (u + 0x7fffu + ((u >> 16) & 1u)) >> 16; }
__device__ __forceinline__ unsigned pk2(float lo, float hi) { return f2bf(lo) | (f2bf(hi) << 16); }
__device__ __forceinline__ float wave_sum(float v) {
#pragma unroll
    for (int o = 1; o < 64; o <<= 1) v += __shfl_xor(v, o);
    return v;
}
__device__ __forceinline__ float sigmoidf_(float x) { return 1.0f / (1.0f + expf(-x)); }
__device__ __forceinline__ float logsigmoidf_(float x) { return fminf(x, 0.f) - log1pf(expf(-fabsf(x))); }

#define XB_TMO      128
#define XB_XCNT(j)  (256  + 64 * (j))
#define XB_XSUB(j)  (1280 + 64 * (j))
#define XB_XGEN(j)  (2304 + 64 * (j))
#define XB_TOP      3328
#define XB_TOPGEN   3392
#define XCD_BAR_WORDS 3456
#define XB_SPIN_CAP (1u << 23)

__device__ __forceinline__ unsigned xb_ld(unsigned* p)              { return __hip_atomic_load(p, __ATOMIC_RELAXED, __HIP_MEMORY_SCOPE_AGENT); }
__device__ __forceinline__ unsigned xb_add(unsigned* p, unsigned v) { return __hip_atomic_fetch_add(p, v, __ATOMIC_RELAXED, __HIP_MEMORY_SCOPE_AGENT); }
__device__ __forceinline__ unsigned xb_xcc_id() { return (unsigned)__builtin_amdgcn_s_getreg((3 << 11) | 20) & 0xFu; }
#define XB_SPIN(cond, bar) do { unsigned _sp = 0; while (cond) { __builtin_amdgcn_s_sleep(1); \
    if ((++_sp & 255u) == 0u) { if (xb_ld(&(bar)[XB_TMO])) break; if (_sp > XB_SPIN_CAP) { atomicAdd(&(bar)[XB_TMO], 1u); break; } } } } while (0)

struct XcdBarrier { unsigned* bar; unsigned x; volatile LAS unsigned* st; };

__device__ __forceinline__ XcdBarrier xcd_barrier_post(unsigned* bar, volatile LAS unsigned* st) {
    XcdBarrier b; b.bar = bar; b.x = xb_xcc_id(); b.st = st;
    if (threadIdx.x == 0) (void)xb_add(&bar[XB_XCNT(b.x)], 1u);
    return b;
}
__device__ __forceinline__ void xcd_barrier_complete(unsigned* bar, unsigned x, unsigned& nloc, unsigned& nx) {
    const unsigned G = gridDim.x * gridDim.y * gridDim.z;
    unsigned sum, cnt, mine, sp = 0u;
    for (;;) {
        sum = 0u; cnt = 0u; mine = 0u;
#pragma unroll
        for (unsigned j = 0; j < 16; ++j) { const unsigned c = xb_ld(&bar[XB_XCNT(j)]); sum += c; cnt += (c > 0u) ? 1u : 0u; mine = (j == x) ? c : mine; }
        if (sum == G) break;
        __builtin_amdgcn_s_sleep(1);
        if ((++sp & 255u) == 0u) { if (xb_ld(&bar[XB_TMO])) break; if (sp > XB_SPIN_CAP) { atomicAdd(&bar[XB_TMO], 1u); break; } }
    }
    nloc = mine > 0u ? mine : 1u; nx = cnt > 0u ? cnt : 1u;
}
__device__ __forceinline__ void xcd_barrier(const XcdBarrier& b) {
    asm volatile("s_waitcnt vmcnt(0)" ::: "memory");
    __syncthreads();
    if (threadIdx.x == 0) {
        unsigned* bar = b.bar;
        __builtin_amdgcn_s_waitcnt(0);
        unsigned nloc = b.st[0], nx = b.st[1];
        if (nloc == 0u) { xcd_barrier_complete(bar, b.x, nloc, nx); b.st[0] = nloc; b.st[1] = nx; }
        const unsigned old = xb_add(&bar[XB_XSUB(b.x)], 1u);
        const unsigned gen = old / nloc;
        if (old + 1u == (gen + 1u) * nloc) {
            __builtin_amdgcn_fence(__ATOMIC_RELEASE, "agent");
            asm volatile("s_waitcnt vmcnt(0)" ::: "memory");
            const unsigned og = xb_add(&bar[XB_TOP], 1u);
            const unsigned tg = og / nx;
            if (og + 1u == (tg + 1u) * nx) xb_add(&bar[XB_TOPGEN], 1u);
            else XB_SPIN(xb_ld(&bar[XB_TOPGEN]) == tg, bar);
            __builtin_amdgcn_fence(__ATOMIC_ACQUIRE, "agent");
            xb_add(&bar[XB_XGEN(b.x)], 1u);
            asm volatile("s_waitcnt vmcnt(0)" ::: "memory");
        } else {
            XB_SPIN(xb_ld(&bar[XB_XGEN(b.x)]) == gen, bar);
            __builtin_amdgcn_fence(__ATOMIC_ACQUIRE, "agent");
            asm volatile("s_waitcnt vmcnt(0)" ::: "memory");
        }
    }
    __syncthreads();
}

struct Args { const float* in[N_IN]; float* out; unsigned char* ws; int ph_lo, ph_hi; };

struct Frame {
    LAS unsigned char* lds;
    unsigned* ctl;
    int tid, lane, wave, G;
    const float* in[N_IN];
    const int* pos;
    float* out; unsigned char* outb; unsigned char* ws;
};

struct ARowGlobal {
    const bf16* base; size_t ld; int m0; const int* gather;
    __device__ __forceinline__ void load4(int r, int k, float (&o)[4]) const {
        const size_t row = gather ? (size_t)gather[m0 + r] : (size_t)(m0 + r);
        const u32x2 v = *(const u32x2*)(base + row * ld + k);
        o[0] = __uint_as_float(v.x << 16); o[1] = __uint_as_float(v.x & 0xffff0000u); o[2] = __uint_as_float(v.y << 16); o[3] = __uint_as_float(v.y & 0xffff0000u);
    }
};
struct ARowLds {
    const LAS bf16* base;
    __device__ __forceinline__ void load4(int r, int k, float (&o)[4]) const {
        const u32x2 v = *(const LAS u32x2*)(base + r * 256 + k);
        o[0] = __uint_as_float(v.x << 16); o[1] = __uint_as_float(v.x & 0xffff0000u); o[2] = __uint_as_float(v.y << 16); o[3] = __uint_as_float(v.y & 0xffff0000u);
    }
};
template <class ARow>
__device__ __forceinline__ void ngemm_acc(LAS float* As, LAS float* Bs, const ARow& arow, const float* __restrict__ W, int ldw, int K, int n0, int Nvalid, float (&acc)[8][4]) {
    const int tid = threadIdx.x, ty = tid >> 5, tx = tid & 31;
    const int ar = tid >> 2, ak = (tid & 3) * 4;
    const int bk = tid >> 5, bn = (tid & 31) * 4;
    for (int k0 = 0; k0 < K; k0 += 16) {
        float a4[4]; arow.load4(ar, k0 + ak, a4);
        f32x4 b4 = (f32x4){0.f, 0.f, 0.f, 0.f};
        if (n0 + bn < Nvalid) b4 = *(const f32x4*)(W + (size_t)(k0 + bk) * ldw + n0 + bn);
        __syncthreads();
        As[(ak + 0) * 132 + ar] = a4[0]; As[(ak + 1) * 132 + ar] = a4[1]; As[(ak + 2) * 132 + ar] = a4[2]; As[(ak + 3) * 132 + ar] = a4[3];
        *(LAS f32x4*)(Bs + bk * 132 + bn) = b4;
        __syncthreads();
#pragma unroll 4
        for (int kk = 0; kk < 16; ++kk) {
            const f32x4 a0 = *(const LAS f32x4*)(As + kk * 132 + ty * 8), a1 = *(const LAS f32x4*)(As + kk * 132 + ty * 8 + 4);
            const f32x4 b = *(const LAS f32x4*)(Bs + kk * 132 + tx * 4);
#pragma unroll
            for (int j = 0; j < 4; ++j) {
                acc[0][j] += a0[0] * b[j]; acc[1][j] += a0[1] * b[j]; acc[2][j] += a0[2] * b[j]; acc[3][j] += a0[3] * b[j];
                acc[4][j] += a1[0] * b[j]; acc[5][j] += a1[1] * b[j]; acc[6][j] += a1[2] * b[j]; acc[7][j] += a1[3] * b[j];
            }
        }
    }
    __syncthreads();
}
#define ZERO_ACC(a) do { _Pragma("unroll") for (int _i = 0; _i < 8; ++_i) _Pragma("unroll") for (int _j = 0; _j < 4; ++_j) a[_i][_j] = 0.f; } while (0)


namespace g2 {
typedef short bf16x8 __attribute__((ext_vector_type(8)));
typedef int v4i_t __attribute__((ext_vector_type(4)));
typedef int v8i_t __attribute__((ext_vector_type(8)));
constexpr int BM = 256, BK = 64, HALF = 128, HTB = HALF * BK * 2, STAGE_BYTES = 8 * HTB, NXCD = 8, WGM = 8;
__host__ __device__ __forceinline__ int lds_byte(int r, int c) { const int st = (r >> 4) * 2 + (c >> 5), rr = r & 15, cc = c & 31, ob = rr * 64 + cc * 2; return st * 1024 + (ob ^ (((ob >> 9) & 1) << 5)); }
__host__ __device__ __forceinline__ void stage_rc(int b, int& R, int& C) { const int st = b / 1024, sb = b % 1024, swz = sb ^ (((sb >> 9) & 1) << 5); R = (st >> 1) * 16 + swz / 64; C = (st & 1) * 32 + (swz % 64) / 2; }
__host__ __device__ __forceinline__ int perm32(int rho) { const int n = rho >> 4, i = rho & 15; return 8 * (i >> 2) + 4 * n + (i & 3); }
__device__ __forceinline__ unsigned cvt_pk_bf16(float lo, float hi) { unsigned r; asm volatile("v_cvt_pk_bf16_f32 %0, %1, %2" : "=v"(r) : "v"(lo), "v"(hi)); return r; }

struct UnitMN { int pm, pn; };
struct DenseOrder {
    typedef UnitMN Unit;
    int nM, nN, nwg, G, c, Kk, pnoff, pncut, pnskip;
    const char* A; const char* Bt;
    __device__ void init(int M, int N, int K, const void* A_, const void* Bt_, int G_, int c_) { nM = M / BM; nN = N / BM; nwg = nM * nN; G = G_; c = c_; Kk = K; A = (const char*)A_; Bt = (const char*)Bt_; pnoff = 0; pncut = 1 << 20; pnskip = 0; }
    __device__ __forceinline__ bool next(int i, Unit& u) const {
        const long L = (long)i * G + c; if (L >= nwg) return false;
        int wgid = (int)L; { const int q = nwg / NXCD, r = nwg % NXCD, xcd = wgid % NXCD, off = wgid / NXCD; wgid = (xcd < r ? xcd * (q + 1) : r * (q + 1) + (xcd - r) * q) + off; }
        const int nig = WGM * nN, gid = wgid / nig, fm = gid * WGM, gsz = (nM - fm) < WGM ? (nM - fm) : WGM;
        u.pm = fm + ((wgid % nig) % gsz); u.pn = (wgid % nig) / gsz; if (u.pn >= pncut) u.pn += pnskip; u.pn += pnoff; return true;
    }
    __device__ __forceinline__ int K(const Unit&) const { return Kk; }
    __device__ __forceinline__ const char* a_base(const Unit&) const { return A; }
    __device__ __forceinline__ unsigned a_row_off(const Unit& u, int r) const { return (unsigned)(u.pm * BM + r) * (unsigned)(Kk * 2); }
    __device__ __forceinline__ const char* b_base(const Unit& u) const { return Bt + (size_t)u.pn * BM * Kk * 2; }
};

template <class Epi, class Sched, bool F8 = false, bool ALIGN_EPI = true>
__device__ __forceinline__ void gemm_phase(LAS unsigned char* lds, const Sched& S, const Epi& E, int f8_scale_b = 127) {
    const int tid = threadIdx.x, wid = __builtin_amdgcn_readfirstlane(tid >> 6), lane = tid & 63, wr = wid >> 2, wc = wid & 3, fr = lane & 15, fq = lane >> 4;
#define G2_RC(i, R, Rb, C2) int R, Rb; unsigned C2; { int _R, _C; stage_rc(tid * 16 + (i) * 8192, _R, _C); R = _R; Rb = Epi::PERM ? (64 * (_R >> 5) + 16 * ((_R & 15) >> 2) + 4 * ((_R & 31) >> 4) + (_R & 3)) : _R; C2 = (unsigned)_C * 2u; }
    const size_t kstep = (size_t)(BK * 2);
    const unsigned ldsw = (unsigned)wid * 1024u;
    const int aoff = lds_byte(wr * 64 + fr, fq * 8), boff = lds_byte(wc * 32 + fr, fq * 8);
#define G2_SA(b, h) (((b) * 2 + (h)) * HTB)
#define G2_SB(b, h) ((4 + (b) * 2 + (h)) * HTB)
#define G2_STAGE(bufoff, gbase, voff) do { _Pragma("unroll") for (int _i = 0; _i < 2; ++_i) \
        __builtin_amdgcn_global_load_lds((const unsigned*)((const char*)(gbase) + (voff)[_i]), (LAS unsigned*)(lds + (bufoff) + ldsw + _i * 8192), 16, 0, 0); } while (0)
#define G2_LDA(dst, b, h) do { _Pragma("unroll") for (int m = 0; m < 4; ++m) { const v4i_t _lo = *(const LAS v4i_t*)(lds + G2_SA(b, h) + aoff + m * 2048), _hi = *(const LAS v4i_t*)(lds + G2_SA(b, h) + aoff + m * 2048 + 1024); \
        dst[m] = __builtin_shufflevector(_lo, _hi, 0, 1, 2, 3, 4, 5, 6, 7); } } while (0)
#define G2_LDB(dst, b, h) do { _Pragma("unroll") for (int n = 0; n < 2; ++n) { const v4i_t _lo = *(const LAS v4i_t*)(lds + G2_SB(b, h) + boff + n * 2048), _hi = *(const LAS v4i_t*)(lds + G2_SB(b, h) + boff + n * 2048 + 1024); \
        dst[n] = __builtin_shufflevector(_lo, _hi, 0, 1, 2, 3, 4, 5, 6, 7); } } while (0)
#define G2_MMA(ai, bj, At, Bt) do { __builtin_amdgcn_s_setprio(1); _Pragma("unroll") for (int m = 0; m < 4; ++m) _Pragma("unroll") for (int n = 0; n < 2; ++n) { \
        if constexpr (F8) asm volatile("v_mfma_scale_f32_16x16x128_f8f6f4 %0, %1, %2, %0, %3, %4 op_sel_hi:[0,0,0]" : "+v"(acc[ai][bj][m][n]) : "v"(Bt[n]), "v"(At[m]), "v"(f8_sb), "v"(f8_sa)); \
        else { acc[ai][bj][m][n] = __builtin_amdgcn_mfma_f32_16x16x32_bf16(__builtin_bit_cast(bf16x8, __builtin_shufflevector(Bt[n], Bt[n], 0, 1, 2, 3)), __builtin_bit_cast(bf16x8, __builtin_shufflevector(At[m], At[m], 0, 1, 2, 3)), acc[ai][bj][m][n], 0, 0, 0); \
               acc[ai][bj][m][n] = __builtin_amdgcn_mfma_f32_16x16x32_bf16(__builtin_bit_cast(bf16x8, __builtin_shufflevector(Bt[n], Bt[n], 4, 5, 6, 7)), __builtin_bit_cast(bf16x8, __builtin_shufflevector(At[m], At[m], 4, 5, 6, 7)), acc[ai][bj][m][n], 0, 0, 0); } } \
        __builtin_amdgcn_s_setprio(0); } while (0)
#define G2_WAIT_V(n) asm volatile("s_waitcnt vmcnt(" #n ")" ::: "memory")
#define G2_WAIT_L(n) asm volatile("s_waitcnt lgkmcnt(" #n ")" ::: "memory")
#define G2_BAR __builtin_amdgcn_s_barrier()
#define G2_SCHED __builtin_amdgcn_sched_barrier(0)
    const int f8_sb = f8_scale_b, f8_sa = 127;
    typename Sched::Unit cur, nxt; int ui = 0;
    if (!S.next(0, cur)) return;
    f32x4 acc[2][2][4][2];
#pragma unroll
    for (int a = 0; a < 2; ++a)
#pragma unroll
        for (int b = 0; b < 2; ++b)
#pragma unroll
            for (int m = 0; m < 4; ++m)
#pragma unroll
                for (int n = 0; n < 2; ++n) acc[a][b][m][n] = (f32x4){0.f, 0.f, 0.f, 0.f};
    v8i_t At[4], B0[2], B1[2];
    unsigned vA0[2], vA1[2], vN0[2], vN1[2], vBc[2], vBN[2];
    int Kc = S.K(cur); asm volatile("" : "+s"(Kc)); int nt = Kc / BK;
    constexpr int HROWS = Epi::PERM ? 8 : HALF;
    size_t hc = (size_t)HROWS * Kc * 2, hN = hc;
#pragma unroll
    for (int i = 0; i < 2; ++i) { G2_RC(i, R, Rb, C2); vA0[i] = S.a_row_off(cur, R) + C2; vA1[i] = S.a_row_off(cur, HALF + R) + C2; vN0[i] = vA0[i]; vN1[i] = vA1[i];
        vBc[i] = (unsigned)(Rb * Kc) * 2u + C2; vBN[i] = vBc[i]; }
    const char* cA = S.a_base(cur);
    const char* cB = S.b_base(cur);
    G2_STAGE(G2_SB(0, 0), cB, vBc); G2_STAGE(G2_SB(0, 1), cB + hc, vBc); G2_STAGE(G2_SA(0, 0), cA, vA0); G2_STAGE(G2_SA(0, 1), cA, vA1);
    if (wr == 1) G2_BAR;
    G2_WAIT_V(2); G2_BAR;
    G2_STAGE(G2_SB(1, 0), cB + kstep, vBc); G2_STAGE(G2_SA(1, 0), cA + kstep, vA0); G2_STAGE(G2_SB(1, 1), cB + hc + kstep, vBc);
    G2_WAIT_V(6); G2_BAR;
    bool has_next = S.next(1, nxt);
    typename Sched::Unit nn;
    for (;;) {
        const bool has_nn = has_next ? S.next(ui + 2, nn) : false;
        const char* nA = has_next ? S.a_base(nxt) : cA; const char* nB = has_next ? S.b_base(nxt) : cB;
        int Kn = has_next ? S.K(nxt) : Kc; asm volatile("" : "+s"(Kn));
        unsigned vP0[2], vP1[2];
        if (has_next) {
#pragma unroll
            for (int i = 0; i < 2; ++i) { G2_RC(i, R, Rb, C2); (void)Rb; vP0[i] = S.a_row_off(nxt, R) + C2; vP1[i] = S.a_row_off(nxt, HALF + R) + C2; } }
        for (int t = 0; t < nt; t += 2) {
            const bool last = (t == nt - 2);
            const char* a1 = cA + (size_t)(t + 1) * kstep;
            const char* a2 = last ? nA : cA + (size_t)(t + 2) * kstep; const char* b2 = last ? nB : cB + (size_t)(t + 2) * kstep;
            const char* a3 = a2 + kstep; const char* b3 = b2 + kstep;
            if (last && has_next) { hN = (size_t)HROWS * Kn * 2;
#pragma unroll
                for (int i = 0; i < 2; ++i) { G2_RC(i, R, Rb, C2); (void)R; vN0[i] = vP0[i]; vN1[i] = vP1[i]; vBN[i] = (unsigned)(Rb * Kn) * 2u + C2; } }
            G2_LDB(B0, 0, 0); G2_LDB(B1, 0, 1); G2_SCHED; G2_LDA(At, 0, 0); G2_STAGE(G2_SA(1, 1), a1, vA1);
            G2_WAIT_V(8); G2_WAIT_L(0); G2_BAR; G2_MMA(0, 0, At, B0); G2_MMA(0, 1, At, B1); G2_BAR; G2_SCHED;
            G2_LDA(At, 0, 1); G2_STAGE(G2_SB(0, 0), b2, vBN); G2_STAGE(G2_SB(0, 1), b2 + hN, vBN); G2_STAGE(G2_SA(0, 0), a2, vN0);
            G2_WAIT_V(8); G2_WAIT_L(0); G2_BAR; G2_MMA(1, 0, At, B0); G2_MMA(1, 1, At, B1); G2_BAR; G2_SCHED;
            G2_LDB(B0, 1, 0); G2_LDB(B1, 1, 1); G2_SCHED; G2_LDA(At, 1, 0); G2_STAGE(G2_SA(0, 1), a2, vN1);
            G2_WAIT_V(8); G2_WAIT_L(0); G2_BAR; G2_MMA(0, 0, At, B0); G2_MMA(0, 1, At, B1); G2_BAR; G2_SCHED;
            G2_LDA(At, 1, 1); G2_STAGE(G2_SB(1, 0), b3, vBN); G2_STAGE(G2_SB(1, 1), b3 + hN, vBN); G2_STAGE(G2_SA(1, 0), a3, vN0);
            G2_WAIT_V(8); G2_WAIT_L(0); G2_BAR; G2_MMA(1, 0, At, B0); G2_MMA(1, 1, At, B1); G2_BAR; G2_SCHED;
        }
        if constexpr (ALIGN_EPI) { if (wr == 0) G2_BAR; }
        int t2 = threadIdx.x; asm volatile("" : "+v"(t2));
        const bool zero = E(acc, cur, wr, wc, t2 & 15, (t2 & 63) >> 4);
        if (!has_next) break;
        if (zero) {
#pragma unroll
        for (int a = 0; a < 2; ++a)
#pragma unroll
            for (int b = 0; b < 2; ++b)
#pragma unroll
                for (int m = 0; m < 4; ++m)
#pragma unroll
                    for (int n = 0; n < 2; ++n) acc[a][b][m][n] = (f32x4){0.f, 0.f, 0.f, 0.f};
        }
        cur = nxt; nxt = nn; has_next = has_nn; cA = nA; cB = nB; Kc = Kn; nt = Kc / BK; hc = hN; ++ui;
#pragma unroll
        for (int i = 0; i < 2; ++i) { vA0[i] = vN0[i]; vA1[i] = vN1[i]; vBc[i] = vBN[i]; }
        if constexpr (ALIGN_EPI) { if (wr == 1) G2_BAR; }
    }
    G2_WAIT_V(0);
    if constexpr (!ALIGN_EPI) { if (wr == 0) G2_BAR; }
    G2_BAR;
#undef G2_RC
#undef G2_SA
#undef G2_SB
#undef G2_STAGE
#undef G2_LDA
#undef G2_LDB
#undef G2_MMA
#undef G2_WAIT_V
#undef G2_WAIT_L
#undef G2_BAR
#undef G2_SCHED
}
}

__device__ __forceinline__ void tr_item(const float* __restrict__ W, int ldw, int k0, int n0src, bf16* WT, int Kd, int drow0, LAS float* scr, int lane) {
#pragma unroll 8
    for (int i = 0; i < 32; ++i) { const int kk = 2 * i + (lane >> 5); scr[kk * 33 + (lane & 31)] = W[(size_t)(k0 + kk) * ldw + n0src + (lane & 31)]; }
    asm volatile("s_waitcnt lgkmcnt(0)" ::: "memory");
    const int c = lane & 7;
#pragma unroll
    for (int j = 0; j < 4; ++j) { const int n = (lane >> 3) + 8 * j; const LAS float* sp = scr + (8 * c) * 33 + n;
        u32x4 o; o.x = pk2(sp[0 * 33], sp[1 * 33]); o.y = pk2(sp[2 * 33], sp[3 * 33]); o.z = pk2(sp[4 * 33], sp[5 * 33]); o.w = pk2(sp[6 * 33], sp[7 * 33]);
        *(u32x4*)(WT + (size_t)(drow0 + n) * Kd + k0 + 8 * c) = o; }
    asm volatile("s_waitcnt lgkmcnt(0)" ::: "memory");
}


__device__ __forceinline__ unsigned pk4_fp8(float a, float b, float c, float d) { int r = __builtin_amdgcn_cvt_pk_fp8_f32(a, b, 0, false); r = __builtin_amdgcn_cvt_pk_fp8_f32(c, d, r, true); return (unsigned)r; }
__device__ __forceinline__ void tr_item8p(const float* __restrict__ Wcol  , int ldw, int k0, unsigned char* WT, int Kd, int drow0, float sc, LAS float* scr, int lane) {
#pragma unroll 8
    for (int i = 0; i < 32; ++i) { const int kk = 2 * i + (lane >> 5); scr[kk * 33 + (lane & 31)] = Wcol[(size_t)(k0 + kk) * ldw] * sc; }
    asm volatile("s_waitcnt lgkmcnt(0)" ::: "memory");
    const int c = lane & 7;
#pragma unroll
    for (int j = 0; j < 4; ++j) { const int n = (lane >> 3) + 8 * j; const LAS float* sp = scr + (8 * c) * 33 + n;
        u32x2 o; o.x = pk4_fp8(sp[0 * 33], sp[1 * 33], sp[2 * 33], sp[3 * 33]); o.y = pk4_fp8(sp[4 * 33], sp[5 * 33], sp[6 * 33], sp[7 * 33]);
        *(u32x2*)(WT + (size_t)(drow0 + n) * Kd + k0 + 8 * c) = o; }
    asm volatile("s_waitcnt lgkmcnt(0)" ::: "memory");
}
__device__ __forceinline__ void tr_item8(const float* __restrict__ W, int ldw, int k0, int n0src, unsigned char* WT, int Kd, int drow0, float sc, LAS float* scr, int lane) {
    tr_item8p(W + n0src + (lane & 31), ldw, k0, WT, Kd, drow0, sc, scr, lane);
}
__device__ __forceinline__ void ph_cvt_small(Frame& F) {
    LAS float* scr = (LAS float*)(F.lds) + F.wave * (64 * 33);
    const int gw = blockIdx.x * NWAVES + F.wave, NGW = F.G * NWAVES;
    constexpr int I_IN = 16 * 232, I_BA = 4 * 32, I_BB = 16 * 32, I_OUT = 16 * 32, I_R = 16 * 8, I_SGU = 16 * 16, I_SD = 4 * 32;
    constexpr int NIT = I_IN + I_BA + I_BB + I_OUT + I_R + I_SGU + I_SD;
    for (int it = gw; it < NIT + 1; it += NGW) {
        int r = it;
        if (r < I_IN) { const int kb = r / 232, nb = r % 232, d0 = nb * 32; tr_item(F.in[I_WIN], INW, kb * 64, d0 < 5376 ? d0 : d0 + 8, (bf16*)(F.ws + WS_WIN_T), 1024, d0, scr, F.lane);
#if INPROJ_FP8
            tr_item8(F.in[I_WIN], INW, kb * 64, d0 < 5376 ? d0 : d0 + 8, F.ws + WS_WIN_T8, 1024, d0, 32.0f, scr, F.lane);
#endif
            continue; } r -= I_IN;
        if (r < I_BA) { const int kb = r / 32, nb = r % 32; tr_item(F.in[I_WBA], 1024, kb * 64, nb * 32, (bf16*)(F.ws + WS_WBA_T), 256, nb * 32, scr, F.lane); continue; } r -= I_BA;
        if (r < I_BB) { const int kb = r / 32, nb = r % 32; tr_item(F.in[I_WBB], 1024, kb * 64, nb * 32, (bf16*)(F.ws + WS_WBB_T), 1024, nb * 32, scr, F.lane); continue; } r -= I_BB;
        if (r < I_OUT) { const int kb = r / 32, nb = r % 32; tr_item(F.in[I_WOUT], 1024, kb * 64, nb * 32, (bf16*)(F.ws + WS_WOUT_T), 1024, nb * 32, scr, F.lane); continue; } r -= I_OUT;
        if (r < I_R) { const int kb = r / 8, nb = r % 8; tr_item(F.in[I_RW], 256, kb * 64, nb * 32, (bf16*)(F.ws + WS_WR_T), 1024, nb * 32, scr, F.lane); continue; } r -= I_R;
        if (r < I_SGU) { const int kb = r / 16, nb = r % 16, d0 = nb * 32, pn = d0 >> 8, q = d0 & 255; const bool up = q >= 128; const int src = pn * 128 + (q & 127);
            tr_item(up ? F.in[I_WSU] : F.in[I_WSG], 256, kb * 64, src, (bf16*)(F.ws + WS_WSGU_T), 1024, d0, scr, F.lane); continue; } r -= I_SGU;
        if (r < I_SD) { const int kb = r / 32, nb = r % 32; tr_item(F.in[I_WSD], 1024, kb * 64, nb * 32, (bf16*)(F.ws + WS_WSD_T), 256, nb * 32, scr, F.lane); continue; } r -= I_SD;
        { float* W8T = (float*)(F.ws + WS_W8T); const float* W = F.in[I_WIN];
          for (int i = F.lane; i < 8 * 1024; i += 64) { const int k = i >> 3, g = i & 7; W8T[i] = W[(size_t)k * INW + 5376 + g]; } }
    }
#if GATES_GEMM
    { bf16* WT = (bf16*)(F.ws + WS_WIN_T) + (size_t)7424 * 1024; const float* W = F.in[I_WIN];
      for (int i = blockIdx.x * NTHR + F.tid; i < 256 * 1024 / 8; i += F.G * NTHR) { const int rr = i >> 7, k0 = (i & 127) * 8; u32x4 o = (u32x4){0u, 0u, 0u, 0u};
          if (rr < 8) { float v[8];
#pragma unroll
              for (int e = 0; e < 8; ++e) v[e] = W[(size_t)(k0 + e) * INW + 5376 + rr];
              o.x = pk2(v[0], v[1]); o.y = pk2(v[2], v[3]); o.z = pk2(v[4], v[5]); o.w = pk2(v[6], v[7]); }
          *(u32x4*)(WT + (size_t)rr * 1024 + k0) = o; } }
#endif
}

__device__ __forceinline__ void ph_mod(Frame& F) {
    LAS float* scT = (LAS float*)F.lds;
    const float* c = F.in[I_C]; const float* W = F.in[I_WADA]; const float* bias = F.in[I_BADA];
    float* mod = (float*)(F.ws + WS_MOD);
    bool filled = false;
    for (int vb = blockIdx.x; vb < 96; vb += F.G) {
        __syncthreads();
        if (!filled) { for (int i = F.tid; i < 32 * 1024; i += NTHR) { const int b = i >> 10, k = i & 1023; const float v = c[i]; scT[k * 32 + b] = v / (1.0f + expf(-v)); } filled = true; }
        __syncthreads();
        const int n = vb * 64 + F.lane;
        float acc[32];
#pragma unroll
        for (int b = 0; b < 32; ++b) acc[b] = 0.f;
#pragma unroll 4
        for (int kk = 0; kk < 128; ++kk) { const int k = F.wave * 128 + kk;
            const float w = W[(size_t)k * 6144 + n];
#pragma unroll
            for (int b4 = 0; b4 < 8; ++b4) { const f32x4 sv = *(const LAS f32x4*)(scT + k * 32 + b4 * 4);
                acc[b4 * 4 + 0] += sv[0] * w; acc[b4 * 4 + 1] += sv[1] * w; acc[b4 * 4 + 2] += sv[2] * w; acc[b4 * 4 + 3] += sv[3] * w; } }
        __syncthreads();
        LAS float* part = (LAS float*)F.lds;
#pragma unroll
        for (int b = 0; b < 32; ++b) part[(F.wave * 32 + b) * 64 + F.lane] = acc[b];
        filled = false;
        __syncthreads();
        for (int i = F.tid; i < 32 * 64; i += NTHR) { const int b = i >> 6, col = i & 63; float sum = bias[vb * 64 + col];
#pragma unroll
            for (int w8 = 0; w8 < 8; ++w8) sum += part[(w8 * 32 + b) * 64 + col];
            mod[b * 6144 + vb * 64 + col] = sum; }
    }
}

__device__ __forceinline__ float wave_sum8(const float (&v)[8], int lane) {
    float a[4], b2[2], c;
#pragma unroll
    for (int i = 0; i < 4; ++i) { const float keep = (lane & 1) ? v[2 * i + 1] : v[2 * i], give = (lane & 1) ? v[2 * i] : v[2 * i + 1]; a[i] = keep + __shfl_xor(give, 1); }
#pragma unroll
    for (int i = 0; i < 2; ++i) { const float keep = (lane & 2) ? a[2 * i + 1] : a[2 * i], give = (lane & 2) ? a[2 * i] : a[2 * i + 1]; b2[i] = keep + __shfl_xor(give, 2); }
    { const float keep = (lane & 4) ? b2[1] : b2[0], give = (lane & 4) ? b2[0] : b2[1]; c = keep + __shfl_xor(give, 4); }
    c += __shfl_xor(c, 8); c += __shfl_xor(c, 16); c += __shfl_xor(c, 32);
    return c;
}
__device__ __forceinline__ void ph_norm1(Frame& F, int mode = 0) {
    const float* x = F.in[I_X]; const float* g = F.in[I_GPREMIX]; const float* mod = (const float*)(F.ws + WS_MOD);
    bf16* H = (bf16*)(F.outb + OUT_H);
    const float* W8T = (const float*)(F.ws + WS_W8T); float* GATES = (float*)(F.ws + WS_GATES); float* ROPE = (float*)(F.ws + WS_ROPE); const float* bg = F.in[I_BGATES];
    const float inv = powf(500000.0f, -(float)(F.lane & 7) / 8.0f); const float bgl = bg[F.lane & 7];
    for (int ci = blockIdx.x * NWAVES + F.wave; ci < T / 32; ci += F.G * NWAVES) {
        const int tb = ci * 32, b = tb / SEQ; const float* sh = mod + b * 6144, *scl = sh + 1024;
        f32x4 gs[4], h1[4];
#pragma unroll
        for (int j = 0; j < 4; ++j) { const int c = F.lane * 4 + 256 * j; const f32x4 gg = *(const f32x4*)(g + c), s1 = *(const f32x4*)(scl + c); h1[j] = *(const f32x4*)(sh + c); gs[j] = gg * (s1 + 1.0f); }
        const int posv = F.pos[tb + (F.lane & 31)];
        f32x4 vn[4];
#pragma unroll
        for (int j = 0; j < 4; ++j) vn[j] = *(const f32x4*)(x + (size_t)tb * D + F.lane * 4 + 256 * j);
#pragma unroll 1
        for (int i = 0; i < 32; ++i) {
            const int t = tb + i;
            asm volatile("" ::: "memory");
            f32x4 v[4]; float ss = 0.f;
#pragma unroll
            for (int j = 0; j < 4; ++j) { v[j] = vn[j]; ss += v[j][0] * v[j][0] + v[j][1] * v[j][1] + v[j][2] * v[j][2] + v[j][3] * v[j][3]; }
            if (i + 1 < 32) {
#pragma unroll
                for (int j = 0; j < 4; ++j) vn[j] = *(const f32x4*)(x + (size_t)(t + 1) * D + F.lane * 4 + 256 * j); }
            const float rstd = rsqrtf(wave_sum(ss) * (1.0f / D) + EPS);
            float gacc[8];
#pragma unroll
            for (int gi = 0; gi < 8; ++gi) gacc[gi] = 0.f;
#pragma unroll
            for (int j = 0; j < 4; ++j) { const int c = F.lane * 4 + 256 * j;
                const f32x4 o = v[j] * rstd * gs[j] + h1[j];
                u32x2 w; w.x = pk2(o[0], o[1]); w.y = pk2(o[2], o[3]); *(u32x2*)(H + (size_t)t * D + c) = w;
#if INPROJ_FP8
                *(unsigned*)(F.ws + WS_H8 + (size_t)t * D + c) = pk4_fp8(o[0], o[1], o[2], o[3]);
#endif
                if (mode != 1 && !GATES_GEMM)
#pragma unroll
                for (int e = 0; e < 4; ++e) { const f32x4 wa = *(const f32x4*)(W8T + (size_t)(c + e) * 8), wb = *(const f32x4*)(W8T + (size_t)(c + e) * 8 + 4);
                    gacc[0] += o[e] * wa[0]; gacc[1] += o[e] * wa[1]; gacc[2] += o[e] * wa[2]; gacc[3] += o[e] * wa[3]; gacc[4] += o[e] * wb[0]; gacc[5] += o[e] * wb[1]; gacc[6] += o[e] * wb[2]; gacc[7] += o[e] * wb[3]; }
                asm volatile("" ::: "memory"); }
#if GATES_GEMM
            const float gsum = 0.f;
#else
            if (mode == 1) continue;
            const float gsum = wave_sum8(gacc, F.lane);
#endif
            const float ang = (float)__builtin_amdgcn_readlane(posv, i) * inv; const float kk = rintf(ang * 0.15915494309189535f);
            float rv = fmaf(ang, 0.15915494309189535f, -kk); rv = fmaf(ang, 6.4206383e-9f, rv);
            if (!GATES_GEMM) { if (F.lane < 8) GATES[(size_t)t * 8 + F.lane] = gsum + bgl; }
            ROPE[(size_t)t * 16 + (F.lane & 15)] = (F.lane & 8) ? __builtin_amdgcn_sinf(rv) : __builtin_amdgcn_cosf(rv);
        }
    }
}

__device__ __forceinline__ void ph_inproj_naive(Frame& F) {
    LAS float* As = (LAS float*)F.lds; LAS float* Bs = As + 16 * 132;
    const bf16* H = (const bf16*)(F.outb + OUT_H); const float* W = F.in[I_WIN]; const float* bg = F.in[I_BGATES];
    bf16* Q = (bf16*)(F.ws + WS_Q); bf16* Kt = (bf16*)(F.ws + WS_K); bf16* V = (bf16*)(F.ws + WS_V); bf16* MQK = (bf16*)(F.ws + WS_MQK); bf16* MV = (bf16*)(F.ws + WS_MV);
    bf16* MO = (bf16*)(F.ws + WS_MO); bf16* GAB = (bf16*)(F.ws + WS_GAB); float* GATES = (float*)(F.ws + WS_GATES);
    constexpr int NTN = (INW + 127) / 128;
    const int ty = F.tid >> 5, tx = F.tid & 31;
    for (int vb = blockIdx.x; vb < (T / 128) * NTN; vb += F.G) {
        const int tm = vb / NTN, tn = vb % NTN, m0 = tm * 128, n0 = tn * 128;
        float acc[8][4]; ZERO_ACC(acc);
        ARowGlobal ar{H, (size_t)D, m0, nullptr};
        ngemm_acc(As, Bs, ar, W, INW, D, n0, INW, acc);
#pragma unroll
        for (int i = 0; i < 8; ++i)
#pragma unroll
            for (int j = 0; j < 4; ++j) {
                const size_t row = (size_t)(m0 + ty * 8 + i); const int col = n0 + tx * 4 + j; const float v = acc[i][j];
                if (col < 768) Q[row * 768 + col] = (bf16)f2bf(v);
                else if (col < 1536) Kt[row * 768 + col - 768] = (bf16)f2bf(v);
                else if (col < 2304) V[row * 768 + col - 1536] = (bf16)f2bf(v);
                else if (col < 3328) MQK[row * 1024 + col - 2304] = (bf16)f2bf(v);
                else if (col < 4352) MV[row * 1024 + col - 3328] = (bf16)f2bf(v);
                else if (col < 5376) MO[row * 1024 + col - 4352] = (bf16)f2bf(v);
                else if (col < 5384) GATES[row * 8 + col - 5376] = v + bg[col - 5376];
                else if (col < INW) GAB[row * 2048 + col - 5384] = (bf16)f2bf(v);
            }
    }
}


__device__ __forceinline__ float fsig(float x) { return __builtin_amdgcn_rcpf(1.0f + __builtin_amdgcn_exp2f(-1.4426950408889634f * x)); }

__device__ __forceinline__ unsigned pk4_sig_u8(const f32x4 v) { int r = 0;
    r = __builtin_amdgcn_cvt_pk_u8_f32(256.0f * fsig(v[0]) - 0.5f, 0, r); r = __builtin_amdgcn_cvt_pk_u8_f32(256.0f * fsig(v[1]) - 0.5f, 1, r);
    r = __builtin_amdgcn_cvt_pk_u8_f32(256.0f * fsig(v[2]) - 0.5f, 2, r); r = __builtin_amdgcn_cvt_pk_u8_f32(256.0f * fsig(v[3]) - 0.5f, 3, r); return (unsigned)r; }
__device__ __forceinline__ f32x4 unpk4_sig_u8(unsigned w) { return (f32x4){((float)(w & 0xffu) + 0.5f) * (1.0f / 256.0f), ((float)((w >> 8) & 0xffu) + 0.5f) * (1.0f / 256.0f), ((float)((w >> 16) & 0xffu) + 0.5f) * (1.0f / 256.0f), ((float)(w >> 24) + 0.5f) * (1.0f / 256.0f)}; }
struct EpiInproj {
    static constexpr bool PERM = true;
    unsigned char* ws; const float* rope; int nostore; const float* bgates;
    __device__ __forceinline__ bool operator()(const f32x4 (&acc)[2][2][4][2], const g2::UnitMN& u, int wr, int wc, int fr, int fq) const {
        if (nostore == 1) { if (acc[0][0][0][0][0] == 123.456f) ws[0] = 1; return true; }
        const int pn = u.pn; size_t boff; int ld, colt;
        if (pn == 29) {
            if (wc == 0 && fq == 0) { float* GT = (float*)(ws + WS_GATES); const f32x4 b0 = *(const f32x4*)bgates, b1 = *(const f32x4*)(bgates + 4);
#pragma unroll
                for (int ai = 0; ai < 2; ++ai)
#pragma unroll
                    for (int m = 0; m < 4; ++m) { const size_t row = (size_t)(u.pm * 256 + wr * 64 + fr + ai * 128 + m * 16);
                        *(f32x4*)(GT + row * 8) = acc[ai][0][m][0] + b0; *(f32x4*)(GT + row * 8 + 4) = acc[ai][0][m][1] + b1; } }
            return true; }
        if (pn < 9) { boff = pn < 3 ? WS_Q : (pn < 6 ? WS_K : WS_V); ld = 768; colt = (pn % 3) * 256; }
        else if (pn < 13) { boff = WS_MQK; ld = 1024; colt = (pn - 9) * 256; }
        else if (pn < 17) { boff = WS_MV; ld = 1024; colt = (pn - 13) * 256; }
        else if (pn < 21) { boff = WS_MO; ld = 1024; colt = (pn - 17) * 256; }
        else { boff = WS_GAB; ld = 2048; colt = (pn - 21) * 256; }
        bf16* base = (bf16*)(ws + boff);
#if GATES_U8
        if (pn >= 17) {
            unsigned char* b8 = ws + (pn < 21 ? WS_MO : WS_GAB); const int ld8 = pn < 21 ? 1024 : 2048, col8 = (pn < 21 ? (pn - 17) : (pn - 21)) * 256 + wc * 64 + 16 * fq; const int row0g = u.pm * 256 + wr * 64 + fr;
#pragma unroll
            for (int ai = 0; ai < 2; ++ai)
#pragma unroll
                for (int m = 0; m < 4; ++m) { const size_t row = (size_t)(row0g + ai * 128 + m * 16);
                    u32x4 w; w.x = pk4_sig_u8(acc[ai][0][m][0]); w.y = pk4_sig_u8(acc[ai][0][m][1]); w.z = pk4_sig_u8(acc[ai][1][m][0]); w.w = pk4_sig_u8(acc[ai][1][m][1]);
                    __builtin_nontemporal_store(w, (u32x4*)(b8 + row * ld8 + col8)); }
            return true; }
#endif
        const bool do_rope = (pn < 6) && (fq == 0);
        const int row0 = u.pm * 256 + wr * 64 + fr, col0 = colt + wc * 64 + 16 * fq;
#pragma unroll
        for (int ai = 0; ai < 2; ++ai) {
            f32x4 rc[4][4];
            if (do_rope) {
#pragma unroll
                for (int m = 0; m < 4; ++m) { const f32x4* rp = (const f32x4*)(rope + (size_t)(row0 + ai * 128 + m * 16) * 16); rc[m][0] = rp[0]; rc[m][1] = rp[1]; rc[m][2] = rp[2]; rc[m][3] = rp[3]; } }
#pragma unroll
            for (int m = 0; m < 4; ++m) {
                const size_t row = (size_t)(row0 + ai * 128 + m * 16);
                f32x4 a0 = acc[ai][0][m][0], a1 = acc[ai][0][m][1], b0 = acc[ai][1][m][0], b1 = acc[ai][1][m][1];
                if (do_rope) { const f32x4 c0 = rc[m][0], c1 = rc[m][1], s0 = rc[m][2], s1 = rc[m][3];
                    const f32x4 x0 = a0 * c0 - b0 * s0, x1 = a1 * c1 - b1 * s1, y0 = b0 * c0 + a0 * s0, y1 = b1 * c1 + a1 * s1; a0 = x0; a1 = x1; b0 = y0; b1 = y1; }
                u32x4 w0, w1; w0.x = g2::cvt_pk_bf16(a0[0], a0[1]); w0.y = g2::cvt_pk_bf16(a0[2], a0[3]); w0.z = g2::cvt_pk_bf16(a1[0], a1[1]); w0.w = g2::cvt_pk_bf16(a1[2], a1[3]);
                w1.x = g2::cvt_pk_bf16(b0[0], b0[1]); w1.y = g2::cvt_pk_bf16(b0[2], b0[3]); w1.z = g2::cvt_pk_bf16(b1[0], b1[1]); w1.w = g2::cvt_pk_bf16(b1[2], b1[3]);
                __builtin_nontemporal_store(w0, (u32x4*)(base + row * ld + col0)); if (nostore != 2) __builtin_nontemporal_store(w1, (u32x4*)(base + row * ld + col0 + 8));
            } }
        return true;
    }
};
__device__ __forceinline__ void ph_inproj_fast(Frame& F, int nostore = 0) {
#if STAGGER_NS > 0
    {
      const unsigned long long t0 = __builtin_amdgcn_s_memrealtime(); const unsigned long long dl = (unsigned long long)((blockIdx.x >> 3) & 15) * (STAGGER_NS / 10) / 16;
      while (__builtin_amdgcn_s_memrealtime() - t0 < dl) __builtin_amdgcn_s_sleep(4); }
#endif
#if INPROJ_FP8
    { g2::DenseOrder S; S.init(T, 25 * 256, D / 2, F.ws + WS_H8, F.ws + WS_WIN_T8, F.G, (int)blockIdx.x); S.pncut = 9; S.pnskip = 4;
      EpiInproj E{F.ws, (const float*)(F.ws + WS_ROPE), nostore, F.in[I_BGATES]};
      g2::gemm_phase<EpiInproj, g2::DenseOrder, true>(F.lds, S, E, 127 - 5); }
#if GATES_GEMM
    { g2::DenseOrder S; S.init(T, 5 * 256, D, F.outb + OUT_H, F.ws + WS_WIN_T, F.G, (int)blockIdx.x); S.pnoff = 9; S.pncut = 4; S.pnskip = 16;
#else
    { g2::DenseOrder S; S.init(T, 4 * 256, D, F.outb + OUT_H, F.ws + WS_WIN_T, F.G, (int)blockIdx.x); S.pnoff = 9;
#endif
      EpiInproj E{F.ws, (const float*)(F.ws + WS_ROPE), nostore, F.in[I_BGATES]};
      g2::gemm_phase<EpiInproj, g2::DenseOrder>(F.lds, S, E); }
#else
    g2::DenseOrder S; S.init(T, 7424, D, F.outb + OUT_H, F.ws + WS_WIN_T, F.G, (int)blockIdx.x);
    EpiInproj E{F.ws, (const float*)(F.ws + WS_ROPE), nostore, F.in[I_BGATES]};
    g2::gemm_phase<EpiInproj, g2::DenseOrder>(F.lds, S, E);
#endif
}


__device__ __forceinline__ void unpack8(const u32x4 w, float (&o)[8]) {
#pragma unroll
    for (int e = 0; e < 4; ++e) { o[2 * e] = __uint_as_float(w[e] << 16); o[2 * e + 1] = __uint_as_float(w[e] & 0xffff0000u); }
}
struct UnitBr { int pm, pn, sub; };
struct BranchOrder {
    typedef UnitBr Unit;
    g2::DenseOrder d; const char *YA, *YB, *WA, *WB;
    __device__ __forceinline__ bool next(int i, Unit& u) const { g2::UnitMN t; if (!d.next(i >> 1, t)) return false; u.pm = t.pm; u.pn = t.pn; u.sub = i & 1; return true; }
    __device__ __forceinline__ int K(const Unit& u) const { return u.sub ? 1024 : 256; }
    __device__ __forceinline__ const char* a_base(const Unit& u) const { return u.sub ? YB : YA; }
    __device__ __forceinline__ unsigned a_row_off(const Unit& u, int r) const { return (unsigned)(u.pm * 256 + r) * (u.sub ? 2048u : 512u); }
    __device__ __forceinline__ const char* b_base(const Unit& u) const { return u.sub ? WB + (size_t)u.pn * 256 * 2048 : WA + (size_t)u.pn * 256 * 512; }
};
struct EpiBranch {
    static constexpr bool PERM = true;
    const bf16* GAB; bf16* MG;
    __device__ __forceinline__ bool operator()(f32x4 (&acc)[2][2][4][2], const UnitBr& u, int wr, int wc, int fr, int fq) const {
        const int row0 = u.pm * 256 + wr * 64 + fr, col0 = u.pn * 256 + wc * 64 + 16 * fq;
#pragma unroll
        for (int ai = 0; ai < 2; ++ai)
#pragma unroll
            for (int m = 0; m < 4; ++m) { const size_t row = (size_t)(row0 + ai * 128 + m * 16);
                u32x4 wout[2];
#if GATES_U8
                { const unsigned char* g8 = (const unsigned char*)GAB + row * 2048 + col0; const u32x4 gbq = *(const u32x4*)(g8 + 1024);
                  if (u.sub == 0) { const u32x4 gaq = *(const u32x4*)g8;
#pragma unroll
                      for (int bj = 0; bj < 2; ++bj)
#pragma unroll
                          for (int n = 0; n < 2; ++n) { const f32x4 sa = unpk4_sig_u8(gaq[2 * bj + n]), sb = unpk4_sig_u8(gbq[2 * bj + n]);
#pragma unroll
                              for (int e = 0; e < 4; ++e) acc[ai][bj][m][n][e] *= sa[e] * __builtin_amdgcn_rcpf(sb[e]); } }
                  else {
#pragma unroll
                      for (int bj = 0; bj < 2; ++bj) { const f32x4 s0 = unpk4_sig_u8(gbq[2 * bj]), s1 = unpk4_sig_u8(gbq[2 * bj + 1]); const f32x4 v0 = acc[ai][bj][m][0] * s0, v1 = acc[ai][bj][m][1] * s1;
                          wout[bj].x = g2::cvt_pk_bf16(v0[0], v0[1]); wout[bj].y = g2::cvt_pk_bf16(v0[2], v0[3]); wout[bj].z = g2::cvt_pk_bf16(v1[0], v1[1]); wout[bj].w = g2::cvt_pk_bf16(v1[2], v1[3]); } } }
#else
#pragma unroll
                for (int bj = 0; bj < 2; ++bj) { const int col = col0 + 8 * bj;
                    float gb[8]; unpack8(*(const u32x4*)(GAB + row * 2048 + 1024 + col), gb);
                    if (u.sub == 0) { float ga[8]; unpack8(*(const u32x4*)(GAB + row * 2048 + col), ga);
#pragma unroll
                        for (int e = 0; e < 4; ++e) { acc[ai][bj][m][0][e] *= fsig(ga[e]) * (1.0f + __builtin_amdgcn_exp2f(-1.4426950408889634f * gb[e]));
                                                      acc[ai][bj][m][1][e] *= fsig(ga[4 + e]) * (1.0f + __builtin_amdgcn_exp2f(-1.4426950408889634f * gb[4 + e])); } }
                    else { f32x4 v0, v1;
#pragma unroll
                        for (int e = 0; e < 4; ++e) { v0[e] = acc[ai][bj][m][0][e] * fsig(gb[e]); v1[e] = acc[ai][bj][m][1][e] * fsig(gb[4 + e]); }
                        wout[bj].x = g2::cvt_pk_bf16(v0[0], v0[1]); wout[bj].y = g2::cvt_pk_bf16(v0[2], v0[3]); wout[bj].z = g2::cvt_pk_bf16(v1[0], v1[1]); wout[bj].w = g2::cvt_pk_bf16(v1[2], v1[3]); } }
#endif
                if (u.sub != 0) { *(u32x4*)(MG + row * 1024 + col0) = wout[0]; *(u32x4*)(MG + row * 1024 + col0 + 8) = wout[1]; } }
        return u.sub != 0;
    }
};
__device__ __forceinline__ void ph_branch_fast(Frame& F) {
    BranchOrder S; S.d.init(T, 1024, 1024, nullptr, nullptr, F.G, (int)blockIdx.x);
    S.YA = (const char*)(F.outb + OUT_YA); S.YB = (const char*)(F.outb + OUT_YB); S.WA = (const char*)(F.ws + WS_WBA_T); S.WB = (const char*)(F.ws + WS_WBB_T);
    EpiBranch E{(const bf16*)(F.ws + WS_GAB), (bf16*)(F.ws + WS_MERGED)};
    g2::gemm_phase<EpiBranch, BranchOrder>(F.lds, S, E);
}
struct EpiBf16Plain {
    static constexpr bool PERM = true;
    bf16* O; int ld;
    __device__ __forceinline__ bool operator()(const f32x4 (&acc)[2][2][4][2], const g2::UnitMN& u, int wr, int wc, int fr, int fq) const {
        const int row0 = u.pm * 256 + wr * 64 + fr, col0 = u.pn * 256 + wc * 64 + 16 * fq;
#pragma unroll
        for (int ai = 0; ai < 2; ++ai)
#pragma unroll
            for (int m = 0; m < 4; ++m) { bf16* rp = O + (size_t)(row0 + ai * 128 + m * 16) * ld + col0;
#pragma unroll
                for (int bj = 0; bj < 2; ++bj) { const f32x4 v0 = acc[ai][bj][m][0], v1 = acc[ai][bj][m][1];
                    u32x4 w; w.x = g2::cvt_pk_bf16(v0[0], v0[1]); w.y = g2::cvt_pk_bf16(v0[2], v0[3]); w.z = g2::cvt_pk_bf16(v1[0], v1[1]); w.w = g2::cvt_pk_bf16(v1[2], v1[3]);
                    *(u32x4*)(rp + bj * 8) = w; } }
        return true;
    }
};
struct EpiF32Plain {
    static constexpr bool PERM = false;
    float* O; int ld;
    __device__ __forceinline__ bool operator()(const f32x4 (&acc)[2][2][4][2], const g2::UnitMN& u, int wr, int wc, int fr, int fq) const {
        const int row0 = u.pm * 256 + wr * 64 + fr, col0 = u.pn * 256 + wc * 32 + 4 * fq;
#pragma unroll
        for (int ai = 0; ai < 2; ++ai)
#pragma unroll
            for (int m = 0; m < 4; ++m) { float* rp = O + (size_t)(row0 + ai * 128 + m * 16) * ld + col0;
#pragma unroll
                for (int bj = 0; bj < 2; ++bj)
#pragma unroll
                    for (int n = 0; n < 2; ++n) *(f32x4*)(rp + bj * 128 + n * 16) = acc[ai][bj][m][n]; }
        return true;
    }
};
__device__ __forceinline__ void ph_outproj_fast(Frame& F) {
    g2::DenseOrder S; S.init(T, 1024, 1024, F.ws + WS_MERGED, F.ws + WS_WOUT_T, F.G, (int)blockIdx.x);
    EpiBf16Plain E{(bf16*)(F.ws + WS_YMIX), 1024};
    g2::gemm_phase<EpiBf16Plain, g2::DenseOrder>(F.lds, S, E);
}
__device__ __forceinline__ void ph_router_fast(Frame& F);
template <class BlockIter> __device__ __forceinline__ void ph_topk4(Frame& F, const BlockIter& BI);
__device__ __forceinline__ void ph_router_fast(Frame& F) {
    g2::DenseOrder S; S.init(T, 256, 1024, F.ws + WS_H2, F.ws + WS_WR_T, F.G, (int)blockIdx.x);
    EpiF32Plain E{(float*)(F.ws + WS_LOGITS), 256};
    g2::gemm_phase<EpiF32Plain, g2::DenseOrder>(F.lds, S, E);
}
__device__ __forceinline__ void ph_cvt_experts(Frame& F) {
    LAS float* scr = (LAS float*)(F.lds) + F.wave * (64 * 33);
    const int gw = blockIdx.x * NWAVES + F.wave, NGW = F.G * NWAVES;
    for (int it = gw; it < NE * 384; it += NGW) {
        const int e = it / 384, r = it % 384;
        if (r < 256) { const int kb = r >> 4, nb = r & 15, d0 = nb * 32, pn = d0 >> 8, q = d0 & 255; const bool up = q >= 128; const int src = pn * 128 + (q & 127);
            tr_item((up ? F.in[I_WEU] : F.in[I_WEG]) + (size_t)e * 1024 * 256, 256, kb * 64, src, (bf16*)(F.ws + WS_WGU) + (size_t)e * 512 * 1024, 1024, d0, scr, F.lane); }
        else { const int q = r - 256, kb = q >> 5, nb = q & 31;
            tr_item(F.in[I_WED] + (size_t)e * 256 * 1024, 1024, kb * 64, nb * 32, (bf16*)(F.ws + WS_WD) + (size_t)e * 1024 * 256, 256, nb * 32, scr, F.lane); }
    }
}

constexpr int CVT_BATCH = 128, CVT_NBATCH = (NE + 1) * 384 / CVT_BATCH;
struct CvtD { const float* Wq; int ldw, k0; unsigned char* WT; int Kd, drow0; float sc; };
__device__ __forceinline__ CvtD cvt_desc(Frame& F, int it) {
    CvtD d; const int e = it / 384, r = it % 384; const bool sh = e == NE;
    if (r < 256) { const int kb = r >> 4, nb = r & 15, d0 = nb * 32, pn = d0 >> 8;
        const int cc = (d0 & 255) + 4 * (F.lane & 7); const bool up = (cc >> 3) & 1; const int col = pn * 128 + 8 * (cc >> 4) + (cc & 7);
        const float* pg = sh ? F.in[I_WSG] : F.in[I_WEG] + (size_t)e * 1024 * 256; const float* pu = sh ? F.in[I_WSU] : F.in[I_WEU] + (size_t)e * 1024 * 256;
        d.Wq = (up ? pu : pg) + col; d.ldw = 256; d.k0 = kb * 64; d.WT = sh ? F.ws + WS_WSGU8 : F.ws + WS_WGU8 + (size_t)e * 512 * 1024; d.Kd = 1024; d.drow0 = d0; d.sc = 32.0f; }
    else { const int q = r - 256, kb = q >> 5, nb = q & 31;
        const float* W = sh ? F.in[I_WSD] : F.in[I_WED] + (size_t)e * 256 * 1024;
        d.Wq = W + nb * 32 + 4 * (F.lane & 7); d.ldw = 1024; d.k0 = kb * 64; d.WT = sh ? F.ws + WS_WSD8 : F.ws + WS_WD8 + (size_t)e * 1024 * 256; d.Kd = 256; d.drow0 = nb * 32; d.sc = 16.0f; }
    return d;
}
struct CvtR { f32x4 v[8]; };
__device__ __forceinline__ void cvt_load(const CvtD& d, CvtR& R, int lane) {
    const int kg = lane >> 3;
#pragma unroll
    for (int i = 0; i < 8; ++i) R.v[i] = *(const f32x4*)(d.Wq + (size_t)(d.k0 + kg + 8 * i) * d.ldw);
}
__device__ __forceinline__ void cvt_store(const CvtD& d, const CvtR& R, LAS float* scr, int lane) {
    const int kg = lane >> 3, q4 = (lane & 7) * 4;
#pragma unroll
    for (int i = 0; i < 8; ++i) { const f32x4 v = R.v[i] * d.sc; LAS float* p = scr + (kg + 8 * i) * 33 + q4; p[0] = v[0]; p[1] = v[1]; p[2] = v[2]; p[3] = v[3]; }
    asm volatile("s_waitcnt lgkmcnt(0)" ::: "memory");
    const int c = lane & 7;
#pragma unroll
    for (int j = 0; j < 4; ++j) { const int n = (lane >> 3) + 8 * j; const LAS float* sp = scr + (8 * c) * 33 + n;
        u32x2 o; o.x = pk4_fp8(sp[0 * 33], sp[1 * 33], sp[2 * 33], sp[3 * 33]); o.y = pk4_fp8(sp[4 * 33], sp[5 * 33], sp[6 * 33], sp[7 * 33]);
        *(u32x2*)(d.WT + (size_t)(d.drow0 + n) * d.Kd + d.k0 + 8 * c) = o; }
    asm volatile("s_waitcnt lgkmcnt(0)" ::: "memory");
}
__device__ __forceinline__ void cvt_experts8_batch(Frame& F, int batch) {
    LAS float* scr = (LAS float*)(F.lds) + F.wave * (64 * 33);
    const int it0 = batch * CVT_BATCH + F.wave;
    CvtD d = cvt_desc(F, it0); CvtR R; cvt_load(d, R, F.lane);
#pragma unroll 1
    for (int k = 0; k < CVT_BATCH / NWAVES; ++k) {
        const CvtD dc = d; const CvtR Rc = R;
        if (k + 1 < CVT_BATCH / NWAVES) { d = cvt_desc(F, it0 + NWAVES * (k + 1)); cvt_load(d, R, F.lane); }
        cvt_store(dc, Rc, scr, F.lane);
    }
}
struct UnitEx { int u, sub, e; };
struct GuOrder {
    typedef UnitEx Unit;
    int NT, nun, G, vcu; const int* UNITEXP; const int* ROWTOK; const char *H2, *WGU, *WSGU;
    __device__ __forceinline__ bool next(int i, Unit& x) const { const int L = i * G + vcu; if (L >= nun) return false; x.u = L >> 1; x.sub = L & 1; x.e = x.u < NT ? UNITEXP[x.u] : -1; return true; }
    __device__ __forceinline__ int K(const Unit&) const { return 1024; }
    __device__ __forceinline__ const char* a_base(const Unit&) const { return H2; }
    __device__ __forceinline__ unsigned a_row_off(const Unit& x, int r) const { return (unsigned)ROWTOK[(unsigned)(x.u * 256 + r)] * 2048u; }
    __device__ __forceinline__ const char* b_base(const Unit& x) const { return (x.e >= 0 ? WGU + (size_t)x.e * (512 * 1024 * 2) : WSGU) + (size_t)x.sub * (256 * 1024 * 2); }
};
struct EpiGu {
    static constexpr bool PERM = true;
    int NT; bf16 *HIDR, *HIDS;
    __device__ __forceinline__ bool operator()(const f32x4 (&acc)[2][2][4][2], const UnitEx& x, int wr, int wc, int fr, int fq) const {
        bf16* base = x.e >= 0 ? HIDR + (size_t)x.u * 256 * 256 : HIDS + (size_t)(x.u - NT) * 256 * 256;
        const int row0 = wr * 64 + fr, col0 = x.sub * 128 + wc * 32 + 8 * fq;
#pragma unroll
        for (int ai = 0; ai < 2; ++ai)
#pragma unroll
            for (int m = 0; m < 4; ++m) { const f32x4 g0 = acc[ai][0][m][0], g1 = acc[ai][0][m][1], u0 = acc[ai][1][m][0], u1 = acc[ai][1][m][1]; f32x4 h0, h1;
#pragma unroll
                for (int e = 0; e < 4; ++e) { h0[e] = g0[e] * fsig(g0[e]) * u0[e]; h1[e] = g1[e] * fsig(g1[e]) * u1[e]; }
                u32x4 w; w.x = g2::cvt_pk_bf16(h0[0], h0[1]); w.y = g2::cvt_pk_bf16(h0[2], h0[3]); w.z = g2::cvt_pk_bf16(h1[0], h1[1]); w.w = g2::cvt_pk_bf16(h1[2], h1[3]);
                *(u32x4*)(base + (size_t)(row0 + ai * 128 + m * 16) * 256 + col0) = w; asm volatile("" ::: "memory"); }
        return true;
    }
};
struct DownOrder {
    typedef UnitEx Unit;
    int NT, nun, G, vcu; const int* UNITEXP; const char *HIDR, *HIDS, *WD, *WSD;
    __device__ __forceinline__ bool next(int i, Unit& x) const { const int L = i * G + vcu; if (L >= nun) return false; x.u = L >> 2; x.sub = L & 3; x.e = x.u < NT ? UNITEXP[x.u] : -1; return true; }
    __device__ __forceinline__ int K(const Unit&) const { return 256; }
    __device__ __forceinline__ const char* a_base(const Unit& x) const { return x.e >= 0 ? HIDR : HIDS; }
    __device__ __forceinline__ unsigned a_row_off(const Unit& x, int r) const { return (unsigned)((x.e >= 0 ? x.u : x.u - NT) * 256 + r) * 512u; }
    __device__ __forceinline__ const char* b_base(const Unit& x) const { return (x.e >= 0 ? WD + (size_t)x.e * (1024 * 256 * 2) : WSD) + (size_t)x.sub * (256 * 256 * 2); }
};
struct EpiDown {
    static constexpr bool PERM = false;
    const int* ROWTOK; const float* ROWW; float* out;
    __device__ __forceinline__ bool operator()(const f32x4 (&acc)[2][2][4][2], const UnitEx& x, int wr, int wc, int fr, int fq) const {
        const int row0 = x.u * 256 + wr * 64 + fr; const unsigned col0 = (unsigned)(x.sub * 256 + wc * 32 + 4 * fq);
#pragma unroll
        for (int ai = 0; ai < 2; ++ai)
#pragma unroll
            for (int m = 0; m < 4; ++m) { const int r = row0 + ai * 128 + m * 16; const unsigned tok = (unsigned)ROWTOK[r]; const float w = ROWW[r];
                const unsigned off = tok * 1024u + col0;
#pragma unroll
                for (int bj = 0; bj < 2; ++bj)
#pragma unroll
                    for (int n = 0; n < 2; ++n)
#pragma unroll
                        for (int e = 0; e < 4; ++e) unsafeAtomicAdd(out + (off + (unsigned)(bj * 128 + n * 16 + e)), acc[ai][bj][m][n][e] * w);
                asm volatile("" ::: "memory"); }
        return true;
    }
};
__device__ __forceinline__ void ph_gu_fast(Frame& F) {
    const int NT = (int)__hip_atomic_load(F.ctl + CW_NT, __ATOMIC_RELAXED, __HIP_MEMORY_SCOPE_AGENT);
    const int bx = blockIdx.x; const int vcu = (F.G % 8 == 0) ? (bx % 8) * (F.G / 8) + bx / 8 : bx;
    GuOrder S{NT, 2 * (NT + T / 256), F.G, vcu, (const int*)(F.ws + WS_UNITEXP), (const int*)(F.ws + WS_ROWTOK), (const char*)(F.ws + WS_H2), (const char*)(F.ws + WS_WGU), (const char*)(F.ws + WS_WSGU_T)};
    EpiGu E{NT, (bf16*)(F.ws + WS_HIDR), (bf16*)(F.ws + WS_HIDS)};
    g2::gemm_phase<EpiGu, GuOrder>(F.lds, S, E);
}
__device__ __forceinline__ void ph_down_fast(Frame& F) {
    const int NT = (int)__hip_atomic_load(F.ctl + CW_NT, __ATOMIC_RELAXED, __HIP_MEMORY_SCOPE_AGENT);
    const int bx = blockIdx.x; const int vcu = (F.G % 8 == 0) ? (bx % 8) * (F.G / 8) + bx / 8 : bx;
    DownOrder S{NT, 4 * (NT + T / 256), F.G, vcu, (const int*)(F.ws + WS_UNITEXP), (const char*)(F.ws + WS_HIDR), (const char*)(F.ws + WS_HIDS), (const char*)(F.ws + WS_WD), (const char*)(F.ws + WS_WSD_T)};
    EpiDown E{(const int*)(F.ws + WS_ROWTOK), (const float*)(F.ws + WS_ROWW), F.out};
    g2::gemm_phase<EpiDown, DownOrder>(F.lds, S, E);
}


__device__ __forceinline__ void ph_rope_naive(Frame& F) {
    bf16* Q = (bf16*)(F.ws + WS_Q); bf16* Kt = (bf16*)(F.ws + WS_K);
    for (int t = blockIdx.x * NWAVES + F.wave; t < T; t += F.G * NWAVES) {
        const float p = (float)F.pos[t];
#pragma unroll
        for (int r = 0; r < 3; ++r) {
            const int it = r * 64 + F.lane;
            const int i = it & 7, head = (it >> 3) % 12, qk = it / 96;
            const float inv = powf(500000.0f, -(float)i / 8.0f);
            const float ang = p * inv; const float cs = cosf(ang), sn = sinf(ang);
            bf16* base = (qk ? Kt : Q) + (size_t)t * 768 + head * 64;
            const float x1 = bf2f(base[i]), x2 = bf2f(base[i + 8]);
            base[i] = (bf16)f2bf(x1 * cs - x2 * sn); base[i + 8] = (bf16)f2bf(x2 * cs + x1 * sn);
        }
    }
}

__device__ __forceinline__ void ph_attn_naive_block(Frame& F, int vb) {
    const bf16* Q = (const bf16*)(F.ws + WS_Q); const bf16* Kt = (const bf16*)(F.ws + WS_K); const bf16* V = (const bf16*)(F.ws + WS_V);
    bf16* YA = (bf16*)(F.outb + OUT_YA);
    const int item = vb * NTHR + F.tid; const int t = item >> 2, j = item & 3; const int b = t / SEQ, s = t % SEQ;
    float acc[64];
#pragma unroll
    for (int d = 0; d < 64; ++d) acc[d] = 0.f;
    float m = -INFINITY, l = 0.f;
    for (int g = 0; g < 3; ++g) {
        const int dil = (g == 0) ? 1 : (g == 1) ? 4 : 16; const int head = g * 4 + j;
        float q[64];
        { const u32x4* qp = (const u32x4*)(Q + (size_t)t * 768 + head * 64);
#pragma unroll
          for (int c = 0; c < 8; ++c) { const u32x4 w = qp[c];
#pragma unroll
              for (int e = 0; e < 4; ++e) { q[c * 8 + 2 * e] = __uint_as_float(w[e] << 16) * 0.125f; q[c * 8 + 2 * e + 1] = __uint_as_float(w[e] & 0xffff0000u) * 0.125f; } } }
        const int lq = s / dil; const int nk = (lq < 128 ? lq : 128) + 1;
        for (int jj = 0; jj < nk; ++jj) {
            const size_t tk = (size_t)b * SEQ + (s - jj * dil);
            const u32x4* kp = (const u32x4*)(Kt + tk * 768 + head * 64);
            float dot = 0.f;
#pragma unroll
            for (int c = 0; c < 8; ++c) { const u32x4 w = kp[c];
#pragma unroll
                for (int e = 0; e < 4; ++e) { dot += q[c * 8 + 2 * e] * __uint_as_float(w[e] << 16); dot += q[c * 8 + 2 * e + 1] * __uint_as_float(w[e] & 0xffff0000u); } }
            const float mn = fmaxf(m, dot); const float corr = expf(m - mn), p = expf(dot - mn);
            l = l * corr + p; m = mn;
            const u32x4* vp = (const u32x4*)(V + tk * 768 + head * 64);
#pragma unroll
            for (int c = 0; c < 8; ++c) { const u32x4 w = vp[c];
#pragma unroll
                for (int e = 0; e < 4; ++e) { acc[c * 8 + 2 * e] = acc[c * 8 + 2 * e] * corr + p * __uint_as_float(w[e] << 16); acc[c * 8 + 2 * e + 1] = acc[c * 8 + 2 * e + 1] * corr + p * __uint_as_float(w[e] & 0xffff0000u); } }
        }
    }
    const float rl = 1.0f / l;
    u32x4* op = (u32x4*)(YA + (size_t)t * 256 + j * 64);
#pragma unroll
    for (int c = 0; c < 8; ++c) { u32x4 w;
#pragma unroll
        for (int e = 0; e < 4; ++e) w[e] = pk2(acc[c * 8 + 2 * e] * rl, acc[c * 8 + 2 * e + 1] * rl);
        op[c] = w; }
}


typedef short v4i16_t __attribute__((ext_vector_type(4)));
typedef short bf16x8_t __attribute__((ext_vector_type(8)));
constexpr int ATT_RS = 144;
constexpr int ATT_ROWS = 272;
constexpr int ATT_UNITS = 48 * 128;
__device__ __forceinline__ void attn_unit_fast(Frame& F, int uidx) {
    const int bj = uidx / 48, r48 = uidx % 48, b = bj >> 2, j = bj & 3, g = r48 >> 4, q16 = r48 & 15;
    const int dil = (g == 0) ? 1 : (g == 1) ? 4 : 16;
    const int rho = (g == 0) ? 0 : (g == 1) ? (q16 >> 2) : q16, n = (g == 0) ? q16 : (g == 1) ? (q16 & 3) : 0;
    const int head = g * 4 + j;
    const bf16* Q = (const bf16*)(F.ws + WS_Q); const bf16* Kg = (const bf16*)(F.ws + WS_K); const bf16* Vg = (const bf16*)(F.ws + WS_V);
    bf16* OG = (bf16*)(F.outb + OUT_OG) + (size_t)g * T * 256; float* LSE = (float*)(F.ws + WS_LSE) + (size_t)g * T * 4;
    LAS unsigned char* Kt = F.lds; LAS unsigned char* Vt = F.lds + ATT_ROWS * ATT_RS;
    const int tid = F.tid, lane = F.lane, w = F.wave, ql = lane & 15, g4 = lane >> 4;
    __syncthreads();
#pragma unroll
    for (int i = 0; i < 4; ++i) { const int p = tid + NTHR * i, row = p >> 3, c = p & 7; const int lk = (n - 1) * 128 + row;
        u32x4 kv = (u32x4){0u, 0u, 0u, 0u}, vv = kv;
        if (lk >= 0) { const size_t off = ((size_t)b * SEQ + (size_t)lk * dil + rho) * 768 + head * 64 + c * 8; kv = *(const u32x4*)(Kg + off); vv = *(const u32x4*)(Vg + off); }
        *(LAS u32x4*)(Kt + row * ATT_RS + c * 16) = kv; *(LAS u32x4*)(Vt + row * ATT_RS + c * 16) = vv; }
    if (tid < 128) { const int row = 256 + (tid >> 3), c = tid & 7; *(LAS u32x4*)(Kt + row * ATT_RS + c * 16) = (u32x4){0u, 0u, 0u, 0u}; *(LAS u32x4*)(Vt + row * ATT_RS + c * 16) = (u32x4){0u, 0u, 0u, 0u}; }
    const int qi = 16 * w + ql; const size_t tq = (size_t)b * SEQ + (size_t)(n * 128 + qi) * dil + rho;
    bf16x8_t Qf[2];
#pragma unroll
    for (int ks = 0; ks < 2; ++ks) Qf[ks] = *(const bf16x8_t*)(Q + tq * 768 + head * 64 + 32 * ks + 8 * g4);
    __syncthreads();
    f32x4 O[4];
#pragma unroll
    for (int dt = 0; dt < 4; ++dt) O[dt] = (f32x4){0.f, 0.f, 0.f, 0.f};
    float m = -INFINITY, lsum = 0.f;
    const float SC = 0.125f * 1.4426950408889634f;
    const int qq = ql >> 2, pp4 = ql & 3;
#pragma unroll 1
    for (int pp = 4; pp >= 0; --pp) {
        const int t0 = w + 2 * pp, t1 = t0 + 1;
        f32x4 S0 = (f32x4){0.f, 0.f, 0.f, 0.f}, S1 = S0;
#pragma unroll
        for (int ks = 0; ks < 2; ++ks) {
            const bf16x8_t k0 = *(const LAS bf16x8_t*)(Kt + (16 * t0 + ql) * ATT_RS + (32 * ks + 8 * g4) * 2);
            const bf16x8_t k1 = *(const LAS bf16x8_t*)(Kt + (16 * t1 + ql) * ATT_RS + (32 * ks + 8 * g4) * 2);
            S0 = __builtin_amdgcn_mfma_f32_16x16x32_bf16(k0, Qf[ks], S0, 0, 0, 0);
            S1 = __builtin_amdgcn_mfma_f32_16x16x32_bf16(k1, Qf[ks], S1, 0, 0, 0);
        }
        float tmax = -INFINITY;
#pragma unroll
        for (int r = 0; r < 4; ++r) {
            const int k0i = 16 * t0 + 4 * g4 + r, k1i = k0i + 16;
            const bool v0 = (k0i >= qi) && (k0i <= qi + 128) && (n > 0 || k0i >= 128), v1 = (k1i >= qi) && (k1i <= qi + 128) && (n > 0 || k1i >= 128);
            S0[r] = v0 ? S0[r] * SC : -INFINITY; S1[r] = v1 ? S1[r] * SC : -INFINITY;
            tmax = fmaxf(tmax, fmaxf(S0[r], S1[r]));
        }
        tmax = fmaxf(tmax, __shfl_xor(tmax, 16)); tmax = fmaxf(tmax, __shfl_xor(tmax, 32));
        const float mn = fmaxf(m, tmax);
        const float corr = __builtin_amdgcn_exp2f(m - mn); m = mn;
        float ps = 0.f; float p0[4], p1[4];
#pragma unroll
        for (int r = 0; r < 4; ++r) { p0[r] = __builtin_amdgcn_exp2f(S0[r] - mn); p1[r] = __builtin_amdgcn_exp2f(S1[r] - mn); ps += p0[r] + p1[r]; }
        lsum = lsum * corr + ps;
        u32x4 pk; pk.x = g2::cvt_pk_bf16(p0[0], p0[1]); pk.y = g2::cvt_pk_bf16(p0[2], p0[3]); pk.z = g2::cvt_pk_bf16(p1[0], p1[1]); pk.w = g2::cvt_pk_bf16(p1[2], p1[3]);
        const bf16x8_t Pf = __builtin_bit_cast(bf16x8_t, pk);
#pragma unroll
        for (int dt = 0; dt < 4; ++dt) {
            O[dt] = O[dt] * corr;
            const v4i16_t lo = __builtin_amdgcn_ds_read_tr16_b64_v4i16((LAS v4i16_t*)(Vt + (16 * t0 + 4 * g4 + qq) * ATT_RS + (16 * dt + 4 * pp4) * 2));
            const v4i16_t hi = __builtin_amdgcn_ds_read_tr16_b64_v4i16((LAS v4i16_t*)(Vt + (16 * t1 + 4 * g4 + qq) * ATT_RS + (16 * dt + 4 * pp4) * 2));
            const bf16x8_t Vf = __builtin_shufflevector(lo, hi, 0, 1, 2, 3, 4, 5, 6, 7);
            O[dt] = __builtin_amdgcn_mfma_f32_16x16x32_bf16(Vf, Pf, O[dt], 0, 0, 0);
        }
    }
    lsum += __shfl_xor(lsum, 16); lsum += __shfl_xor(lsum, 32);
    const float rl = 1.0f / lsum;
#pragma unroll
    for (int dt = 0; dt < 4; ++dt) { u32x2 o; o.x = g2::cvt_pk_bf16(O[dt][0] * rl, O[dt][1] * rl); o.y = g2::cvt_pk_bf16(O[dt][2] * rl, O[dt][3] * rl);
        *(u32x2*)(OG + tq * 256 + j * 64 + 16 * dt + 4 * g4) = o; }
    if (g4 == 0) LSE[tq * 4 + j] = m + __builtin_amdgcn_logf(lsum);
}
struct AttU { int b, j, g, dil, rho, n, head; };
__device__ __forceinline__ AttU att_unit(int uidx) { AttU u; const int bj = uidx / 48, r48 = uidx % 48; u.b = bj >> 2; u.j = bj & 3; u.g = r48 >> 4; const int q16 = r48 & 15;
    u.dil = (u.g == 0) ? 1 : (u.g == 1) ? 4 : 16; u.rho = (u.g == 0) ? 0 : (u.g == 1) ? (q16 >> 2) : q16; u.n = (u.g == 0) ? q16 : (u.g == 1) ? (q16 & 3) : 0; u.head = u.g * 4 + u.j; return u; }
struct AttR { u32x4 kv[4], vv[4]; bf16x8_t q[2]; };
__device__ __forceinline__ void att_load(Frame& F, const AttU& u, AttR& R) {
    const bf16* Q = (const bf16*)(F.ws + WS_Q); const bf16* Kg = (const bf16*)(F.ws + WS_K); const bf16* Vg = (const bf16*)(F.ws + WS_V);
#pragma unroll
    for (int i = 0; i < 4; ++i) { const int p = F.tid + NTHR * i, row = p >> 3, c = p & 7; const int lk = (u.n - 1) * 128 + row;
        R.kv[i] = (u32x4){0u, 0u, 0u, 0u}; R.vv[i] = R.kv[i];
        if (lk >= 0) { const size_t off = ((size_t)u.b * SEQ + (size_t)lk * u.dil + u.rho) * 768 + u.head * 64 + c * 8; R.kv[i] = *(const u32x4*)(Kg + off); R.vv[i] = *(const u32x4*)(Vg + off); } }
    const int qi = 16 * F.wave + (F.lane & 15), g4 = F.lane >> 4; const size_t tq = (size_t)u.b * SEQ + (size_t)(u.n * 128 + qi) * u.dil + u.rho;
#pragma unroll
    for (int ks = 0; ks < 2; ++ks) R.q[ks] = *(const bf16x8_t*)(Q + tq * 768 + u.head * 64 + 32 * ks + 8 * g4);
}
__device__ __forceinline__ void attn_queue_run(Frame& F, unsigned* qc, volatile LAS unsigned* MISC) {
    LAS unsigned char* Kt = F.lds; LAS unsigned char* Vt = F.lds + ATT_ROWS * ATT_RS;
    unsigned nxt = 0u;
    __syncthreads();
    if (F.tid == 0) MISC[0] = atomicAdd(qc, 1u);
    __syncthreads();
    int uidx = (int)MISC[0];
    if (uidx >= ATT_UNITS) return;
    if (F.tid == 0) nxt = atomicAdd(qc, 1u);
    AttR R; AttU u = att_unit(uidx); att_load(F, u, R);
    for (;;) {
        const int tid = F.tid, lane = F.lane, w = F.wave, ql = lane & 15, g4 = lane >> 4;
        const int b = u.b, j = u.j, g = u.g, dil = u.dil, rho = u.rho, n = u.n;
        bf16* OG = (bf16*)(F.outb + OUT_OG) + (size_t)g * T * 256; float* LSE = (float*)(F.ws + WS_LSE) + (size_t)g * T * 4;
        __syncthreads();
#pragma unroll
        for (int i = 0; i < 4; ++i) { const int p = tid + NTHR * i, row = p >> 3, c = p & 7; *(LAS u32x4*)(Kt + row * ATT_RS + c * 16) = R.kv[i]; *(LAS u32x4*)(Vt + row * ATT_RS + c * 16) = R.vv[i]; }
        if (tid < 128) { const int row = 256 + (tid >> 3), c = tid & 7; *(LAS u32x4*)(Kt + row * ATT_RS + c * 16) = (u32x4){0u, 0u, 0u, 0u}; *(LAS u32x4*)(Vt + row * ATT_RS + c * 16) = (u32x4){0u, 0u, 0u, 0u}; }
        bf16x8_t Qf[2]; Qf[0] = R.q[0]; Qf[1] = R.q[1];
        if (tid == 0) MISC[0] = nxt;
        __syncthreads();
        const int un = (int)MISC[0]; const bool more = un < ATT_UNITS;
        AttU u2 = u;
        if (more) { if (tid == 0) nxt = atomicAdd(qc, 1u); u2 = att_unit(un); att_load(F, u2, R); }
        const int qi = 16 * w + ql; const size_t tq = (size_t)b * SEQ + (size_t)(n * 128 + qi) * dil + rho;
    f32x4 O[4];
#pragma unroll
    for (int dt = 0; dt < 4; ++dt) O[dt] = (f32x4){0.f, 0.f, 0.f, 0.f};
    float m = -INFINITY, lsum = 0.f;
    const float SC = 0.125f * 1.4426950408889634f;
    const int qq = ql >> 2, pp4 = ql & 3;
#pragma unroll 1
    for (int pp = 4; pp >= 0; --pp) {
        const int t0 = w + 2 * pp, t1 = t0 + 1;
        f32x4 S0 = (f32x4){0.f, 0.f, 0.f, 0.f}, S1 = S0;
#pragma unroll
        for (int ks = 0; ks < 2; ++ks) {
            const bf16x8_t k0 = *(const LAS bf16x8_t*)(Kt + (16 * t0 + ql) * ATT_RS + (32 * ks + 8 * g4) * 2);
            const bf16x8_t k1 = *(const LAS bf16x8_t*)(Kt + (16 * t1 + ql) * ATT_RS + (32 * ks + 8 * g4) * 2);
            S0 = __builtin_amdgcn_mfma_f32_16x16x32_bf16(k0, Qf[ks], S0, 0, 0, 0);
            S1 = __builtin_amdgcn_mfma_f32_16x16x32_bf16(k1, Qf[ks], S1, 0, 0, 0);
        }
        float tmax = -INFINITY;
#pragma unroll
        for (int r = 0; r < 4; ++r) {
            const int k0i = 16 * t0 + 4 * g4 + r, k1i = k0i + 16;
            const bool v0 = (k0i >= qi) && (k0i <= qi + 128) && (n > 0 || k0i >= 128), v1 = (k1i >= qi) && (k1i <= qi + 128) && (n > 0 || k1i >= 128);
            S0[r] = v0 ? S0[r] * SC : -INFINITY; S1[r] = v1 ? S1[r] * SC : -INFINITY;
            tmax = fmaxf(tmax, fmaxf(S0[r], S1[r]));
        }
        tmax = fmaxf(tmax, __shfl_xor(tmax, 16)); tmax = fmaxf(tmax, __shfl_xor(tmax, 32));
        const float mn = fmaxf(m, tmax);
        const float corr = __builtin_amdgcn_exp2f(m - mn); m = mn;
        float ps = 0.f; float p0[4], p1[4];
#pragma unroll
        for (int r = 0; r < 4; ++r) { p0[r] = __builtin_amdgcn_exp2f(S0[r] - mn); p1[r] = __builtin_amdgcn_exp2f(S1[r] - mn); ps += p0[r] + p1[r]; }
        lsum = lsum * corr + ps;
        u32x4 pk; pk.x = g2::cvt_pk_bf16(p0[0], p0[1]); pk.y = g2::cvt_pk_bf16(p0[2], p0[3]); pk.z = g2::cvt_pk_bf16(p1[0], p1[1]); pk.w = g2::cvt_pk_bf16(p1[2], p1[3]);
        const bf16x8_t Pf = __builtin_bit_cast(bf16x8_t, pk);
#pragma unroll
        for (int dt = 0; dt < 4; ++dt) {
            O[dt] = O[dt] * corr;
            const v4i16_t lo = __builtin_amdgcn_ds_read_tr16_b64_v4i16((LAS v4i16_t*)(Vt + (16 * t0 + 4 * g4 + qq) * ATT_RS + (16 * dt + 4 * pp4) * 2));
            const v4i16_t hi = __builtin_amdgcn_ds_read_tr16_b64_v4i16((LAS v4i16_t*)(Vt + (16 * t1 + 4 * g4 + qq) * ATT_RS + (16 * dt + 4 * pp4) * 2));
            const bf16x8_t Vf = __builtin_shufflevector(lo, hi, 0, 1, 2, 3, 4, 5, 6, 7);
            O[dt] = __builtin_amdgcn_mfma_f32_16x16x32_bf16(Vf, Pf, O[dt], 0, 0, 0);
        }
    }
    lsum += __shfl_xor(lsum, 16); lsum += __shfl_xor(lsum, 32);
    const float rl = 1.0f / lsum;
#pragma unroll
    for (int dt = 0; dt < 4; ++dt) { u32x2 o; o.x = g2::cvt_pk_bf16(O[dt][0] * rl, O[dt][1] * rl); o.y = g2::cvt_pk_bf16(O[dt][2] * rl, O[dt][3] * rl);
        *(u32x2*)(OG + tq * 256 + j * 64 + 16 * dt + 4 * g4) = o; }
    if (g4 == 0) LSE[tq * 4 + j] = m + __builtin_amdgcn_logf(lsum);
        if (!more) break;
        u = u2;
    }
}
__device__ __forceinline__ void ph_attn_combine(Frame& F, int own = -1) {
    const bf16* OG = (const bf16*)(F.outb + OUT_OG); const float* LSE = (const float*)(F.ws + WS_LSE); bf16* YA = (bf16*)(F.outb + OUT_YA);
    const int j = F.lane >> 4, c = (F.lane & 15) * 4;
    const int nit = own >= 0 ? ((T / 256 - own + F.G - 1) / F.G) * 32 : (T - (int)(blockIdx.x * NWAVES + F.wave) + F.G * NWAVES - 1) / (F.G * NWAVES);
#define AC_TOK(it) (own >= 0 ? ((own + ((it) >> 5) * F.G) << 8) + F.wave * 32 + ((it) & 31) : (int)(blockIdx.x * NWAVES + F.wave) + (it) * F.G * NWAVES)
#define AC_LOAD(tt) do { _Pragma("unroll") for (int g = 0; g < 3; ++g) { ln[g] = LSE[((size_t)g * T + (tt)) * 4 + j]; wn[g] = *(const u32x2*)(OG + ((size_t)g * T + (tt)) * 256 + j * 64 + c); } } while (0)
    float ln[3]; u32x2 wn[3];
    if (nit > 0) AC_LOAD(AC_TOK(0));
    for (int it = 0; it < nit; ++it) { const int t = AC_TOK(it);
        float l[3], o[3][4]; float mx = -INFINITY;
#pragma unroll
        for (int g = 0; g < 3; ++g) { l[g] = ln[g]; mx = fmaxf(mx, l[g]); const u32x2 w = wn[g];
            o[g][0] = __uint_as_float(w.x << 16); o[g][1] = __uint_as_float(w.x & 0xffff0000u); o[g][2] = __uint_as_float(w.y << 16); o[g][3] = __uint_as_float(w.y & 0xffff0000u); }
        if (it + 1 < nit) AC_LOAD(AC_TOK(it + 1));
        float ws = 0.f, y[4] = {0.f, 0.f, 0.f, 0.f};
#pragma unroll
        for (int g = 0; g < 3; ++g) { const float e = __builtin_amdgcn_exp2f(l[g] - mx); ws += e;
#pragma unroll
            for (int k = 0; k < 4; ++k) y[k] += e * o[g][k]; }
        const float rw = 1.0f / ws;
        u32x2 w; w.x = pk2(y[0] * rw, y[1] * rw); w.y = pk2(y[2] * rw, y[3] * rw);
        *(u32x2*)(YA + (size_t)t * 256 + j * 64 + c) = w;
    }
#undef AC_LOAD
#undef AC_TOK
}

__device__ __forceinline__ void ph_mlstm_naive_unit(Frame& F, int bh) {
    const int b = bh >> 2, h = bh & 3, tid = F.tid, v = tid & 255, dh = tid >> 8;
    LAS float* qs = (LAS float*)F.lds; LAS float* ks = qs + 128; LAS float* red = ks + 128; LAS float* sc = red + 512;
    const bf16* MQK = (const bf16*)(F.ws + WS_MQK); const bf16* MV = (const bf16*)(F.ws + WS_MV); const bf16* MO = (const bf16*)(F.ws + WS_MO);
    const float* GATES = (const float*)(F.ws + WS_GATES); bf16* YB = (bf16*)(F.outb + OUT_YB);
    const float* cw = F.in[I_CONVW]; const float* cbv = F.in[I_CONVB];
    float C[64];
#pragma unroll
    for (int d = 0; d < 64; ++d) C[d] = 0.f;
    float nst = 0.f, m = 0.f;
    const int ch = (tid < 128) ? (h * 128 + tid) : (512 + h * 128 + ((tid - 128) & 127));
    const float w0 = cw[ch], w1 = cw[1024 + ch], w2 = cw[2048 + ch], w3 = cw[3072 + ch], cb = cbv[ch];
    float xh0 = 0.f, xh1 = 0.f, xh2 = 0.f;
    const float gm = F.in[I_GMLSTM][h * 256 + v];
    __syncthreads();
    for (int s = 0; s < SEQ; ++s) {
        const size_t t = (size_t)b * SEQ + s;
        if (tid < 256) {
            const float xc = bf2f(MQK[t * 1024 + ch]);
            float y = cb + w0 * xh0 + w1 * xh1 + w2 * xh2 + w3 * xc; xh0 = xh1; xh1 = xh2; xh2 = xc;
            y = y / (1.0f + expf(-y));
            if (tid < 128) qs[tid] = y; else ks[tid - 128] = y * 0.08838834764831845f;
        }
        const float ig = GATES[t * 8 + h], fg = GATES[t * 8 + 4 + h];
        const float lf = logsigmoidf_(fg); const float mn = fmaxf(lf + m, ig); const float fd = expf(lf + m - mn), iw = expf(ig - mn); m = mn;
        const float vv = bf2f(MV[t * 1024 + h * 256 + v]);
        __syncthreads();
        float part = 0.f; const float ivv = iw * vv;
#pragma unroll
        for (int d4 = 0; d4 < 16; ++d4) { const f32x4 k4 = *(const LAS f32x4*)(ks + dh * 64 + d4 * 4), q4 = *(const LAS f32x4*)(qs + dh * 64 + d4 * 4);
#pragma unroll
            for (int e = 0; e < 4; ++e) { C[d4 * 4 + e] = fd * C[d4 * 4 + e] + ivv * k4[e]; part += C[d4 * 4 + e] * q4[e]; } }
        red[tid] = part;
        float nq = 0.f;
        if (tid < 128) { nst = fd * nst + iw * ks[tid]; nq = nst * qs[tid]; }
        nq = wave_sum(nq);
        if (F.lane == 0 && F.wave < 2) sc[F.wave] = nq;
        __syncthreads();
        const float num = red[v] + red[v + 256]; const float den = sc[0] + sc[1];
        const float hv = num / fmaxf(fabsf(den), expf(-mn));
        float sq = (dh == 0) ? hv * hv : 0.f; sq = wave_sum(sq);
        if (F.lane == 0) sc[2 + F.wave] = sq;
        __syncthreads();
        if (dh == 0) {
            const float ssum = sc[2] + sc[3] + sc[4] + sc[5];
            float y = hv * rsqrtf(ssum * (1.0f / 256.0f) + EPS) * gm;
            y *= sigmoidf_(bf2f(MO[t * 1024 + h * 256 + v]));
            YB[t * 1024 + h * 256 + v] = (bf16)f2bf(y);
        }
    }
    __syncthreads();
}


typedef float f32x16 __attribute__((ext_vector_type(16)));
typedef __bf16 bf16x2_t __attribute__((ext_vector_type(2)));
__device__ __forceinline__ unsigned cvtpk(float lo, float hi) { const f32x2 v = {lo, hi}; const bf16x2_t b = __builtin_convertvector(v, bf16x2_t); return __builtin_bit_cast(unsigned, b); }
__device__ __forceinline__ int crow32(int reg, int h2) { return (reg & 3) + 8 * (reg >> 2) + 4 * h2; }
constexpr int ML_QS = 272, ML_VS = 528, ML_SS = 144;
constexpr int ML_Q = 0, ML_K = 17408, ML_WKT = 34816, ML_WS = 144, ML_V = 53248, ML_SC = 87040, ML_RAW = 96768, ML_TAB = 131584, ML_H = 0;
#define MFMA32(a, b, c) __builtin_amdgcn_mfma_f32_32x32x16_bf16((a), (b), (c), 0, 0, 0)
__device__ __forceinline__ bf16x8_t tr2(LAS unsigned char* p, int rowstride) {
    const v4i16_t lo = __builtin_amdgcn_ds_read_tr16_b64_v4i16((LAS v4i16_t*)p);
    const v4i16_t hi = __builtin_amdgcn_ds_read_tr16_b64_v4i16((LAS v4i16_t*)(p + 4 * rowstride));
    return __builtin_shufflevector(lo, hi, 0, 1, 2, 3, 4, 5, 6, 7);
}
__device__ __forceinline__ void ml_gate_tables(LAS float* gt, float ig, float fg, float& mcar, int lane) {
    float bb = logsigmoidf_(fg);
#pragma unroll
    for (int o = 1; o < 64; o <<= 1) { const float v = __shfl_up(bb, o); if (lane >= o) bb += v; }
    const float a = ig - bb; float mx = a;
#pragma unroll
    for (int o = 1; o < 64; o <<= 1) { const float v = __shfl_up(mx, o); if (lane >= o) mx = fmaxf(mx, v); }
    const float Ml = fmaxf(mcar, mx);
    const float M63 = __shfl(Ml, 63), b63 = __shfl(bb, 63);
    gt[lane] = a; gt[64 + lane] = Ml; gt[128 + lane] = expf(-(bb + Ml)); gt[192 + lane] = expf(mcar - Ml); gt[256 + lane] = expf(a - M63);
    if (lane == 0) gt[320] = expf(mcar - M63);
    mcar = b63 + M63;
}
static_assert(ML_RAW + 67 * 512 <= MISC_OFF && MISC_OFF + 128 <= ML_TAB && ML_TAB + 11264 <= LDS_BYTES, "mLSTM LDS map");
template <bool FIRST>
__device__ __forceinline__ void ml_dma_raw(LAS unsigned char* L, const bf16* MQK, int b, int h, int c, int w, int lane) {
    const int rr = lane >> 5, seg = (lane >> 4) & 1, c16 = lane & 15;
    unsigned vo = (unsigned)(rr * 1024 + (seg ? 512 + h * 128 : h * 128) + c16 * 8) * 2u; asm volatile("" : "+v"(vo));
    const char* base = (const char*)(MQK + ((size_t)b * SEQ + 64 * c) * 1024) - 3 * 2048;
#pragma unroll
    for (int i = 0; i < 5; ++i) { int p = w * 5 + i; p = p > 33 ? 33 : p;
        const char* g = base + (size_t)p * 4096;
        if ((p < 33 || rr == 0) && (!FIRST || p >= 2 || (p == 1 && rr == 1))) __builtin_amdgcn_global_load_lds((const unsigned*)(g + vo), (LAS unsigned*)(L + ML_RAW + p * 1024), 16, 0, 0); }
}
__device__ __forceinline__ void ml_dma_v(LAS unsigned char* L, const bf16* MV, size_t t0, int h, int w, int lane) {
    unsigned vo = (unsigned)lane * 16u; asm volatile("" : "+v"(vo));
    const char* base = (const char*)(MV + (t0 + w * 8) * 1024 + h * 256);
#pragma unroll
    for (int i = 0; i < 8; ++i) { const int row = w * 8 + i;
        if (lane < 32) __builtin_amdgcn_global_load_lds((const unsigned*)(base + (size_t)i * 2048 + vo), (LAS unsigned*)(L + ML_V + row * ML_VS), 16, 0, 0); }
}
#define ML_SYNC() do { asm volatile("s_waitcnt lgkmcnt(0)" ::: "memory"); __builtin_amdgcn_s_barrier(); asm volatile("" ::: "memory"); } while (0)
__device__ __forceinline__ void mlstm_unit_fast(Frame& F, int bh) {
    const int b = bh >> 2, h = bh & 3, tid = F.tid, lane = F.lane, w = F.wave;
    LAS unsigned char* L = F.lds;
    LAS float* tab = (LAS float*)(L + ML_TAB);
    LAS float *td2 = tab + 1024, *trd = tab + 1088, *tn = tab + 1152, *tcw = tab + 1280, *tgm = tab + 2560;
    const bf16* MQK = (const bf16*)(F.ws + WS_MQK); const bf16* MV = (const bf16*)(F.ws + WS_MV); const bf16* MO = (const bf16*)(F.ws + WS_MO);
    const float* GATES = (const float*)(F.ws + WS_GATES); bf16* YB = (bf16*)(F.outb + OUT_YB);
    const int r32 = lane & 31, h2 = lane >> 5, gq = lane >> 4, i16 = lane & 15, q4 = i16 >> 2, p4 = i16 & 3;
    f32x16 Ct[4];
#pragma unroll
    for (int dt = 0; dt < 4; ++dt)
#pragma unroll
        for (int r = 0; r < 16; ++r) Ct[dt][r] = 0.f;
    float mcar = 0.f;
    __syncthreads();
    if (tid < 128) tn[tid] = 0.f;
    const int cg = tid & 31, tq = tid >> 5; const bool isq = cg < 16;
    if (tid < 256) { int chn = (tid < 128) ? (h * 128 + tid) : (512 + h * 128 + (tid - 128)); asm volatile("" : "+v"(chn)); const float* cw = F.in[I_CONVW];
        tcw[tid] = cw[chn]; tcw[256 + tid] = cw[1024 + chn]; tcw[512 + tid] = cw[2048 + chn]; tcw[768 + tid] = cw[3072 + chn]; tcw[1024 + tid] = F.in[I_CONVB][chn];
        int gi = h * 256 + tid; asm volatile("" : "+v"(gi)); tgm[tid] = F.in[I_GMLSTM][gi]; }
    if (tid < 96) *(LAS u32x4*)(L + ML_RAW + tid * 16) = (u32x4){0u, 0u, 0u, 0u};
    ml_dma_raw<true>(L, MQK, b, h, 0, w, lane);
    ml_dma_v(L, MV, (size_t)b * SEQ, h, w, lane);
    float ign = 0.f, fgn = 0.f;
    if (w == 3) { ign = GATES[((size_t)b * SEQ + lane) * 8 + h]; fgn = GATES[((size_t)b * SEQ + lane) * 8 + 4 + h]; ml_gate_tables(tab, ign, fgn, mcar, lane); }
    asm volatile("s_waitcnt vmcnt(0)" ::: "memory");
#pragma unroll 1
    for (int c = 0; c < SEQ / 64; ++c) {
        const size_t t0 = (size_t)b * SEQ + 64 * c;
        const bool more = c + 1 < SEQ / 64;
        LAS float* gt = tab + (c & 1) * 512;
        LAS float *ta = gt, *tM = gt + 64, *temt = gt + 128, *tin = gt + 192, *te = gt + 256, *tsc = gt + 320;
        asm volatile("s_waitcnt vmcnt(12)" ::: "memory");
        ML_SYNC();
        if (w == 3 && more) { ign = GATES[(t0 + 64 + lane) * 8 + h]; fgn = GATES[(t0 + 64 + lane) * 8 + 4 + h]; }
        {
#pragma unroll
          for (int e4 = 0; e4 < 2; ++e4) {
              const f32x4 w0 = *(const LAS f32x4*)(tcw + 8 * cg + 4 * e4), w1 = *(const LAS f32x4*)(tcw + 256 + 8 * cg + 4 * e4), w2 = *(const LAS f32x4*)(tcw + 512 + 8 * cg + 4 * e4),
                          w3 = *(const LAS f32x4*)(tcw + 768 + 8 * cg + 4 * e4), cb = *(const LAS f32x4*)(tcw + 1024 + 8 * cg + 4 * e4);
              f32x4 xr[7];
#pragma unroll
              for (int j = 0; j < 7; ++j) { const u32x2 rw = *(const LAS u32x2*)(L + ML_RAW + (4 * tq + j) * 512 + cg * 16 + e4 * 8); const unsigned lo = rw.x, hi = rw.y;
                  xr[j] = (f32x4){__uint_as_float(lo << 16), __uint_as_float(lo & 0xffff0000u), __uint_as_float(hi << 16), __uint_as_float(hi & 0xffff0000u)}; }
              f32x4 kv[4];
#pragma unroll
              for (int i = 0; i < 4; ++i) { const int sl = 4 * tq + i;
                  f32x4 v = cb + w0 * xr[i] + w1 * xr[i + 1] + w2 * xr[i + 2] + w3 * xr[i + 3];
#pragma unroll
                  for (int e = 0; e < 4; ++e) v[e] = v[e] * fsig(v[e]);
                  if (isq) { u32x2 o; o.x = pk2(v[0], v[1]); o.y = pk2(v[2], v[3]); *(LAS u32x2*)(L + ML_Q + sl * ML_QS + cg * 16 + e4 * 8) = o; }
                  else { const float es = te[sl]; v = v * 0.08838834764831845f;
                      u32x2 o; o.x = pk2(v[0], v[1]); o.y = pk2(v[2], v[3]); *(LAS u32x2*)(L + ML_K + sl * ML_QS + (cg - 16) * 16 + e4 * 8) = o;
                      kv[i] = v * es; } }
              if (!isq) {
#pragma unroll
                  for (int e = 0; e < 4; ++e) { u32x2 o2; o2.x = pk2(kv[0][e], kv[1][e]); o2.y = pk2(kv[2][e], kv[3][e]);
                      *(LAS u32x2*)(L + ML_WKT + (8 * (cg - 16) + 4 * e4 + e) * ML_WS + 8 * tq) = o2; } } } }
        ML_SYNC();
        if (w == 3 && more) ml_gate_tables(tab + ((c + 1) & 1) * 512, ign, fgn, mcar, lane);
        if (more) ml_dma_raw<false>(L, MQK, b, h, c + 1, w, lane);
        if (w < 3) {
            const int lt = w ? 1 : 0, st = (w == 2) ? 1 : 0;
            f32x16 S;
#pragma unroll
            for (int r = 0; r < 16; ++r) S[r] = 0.f;
#pragma unroll
            for (int ks = 0; ks < 8; ++ks) { const bf16x8_t A = *(const LAS bf16x8_t*)(L + ML_Q + (32 * lt + r32) * ML_QS + (16 * ks + 8 * h2) * 2);
                const bf16x8_t B = *(const LAS bf16x8_t*)(L + ML_K + (32 * st + r32) * ML_QS + (16 * ks + 8 * h2) * 2); S = MFMA32(A, B, S);
                if (ks & 1) asm volatile("" ::: "memory"); }
            const int s = 32 * st + r32; const float as = ta[s];
            const LAS float* tMh = tM + 32 * lt + 4 * h2; LAS unsigned char* scp = L + ML_SC + (32 * lt + 4 * h2) * ML_SS + s * 2; const int lb = 32 * lt + 4 * h2;
#pragma unroll
            for (int r = 0; r < 16; ++r) { const int ro = (r & 3) + 8 * (r >> 2);
                float x = as - tMh[ro]; x = (s <= lb + ro) ? x : -INFINITY;
                *(LAS bf16*)(scp + ro * ML_SS) = (bf16)f2bf(S[r] * __expf(x)); }
        } else if (w >= 4) {
            const int idx = tid - 256, l = idx >> 2, part = idx & 3; float acc = 0.f;
#pragma unroll
            for (int i = 0; i < 4; ++i) { float q8[8]; unpack8(*(const LAS u32x4*)(L + ML_Q + l * ML_QS + (32 * part + 8 * i) * 2), q8);
#pragma unroll
                for (int e = 0; e < 8; ++e) acc += tn[32 * part + 8 * i + e] * q8[e]; }
            acc += __shfl_xor(acc, 1); acc += __shfl_xor(acc, 2);
            if (part == 0) td2[l] = acc;
        }
        if (more) asm volatile("s_waitcnt vmcnt(5)" ::: "memory"); else asm volatile("s_waitcnt vmcnt(0)" ::: "memory");
        ML_SYNC();
        if (tid < 64) { const int l = tid; float d1 = 0.f; const int nb = (l < 32) ? 4 : 8;
            for (int i = 0; i < nb; ++i) { float v8[8]; unpack8(*(const LAS u32x4*)(L + ML_SC + l * ML_SS + i * 16), v8);
#pragma unroll
                for (int e = 0; e < 8; ++e) d1 += v8[e]; }
            const float den = d1 + tin[l] * td2[l]; trd[l] = 1.0f / fmaxf(fabsf(den), temt[l]); }
        bf16x8_t Vf[4];
        { v4i16_t t0_, t1_, t2_, t3_, t4_, t5_, t6_, t7_;
          LAS unsigned char* pv = L + ML_V + (8 * h2 + q4) * ML_VS + (32 * w + 16 * (gq & 1) + 4 * p4) * 2;
          static_assert(ML_VS == 528, "offsets below");
          asm volatile("ds_read_b64_tr_b16 %0, %8\n\tds_read_b64_tr_b16 %1, %8 offset:2112\n\tds_read_b64_tr_b16 %2, %8 offset:8448\n\tds_read_b64_tr_b16 %3, %8 offset:10560\n\t"
                       "ds_read_b64_tr_b16 %4, %8 offset:16896\n\tds_read_b64_tr_b16 %5, %8 offset:19008\n\tds_read_b64_tr_b16 %6, %8 offset:25344\n\tds_read_b64_tr_b16 %7, %8 offset:27456\n\t"
                       "s_waitcnt lgkmcnt(0)"
                       : "=&v"(t0_), "=&v"(t1_), "=&v"(t2_), "=&v"(t3_), "=&v"(t4_), "=&v"(t5_), "=&v"(t6_), "=&v"(t7_) : "v"(pv) : "memory");
          Vf[0] = __builtin_shufflevector(t0_, t1_, 0, 1, 2, 3, 4, 5, 6, 7); Vf[1] = __builtin_shufflevector(t2_, t3_, 0, 1, 2, 3, 4, 5, 6, 7);
          Vf[2] = __builtin_shufflevector(t4_, t5_, 0, 1, 2, 3, 4, 5, 6, 7); Vf[3] = __builtin_shufflevector(t6_, t7_, 0, 1, 2, 3, 4, 5, 6, 7); }
        f32x16 N1[2], N2[2];
#pragma unroll
        for (int lt = 0; lt < 2; ++lt)
#pragma unroll
            for (int r = 0; r < 16; ++r) { N1[lt][r] = 0.f; N2[lt][r] = 0.f; }
#pragma unroll
        for (int ks = 0; ks < 2; ++ks) N1[0] = MFMA32(*(const LAS bf16x8_t*)(L + ML_SC + r32 * ML_SS + (16 * ks + 8 * h2) * 2), Vf[ks], N1[0]);
#pragma unroll
        for (int ks = 0; ks < 4; ++ks) N1[1] = MFMA32(*(const LAS bf16x8_t*)(L + ML_SC + (32 + r32) * ML_SS + (16 * ks + 8 * h2) * 2), Vf[ks], N1[1]);
        asm volatile("" ::: "memory");
#pragma unroll
        for (int dt = 0; dt < 4; ++dt)
#pragma unroll
            for (int s2 = 0; s2 < 2; ++s2) {
                u32x4 pk;
#pragma unroll
                for (int e = 0; e < 4; ++e) pk[e] = cvtpk(Ct[dt][8 * s2 + 2 * e], Ct[dt][8 * s2 + 2 * e + 1]);
                const bf16x8_t Bc = __builtin_bit_cast(bf16x8_t, pk);
#pragma unroll
                for (int lt = 0; lt < 2; ++lt) {
                    const u32x2 lo = *(const LAS u32x2*)(L + ML_Q + (32 * lt + r32) * ML_QS + (32 * dt + 16 * s2 + 4 * h2) * 2);
                    const u32x2 hi = *(const LAS u32x2*)(L + ML_Q + (32 * lt + r32) * ML_QS + (32 * dt + 16 * s2 + 8 + 4 * h2) * 2);
                    const u32x4 a4 = (u32x4){lo.x, lo.y, hi.x, hi.y};
                    N2[lt] = MFMA32(__builtin_bit_cast(bf16x8_t, a4), Bc, N2[lt]); }
                asm volatile("" ::: "memory"); }
        { const float decay = tsc[0];
#pragma unroll
          for (int dt = 0; dt < 4; ++dt) {
#pragma unroll
              for (int r = 0; r < 16; ++r) Ct[dt][r] *= decay;
#pragma unroll
              for (int ks = 0; ks < 4; ++ks) Ct[dt] = MFMA32(*(const LAS bf16x8_t*)(L + ML_WKT + (32 * dt + r32) * ML_WS + (16 * ks + 8 * h2) * 2), Vf[ks], Ct[dt]);
              asm volatile("" ::: "memory"); }
          if (tid < 128) { float acc = decay * tn[tid];
#pragma unroll 8
              for (int s = 0; s < 64; ++s) acc += te[s] * bf2f(*(const LAS bf16*)(L + ML_K + s * ML_QS + tid * 2));
              tn[tid] = acc; } }
        ML_SYNC();
        if (more) ml_dma_v(L, MV, t0 + 64, h, w, lane);
#pragma unroll
        for (int lt = 0; lt < 2; ++lt)
#pragma unroll
            for (int r = 0; r < 16; ++r) { const int ro = 32 * lt + (r & 3) + 8 * (r >> 2); const LAS float* tinh = tin + 4 * h2; const LAS float* trdh = trd + 4 * h2;
                const float hv = (N1[lt][r] + tinh[ro] * N2[lt][r]) * trdh[ro];
                *(LAS bf16*)(L + ML_H + (4 * h2) * ML_VS + (32 * w + r32) * 2 + ro * ML_VS) = (bf16)f2bf(hv); }
#if GATES_U8
        u32x4 moreg[2];
        { const unsigned char* mo = (const unsigned char*)MO + (t0 + (tid >> 3)) * 1024 + h * 256 + (tid & 7) * 32; moreg[0] = *(const u32x4*)mo; moreg[1] = *(const u32x4*)(mo + 16); }
#else
        u32x4 moreg[4];
        { const bf16* mo = MO + (t0 + (tid >> 3)) * 1024 + h * 256 + (tid & 7) * 32;
#pragma unroll
          for (int i = 0; i < 4; ++i) moreg[i] = *(const u32x4*)(mo + 8 * i); }
#endif
        ML_SYNC();
        { const int l = tid >> 3, part = tid & 7; float hv[32]; float ss = 0.f;
#pragma unroll
          for (int i = 0; i < 4; ++i) { float t8[8]; unpack8(*(const LAS u32x4*)(L + ML_H + l * ML_VS + part * 64 + i * 16), t8);
#pragma unroll
              for (int e = 0; e < 8; ++e) { hv[8 * i + e] = t8[e]; ss += t8[e] * t8[e]; } }
          ss += __shfl_xor(ss, 1); ss += __shfl_xor(ss, 2); ss += __shfl_xor(ss, 4);
          const float rstd = rsqrtf(ss * (1.0f / 256.0f) + EPS);
          const LAS float* gm = tgm + part * 32; bf16* yb = YB + (t0 + l) * 1024 + h * 256 + part * 32;
#pragma unroll
          for (int i = 0; i < 4; ++i) { const f32x4 g0 = *(const LAS f32x4*)(gm + 8 * i), g1 = *(const LAS f32x4*)(gm + 8 * i + 4);
#if GATES_U8
              const f32x4 sa = unpk4_sig_u8(moreg[i >> 1][2 * (i & 1)]), sb = unpk4_sig_u8(moreg[i >> 1][2 * (i & 1) + 1]);
              float o[8];
#pragma unroll
              for (int e = 0; e < 8; ++e) o[e] = hv[8 * i + e] * rstd * (e < 4 ? g0[e] * sa[e] : g1[e - 4] * sb[e - 4]);
#else
              float m8[8]; unpack8(moreg[i], m8);
              float o[8];
#pragma unroll
              for (int e = 0; e < 8; ++e) o[e] = hv[8 * i + e] * rstd * (e < 4 ? g0[e] : g1[e - 4]) * fsig(m8[e]);
#endif
              u32x4 wv; wv.x = pk2(o[0], o[1]); wv.y = pk2(o[2], o[3]); wv.z = pk2(o[4], o[5]); wv.w = pk2(o[6], o[7]);
              *(u32x4*)(yb + 8 * i) = wv; } }
    }
    __syncthreads();
}

__device__ __forceinline__ void ph_branch_naive(Frame& F) {
    LAS float* As = (LAS float*)F.lds; LAS float* Bs = As + 16 * 132;
    const bf16* YA = (const bf16*)(F.outb + OUT_YA); const bf16* YB = (const bf16*)(F.outb + OUT_YB); const bf16* GAB = (const bf16*)(F.ws + WS_GAB);
    bf16* MG = (bf16*)(F.ws + WS_MERGED);
    const int ty = F.tid >> 5, tx = F.tid & 31;
    for (int vb = blockIdx.x; vb < (T / 128) * 8; vb += F.G) {
        const int tm = vb >> 3, tn = vb & 7, m0 = tm * 128, n0 = tn * 128;
        float a1[8][4], a2[8][4]; ZERO_ACC(a1); ZERO_ACC(a2);
        ARowGlobal ra{YA, (size_t)256, m0, nullptr}; ngemm_acc(As, Bs, ra, F.in[I_WBA], D, 256, n0, D, a1);
        ARowGlobal rb{YB, (size_t)D, m0, nullptr};  ngemm_acc(As, Bs, rb, F.in[I_WBB], D, D, n0, D, a2);
#pragma unroll
        for (int i = 0; i < 8; ++i) { const size_t row = (size_t)(m0 + ty * 8 + i); const int col = n0 + tx * 4;
            const u32x2 ga = *(const u32x2*)(GAB + row * 2048 + col), gb = *(const u32x2*)(GAB + row * 2048 + 1024 + col);
            const float sga[4] = {sigmoidf_(__uint_as_float(ga.x << 16)), sigmoidf_(__uint_as_float(ga.x & 0xffff0000u)), sigmoidf_(__uint_as_float(ga.y << 16)), sigmoidf_(__uint_as_float(ga.y & 0xffff0000u))};
            const float sgb[4] = {sigmoidf_(__uint_as_float(gb.x << 16)), sigmoidf_(__uint_as_float(gb.x & 0xffff0000u)), sigmoidf_(__uint_as_float(gb.y << 16)), sigmoidf_(__uint_as_float(gb.y & 0xffff0000u))};
            float o[4];
#pragma unroll
            for (int j = 0; j < 4; ++j) o[j] = sga[j] * a1[i][j] + sgb[j] * a2[i][j];
            u32x2 w; w.x = pk2(o[0], o[1]); w.y = pk2(o[2], o[3]); *(u32x2*)(MG + row * D + col) = w; }
    }
}

__device__ __forceinline__ void ph_outproj_naive(Frame& F) {
    LAS float* As = (LAS float*)F.lds; LAS float* Bs = As + 16 * 132;
    const bf16* MG = (const bf16*)(F.ws + WS_MERGED); bf16* YM = (bf16*)(F.ws + WS_YMIX);
    const int ty = F.tid >> 5, tx = F.tid & 31;
    for (int vb = blockIdx.x; vb < (T / 128) * 8; vb += F.G) {
        const int tm = vb >> 3, tn = vb & 7, m0 = tm * 128, n0 = tn * 128;
        float a1[8][4]; ZERO_ACC(a1);
        ARowGlobal ra{MG, (size_t)D, m0, nullptr}; ngemm_acc(As, Bs, ra, F.in[I_WOUT], D, D, n0, D, a1);
#pragma unroll
        for (int i = 0; i < 8; ++i) { const size_t row = (size_t)(m0 + ty * 8 + i); const int col = n0 + tx * 4;
            u32x2 w; w.x = pk2(a1[i][0], a1[i][1]); w.y = pk2(a1[i][2], a1[i][3]); *(u32x2*)(YM + row * D + col) = w; }
    }
}

struct X1In { u32x2 ym[4]; f32x4 xv[4]; };
__device__ __forceinline__ void x1_load(Frame& F, int t, X1In& r) {
    const float* x = F.in[I_X]; const bf16* YM = (const bf16*)(F.ws + WS_YMIX);
#pragma unroll
    for (int j = 0; j < 4; ++j) { r.ym[j] = *(const u32x2*)(YM + (size_t)t * D + F.lane * 4 + 256 * j); r.xv[j] = *(const f32x4*)(x + (size_t)t * D + F.lane * 4 + 256 * j); }
}
__device__ __forceinline__ void x1_compute(Frame& F, int t, const X1In& r, f32x4 (&x1)[4]) {
    const float* mod = (const float*)(F.ws + WS_MOD);
    const int b = t / SEQ; const float* gt1 = mod + b * 6144 + 2048; const float* g = F.in[I_GPOSTMIX];
    f32x4 y[4]; float ss = 0.f;
#pragma unroll
    for (int j = 0; j < 4; ++j) { const u32x2 w = r.ym[j];
        y[j][0] = __uint_as_float(w.x << 16); y[j][1] = __uint_as_float(w.x & 0xffff0000u); y[j][2] = __uint_as_float(w.y << 16); y[j][3] = __uint_as_float(w.y & 0xffff0000u);
        ss += y[j][0] * y[j][0] + y[j][1] * y[j][1] + y[j][2] * y[j][2] + y[j][3] * y[j][3]; }
    const float rstd = rsqrtf(wave_sum(ss) * (1.0f / D) + EPS);
#pragma unroll
    for (int j = 0; j < 4; ++j) { const int c = F.lane * 4 + 256 * j; const f32x4 gg = *(const f32x4*)(g + c), gt = *(const f32x4*)(gt1 + c);
#pragma unroll
        for (int e = 0; e < 4; ++e) x1[j][e] = r.xv[j][e] + gt[e] * (y[j][e] * rstd * gg[e]); }
}
__device__ __forceinline__ void x1_row(Frame& F, int t, f32x4 (&x1)[4]) { X1In r; x1_load(F, t, r); x1_compute(F, t, r, x1); }

__device__ __forceinline__ void ph_normmid(Frame& F) {
    const float* mod = (const float*)(F.ws + WS_MOD); const float* g = F.in[I_GPREFFN]; bf16* H2 = (bf16*)(F.ws + WS_H2);
    const int tstep = F.G * NWAVES; int t = blockIdx.x * NWAVES + F.wave;
    X1In rn; if (t < T) x1_load(F, t, rn);
    for (; t < T; t += tstep) {
        const int b = t / SEQ; const float* sh2 = mod + b * 6144 + 3072, *sc2 = mod + b * 6144 + 4096;
        const X1In rc = rn; if (t + tstep < T) x1_load(F, t + tstep, rn);
        f32x4 x1[4]; x1_compute(F, t, rc, x1);
        float ss = 0.f;
#pragma unroll
        for (int j = 0; j < 4; ++j) ss += x1[j][0] * x1[j][0] + x1[j][1] * x1[j][1] + x1[j][2] * x1[j][2] + x1[j][3] * x1[j][3];
        const float rstd = rsqrtf(wave_sum(ss) * (1.0f / D) + EPS);
#pragma unroll
        for (int j = 0; j < 4; ++j) { const int c = F.lane * 4 + 256 * j; const f32x4 gg = *(const f32x4*)(g + c), s2 = *(const f32x4*)(sc2 + c), h2 = *(const f32x4*)(sh2 + c);
            float o[4];
#pragma unroll
            for (int e = 0; e < 4; ++e) o[e] = x1[j][e] * rstd * gg[e] * (1.0f + s2[e]) + h2[e];
            u32x2 w; w.x = pk2(o[0], o[1]); w.y = pk2(o[2], o[3]); *(u32x2*)(H2 + (size_t)t * D + c) = w;
#if MOE_FP8
            *(unsigned*)(F.ws + WS_H2F8 + (size_t)t * D + c) = pk4_fp8(o[0], o[1], o[2], o[3]);
#endif
#if !FAST_MOE2
            *(f32x4*)(F.out + (size_t)t * D + c) = (f32x4){0.f, 0.f, 0.f, 0.f};
#endif
        }
    }
}

__device__ __forceinline__ void ph_normmid_blocks(Frame& F, int vcu) {
    for (int bi = 0; bi * F.G + vcu < T / 256; ++bi) { const int tblk = bi * F.G + vcu;
    const float* mod = (const float*)(F.ws + WS_MOD); const float* g = F.in[I_GPREFFN]; bf16* H2 = (bf16*)(F.ws + WS_H2);
    const int tstep = 1; int t = tblk * 256 + F.wave * 32; const int tend = t + 32;
    X1In rn; x1_load(F, t, rn);
    for (; t < tend; t += tstep) {
        const int b = t / SEQ; const float* sh2 = mod + b * 6144 + 3072, *sc2 = mod + b * 6144 + 4096;
        const X1In rc = rn; if (t + tstep < tend) x1_load(F, t + tstep, rn);
        f32x4 x1[4]; x1_compute(F, t, rc, x1);
        float ss = 0.f;
#pragma unroll
        for (int j = 0; j < 4; ++j) ss += x1[j][0] * x1[j][0] + x1[j][1] * x1[j][1] + x1[j][2] * x1[j][2] + x1[j][3] * x1[j][3];
        const float rstd = rsqrtf(wave_sum(ss) * (1.0f / D) + EPS);
#pragma unroll
        for (int j = 0; j < 4; ++j) { const int c = F.lane * 4 + 256 * j; const f32x4 gg = *(const f32x4*)(g + c), s2 = *(const f32x4*)(sc2 + c), h2 = *(const f32x4*)(sh2 + c);
            float o[4];
#pragma unroll
            for (int e = 0; e < 4; ++e) o[e] = x1[j][e] * rstd * gg[e] * (1.0f + s2[e]) + h2[e];
            u32x2 w; w.x = pk2(o[0], o[1]); w.y = pk2(o[2], o[3]); *(u32x2*)(H2 + (size_t)t * D + c) = w;
            { u32x2 wx; wx.x = pk2(x1[j][0], x1[j][1]); wx.y = pk2(x1[j][2], x1[j][3]); *(u32x2*)((bf16*)(F.ws + WS_YMIX) + (size_t)t * D + c) = wx; }
#if MOE_FP8
            *(unsigned*)(F.ws + WS_H2F8 + (size_t)t * D + c) = pk4_fp8(o[0], o[1], o[2], o[3]);
#endif
#if !FAST_MOE2
            *(f32x4*)(F.out + (size_t)t * D + c) = (f32x4){0.f, 0.f, 0.f, 0.f};
#endif
        }
    }
}
}

constexpr int HALF_T = T / 2;
__device__ __forceinline__ unsigned char* slot_ptr(unsigned char* ws, unsigned char* outb, int half, int k, int t) {
    const size_t tl = (size_t)(t - half * HALF_T);
    if (k < 2) return outb + (size_t)t * 4096 + k * 2048;
#if MOE_FP8
    int ri;
    if (half == 0) { if (k < 4) return outb + (size_t)(t + HALF_T) * 4096 + (k - 2) * 2048; ri = k - 4; } else ri = k - 2;
    const size_t base = (ri == 0) ? 192 : (ri == 1) ? 256 : (ri == 2) ? 448 : (ri == 3) ? 512 : (ri == 4) ? 576 : (ri == 5) ? 640 : 704;
    return ws + base * MiB + tl * 2048;
#else
    if (half == 0) {
        if (k < 4) return outb + (size_t)(t + HALF_T) * 4096 + (k - 2) * 2048;
        if (k < 6) return ws + (192 + 64 * (size_t)(k - 4)) * MiB + tl * 2048;
        return ws + (512 + 64 * (size_t)(k - 6)) * MiB + tl * 2048;
    }
    if (k < 4) return ws + (192 + 64 * (size_t)(k - 2)) * MiB + tl * 2048;
    if (k < 8) return ws + (512 + 64 * (size_t)(k - 4)) * MiB + tl * 2048;
    return ws + 768 * MiB + tl * 2048;
#endif
}
__device__ __forceinline__ void ph_topk2(Frame& F) {
    const float* LG = (const float*)(F.ws + WS_LOGITS); const float* rb = F.in[I_RB];
    int* TOPI = (int*)(F.ws + WS_TOPI); float* TOPW = (float*)(F.ws + WS_TOPW); int* HIST = (int*)(F.ws + WS_HIST);
    LAS float* selw = (LAS float*)F.lds + F.wave * 512; LAS float* gsw = selw + 256;
    LAS unsigned* hist = (LAS unsigned*)(F.lds + 8 * 512 * 4);
    const int lane = F.lane, hf = lane >> 5;
    for (int tb = blockIdx.x; tb < T / 256; tb += F.G) {
        __syncthreads();
        if (F.tid < 256) hist[F.tid] = 0u;
        __syncthreads();
        for (int it = 0; it < 32; ++it) {
            const int t = tb * 256 + F.wave * 32 + it;
            float sc[4], sel[4];
#pragma unroll
            for (int i = 0; i < 4; ++i) { sc[i] = sigmoidf_(LG[(size_t)t * NE + lane + 64 * i]); sel[i] = sc[i] + rb[lane + 64 * i]; selw[lane + 64 * i] = sel[i]; }
            asm volatile("s_waitcnt lgkmcnt(0)" ::: "memory");
            if (lane < 8) { float m1 = -INFINITY, m2 = -INFINITY;
#pragma unroll
                for (int q = 0; q < 8; ++q) { const f32x4 v = *(const LAS f32x4*)(selw + lane * 32 + q * 4);
#pragma unroll
                    for (int e = 0; e < 4; ++e) { const float x = v[e]; const float lo = fminf(m1, x); m1 = fmaxf(m1, x); m2 = fmaxf(m2, lo); } }
                gsw[lane] = m1 + m2; }
            asm volatile("s_waitcnt lgkmcnt(0)" ::: "memory");
            float gs[8];
            { const f32x4 a = *(const LAS f32x4*)gsw, b2 = *(const LAS f32x4*)(gsw + 4); gs[0] = a[0]; gs[1] = a[1]; gs[2] = a[2]; gs[3] = a[3]; gs[4] = b2[0]; gs[5] = b2[1]; gs[6] = b2[2]; gs[7] = b2[3]; }
            bool gsel[8];
#pragma unroll
            for (int a = 0; a < 8; ++a) { int rank = 0;
#pragma unroll
                for (int c = 0; c < 8; ++c) rank += (gs[c] > gs[a] || (gs[c] == gs[a] && c < a)) ? 1 : 0;
                gsel[a] = rank < 4; }
            asm volatile("" ::: "memory");
#pragma unroll
            for (int i = 0; i < 4; ++i) { const bool ok = hf ? gsel[2 * i + 1] : gsel[2 * i]; if (!ok) sel[i] = -INFINITY; selw[lane + 64 * i] = sel[i]; }
            asm volatile("s_waitcnt lgkmcnt(0)" ::: "memory");
            int rk[4] = {0, 0, 0, 0};
#pragma unroll 4
            for (int q = 0; q < 64; ++q) { const f32x4 v = *(const LAS f32x4*)(selw + q * 4);
#pragma unroll
                for (int e = 0; e < 4; ++e) { const float x = v[e]; const int xe = q * 4 + e;
#pragma unroll
                    for (int i = 0; i < 4; ++i) rk[i] += (x > sel[i] || (x == sel[i] && xe < lane + 64 * i)) ? 1 : 0; } }
            asm volatile("" ::: "memory");
            float part = 0.f;
#pragma unroll
            for (int i = 0; i < 4; ++i) { if (sel[i] == -INFINITY) rk[i] = 999; if (rk[i] < TOPK) part += sc[i]; }
            const float wsum = wave_sum(part);
#pragma unroll
            for (int i = 0; i < 4; ++i) if (rk[i] < TOPK) { TOPI[(size_t)t * TOPK + rk[i]] = lane + 64 * i; TOPW[(size_t)t * TOPK + rk[i]] = sc[i] / wsum * 2.5f; __hip_atomic_fetch_add(&hist[lane + 64 * i], 1u, __ATOMIC_RELAXED, __HIP_MEMORY_SCOPE_WORKGROUP); }
        }
        __syncthreads();
        if (F.tid < 256) HIST[tb * 256 + F.tid] = (int)hist[F.tid];
    }
}

__device__ __forceinline__ unsigned mono_key(float v, int e) {
    unsigned u = __float_as_uint(v); u ^= (u & 0x80000000u) ? 0xffffffffu : 0x80000000u; return (u & 0xffffff00u) | (unsigned)(255 - e); }
struct StrideBlocks { int b0, G; __device__ __forceinline__ int block(int i) const { const int tb = b0 + i * G; return tb < T / 256 ? tb : -1; } };
struct RouterBlocks { g2::DenseOrder S; __device__ __forceinline__ int block(int i) const { g2::UnitMN u; return S.next(i, u) ? u.pm : -1; } };
template <class BlockIter>
__device__ __forceinline__ void ph_topk4(Frame& F, const BlockIter& BI) {
    const float* LG = (const float*)(F.ws + WS_LOGITS); const float* rb = F.in[I_RB];
    int* TOPI = (int*)(F.ws + WS_TOPI); float* TOPW = (float*)(F.ws + WS_TOPW); int* HIST = (int*)(F.ws + WS_HIST);
    LAS float* selw = (LAS float*)F.lds + F.wave * 1280; LAS float* gsw = selw + 512; LAS int* gfl = (LAS int*)(selw + 528); LAS int* resI = (LAS int*)(selw + 768); LAS float* resW = selw + 1024;
    LAS unsigned* hist = (LAS unsigned*)(F.lds + 8 * 1280 * 4);
    const int lane = F.lane, hf = lane >> 5;
    float rbv[4];
#pragma unroll
    for (int i = 0; i < 4; ++i) rbv[i] = rb[lane + 64 * i];
#define LWAIT() asm volatile("s_waitcnt lgkmcnt(0)" ::: "memory")
    for (int bi = 0;; ++bi) {
        const int tb = BI.block(bi); if (tb < 0) break;
        __syncthreads();
        if (F.tid < 256) hist[F.tid] = 0u;
        __syncthreads();
        const int tbase = tb * 256 + F.wave * 32;
        float lgn[2][4];
#pragma unroll
        for (int u = 0; u < 2; ++u)
#pragma unroll
            for (int i = 0; i < 4; ++i) lgn[u][i] = LG[(size_t)(tbase + 16 * u) * NE + lane + 64 * i];
#pragma unroll 1
        for (int it = 0; it < 16; ++it) {
            float sc[2][4], sel[2][4];
#pragma unroll
            for (int u = 0; u < 2; ++u)
#pragma unroll
                for (int i = 0; i < 4; ++i) { sc[u][i] = fsig(lgn[u][i]); sel[u][i] = sc[u][i] + rbv[i]; selw[u * 256 + lane + 64 * i] = sel[u][i]; }
            if (it + 1 < 16) {
#pragma unroll
                for (int u = 0; u < 2; ++u)
#pragma unroll
                    for (int i = 0; i < 4; ++i) lgn[u][i] = LG[(size_t)(tbase + 16 * u + it + 1) * NE + lane + 64 * i]; }
            LWAIT();
            if (lane < 16) { float m1 = -INFINITY, m2 = -INFINITY;
#pragma unroll
                for (int q = 0; q < 8; ++q) { const f32x4 v = *(const LAS f32x4*)(selw + lane * 32 + q * 4);
#pragma unroll
                    for (int e = 0; e < 4; ++e) { const float x = v[e]; const float lo = fminf(m1, x); m1 = fmaxf(m1, x); m2 = fmaxf(m2, lo); } }
                gsw[lane] = m1 + m2; }
            LWAIT();
            if (lane < 16) { const LAS float* gp = gsw + (lane & 8); const f32x4 a = *(const LAS f32x4*)gp, b2 = *(const LAS f32x4*)(gp + 4); const float gs[8] = {a[0], a[1], a[2], a[3], b2[0], b2[1], b2[2], b2[3]};
                const int gl = lane & 7; float me = 0.f;
#pragma unroll
                for (int c = 0; c < 8; ++c) me = (gl == c) ? gs[c] : me;
                int rank = 0;
#pragma unroll
                for (int c = 0; c < 8; ++c) rank += (gs[c] > me || (gs[c] == me && c < gl)) ? 1 : 0;
                gfl[lane] = rank < 4 ? 1 : 0; }
            LWAIT();
            unsigned key[2][4];
#pragma unroll
            for (int u = 0; u < 2; ++u) { const u32x4 a = *(const LAS u32x4*)(gfl + 8 * u), b2 = *(const LAS u32x4*)(gfl + 8 * u + 4); const int fl[8] = {(int)a[0], (int)a[1], (int)a[2], (int)a[3], (int)b2[0], (int)b2[1], (int)b2[2], (int)b2[3]};
#pragma unroll
                for (int i = 0; i < 4; ++i) { const int f = hf ? fl[2 * i + 1] : fl[2 * i]; key[u][i] = f ? mono_key(sel[u][i], lane + 64 * i) : 0u; } }
            unsigned prefix[2] = {0u, 0u};
#pragma unroll
            for (int bit = 31; bit >= 0; --bit)
#pragma unroll
                for (int u = 0; u < 2; ++u) { const unsigned cand = prefix[u] | (1u << bit); int cnt = 0;
#pragma unroll
                    for (int i = 0; i < 4; ++i) cnt += __builtin_popcountll(__builtin_amdgcn_ballot_w64(key[u][i] >= cand));
                    prefix[u] = (cnt >= TOPK) ? cand : prefix[u]; }
#pragma unroll
            for (int u = 0; u < 2; ++u) {
                int slot[4]; bool pick[4]; int base = 0; float part = 0.f;
#pragma unroll
                for (int i = 0; i < 4; ++i) { pick[i] = key[u][i] >= prefix[u]; const unsigned long long bm = __builtin_amdgcn_ballot_w64(pick[i]);
                    slot[i] = base + (int)__builtin_amdgcn_mbcnt_hi((unsigned)(bm >> 32), __builtin_amdgcn_mbcnt_lo((unsigned)bm, 0u)); base += __builtin_popcountll(bm);
                    part += pick[i] ? sc[u][i] : 0.f; }
                const float wsum = wave_sum(part);
                const float sc25 = 2.5f / wsum;
#pragma unroll
                for (int i = 0; i < 4; ++i) if (pick[i]) { const int e = lane + 64 * i, ri = (16 * u + it) * TOPK + slot[i]; resI[ri] = e; resW[ri] = sc[u][i] * sc25; __hip_atomic_fetch_add(&hist[e], 1u, __ATOMIC_RELAXED, __HIP_MEMORY_SCOPE_WORKGROUP); } }
        }
        LWAIT();
        *(u32x4*)(TOPI + (size_t)tbase * TOPK + lane * 4) = *(const LAS u32x4*)(resI + lane * 4); *(f32x4*)(TOPW + (size_t)tbase * TOPK + lane * 4) = *(const LAS f32x4*)(resW + lane * 4);
        __syncthreads();
        if (F.tid < 256) HIST[tb * 256 + F.tid] = (int)hist[F.tid];
    }
#undef LWAIT
}

struct UnitBO { int pm, pn, kind; };
struct BOOrder {
    typedef UnitBO Unit;
    int G, vcu; const char *YA, *YB, *MG, *WA, *WB, *WO;
    __device__ __forceinline__ bool next(int i, Unit& u) const { const int rt = i / 12, j = i - rt * 12; u.pm = rt * G + vcu; if (u.pm >= T / 256) return false;
        if (j < 8) { u.pn = j >> 1; u.kind = j & 1; } else { u.pn = j - 8; u.kind = 2; } return true; }
    __device__ __forceinline__ int K(const Unit& u) const { return u.kind == 0 ? 256 : 1024; }
    __device__ __forceinline__ const char* a_base(const Unit& u) const { const char* p = YA; if (u.kind == 1) p = YB; asm volatile("" : "+s"(p)); if (u.kind == 2) p = MG; return p; }
    __device__ __forceinline__ unsigned a_row_off(const Unit& u, int r) const { return (unsigned)(u.pm * 256 + r) * (u.kind == 0 ? 512u : 2048u); }
    __device__ __forceinline__ const char* b_base(const Unit& u) const { const char* p = WA + (size_t)u.pn * 256 * 512; if (u.kind == 1) p = WB + (size_t)u.pn * 256 * 2048; asm volatile("" : "+s"(p)); if (u.kind == 2) p = WO + (size_t)u.pn * 256 * 2048; return p; }
};
struct EpiBO {
    static constexpr bool PERM = true;
    const unsigned char* GAB8; bf16* MG; bf16* YM;
    __device__ __forceinline__ bool operator()(f32x4 (&acc)[2][2][4][2], const UnitBO& u, int wr, int wc, int fr, int fq) const {
        const int row0 = u.pm * 256 + wr * 64 + fr, col0 = u.pn * 256 + wc * 64 + 16 * fq;
        if (u.kind == 0) {
            u32x4 gaq[8], gbq[8];
#pragma unroll
            for (int ai = 0; ai < 2; ++ai)
#pragma unroll
                for (int m = 0; m < 4; ++m) { const unsigned char* g8 = GAB8 + (size_t)(row0 + ai * 128 + m * 16) * 2048 + col0; gaq[ai * 4 + m] = *(const u32x4*)g8; gbq[ai * 4 + m] = *(const u32x4*)(g8 + 1024); }
#pragma unroll
            for (int ai = 0; ai < 2; ++ai)
#pragma unroll
                for (int m = 0; m < 4; ++m)
#pragma unroll
                    for (int bj = 0; bj < 2; ++bj)
#pragma unroll
                        for (int n = 0; n < 2; ++n) { const f32x4 sa = unpk4_sig_u8(gaq[ai * 4 + m][2 * bj + n]), sb = unpk4_sig_u8(gbq[ai * 4 + m][2 * bj + n]);
#pragma unroll
                            for (int e = 0; e < 4; ++e) acc[ai][bj][m][n][e] *= sa[e] * __builtin_amdgcn_rcpf(sb[e]); }
            return false;
        }
        bf16* dbase = YM; if (u.kind == 1) dbase = MG; asm volatile("" : "+s"(dbase));
        u32x4 gbq[8];
        if (u.kind == 1) {
#pragma unroll
            for (int ai = 0; ai < 2; ++ai)
#pragma unroll
                for (int m = 0; m < 4; ++m) gbq[ai * 4 + m] = *(const u32x4*)(GAB8 + (size_t)(row0 + ai * 128 + m * 16) * 2048 + 1024 + col0);
        }
#pragma unroll
        for (int ai = 0; ai < 2; ++ai)
#pragma unroll
            for (int m = 0; m < 4; ++m) { const size_t row = (size_t)(row0 + ai * 128 + m * 16);
                f32x4 s0 = (f32x4){1.f, 1.f, 1.f, 1.f}, s1 = s0, s2 = s0, s3 = s0;
                if (u.kind == 1) { const u32x4 g = gbq[ai * 4 + m]; s0 = unpk4_sig_u8(g[0]); s1 = unpk4_sig_u8(g[1]); s2 = unpk4_sig_u8(g[2]); s3 = unpk4_sig_u8(g[3]); }
                const f32x4 v0 = acc[ai][0][m][0] * s0, v1 = acc[ai][0][m][1] * s1, v2 = acc[ai][1][m][0] * s2, v3 = acc[ai][1][m][1] * s3;
                u32x4 w0, w1; w0.x = g2::cvt_pk_bf16(v0[0], v0[1]); w0.y = g2::cvt_pk_bf16(v0[2], v0[3]); w0.z = g2::cvt_pk_bf16(v1[0], v1[1]); w0.w = g2::cvt_pk_bf16(v1[2], v1[3]);
                w1.x = g2::cvt_pk_bf16(v2[0], v2[1]); w1.y = g2::cvt_pk_bf16(v2[2], v2[3]); w1.z = g2::cvt_pk_bf16(v3[0], v3[1]); w1.w = g2::cvt_pk_bf16(v3[2], v3[3]);
                bf16* dst = dbase + row * 1024 + col0;
                *(u32x4*)dst = w0; *(u32x4*)(dst + 8) = w1; }
        return true;
    }
};
struct OwnBlocks { int vcu, G; __device__ __forceinline__ int block(int i) const { const int tb = i * G + vcu; return tb < T / 256 ? tb : -1; } };
struct OwnRouterOrder {
    typedef g2::UnitMN Unit;
    int G, vcu; const char *H2, *WR;
    __device__ __forceinline__ bool next(int i, Unit& u) const { u.pm = i * G + vcu; u.pn = 0; return u.pm < T / 256; }
    __device__ __forceinline__ int K(const Unit&) const { return 1024; }
    __device__ __forceinline__ const char* a_base(const Unit&) const { return H2; }
    __device__ __forceinline__ unsigned a_row_off(const Unit& u, int r) const { return (unsigned)(u.pm * 256 + r) * 2048u; }
    __device__ __forceinline__ const char* b_base(const Unit&) const { return WR; }
};
__device__ __forceinline__ void ph_normmid_blocks(Frame& F, int vcu);
__device__ __forceinline__ void ph_tokblock(Frame& F) {
    const int bx = blockIdx.x; const int vcu = (F.G % 8 == 0) ? (bx % 8) * (F.G / 8) + bx / 8 : bx;
#if FUSE_ATTN_COMBINE
    ph_attn_combine(F, vcu);
    asm volatile("s_waitcnt vmcnt(0)" ::: "memory"); __syncthreads();
#endif
    { BOOrder S{F.G, vcu, (const char*)(F.outb + OUT_YA), (const char*)(F.outb + OUT_YB), (const char*)(F.ws + WS_MERGED), (const char*)(F.ws + WS_WBA_T), (const char*)(F.ws + WS_WBB_T), (const char*)(F.ws + WS_WOUT_T)};
      EpiBO E{(const unsigned char*)(F.ws + WS_GAB), (bf16*)(F.ws + WS_MERGED), (bf16*)(F.ws + WS_YMIX)};
      g2::gemm_phase<EpiBO, BOOrder>(F.lds, S, E); }
    asm volatile("s_waitcnt vmcnt(0)" ::: "memory"); __syncthreads();
    ph_normmid_blocks(F, vcu);
    asm volatile("s_waitcnt vmcnt(0)" ::: "memory"); __syncthreads();
    { OwnRouterOrder S{F.G, vcu, (const char*)(F.ws + WS_H2), (const char*)(F.ws + WS_WR_T)};
      EpiF32Plain E{(float*)(F.ws + WS_LOGITS), 256};
      g2::gemm_phase<EpiF32Plain, OwnRouterOrder>(F.lds, S, E); }
    asm volatile("s_waitcnt vmcnt(0)" ::: "memory"); __syncthreads();
    ph_topk4(F, OwnBlocks{vcu, F.G});
}
__device__ __forceinline__ void ph_scan2(Frame& F) {
    if (blockIdx.x != 0) return;
    const int* HIST = (const int*)(F.ws + WS_HIST); int* BASEREL = (int*)(F.ws + WS_BASEREL); int* TSG = (int*)(F.ws + WS_TSG); int* TE = (int*)(F.ws + WS_TE);
    unsigned long long* THOFF = (unsigned long long*)(F.ws + WS_THOFF); unsigned long long* DEST = (unsigned long long*)(F.ws + WS_DEST);
    int* ROWTOK = (int*)(F.ws + WS_ROWTOK); float* ROWW = (float*)(F.ws + WS_ROWW);
    LAS int* pre = (LAS int*)F.lds;
    const int e = F.tid;
    int n0 = 0, n1 = 0;
    __syncthreads();
    if (e < NE) {
        for (int tb = 0; tb < 128; ++tb) { const int c = HIST[tb * 256 + e]; BASEREL[tb * 256 + e] = n0; n0 += c; }
        for (int tb = 128; tb < 256; ++tb) { const int c = HIST[tb * 256 + e]; BASEREL[tb * 256 + e] = n1; n1 += c; }
        pre[e] = (n0 + 255) >> 8; pre[256 + e] = (n1 + 255) >> 8;
    }
    __syncthreads();
    if (F.tid == 0) { int a = 0; for (int i = 0; i < NE; ++i) { const int c = pre[i]; pre[i] = a; a += c; } pre[512] = a;
        int b2 = a + 128; for (int i = 0; i < NE; ++i) { const int c = pre[256 + i]; pre[256 + i] = b2; b2 += c; } pre[513] = b2 - (a + 128);
        F.ctl[CW_NT0] = (unsigned)(a + 128); F.ctl[CW_NT] = (unsigned)(b2 + 128); }
    __syncthreads();
    const int R0 = pre[512], R1 = pre[513];
    unsigned char* dump = F.ws + WS_DUMP;
    if (e < NE) {
        const int ts0 = pre[e], ts1 = pre[256 + e], nt0 = (n0 + 255) >> 8, nt1 = (n1 + 255) >> 8;
        TSG[e] = ts0; TSG[256 + e] = ts1;
        for (int u = 0; u < nt0; ++u) { TE[ts0 + u] = e; THOFF[ts0 + u] = (unsigned long long)WS_HIDR + (unsigned long long)(ts0 + u) * (256 * 512); }
        for (int u = 0; u < nt1; ++u) { TE[ts1 + u] = e; THOFF[ts1 + u] = (unsigned long long)WS_HIDR + (unsigned long long)(ts1 + u - 128) * (256 * 512); }
        for (int r = n0; r < nt0 * 256; ++r) { const int p = ts0 * 256 + r; ROWTOK[p] = p & (T - 1); ROWW[p] = 0.f; DEST[p] = (unsigned long long)dump; }
        for (int r = n1; r < nt1 * 256; ++r) { const int p = ts1 * 256 + r; ROWTOK[p] = p & (T - 1); ROWW[p] = 0.f; DEST[p] = (unsigned long long)dump; }
    }
#pragma unroll 1
    for (int half = 0; half < 2; ++half) { const int tb0 = half ? (R0 + 128 + R1) : R0;
        if (F.tid < 128) { TE[tb0 + F.tid] = 256; THOFF[tb0 + F.tid] = (unsigned long long)WS_HIDS + (unsigned long long)(half * HALF_T + F.tid * 256) * 512; }
        for (int i = F.tid; i < HALF_T; i += NTHR) { const int tok = half * HALF_T + i; const int p = tb0 * 256 + i; ROWTOK[p] = tok; ROWW[p] = 1.0f; DEST[p] = (unsigned long long)slot_ptr(F.ws, F.outb, half, 8, tok); } }
}
__device__ __forceinline__ void ph_scatter2(Frame& F) {
    const int* TOPI = (const int*)(F.ws + WS_TOPI); const float* TOPW = (const float*)(F.ws + WS_TOPW); const int* BASEREL = (const int*)(F.ws + WS_BASEREL); const int* TSG = (const int*)(F.ws + WS_TSG);
    int* ROWTOK = (int*)(F.ws + WS_ROWTOK); float* ROWW = (float*)(F.ws + WS_ROWW); unsigned long long* DEST = (unsigned long long*)(F.ws + WS_DEST);
    LAS unsigned* cur = (LAS unsigned*)F.lds;
    for (int tb = blockIdx.x; tb < T / 256; tb += F.G) {
        const int half = tb >> 7;
        __syncthreads();
        if (F.tid < 256) cur[F.tid] = (unsigned)(TSG[half * 256 + F.tid] * 256 + BASEREL[tb * 256 + F.tid]);
        __syncthreads();
#pragma unroll
        for (int i = 0; i < 4; ++i) { const int item = F.tid + NTHR * i; const int t = tb * 256 + (item >> 3), k = item & 7;
            const int e = TOPI[(size_t)t * TOPK + k]; const unsigned p = __hip_atomic_fetch_add(&cur[e], 1u, __ATOMIC_RELAXED, __HIP_MEMORY_SCOPE_WORKGROUP);
            ROWTOK[p] = t; ROWW[p] = TOPW[(size_t)t * TOPK + k]; DEST[p] = (unsigned long long)slot_ptr(F.ws, F.outb, half, k, t); }
    }
}

#if MOE_FP8
constexpr size_t HIDR_OFF = WS_HIDR8, HIDS_OFF = WS_HIDS8; constexpr int HID_ROWB = 256;
#else
constexpr size_t HIDR_OFF = WS_HIDR, HIDS_OFF = WS_HIDS; constexpr int HID_ROWB = 512;
#endif
__device__ __forceinline__ void ph_scatter3(Frame& F) {
    const int* TOPI = (const int*)(F.ws + WS_TOPI); const float* TOPW = (const float*)(F.ws + WS_TOPW); const int* HIST = (const int*)(F.ws + WS_HIST);
    int* TE = (int*)(F.ws + WS_TE); unsigned long long* THOFF = (unsigned long long*)(F.ws + WS_THOFF);
    int* ROWTOK = (int*)(F.ws + WS_ROWTOK); float* ROWW = (float*)(F.ws + WS_ROWW); unsigned long long* DEST = (unsigned long long*)(F.ws + WS_DEST);
    LAS int* pre = (LAS int*)F.lds;
    LAS unsigned* cur = (LAS unsigned*)(F.lds + 4096);
    LAS int* cnt = (LAS int*)(F.lds + 8192);
    unsigned char* dump = F.ws + WS_DUMP;
    for (int tb = blockIdx.x; tb < T / 256; tb += F.G) {
        const int half = tb >> 7; const int e = F.tid;
        int n0 = 0, n1 = 0, mybase = 0;
        __syncthreads();
        if (e < NE) {
#pragma unroll 8
            for (int t2 = 0; t2 < 128; ++t2) { const int c = HIST[t2 * 256 + e]; if (half == 0 && t2 < tb) mybase += c; n0 += c; }
#pragma unroll 8
            for (int t2 = 128; t2 < 256; ++t2) { const int c = HIST[t2 * 256 + e]; if (half == 1 && t2 < tb) mybase += c; n1 += c; }
            pre[e] = (n0 + 255) >> 8; pre[256 + e] = (n1 + 255) >> 8; cnt[e] = n0; cnt[256 + e] = n1;
        }
        __syncthreads();
        if (F.wave == 0) {
            int v[8]; int s0 = 0, s1 = 0;
#pragma unroll
            for (int i = 0; i < 4; ++i) { v[i] = pre[4 * F.lane + i]; v[4 + i] = pre[256 + 4 * F.lane + i]; s0 += v[i]; s1 += v[4 + i]; }
            int i0 = s0, i1 = s1;
#pragma unroll
            for (int o = 1; o < 64; o <<= 1) { const int a0 = __shfl_up(i0, o), a1 = __shfl_up(i1, o); if (F.lane >= o) { i0 += a0; i1 += a1; } }
            const int R0 = __shfl(i0, 63), R1 = __shfl(i1, 63);
            int x0 = i0 - s0, x1 = R0 + 128 + (i1 - s1);
#pragma unroll
            for (int i = 0; i < 4; ++i) { pre[4 * F.lane + i] = x0; x0 += v[i]; pre[256 + 4 * F.lane + i] = x1; x1 += v[4 + i]; }
            if (F.lane == 0) { pre[512] = R0; pre[513] = R1; if (tb == 0) { F.ctl[CW_NT0] = (unsigned)(R0 + 128); F.ctl[CW_NT] = (unsigned)(R0 + R1 + 256); } }
        }
        __syncthreads();
        const int R0 = pre[512], R1 = pre[513];
        if (e < NE) cur[e] = (unsigned)(pre[half * 256 + e] * 256 + mybase);
        { const int ee = tb; const int ts0 = pre[ee], ts1 = pre[256 + ee], c0 = cnt[ee], c1 = cnt[256 + ee], nt0 = (c0 + 255) >> 8, nt1 = (c1 + 255) >> 8;
          if (F.tid < nt0) { TE[ts0 + F.tid] = ee; THOFF[ts0 + F.tid] = (unsigned long long)HIDR_OFF + (unsigned long long)(ts0 + F.tid) * (256 * HID_ROWB); }
          if (F.tid < nt1) { TE[ts1 + F.tid] = ee; THOFF[ts1 + F.tid] = (unsigned long long)HIDR_OFF + (unsigned long long)(ts1 + F.tid - 128) * (256 * HID_ROWB); }
          if (F.tid < 256) { const int r0p = c0 + F.tid; if (r0p < nt0 * 256) { const int p = ts0 * 256 + r0p; ROWTOK[p] = p & (T - 1); ROWW[p] = 0.f; DEST[p] = (unsigned long long)dump; }
                             const int r1p = c1 + F.tid; if (r1p < nt1 * 256) { const int p = ts1 * 256 + r1p; ROWTOK[p] = p & (T - 1); ROWW[p] = 0.f; DEST[p] = (unsigned long long)dump; } } }
        { const int stile = (half ? (R0 + 128 + R1) : R0) + (tb & 127);
          if (F.tid == 0) { TE[stile] = 256; THOFF[stile] = (unsigned long long)HIDS_OFF + (unsigned long long)(tb * 256) * HID_ROWB; }
          if (F.tid < 256) { const int tok = tb * 256 + F.tid; const int p = stile * 256 + F.tid; ROWTOK[p] = tok; ROWW[p] = 1.0f; DEST[p] = (unsigned long long)slot_ptr(F.ws, F.outb, half, 8, tok); } }
        __syncthreads();
#pragma unroll
        for (int i = 0; i < 4; ++i) { const int item = F.tid + NTHR * i; const int t = tb * 256 + (item >> 3), k = item & 7;
            const int ex = TOPI[(size_t)t * TOPK + k]; const unsigned p = __hip_atomic_fetch_add(&cur[ex], 1u, __ATOMIC_RELAXED, __HIP_MEMORY_SCOPE_WORKGROUP);
            ROWTOK[p] = t; ROWW[p] = TOPW[(size_t)t * TOPK + k]; DEST[p] = (unsigned long long)slot_ptr(F.ws, F.outb, half, k, t); }
    }
}
struct UnitEx2 { int u, sub, e; const char* ab; };
struct GuOrder2 {
    typedef UnitEx2 Unit;
    int nun, G, vcu; const int* TE; const int* ROWTOK; const char *H2, *WGU, *WSGU;
    __device__ __forceinline__ bool next(int i, Unit& x) const { const int L = i * G + vcu; if (L >= nun) return false; x.u = L >> 1; x.sub = L & 1; x.e = TE[x.u]; x.ab = nullptr; return true; }
    __device__ __forceinline__ int K(const Unit&) const { return 1024; }
    __device__ __forceinline__ const char* a_base(const Unit&) const { return H2; }
    __device__ __forceinline__ unsigned a_row_off(const Unit& x, int r) const { return (unsigned)ROWTOK[(unsigned)(x.u * 256 + r)] * 2048u; }
    __device__ __forceinline__ const char* b_base(const Unit& x) const { return (x.e < 256 ? WGU + (size_t)x.e * (512 * 1024 * 2) : WSGU) + (size_t)x.sub * (256 * 1024 * 2); }
};
struct EpiGu2 {
    static constexpr bool PERM = true;
    unsigned char* ws; const unsigned long long* THOFF;
    __device__ __forceinline__ bool operator()(const f32x4 (&acc)[2][2][4][2], const UnitEx2& x, int wr, int wc, int fr, int fq) const {
        bf16* base = (bf16*)(ws + THOFF[x.u]);
        const int row0 = wr * 64 + fr, col0 = x.sub * 128 + wc * 32 + 8 * fq;
#pragma unroll
        for (int ai = 0; ai < 2; ++ai)
#pragma unroll
            for (int m = 0; m < 4; ++m) { const f32x4 g0 = acc[ai][0][m][0], g1 = acc[ai][0][m][1], u0 = acc[ai][1][m][0], u1 = acc[ai][1][m][1]; f32x4 h0, h1;
#pragma unroll
                for (int e = 0; e < 4; ++e) { h0[e] = g0[e] * fsig(g0[e]) * u0[e]; h1[e] = g1[e] * fsig(g1[e]) * u1[e]; }
                u32x4 w; w.x = g2::cvt_pk_bf16(h0[0], h0[1]); w.y = g2::cvt_pk_bf16(h0[2], h0[3]); w.z = g2::cvt_pk_bf16(h1[0], h1[1]); w.w = g2::cvt_pk_bf16(h1[2], h1[3]);
                *(u32x4*)(base + (size_t)(row0 + ai * 128 + m * 16) * 256 + col0) = w; asm volatile("" ::: "memory"); }
        return true;
    }
};
struct DownOrder2 {
    typedef UnitEx2 Unit;
    int tlo, nun, G, vcu; const int* TE; const unsigned long long* THOFF; const char *wsb, *WD, *WSD;
    __device__ __forceinline__ bool next(int i, Unit& x) const { const int L = i * G + vcu; if (L >= nun) return false; x.u = tlo + (L >> 2); x.sub = L & 3; x.e = TE[x.u]; x.ab = nullptr; return true; }
    __device__ __forceinline__ int K(const Unit&) const { return 256; }
    __device__ __forceinline__ const char* a_base(const Unit& x) const { return wsb + THOFF[x.u]; }
    __device__ __forceinline__ unsigned a_row_off(const Unit&, int r) const { return (unsigned)r * 512u; }
    __device__ __forceinline__ const char* b_base(const Unit& x) const { return (x.e < 256 ? WD + (size_t)x.e * (1024 * 256 * 2) : WSD) + (size_t)x.sub * (256 * 256 * 2); }
};
struct EpiDown2 {
    static constexpr bool PERM = true;
    const unsigned long long* DEST; const float* ROWW;
    __device__ __forceinline__ bool operator()(const f32x4 (&acc)[2][2][4][2], const UnitEx2& x, int wr, int wc, int fr, int fq) const {
        const int row0 = x.u * 256 + wr * 64 + fr; const int cb = (x.sub * 256 + wc * 32 + 8 * fq) * 2;
#pragma unroll
        for (int ai = 0; ai < 2; ++ai)
#pragma unroll
            for (int m = 0; m < 4; ++m) { const int r = row0 + ai * 128 + m * 16; unsigned char* dp = (unsigned char*)DEST[r] + cb; const float w = ROWW[r];
#pragma unroll
                for (int bj = 0; bj < 2; ++bj) { const f32x4 v0 = acc[ai][bj][m][0] * w, v1 = acc[ai][bj][m][1] * w;
                    u32x4 o; o.x = g2::cvt_pk_bf16(v0[0], v0[1]); o.y = g2::cvt_pk_bf16(v0[2], v0[3]); o.z = g2::cvt_pk_bf16(v1[0], v1[1]); o.w = g2::cvt_pk_bf16(v1[2], v1[3]);
                    *(u32x4*)(dp + bj * 256) = o; }
                asm volatile("" ::: "memory"); }
        return true;
    }
};
__device__ __forceinline__ void ph_gu2(Frame& F) {
    const int NT = (int)__hip_atomic_load(F.ctl + CW_NT, __ATOMIC_RELAXED, __HIP_MEMORY_SCOPE_AGENT);
    const int bx = blockIdx.x; const int vcu = (F.G % 8 == 0) ? (bx % 8) * (F.G / 8) + bx / 8 : bx;
    GuOrder2 S{2 * NT, F.G, vcu, (const int*)(F.ws + WS_TE), (const int*)(F.ws + WS_ROWTOK), (const char*)(F.ws + WS_H2), (const char*)(F.ws + WS_WGU), (const char*)(F.ws + WS_WSGU_T)};
    EpiGu2 E{F.ws, (const unsigned long long*)(F.ws + WS_THOFF)};
    g2::gemm_phase<EpiGu2, GuOrder2>(F.lds, S, E);
}
__device__ __forceinline__ void ph_down2(Frame& F, int half) {
    const int NT = (int)__hip_atomic_load(F.ctl + CW_NT, __ATOMIC_RELAXED, __HIP_MEMORY_SCOPE_AGENT), NT0 = (int)__hip_atomic_load(F.ctl + CW_NT0, __ATOMIC_RELAXED, __HIP_MEMORY_SCOPE_AGENT);
    const int tlo = half ? NT0 : 0, thi = half ? NT : NT0;
    const int bx = blockIdx.x; const int vcu = (F.G % 8 == 0) ? (bx % 8) * (F.G / 8) + bx / 8 : bx;
    DownOrder2 S{tlo, 4 * (thi - tlo), F.G, vcu, (const int*)(F.ws + WS_TE), (const unsigned long long*)(F.ws + WS_THOFF), (const char*)F.ws, (const char*)(F.ws + WS_WD), (const char*)(F.ws + WS_WSD_T)};
    EpiDown2 E{(const unsigned long long*)(F.ws + WS_DEST), (const float*)(F.ws + WS_ROWW)};
    g2::gemm_phase<EpiDown2, DownOrder2>(F.lds, S, E);
}

struct GuOrder8 {
    typedef UnitEx2 Unit;
    int nun, G, vcu; const int* TE; const int* ROWTOK; const char *H2, *WGU, *WSGU;
    __device__ __forceinline__ bool next(int i, Unit& x) const { const int L = i * G + vcu; if (L >= nun) return false; x.u = L >> 1; x.sub = L & 1; x.e = TE[x.u]; x.ab = nullptr; return true; }
    __device__ __forceinline__ int K(const Unit&) const { return 512; }
    __device__ __forceinline__ const char* a_base(const Unit&) const { return H2; }
    __device__ __forceinline__ unsigned a_row_off(const Unit& x, int r) const { return (unsigned)ROWTOK[(unsigned)(x.u * 256 + r)] * 1024u; }
    __device__ __forceinline__ const char* b_base(const Unit& x) const { return (x.e < 256 ? WGU + (size_t)x.e * (512 * 1024) : WSGU) + (size_t)x.sub * (256 * 1024); }
};
struct EpiGu8 {
    static constexpr bool PERM = true;
    unsigned char* ws; const unsigned long long* THOFF;
    __device__ __forceinline__ bool operator()(const f32x4 (&acc)[2][2][4][2], const UnitEx2& x, int wr, int wc, int fr, int fq) const {
        unsigned char* base = ws + THOFF[x.u];
        const int row0 = wr * 64 + fr, col0 = x.sub * 128 + wc * 32 + 8 * fq;
#pragma unroll
        for (int ai = 0; ai < 2; ++ai)
#pragma unroll
            for (int m = 0; m < 4; ++m) { const f32x4 g0 = acc[ai][0][m][0], g1 = acc[ai][0][m][1], u0 = acc[ai][1][m][0], u1 = acc[ai][1][m][1]; f32x4 h0, h1;
#pragma unroll
                for (int e = 0; e < 4; ++e) { h0[e] = g0[e] * fsig(g0[e]) * u0[e]; h1[e] = g1[e] * fsig(g1[e]) * u1[e]; }
                u32x2 w; w.x = pk4_fp8(h0[0], h0[1], h0[2], h0[3]); w.y = pk4_fp8(h1[0], h1[1], h1[2], h1[3]);
                *(u32x2*)(base + (size_t)(row0 + ai * 128 + m * 16) * 256 + col0) = w; asm volatile("" ::: "memory"); }
        return true;
    }
};
struct DownOrder8 {
    typedef UnitEx2 Unit;
    int tlo, nun, G, vcu; const int* TE; const unsigned long long* THOFF; const char *wsb, *WD, *WSD;
    __device__ __forceinline__ bool next(int i, Unit& x) const { const int tl = (i >> 2) * G + vcu; if (4 * tl >= nun) return false; x.u = tlo + tl; x.sub = i & 3; x.e = TE[x.u]; x.ab = wsb + THOFF[x.u]; return true; }
    __device__ __forceinline__ int K(const Unit&) const { return 128; }
    __device__ __forceinline__ const char* a_base(const Unit& x) const { return x.ab; }
    __device__ __forceinline__ unsigned a_row_off(const Unit&, int r) const { return (unsigned)r * 256u; }
    __device__ __forceinline__ const char* b_base(const Unit& x) const { return (x.e < 256 ? WD + (size_t)x.e * (1024 * 256) : WSD) + (size_t)x.sub * (256 * 256); }
};
__device__ __forceinline__ void ph_gu8(Frame& F) {
    const int NT = (int)__hip_atomic_load(F.ctl + CW_NT, __ATOMIC_RELAXED, __HIP_MEMORY_SCOPE_AGENT);
    const int bx = blockIdx.x; const int vcu = (F.G % 8 == 0) ? (bx % 8) * (F.G / 8) + bx / 8 : bx;
    GuOrder8 S{2 * NT, F.G, vcu, (const int*)(F.ws + WS_TE), (const int*)(F.ws + WS_ROWTOK), (const char*)(F.ws + WS_H2F8), (const char*)(F.ws + WS_WGU8), (const char*)(F.ws + WS_WSGU8)};
    EpiGu8 E{F.ws, (const unsigned long long*)(F.ws + WS_THOFF)};
    g2::gemm_phase<EpiGu8, GuOrder8, true>(F.lds, S, E, 127 - 5);
}
__device__ __forceinline__ void ph_down8(Frame& F, int half) {
    const int NT = (int)__hip_atomic_load(F.ctl + CW_NT, __ATOMIC_RELAXED, __HIP_MEMORY_SCOPE_AGENT), NT0 = (int)__hip_atomic_load(F.ctl + CW_NT0, __ATOMIC_RELAXED, __HIP_MEMORY_SCOPE_AGENT);
    const int tlo = half ? NT0 : 0, thi = half ? NT : NT0;
    const int bx = blockIdx.x; const int vcu = (F.G % 8 == 0) ? (bx % 8) * (F.G / 8) + bx / 8 : bx;
    DownOrder8 S{tlo, 4 * (thi - tlo), F.G, vcu, (const int*)(F.ws + WS_TE), (const unsigned long long*)(F.ws + WS_THOFF), (const char*)F.ws, (const char*)(F.ws + WS_WD8), (const char*)(F.ws + WS_WSD8)};
    EpiDown2 E{(const unsigned long long*)(F.ws + WS_DEST), (const float*)(F.ws + WS_ROWW)};
    g2::gemm_phase<EpiDown2, DownOrder8, true>(F.lds, S, E, 127 - 4);
}
__device__ __forceinline__ void ph_combine2(Frame& F, int half) {
    const float* mod = (const float*)(F.ws + WS_MOD); const float* g = F.in[I_GPOSTFFN];
    for (int t = half * HALF_T + blockIdx.x * NWAVES + F.wave; t < (half + 1) * HALF_T; t += F.G * NWAVES) {
        const int b = t / SEQ; const float* gt2 = mod + b * 6144 + 5120;
        float y[16];
#pragma unroll
        for (int i = 0; i < 16; ++i) y[i] = 0.f;
#pragma unroll
        for (int k = 0; k < 9; ++k) { const unsigned char* sp = slot_ptr(F.ws, F.outb, half, k, t);
#pragma unroll
            for (int j = 0; j < 4; ++j) { const u32x2 w = *(const u32x2*)(sp + (F.lane * 4 + 256 * j) * 2);
                y[4 * j + 0] += __uint_as_float(w.x << 16); y[4 * j + 1] += __uint_as_float(w.x & 0xffff0000u); y[4 * j + 2] += __uint_as_float(w.y << 16); y[4 * j + 3] += __uint_as_float(w.y & 0xffff0000u); } }
        f32x4 x1[4]; x1_row(F, t, x1);
        float ss = 0.f;
#pragma unroll
        for (int i = 0; i < 16; ++i) ss += y[i] * y[i];
        const float rstd = rsqrtf(wave_sum(ss) * (1.0f / D) + EPS);
#pragma unroll
        for (int j = 0; j < 4; ++j) { const int c = F.lane * 4 + 256 * j; const f32x4 gg = *(const f32x4*)(g + c), gt = *(const f32x4*)(gt2 + c);
            f32x4 o;
#pragma unroll
            for (int e = 0; e < 4; ++e) o[e] = x1[j][e] + gt[e] * (y[4 * j + e] * rstd * gg[e]);
            *(f32x4*)(F.out + (size_t)t * D + c) = o; }
    }
}


constexpr float SLOT_SC = 16.0f;
__device__ __forceinline__ unsigned char* slot8_ptr(unsigned char* ws, unsigned char* outb, int k, int t) {
    if (k < 4) return outb + (size_t)t * 4096 + k * 1024;
    const int ri = k - 4; const size_t base = (ri == 0) ? 192 : (ri == 1) ? 256 : (ri == 2) ? 320 : (ri == 3) ? 384 : 736;
    return ws + base * MiB + (size_t)t * 1024;
}
constexpr size_t YS_A = 192 * MiB, YS_B = 736 * MiB; constexpr int YS_NA = 262144;
__device__ __forceinline__ unsigned char* ys_row(unsigned char* ws, int p) { return ws + (p < YS_NA ? YS_A + (size_t)p * 1024 : YS_B + (size_t)(p - YS_NA) * 1024); }
static_assert(YS_NA % 256 == 0 && YS_A + (size_t)YS_NA * 1024 <= WS_HIDS8 && YS_B + (size_t)(T * 8 + 256 * 255 - YS_NA) * 1024 <= WS_NEED, "dense MoE output map");
__device__ __forceinline__ void ph_scatter4(Frame& F) {
    const int* TOPI = (const int*)(F.ws + WS_TOPI); const float* TOPW = (const float*)(F.ws + WS_TOPW); const int* HIST = (const int*)(F.ws + WS_HIST);
    int* TE = (int*)(F.ws + WS_TE); unsigned long long* THOFF = (unsigned long long*)(F.ws + WS_THOFF);
    int* ROWTOK = (int*)(F.ws + WS_ROWTOK); float* ROWW = (float*)(F.ws + WS_ROWW); int* POS = (int*)(F.ws + WS_DEST);
    LAS int* pre = (LAS int*)F.lds;
    LAS unsigned* cur = (LAS unsigned*)(F.lds + 4096);
    LAS int* cnt = (LAS int*)(F.lds + 8192);
    for (int tb = blockIdx.x; tb < T / 256; tb += F.G) {
        const int e = F.tid; int n0 = 0, mybase = 0;
        __syncthreads();
        if (e < NE) {
#pragma unroll 8
            for (int t2 = 0; t2 < 256; ++t2) { const int c = HIST[t2 * 256 + e]; if (t2 < tb) mybase += c; n0 += c; }
            pre[e] = (n0 + 255) >> 8; cnt[e] = n0;
        }
        __syncthreads();
        if (F.wave == 0) { int v[4]; int s0 = 0;
#pragma unroll
            for (int i = 0; i < 4; ++i) { v[i] = pre[4 * F.lane + i]; s0 += v[i]; }
            int i0 = s0;
#pragma unroll
            for (int o = 1; o < 64; o <<= 1) { const int a0 = __shfl_up(i0, o); if (F.lane >= o) i0 += a0; }
            const int R = __shfl(i0, 63); int x0 = i0 - s0;
#pragma unroll
            for (int i = 0; i < 4; ++i) { pre[4 * F.lane + i] = x0; x0 += v[i]; }
            if (F.lane == 0) { pre[512] = R; if (tb == 0) { F.ctl[CW_NT0] = (unsigned)R; F.ctl[CW_NT] = (unsigned)(R + 256); } } }
        __syncthreads();
        const int R = pre[512];
        if (e < NE) cur[e] = (unsigned)(pre[e] * 256 + mybase);
        { const int ee = tb; const int ts0 = pre[ee], c0 = cnt[ee], nt0 = (c0 + 255) >> 8;
          if (F.tid < nt0) { TE[ts0 + F.tid] = ee; THOFF[ts0 + F.tid] = (unsigned long long)HIDR_OFF + (unsigned long long)(ts0 + F.tid) * (256 * HID_ROWB); }
          if (F.tid < 256) { const int r0p = c0 + F.tid; if (r0p < nt0 * 256) { const int p = ts0 * 256 + r0p; ROWTOK[p] = p & (T - 1); ROWW[p] = 0.f; } } }
        { const int stile = R + tb;
          if (F.tid == 0) { TE[stile] = 256; THOFF[stile] = (unsigned long long)HIDS_OFF + (unsigned long long)(tb * 256) * HID_ROWB; }
          if (F.tid < 256) { const int tok = tb * 256 + F.tid; const int p = stile * 256 + F.tid; ROWTOK[p] = tok; ROWW[p] = 1.0f; } }
        __syncthreads();
#pragma unroll
        for (int i = 0; i < 4; ++i) { const int item = F.tid + NTHR * i; const int t = tb * 256 + (item >> 3), k = item & 7;
            const int ex = TOPI[(size_t)t * TOPK + k]; const unsigned p = __hip_atomic_fetch_add(&cur[ex], 1u, __ATOMIC_RELAXED, __HIP_MEMORY_SCOPE_WORKGROUP);
            ROWTOK[p] = t; ROWW[p] = TOPW[(size_t)t * TOPK + k]; POS[(size_t)t * TOPK + k] = (int)p; }
    }
}
struct EpiDown8 {
    static constexpr bool PERM = true;
    unsigned char* ws; unsigned char* outb; const float* ROWW; int R; int dbg; unsigned char* dbgbase;
    __device__ __forceinline__ bool operator()(const f32x4 (&acc)[2][2][4][2], const UnitEx2& x, int wr, int wc, int fr, int fq) const {
        const int rl = wr * 64 + fr; const int cb = x.sub * 256 + wc * 64 + 16 * fq;
        const bool sh = x.e == 256;
        unsigned char* base = sh ? outb + (size_t)(x.u - R) * (256 * 4096) : ys_row(ws, x.u * 256); const int pitch = sh ? 4096 : 1024;
        if (dbg == 2) base = dbgbase + (size_t)((x.u * 256) & 65535) * 1024;
        float wv[8];
#pragma unroll
        for (int q = 0; q < 8; ++q) wv[q] = ROWW[x.u * 256 + rl + (q >> 2) * 128 + (q & 3) * 16];
#pragma unroll
        for (int ai = 0; ai < 2; ++ai)
#pragma unroll
            for (int m = 0; m < 4; ++m) { const int i = rl + ai * 128 + m * 16; unsigned char* dp = base + (size_t)i * (dbg == 2 ? 1024 : pitch) + cb; const float w = wv[ai * 4 + m] * SLOT_SC;
                if (dbg == 1) { if (acc[ai][0][m][0][0] == 123.456f) dp[0] = 1; continue; }
                const f32x4 a0 = acc[ai][0][m][0] * w, a1 = acc[ai][0][m][1] * w, b0 = acc[ai][1][m][0] * w, b1 = acc[ai][1][m][1] * w;
                u32x4 o; o.x = pk4_fp8(a0[0], a0[1], a0[2], a0[3]); o.y = pk4_fp8(a1[0], a1[1], a1[2], a1[3]); o.z = pk4_fp8(b0[0], b0[1], b0[2], b0[3]); o.w = pk4_fp8(b1[0], b1[1], b1[2], b1[3]);
                *(u32x4*)dp = o;
                asm volatile("" ::: "memory"); }
        return true;
    }
};
__device__ __forceinline__ void ph_down9(Frame& F, int dbg = 0) {
    const int NT = (int)__hip_atomic_load(F.ctl + CW_NT, __ATOMIC_RELAXED, __HIP_MEMORY_SCOPE_AGENT);
    const int bx = blockIdx.x; const int vcu = (F.G % 8 == 0) ? (bx % 8) * (F.G / 8) + bx / 8 : bx;
    DownOrder8 S{0, 4 * NT, F.G, vcu, (const int*)(F.ws + WS_TE), (const unsigned long long*)(F.ws + WS_THOFF), (const char*)F.ws, (const char*)(F.ws + WS_WD8), (const char*)(F.ws + WS_WSD8)};
    const int R = (int)__hip_atomic_load(F.ctl + CW_NT0, __ATOMIC_RELAXED, __HIP_MEMORY_SCOPE_AGENT);
    EpiDown8 E{F.ws, F.outb, (const float*)(F.ws + WS_ROWW), R, dbg, F.ws + 640 * MiB};
    g2::gemm_phase<EpiDown8, DownOrder8, true, DOWN_ALIGN>(F.lds, S, E, 127 - 4);
}
struct X1B { u32x2 xm[4]; };
__device__ __forceinline__ void x1b_load(Frame& F, int t, X1B& r) {
    const bf16* XM = (const bf16*)(F.ws + WS_YMIX);
#pragma unroll
    for (int j = 0; j < 4; ++j) r.xm[j] = *(const u32x2*)(XM + (size_t)t * D + F.lane * 4 + 256 * j);
}
__device__ __forceinline__ void ph_combine9(Frame& F) {
    const float* mod = (const float*)(F.ws + WS_MOD); const float* g = F.in[I_GPOSTFFN];
    const int* POS = (const int*)(F.ws + WS_DEST);
#define C9_TOK(qq) ((int)((blockIdx.x + ((qq) >> 5) * F.G) << 8) + F.wave + 8 * ((qq) & 31))
#define C9_POS(tt) (((tt) < T) ? POS[(size_t)(tt) * TOPK + (F.lane & 7)] : 0)
#define C9_LOAD(SN, tt, pp) do { _Pragma("unroll") for (int k = 0; k < 9; ++k) { \
        const unsigned char* sp = (k < 8) ? ys_row(F.ws, __builtin_amdgcn_readlane((pp), k)) : F.outb + (size_t)(tt) * 4096; \
        _Pragma("unroll") for (int j = 0; j < 4; ++j) SN[k][j] = *(const int*)(sp + F.lane * 4 + 256 * j); } } while (0)
#define C9_STEP(SN, tt, tn1, tnx, pnx) do { \
        float y[16]; \
        _Pragma("unroll") for (int i = 0; i < 16; ++i) y[i] = 0.f; \
        _Pragma("unroll") for (int k = 0; k < 9; ++k) _Pragma("unroll") for (int j = 0; j < 4; ++j) { const int w = SN[k][j]; \
            y[4 * j + 0] += __builtin_amdgcn_cvt_f32_fp8(w, 0); y[4 * j + 1] += __builtin_amdgcn_cvt_f32_fp8(w, 1); y[4 * j + 2] += __builtin_amdgcn_cvt_f32_fp8(w, 2); y[4 * j + 3] += __builtin_amdgcn_cvt_f32_fp8(w, 3); } \
        const X1B rc = rn; \
        if ((tn1) < T) x1b_load(F, (tn1), rn); \
        if ((tnx) < T) C9_LOAD(SN, (tnx), (pnx)); \
        const int b = (tt) / SEQ; const float* gt2 = mod + b * 6144 + 5120; \
        f32x4 x1[4]; \
        _Pragma("unroll") for (int j = 0; j < 4; ++j) { const u32x2 w = rc.xm[j]; x1[j] = (f32x4){__uint_as_float(w.x << 16), __uint_as_float(w.x & 0xffff0000u), __uint_as_float(w.y << 16), __uint_as_float(w.y & 0xffff0000u)}; } \
        float ss = 0.f; \
        _Pragma("unroll") for (int i = 0; i < 16; ++i) ss += y[i] * y[i]; \
        const float rstd = rsqrtf(wave_sum(ss) * (1.0f / (D * SLOT_SC * SLOT_SC)) + EPS);            \
        _Pragma("unroll") for (int j = 0; j < 4; ++j) { const int c = F.lane * 4 + 256 * j; const f32x4 gg = *(const f32x4*)(g + c), gt = *(const f32x4*)(gt2 + c); \
            f32x4 o; \
            _Pragma("unroll") for (int e = 0; e < 4; ++e) o[e] = x1[j][e] + gt[e] * (y[4 * j + e] * (1.0f / SLOT_SC) * rstd * gg[e]); \
            *(f32x4*)(F.out + (size_t)(tt) * D + c) = o; } } while (0)
    X1B rn; int sA[9][4], sB[9][4];
    int q = 0, t0 = C9_TOK(0), t1 = C9_TOK(1);
    { const int p0 = C9_POS(t0), p1 = C9_POS(t1);
      if (t0 < T) { x1b_load(F, t0, rn); C9_LOAD(sA, t0, p0); }
      if (t1 < T) C9_LOAD(sB, t1, p1); }
    int p2 = C9_POS(C9_TOK(2)), p3 = C9_POS(C9_TOK(3));
    for (; t0 < T; q += 2) {
        { int ln = F.lane; asm volatile("" : "+v"(ln)); F.lane = ln; }
        const int t2 = C9_TOK(q + 2), t3 = C9_TOK(q + 3);
        const int p4 = C9_POS(C9_TOK(q + 4)), p5 = C9_POS(C9_TOK(q + 5));
        C9_STEP(sA, t0, t1, t2, p2);
        if (t1 < T) C9_STEP(sB, t1, t2, t3, p3);
        t0 = t2; t1 = t3; p2 = p4; p3 = p5;
    }
#undef C9_STEP
#undef C9_LOAD
#undef C9_POS
#undef C9_TOK
}
__device__ __forceinline__ void ph_router_naive(Frame& F) {
    LAS float* As = (LAS float*)F.lds; LAS float* Bs = As + 16 * 132;
    const bf16* H2 = (const bf16*)(F.ws + WS_H2); float* LG = (float*)(F.ws + WS_LOGITS);
    const int ty = F.tid >> 5, tx = F.tid & 31;
    for (int vb = blockIdx.x; vb < (T / 128) * 2; vb += F.G) {
        const int tm = vb >> 1, tn = vb & 1, m0 = tm * 128, n0 = tn * 128;
        float a1[8][4]; ZERO_ACC(a1);
        ARowGlobal ra{H2, (size_t)D, m0, nullptr}; ngemm_acc(As, Bs, ra, F.in[I_RW], NE, D, n0, NE, a1);
#pragma unroll
        for (int i = 0; i < 8; ++i) { const size_t row = (size_t)(m0 + ty * 8 + i); const int col = n0 + tx * 4;
            *(f32x4*)(LG + row * NE + col) = (f32x4){a1[i][0], a1[i][1], a1[i][2], a1[i][3]}; }
    }
}

__device__ __forceinline__ float half_max(float v) {
#pragma unroll
    for (int o = 1; o < 32; o <<= 1) v = fmaxf(v, __shfl_xor(v, o));
    return v;
}
__device__ __forceinline__ void ph_topk(Frame& F) {
    const float* LG = (const float*)(F.ws + WS_LOGITS); const float* rb = F.in[I_RB];
    int* TOPI = (int*)(F.ws + WS_TOPI); float* TOPW = (float*)(F.ws + WS_TOPW); unsigned* counts = F.ctl + CW_COUNTS;
    const int lane = F.lane, hf = lane >> 5;
    for (int t = blockIdx.x * NWAVES + F.wave; t < T; t += F.G * NWAVES) {
        float sc[4], sel[4];
#pragma unroll
        for (int i = 0; i < 4; ++i) { sc[i] = sigmoidf_(LG[(size_t)t * NE + lane + 64 * i]); sel[i] = sc[i] + rb[lane + 64 * i]; }
        float gs[8];
#pragma unroll
        for (int i = 0; i < 4; ++i) {
            const float m1 = half_max(sel[i]);
            const unsigned long long bal = __ballot(sel[i] == m1); const unsigned hb = hf ? (unsigned)(bal >> 32) : (unsigned)bal;
            const int first = __ffs(hb) - 1;
            const float v2 = ((lane & 31) == first) ? -INFINITY : sel[i];
            const float m2 = half_max(v2);
            const float g = m1 + m2;
            const float go = __shfl_xor(g, 32);
            gs[2 * i] = hf ? go : g; gs[2 * i + 1] = hf ? g : go;
        }
        bool gsel[8];
#pragma unroll
        for (int a = 0; a < 8; ++a) { int rank = 0;
#pragma unroll
            for (int c = 0; c < 8; ++c) rank += (gs[c] > gs[a] || (gs[c] == gs[a] && c < a)) ? 1 : 0;
            gsel[a] = rank < 4; }
#pragma unroll
        for (int i = 0; i < 4; ++i) { const bool ok = hf ? gsel[2 * i + 1] : gsel[2 * i]; if (!ok) sel[i] = -INFINITY; }
        int myidx = 0; float myw = 0.f; float wsum = 0.f;
#pragma unroll
        for (int k = 0; k < TOPK; ++k) {
            float bv = sel[0]; int bi = lane;
#pragma unroll
            for (int i = 1; i < 4; ++i) if (sel[i] > bv) { bv = sel[i]; bi = lane + 64 * i; }
#pragma unroll
            for (int o = 1; o < 64; o <<= 1) { const float ov = __shfl_xor(bv, o); const int oi = __shfl_xor(bi, o); if (ov > bv || (ov == bv && oi < bi)) { bv = ov; bi = oi; } }
            const int ol = bi & 63, oi = bi >> 6;
            float s = (oi == 0) ? sc[0] : (oi == 1) ? sc[1] : (oi == 2) ? sc[2] : sc[3];
            s = __shfl(s, ol);
            if (lane == ol) { if (oi == 0) sel[0] = -INFINITY; else if (oi == 1) sel[1] = -INFINITY; else if (oi == 2) sel[2] = -INFINITY; else sel[3] = -INFINITY; }
            wsum += s;
            if (lane == k) { myidx = bi; myw = s; }
        }
        if (lane < TOPK) { TOPI[(size_t)t * TOPK + lane] = myidx; TOPW[(size_t)t * TOPK + lane] = myw / wsum * 2.5f; atomicAdd(&counts[myidx], 1u); }
    }
}


__device__ __forceinline__ void ph_topk_serial(Frame& F) {
    const float* LG = (const float*)(F.ws + WS_LOGITS); const float* rb = F.in[I_RB];
    int* TOPI = (int*)(F.ws + WS_TOPI); float* TOPW = (float*)(F.ws + WS_TOPW); unsigned* counts = F.ctl + CW_COUNTS;
    LAS float* sel = (LAS float*)F.lds + F.wave * 1024; LAS float* scr = sel + 256; LAS float* gsc = scr + 256; LAS int* gok = (LAS int*)(gsc + 8); LAS int* bi = gok + 8; LAS float* bw = (LAS float*)(bi + 8);
    for (int t = blockIdx.x * NWAVES + F.wave; t < T; t += F.G * NWAVES) {
        for (int i = 0; i < 4; ++i) { const int e = F.lane + 64 * i; const float s = sigmoidf_(LG[(size_t)t * NE + e]); scr[e] = s; sel[e] = s + rb[e]; }
        __builtin_amdgcn_s_waitcnt(0);
        if (F.lane == 0) {
            for (int g = 0; g < 8; ++g) { float m1 = -INFINITY, m2 = -INFINITY; for (int q = 0; q < 32; ++q) { const float v = sel[g * 32 + q]; if (v > m1) { m2 = m1; m1 = v; } else if (v > m2) m2 = v; } gsc[g] = m1 + m2; gok[g] = 0; }
            for (int k = 0; k < 4; ++k) { int best = -1; float bv = -INFINITY; for (int g = 0; g < 8; ++g) if (!gok[g] && gsc[g] > bv) { bv = gsc[g]; best = g; } gok[best] = 1; }
            for (int e = 0; e < 256; ++e) if (!gok[e >> 5]) sel[e] = -INFINITY;
            float ws = 0.f;
            for (int k = 0; k < 8; ++k) { int best = 0; float bv = -INFINITY; for (int e = 0; e < 256; ++e) if (sel[e] > bv) { bv = sel[e]; best = e; } sel[best] = -INFINITY; bi[k] = best; bw[k] = scr[best]; ws += scr[best]; }
            for (int k = 0; k < 8; ++k) { TOPI[(size_t)t * 8 + k] = bi[k]; TOPW[(size_t)t * 8 + k] = bw[k] / ws * 2.5f; atomicAdd(&counts[bi[k]], 1u); }
        }
        __builtin_amdgcn_s_waitcnt(0);
    }
}

__device__ __forceinline__ void ph_scan(Frame& F) {
    if (blockIdx.x != 0) return;
    LAS int* pre = (LAS int*)F.lds;
    unsigned* counts = F.ctl + CW_COUNTS; int* ROWTOK = (int*)(F.ws + WS_ROWTOK); float* ROWW = (float*)(F.ws + WS_ROWW);
    int* UNITEXP = (int*)(F.ws + WS_UNITEXP); int* EXPTILE0 = (int*)(F.ws + WS_EXPTILE0);
    __syncthreads();
    int n = 0, nt = 0;
    if (F.tid < NE) { n = (int)counts[F.tid]; nt = (n + 255) >> 8; pre[F.tid] = nt; }
    __syncthreads();
    if (F.tid == 0) { int s = 0; for (int e = 0; e < NE; ++e) { const int c = pre[e]; pre[e] = s; s += c; } F.ctl[CW_NT] = (unsigned)s; }
    __syncthreads();
    if (F.tid < NE) {
        const int t0 = pre[F.tid]; EXPTILE0[F.tid] = t0;
        for (int u = 0; u < nt; ++u) UNITEXP[t0 + u] = F.tid;
        for (int r = n; r < nt * 256; ++r) { ROWTOK[t0 * 256 + r] = (t0 * 256 + r) & (T - 1); ROWW[t0 * 256 + r] = 0.f; }
    }
    __syncthreads();
    { const int NTv = (int)F.ctl[CW_NT];
      for (int i = F.tid; i < T; i += NTHR) { ROWTOK[NTv * 256 + i] = i; ROWW[NTv * 256 + i] = 1.0f; } }
}

__device__ __forceinline__ void ph_scatter(Frame& F) {
    const int* TOPI = (const int*)(F.ws + WS_TOPI); const float* TOPW = (const float*)(F.ws + WS_TOPW);
    int* ROWTOK = (int*)(F.ws + WS_ROWTOK); float* ROWW = (float*)(F.ws + WS_ROWW); const int* EXPTILE0 = (const int*)(F.ws + WS_EXPTILE0);
    unsigned* cursor = F.ctl + CW_CURSOR;
    for (int i = blockIdx.x * NTHR + F.tid; i < T * TOPK; i += F.G * NTHR) {
        const int e = TOPI[i]; const unsigned p = atomicAdd(&cursor[e], 1u);
        const size_t r = (size_t)EXPTILE0[e] * 256 + p;
        ROWTOK[r] = i >> 3; ROWW[r] = TOPW[i];
    }
}

__device__ __forceinline__ void ph_experts_naive(Frame& F) {
    LAS float* As = (LAS float*)F.lds; LAS float* Bs = As + 16 * 132; LAS bf16* hid = (LAS bf16*)(F.lds + 32768);
    const bf16* H2 = (const bf16*)(F.ws + WS_H2);
    const int* ROWTOK = (const int*)(F.ws + WS_ROWTOK); const float* ROWW = (const float*)(F.ws + WS_ROWW); const int* UNITEXP = (const int*)(F.ws + WS_UNITEXP);
    const int NT = (int)__hip_atomic_load(F.ctl + CW_NT, __ATOMIC_RELAXED, __HIP_MEMORY_SCOPE_AGENT);
    const int ty = F.tid >> 5, tx = F.tid & 31;
    const int nvb = 2 * NT + T / 128;
    for (int vb = blockIdx.x; vb < nvb; vb += F.G) {
        const bool shared = vb >= 2 * NT;
        const float *Wg, *Wu, *Wd; int r0; const int* gather;
        if (shared) { Wg = F.in[I_WSG]; Wu = F.in[I_WSU]; Wd = F.in[I_WSD]; r0 = (vb - 2 * NT) * 128; gather = nullptr; }
        else { const int u = vb >> 1; const int e = UNITEXP[u]; Wg = F.in[I_WEG] + (size_t)e * 1024 * 256; Wu = F.in[I_WEU] + (size_t)e * 1024 * 256; Wd = F.in[I_WED] + (size_t)e * 256 * 1024;
               r0 = u * 256 + (vb & 1) * 128; gather = ROWTOK; }
        ARowGlobal ra{H2, (size_t)D, r0, gather};
        for (int nh = 0; nh < 2; ++nh) {
            float ag[8][4], au[8][4]; ZERO_ACC(ag); ZERO_ACC(au);
            ngemm_acc(As, Bs, ra, Wg, 256, D, nh * 128, 256, ag);
            ngemm_acc(As, Bs, ra, Wu, 256, D, nh * 128, 256, au);
#pragma unroll
            for (int i = 0; i < 8; ++i) { float o[4];
#pragma unroll
                for (int j = 0; j < 4; ++j) { const float g = ag[i][j]; o[j] = g / (1.0f + expf(-g)) * au[i][j]; }
                u32x2 w; w.x = pk2(o[0], o[1]); w.y = pk2(o[2], o[3]); *(LAS u32x2*)(hid + (ty * 8 + i) * 256 + nh * 128 + tx * 4) = w; }
        }
        __syncthreads();
        ARowLds rl{hid};
        for (int nc = 0; nc < 8; ++nc) {
            float ad[8][4]; ZERO_ACC(ad);
            ngemm_acc(As, Bs, rl, Wd, D, 256, nc * 128, D, ad);
#pragma unroll
            for (int i = 0; i < 8; ++i) { const int r = r0 + ty * 8 + i; const int tok = shared ? r : ROWTOK[r]; const float w = shared ? 1.0f : ROWW[r];
                if (w != 0.f) {
#pragma unroll
                    for (int j = 0; j < 4; ++j) unsafeAtomicAdd(F.out + (size_t)tok * D + nc * 128 + tx * 4 + j, ad[i][j] * w); } }
        }
        __syncthreads();
    }
}


__device__ __forceinline__ void ph_experts_brute(Frame& F) {
    LAS float* hs = (LAS float*)F.lds;
    LAS float* hid = hs + 1024;
    LAS float* pg = hid + 256;
    const bf16* H2 = (const bf16*)(F.ws + WS_H2); const int* TOPI = (const int*)(F.ws + WS_TOPI); const float* TOPW = (const float*)(F.ws + WS_TOPW);
    const int tid = F.tid, j = tid & 255, kh = tid >> 8;
    for (int t = blockIdx.x; t < T; t += F.G) {
        __syncthreads();
        hs[tid] = bf2f(H2[(size_t)t * D + tid]); hs[tid + 512] = bf2f(H2[(size_t)t * D + tid + 512]);
        float o0 = 0.f, o1 = 0.f;
        __syncthreads();
        for (int k9 = 0; k9 < 9; ++k9) {
            const float *Wg, *Wu, *Wd; float w;
            if (k9 == 8) { Wg = F.in[I_WSG]; Wu = F.in[I_WSU]; Wd = F.in[I_WSD]; w = 1.0f; }
            else { const int e = TOPI[(size_t)t * 8 + k9]; w = TOPW[(size_t)t * 8 + k9]; Wg = F.in[I_WEG] + (size_t)e * 1024 * 256; Wu = F.in[I_WEU] + (size_t)e * 1024 * 256; Wd = F.in[I_WED] + (size_t)e * 256 * 1024; }
            float g = 0.f, u = 0.f;
            for (int k = kh * 512; k < kh * 512 + 512; ++k) { const float hv = hs[k]; g += hv * Wg[(size_t)k * 256 + j]; u += hv * Wu[(size_t)k * 256 + j]; }
            pg[tid] = g; pg[512 + tid] = u;
            __syncthreads();
            if (tid < 256) { const float gg = pg[tid] + pg[tid + 256], uu = pg[512 + tid] + pg[512 + tid + 256]; hid[tid] = gg / (1.0f + expf(-gg)) * uu * w; }
            __syncthreads();
            for (int q = 0; q < 256; ++q) { const float hv = hid[q]; o0 += hv * Wd[(size_t)q * 1024 + tid]; o1 += hv * Wd[(size_t)q * 1024 + tid + 512]; }
        }
        F.out[(size_t)t * D + tid] = o0; F.out[(size_t)t * D + tid + 512] = o1;
    }
}

__device__ __forceinline__ void ph_final(Frame& F) {
    const float* mod = (const float*)(F.ws + WS_MOD); const float* g = F.in[I_GPOSTFFN];
    for (int t = blockIdx.x * NWAVES + F.wave; t < T; t += F.G * NWAVES) {
        const int b = t / SEQ; const float* gt2 = mod + b * 6144 + 5120;
        f32x4 x1[4]; x1_row(F, t, x1);
        f32x4 y[4]; float ss = 0.f;
#pragma unroll
        for (int j = 0; j < 4; ++j) { y[j] = *(const f32x4*)(F.out + (size_t)t * D + F.lane * 4 + 256 * j); ss += y[j][0] * y[j][0] + y[j][1] * y[j][1] + y[j][2] * y[j][2] + y[j][3] * y[j][3]; }
        const float rstd = rsqrtf(wave_sum(ss) * (1.0f / D) + EPS);
#pragma unroll
        for (int j = 0; j < 4; ++j) { const int c = F.lane * 4 + 256 * j; const f32x4 gg = *(const f32x4*)(g + c), gt = *(const f32x4*)(gt2 + c);
            f32x4 o;
#pragma unroll
            for (int e = 0; e < 4; ++e) o[e] = x1[j][e] + DBG_MOE_SCALE * gt[e] * (y[j][e] * rstd * gg[e]);
#if DBG_STAMP_A >= 0
            { const float dl = (float)(F.ctl[CW_STAMP + DBG_STAMP_B] - F.ctl[CW_STAMP + DBG_STAMP_A]) * 1e-6f; const f32x4 xv = *(const f32x4*)(F.in[I_X] + (size_t)t * D + c); o = o + xv * dl; }
#endif
            *(f32x4*)(F.out + (size_t)t * D + c) = o; }
    }
}

enum { PH_MOD = 0, PH_NORM1, PH_INPROJ, PH_ROPE, PH_MIX, PH_BRANCH, PH_OUTPROJ, PH_NORMMID, PH_ROUTER, PH_TOPK, PH_SCAN, PH_SCATTER, PH_EXPERTS, PH_FINAL, N_PHASES };

__global__ void __launch_bounds__(NTHR, 2) mk_fwd(Args args) {
    extern __shared__ __attribute__((aligned(16))) unsigned char lds_raw[];
    Frame F;
    F.lds = (LAS unsigned char*)lds_raw;
    F.tid = threadIdx.x; F.lane = F.tid & 63; F.wave = __builtin_amdgcn_readfirstlane(F.tid >> 6); F.G = gridDim.x;
#pragma unroll
    for (int i = 0; i < N_IN; ++i) F.in[i] = args.in[i];
    F.pos = (const int*)args.in[I_POS];
    F.out = args.out; F.outb = (unsigned char*)args.out; F.ws = args.ws; F.ctl = (unsigned*)(args.ws + WS_CTL);
    volatile LAS unsigned* MISC = (volatile LAS unsigned*)(F.lds + MISC_OFF);
    if (F.tid < 32) MISC[F.tid] = 0u;
    __syncthreads();
    const int lo = args.ph_lo, hi = args.ph_hi;
#define STAMP(id) do { if (DBG_STAMP_A >= 0 && blockIdx.x == 0 && threadIdx.x == 0) F.ctl[CW_STAMP + (id)] = (unsigned)wall_clock64(); } while (0)
#define REFRESH() do { int _t = threadIdx.x; asm volatile("" : "+v"(_t)); F.tid = _t; F.lane = _t & 63; F.wave = __builtin_amdgcn_readfirstlane(_t >> 6); } while (0)
    XcdBarrier bar; bar.bar = F.ctl + CW_BAR; bar.x = 0; bar.st = nullptr;
    if (hi - lo > 1) bar = xcd_barrier_post(F.ctl + CW_BAR, MISC + 8);
#ifndef PH_MASK
#define PH_MASK 0xFFFFFFu
#endif
#define IN(k) ((((PH_MASK) >> (k)) & 1u) && lo <= (k) && (k) < hi)
#define SEAM(k) do { if (IN(k) && IN((k) + 1)) xcd_barrier(bar); } while (0)

    STAMP(0);
    if (IN(PH_MOD)) { REFRESH(); ph_mod(F); ph_cvt_small(F); if (DUP == 0) { __syncthreads(); ph_mod(F); ph_cvt_small(F); } } SEAM(PH_MOD); STAMP(1);
    if (IN(PH_NORM1)) { REFRESH(); ph_norm1(F); if (DUP == 1) ph_norm1(F); if (DUP == 30) { int md = 1; asm volatile("" : "+s"(md)); ph_norm1(F, md); } } SEAM(PH_NORM1); STAMP(2);
#if FAST_INPROJ
    if (IN(PH_INPROJ)) { REFRESH(); ph_inproj_fast(F); if (DUP == 2) ph_inproj_fast(F); if (DUP == 20 || DUP == 21 || DUP == 22) { int ns = (DUP == 20) ? 1 : (DUP == 21) ? 2 : 0; asm volatile("" : "+s"(ns)); ph_inproj_fast(F, ns); } }
    SEAM(PH_INPROJ); STAMP(3);
#else
    if (IN(PH_INPROJ)) { REFRESH(); ph_inproj_naive(F); }
    SEAM(PH_INPROJ);
    if (IN(PH_ROPE)) { REFRESH(); ph_rope_naive(F); }
    SEAM(PH_ROPE);
#endif
    if (IN(PH_MIX)) { REFRESH();
#if FAST_ATTN
#if FAST_MLSTM
        if (blockIdx.x < 128) { int nrep = (DUP == 3) ? 2 : 1; asm volatile("" : "+s"(nrep));
#pragma unroll 1
            for (int rep = 0; rep < nrep; ++rep) mlstm_unit_fast(F, blockIdx.x); }
#else
        if (blockIdx.x < 128) ph_mlstm_naive_unit(F, blockIdx.x);
#endif
        { int first = (blockIdx.x >= 128 && (int)((blockIdx.x >> 3) & 3) < MIX_CVT_FIRST) ? 1 : 0; first = __builtin_amdgcn_readfirstlane(first);
#if MOE_FP8
          if (first) for (;;) {
              __syncthreads();
              if (F.tid == 0) MISC[0] = atomicAdd(F.ctl + CW_CVTQ, 1u);
              __syncthreads();
              const int bt = (int)MISC[0];
              if (bt >= CVT_NBATCH) break;
              cvt_experts8_batch(F, bt);
          }
#endif
#if ATTN_PIPE
          attn_queue_run(F, F.ctl + CW_ATTQ, MISC);
#else
          for (;;) {
              __syncthreads();
              if (F.tid == 0) MISC[0] = atomicAdd(F.ctl + CW_ATTQ, 1u);
              __syncthreads();
              const int uidx = (int)MISC[0];
              if (uidx >= ATT_UNITS) break;
              attn_unit_fast(F, uidx);
          }
#endif
#if MOE_FP8
          for (;;) {
              __syncthreads();
              if (F.tid == 0) MISC[0] = atomicAdd(F.ctl + CW_CVTQ, 1u);
              __syncthreads();
              const int bt = (int)MISC[0];
              if (bt >= CVT_NBATCH) break;
              cvt_experts8_batch(F, bt);
          }
#endif
        }
#else
        for (int vb = blockIdx.x; vb < 128 + 512; vb += F.G) { if (vb < 128) ph_mlstm_naive_unit(F, vb); else ph_attn_naive_block(F, vb - 128); }
#endif
    } SEAM(PH_MIX); STAMP(4);
#if FAST_ATTN
#if !(FUSE_ATTN_COMBINE && FUSE_TOKBLOCK)
    if (IN(PH_MIX)) { REFRESH(); ph_attn_combine(F); if (DUP == 13) ph_attn_combine(F); xcd_barrier(bar); }
#endif
#endif
    STAMP(5);
#if FUSE_TOKBLOCK
    if (IN(PH_BRANCH)) { REFRESH(); ph_tokblock(F); }
#else
#if FAST_BRANCH
    if (IN(PH_BRANCH)) { REFRESH(); ph_branch_fast(F); if (DUP == 4) ph_branch_fast(F); }
    SEAM(PH_BRANCH); STAMP(6);
    if (IN(PH_OUTPROJ)) { REFRESH(); ph_outproj_fast(F); if (DUP == 5) ph_outproj_fast(F); }
    SEAM(PH_OUTPROJ); STAMP(7);
#else
    if (IN(PH_BRANCH)) { REFRESH(); ph_branch_naive(F); }
    SEAM(PH_BRANCH);
    if (IN(PH_OUTPROJ)) { REFRESH(); ph_outproj_naive(F); }
    SEAM(PH_OUTPROJ);
#endif
    if (IN(PH_NORMMID)) { REFRESH(); ph_normmid(F);
#if FAST_EXPERTS
#if MOE_FP8
        if (DUP == 6) ph_normmid(F);
#else
        ph_cvt_experts(F); if (DUP == 6) { ph_normmid(F); ph_cvt_experts(F); }
#endif
#endif
    }
    SEAM(PH_NORMMID); STAMP(8);
#if FAST_ROUTER
    if (IN(PH_ROUTER)) { REFRESH(); ph_router_fast(F); if (DUP == 7) ph_router_fast(F);
#if FUSE_ROUTER_TOPK
        asm volatile("s_waitcnt vmcnt(0)" ::: "memory"); __syncthreads();
        REFRESH(); { RouterBlocks RB; RB.S.init(T, 256, 1024, nullptr, nullptr, F.G, (int)blockIdx.x); ph_topk4(F, RB); }
#endif
    }
#else
    if (IN(PH_ROUTER)) { REFRESH(); ph_router_naive(F); }
#endif
#if !FUSE_ROUTER_TOPK
    SEAM(PH_ROUTER);
#endif
    STAMP(9);
#endif
    #if FAST_MOE2
#if FAST_TOPK4
    if (IN(PH_TOPK) && !FUSE_ROUTER_TOPK && !FUSE_TOKBLOCK) { REFRESH(); ph_topk4(F, StrideBlocks{(int)blockIdx.x, F.G}); }
#else
    if (IN(PH_TOPK)) { REFRESH(); ph_topk2(F); if (DUP == 8) ph_topk2(F); }
#endif
    SEAM(PH_TOPK); STAMP(10);
#if SLOT8
    if (IN(PH_SCATTER)) { REFRESH(); ph_scatter4(F); if (DUP == 9) ph_scatter4(F); } SEAM(PH_SCATTER); STAMP(12);
    if (IN(PH_EXPERTS)) { REFRESH(); ph_gu8(F); if (DUP == 10) ph_gu8(F); xcd_barrier(bar); STAMP(13); REFRESH(); ph_down9(F); if (DUP == 11) ph_down9(F); if (DUP == 40 || DUP == 41) { int dm = (DUP == 40) ? 1 : 2; asm volatile("" : "+s"(dm)); ph_down9(F, dm); } }
    SEAM(PH_EXPERTS); STAMP(14);
    if (IN(PH_FINAL)) { REFRESH(); ph_combine9(F); if (DUP == 12) { __syncthreads(); ph_combine9(F); } }
#else
    if (IN(PH_SCATTER)) { REFRESH(); ph_scatter3(F); } SEAM(PH_SCATTER); STAMP(12);
#if MOE_FP8
    if (IN(PH_EXPERTS)) { REFRESH(); ph_gu8(F); if (DUP == 10) ph_gu8(F); xcd_barrier(bar); STAMP(13); REFRESH(); ph_down8(F, 0); if (DUP == 11) ph_down8(F, 0); xcd_barrier(bar); REFRESH(); ph_combine2(F, 0); xcd_barrier(bar); REFRESH(); ph_down8(F, 1); }
#else
    if (IN(PH_EXPERTS)) { REFRESH(); ph_gu2(F); if (DUP == 10) ph_gu2(F); xcd_barrier(bar); STAMP(13); REFRESH(); ph_down2(F, 0); if (DUP == 11) ph_down2(F, 0); xcd_barrier(bar); REFRESH(); ph_combine2(F, 0); xcd_barrier(bar); REFRESH(); ph_down2(F, 1); }
#endif
    SEAM(PH_EXPERTS); STAMP(14);
    if (IN(PH_FINAL)) { REFRESH(); ph_combine2(F, 1); if (DUP == 12) { __syncthreads(); } }
#endif
#else
#if DBG_TOPK_SERIAL
    if (IN(PH_TOPK)) { REFRESH(); ph_topk_serial(F); }
#else
    if (IN(PH_TOPK)) { REFRESH(); ph_topk(F); }
#endif
    SEAM(PH_TOPK); STAMP(10);
    if (IN(PH_SCAN)) { REFRESH(); ph_scan(F); } SEAM(PH_SCAN); STAMP(11);
    if (IN(PH_SCATTER)) { REFRESH(); ph_scatter(F); } SEAM(PH_SCATTER); STAMP(12);
#if DBG_BRUTE
    if (IN(PH_EXPERTS)) { REFRESH(); ph_experts_brute(F); }
#elif FAST_EXPERTS
    if (IN(PH_EXPERTS)) { REFRESH(); ph_gu_fast(F); xcd_barrier(bar); STAMP(13); REFRESH(); ph_down_fast(F); }
#else
    if (IN(PH_EXPERTS)) { REFRESH(); ph_experts_naive(F); }
#endif
    SEAM(PH_EXPERTS); STAMP(14);
    if (IN(PH_FINAL)) { REFRESH(); ph_final(F); }
#endif
#undef IN
#undef SEAM
}

extern "C" void kernel_launch(void* const* d_in, const int* in_sizes, int n_in, void* d_out, int out_size, void* d_ws, size_t ws_size, hipStream_t stream) {
    static int grid = 0;
    if (grid == 0) {
        if (n_in != N_IN || out_size != T * D || ws_size < WS_NEED) { fprintf(stderr, "kernel_launch: unexpected shapes (n_in %d, out %d, ws %zu); nothing launched\n", n_in, out_size, ws_size); grid = -1; return; }
        int dev = 0, cus = 0, per_cu = 0;
        if (hipGetDevice(&dev) != hipSuccess || hipDeviceGetAttribute(&cus, hipDeviceAttributeMultiprocessorCount, dev) != hipSuccess) { grid = -1; return; }
        if (hipFuncSetAttribute((const void*)mk_fwd, hipFuncAttributeMaxDynamicSharedMemorySize, LDS_BYTES) != hipSuccess) { fprintf(stderr, "kernel_launch: hipFuncSetAttribute failed\n"); grid = -1; return; }
        if (hipOccupancyMaxActiveBlocksPerMultiprocessor(&per_cu, (const void*)mk_fwd, NTHR, LDS_BYTES) != hipSuccess || per_cu < 1) fprintf(stderr, "kernel_launch: occupancy query reports %d\n", per_cu);
        (void)hipGetLastError();
        grid = cus;
    }
    if (grid < 0) return;
    if (hipMemsetAsync((char*)d_ws + WS_CTL, 0, CTL_ZERO_BYTES, stream) != hipSuccess) return;
    Args a{};
    for (int i = 0; i < N_IN; ++i) a.in[i] = (const float*)d_in[i];
    a.out = (float*)d_out; a.ws = (unsigned char*)d_ws;
#if MK_SPLIT
    for (int p = 0; p < N_PHASES; ++p) { a.ph_lo = p; a.ph_hi = p + 1; hipLaunchKernelGGL(mk_fwd, dim3(grid), dim3(NTHR), LDS_BYTES, stream, a); }
#elif defined(MK_CUTS)
    { const int cuts[] = MK_CUTS; const int nc = sizeof(cuts) / sizeof(int);
      for (int i = 0; i + 1 < nc; ++i) { a.ph_lo = cuts[i]; a.ph_hi = cuts[i + 1];
          if (i) hipMemsetAsync((char*)d_ws + WS_CTL + CW_BAR * 4, 0, XCD_BAR_WORDS * 4, stream);
          hipLaunchKernelGGL(mk_fwd, dim3(grid), dim3(NTHR), LDS_BYTES, stream, a); } }
#else
    a.ph_lo = 0; a.ph_hi = N_PHASES;
    hipLaunchKernelGGL(mk_fwd, dim3(grid), dim3(NTHR), LDS_BYTES, stream, a);
#endif
}
```

```cpp
#include <hip/hip_runtime.h>
#include <cstdio>
#include <cstdint>

#define GAS __attribute__((address_space(1)))
#define LAS __attribute__((address_space(3)))
typedef unsigned short bf16;
typedef float f32x4 __attribute__((ext_vector_type(4)));
typedef float f32x2 __attribute__((ext_vector_type(2)));
typedef unsigned u32x4 __attribute__((ext_vector_type(4)));
typedef unsigned u32x2 __attribute__((ext_vector_type(2)));

#ifndef DBG_MOE_SCALE
#define DBG_MOE_SCALE 1.0f
#endif
#ifndef DBG_BRUTE
#define DBG_BRUTE 0
#endif
#ifndef DBG_TOPK_SERIAL
#define DBG_TOPK_SERIAL 1
#endif

#ifndef FAST_INPROJ
#define FAST_INPROJ 1
#endif
#ifndef FAST_BRANCH
#define FAST_BRANCH 1
#endif
#ifndef FAST_ROUTER
#define FAST_ROUTER 1
#endif
#ifndef FAST_EXPERTS
#define FAST_EXPERTS 1
#endif
#ifndef FAST_ATTN
#define FAST_ATTN 1
#endif
#ifndef FAST_MLSTM
#define FAST_MLSTM 1
#endif
#ifndef DBG_STAMP_A
#define DBG_STAMP_A -1
#endif
#ifndef DBG_STAMP_B
#define DBG_STAMP_B 0
#endif
#ifndef FAST_MOE2
#define FAST_MOE2 1
#endif
#ifndef DUP
#define DUP -1
#ifndef DOWN_A_RESIDENT
#define DOWN_A_RESIDENT true
#endif
#ifndef BO_FP8
#define BO_FP8 1
#endif
#define BO_ASC 8.0f
#ifndef GATES_FP8
#define GATES_FP8 1
#endif
#ifndef ATTN_PIPE
#define ATTN_PIPE 1
#endif
#ifndef FUSE_ATTN_COMBINE
#define FUSE_ATTN_COMBINE 1
#endif
#ifndef MIX_CVT_FIRST
#define MIX_CVT_FIRST 3
#endif
#endif
#ifndef FAST_TOPK4
#define FAST_TOPK4 1
#endif
#ifndef MOE_FP8
#define MOE_FP8 1
#endif
#ifndef STAGGER_NS
#define STAGGER_NS 0
#endif
#ifndef INPROJ_FP8
#define INPROJ_FP8 1
#endif
#ifndef SLOT8
#define SLOT8 1
#endif
#ifndef GATES_GEMM
#define GATES_GEMM 1
#endif
#ifndef GATES_U8
#define GATES_U8 1
#endif
#ifndef DOWN_ALIGN
#define DOWN_ALIGN true
#endif
#ifndef FUSE_ROUTER_TOPK
#define FUSE_ROUTER_TOPK 1
#endif
#ifndef FUSE_TOKBLOCK
#define FUSE_TOKBLOCK 1
#endif
#ifndef MK_SPLIT
#define MK_SPLIT 0
#endif

constexpr int D = 1024, NB = 32, SEQ = 2048, T = NB * SEQ;
constexpr int INW = 7432;
constexpr int NE = 256, TOPK = 8;
constexpr int NTHR = 512, NWAVES = 8;
constexpr float EPS = 1e-6f;

enum { I_X = 0, I_C, I_POS, I_WADA, I_BADA, I_GPREMIX, I_GPOSTMIX, I_GPREFFN, I_GPOSTFFN, I_WIN, I_CONVW, I_CONVB, I_BGATES, I_GMLSTM,
       I_WBA, I_WBB, I_WOUT, I_RW, I_RB, I_WEG, I_WEU, I_WED, I_WSG, I_WSU, I_WSD, N_IN };

constexpr size_t MiB = 1u << 20;
constexpr size_t WS_CTL = 0, CTL_ZERO_BYTES = 1 * MiB;
constexpr size_t WS_MOD = 1 * MiB;
constexpr size_t WS_GATES = 2 * MiB;
constexpr size_t WS_TOPI = 4 * MiB;
constexpr size_t WS_TOPW = 6 * MiB;
constexpr size_t WS_ROWTOK = 8 * MiB;
constexpr size_t WS_ROWW = 12 * MiB;
constexpr size_t WS_UNITEXP = 16 * MiB;
constexpr size_t WS_EXPTILE0 = 16 * MiB + 65536;
constexpr size_t WS_HIST = 17 * MiB;
constexpr size_t WS_BASEREL = 17 * MiB + 262144;
constexpr size_t WS_TSG = 17 * MiB + 524288;
constexpr size_t WS_TE = 17 * MiB + 528384;
constexpr size_t WS_THOFF = 17 * MiB + 544768;
constexpr size_t WS_DEST = 52 * MiB;
constexpr size_t WS_DUMP = 18 * MiB;
constexpr size_t WS_ROPE = 20 * MiB;
constexpr size_t WS_W8T = 24 * MiB;
constexpr size_t WS_WIN_T = 25 * MiB;
constexpr size_t WS_WBA_T = 40 * MiB;
constexpr size_t WS_WBB_T = 41 * MiB;
constexpr size_t WS_WOUT_T = 43 * MiB;
constexpr size_t WS_WR_T = 45 * MiB;
constexpr size_t WS_WSGU_T = 46 * MiB;
constexpr size_t WS_WSD_T = 47 * MiB;
constexpr size_t WS_LSE = 48 * MiB;
constexpr size_t WS_Q = 64 * MiB, WS_K = 160 * MiB, WS_V = 256 * MiB;
constexpr size_t WS_MQK = 352 * MiB, WS_MV = 480 * MiB, WS_MO = 608 * MiB;
constexpr size_t WS_GAB = 736 * MiB;
constexpr size_t WS_MERGED = 192 * MiB;
constexpr size_t WS_MERGED8 = 992 * MiB;
constexpr size_t WS_YMIX = 64 * MiB;
constexpr size_t WS_H2 = 192 * MiB;
constexpr size_t WS_LOGITS = 384 * MiB;
constexpr size_t WS_WD = 384 * MiB;
constexpr size_t WS_WGU = 512 * MiB;
constexpr size_t WS_HIDS = 320 * MiB;
constexpr size_t WS_HIDR = 768 * MiB;
constexpr size_t WS_NEED = 1064 * MiB;
constexpr size_t WS_H8 = 992 * MiB;
constexpr size_t WS_WIN_T8 = 1056 * MiB;
constexpr size_t WS_H2F8 = 320 * MiB;
constexpr size_t WS_WD8 = 672 * MiB;
constexpr size_t WS_WGU8 = 864 * MiB;
constexpr size_t WS_WSGU8 = 46 * MiB;
constexpr size_t WS_WSD8 = 47 * MiB;
constexpr size_t WS_HIDS8 = 448 * MiB;
constexpr size_t WS_HIDR8 = 480 * MiB;
constexpr size_t OUT_H = 0;
constexpr size_t OUT_YA = 0;
constexpr size_t OUT_YB = 128 * MiB;
constexpr size_t OUT_OG = 32 * MiB;

constexpr int CW_BAR = 4096;
constexpr int CW_STAMP = 8192;
constexpr int CW_CVTQ = 12800;
constexpr int CW_ATTQ = 12288;
constexpr int CW_COUNTS = 16384, CW_CURSOR = 16384 + 256, CW_NT = 16384 + 512, CW_NT0 = 16384 + 576;

constexpr int LDS_BYTES = 147456;
constexpr int MISC_OFF = 131072 + 320;

__device__ __forceinline__ float bf2f(bf16 b) { return __uint_as_float(((unsigned)b) << 16); }
__device__ __forceinline__ unsigned f2bf(float f) { unsigned u = __float_as_uint(f); return (u + 0x7fffu + ((u >> 16) & 1u)) >> 16; }
__device__ __forceinline__ unsigned pk2(float lo, float hi) { return f2bf(lo) | (f2bf(hi) << 16); }
__device__ __forceinline__ float wave_sum(float v) {
#pragma unroll
    for (int o = 1; o < 64; o <<= 1) v += __shfl_xor(v, o);
    return v;
}
__device__ __forceinline__ float sigmoidf_(float x) { return 1.0f / (1.0f + expf(-x)); }
__device__ __forceinline__ float logsigmoidf_(float x) { return fminf(x, 0.f) - log1pf(expf(-fabsf(x))); }

#define XB_TMO      128
#define XB_XCNT(j)  (256  + 64 * (j))
#define XB_XSUB(j)  (1280 + 64 * (j))
#define XB_XGEN(j)  (2304 + 64 * (j))
#define XB_TOP      3328
#define XB_TOPGEN   3392
#define XCD_BAR_WORDS 3456
#define XB_SPIN_CAP (1u << 23)

__device__ __forceinline__ unsigned xb_ld(unsigned* p)              { return __hip_atomic_load(p, __ATOMIC_RELAXED, __HIP_MEMORY_SCOPE_AGENT); }
__device__ __forceinline__ unsigned xb_add(unsigned* p, unsigned v) { return __hip_atomic_fetch_add(p, v, __ATOMIC_RELAXED, __HIP_MEMORY_SCOPE_AGENT); }
__device__ __forceinline__ unsigned xb_xcc_id() { return (unsigned)__builtin_amdgcn_s_getreg((3 << 11) | 20) & 0xFu; }
#define XB_SPIN(cond, bar) do { unsigned _sp = 0; while (cond) { __builtin_amdgcn_s_sleep(1); \
    if ((++_sp & 255u) == 0u) { if (xb_ld(&(bar)[XB_TMO])) break; if (_sp > XB_SPIN_CAP) { atomicAdd(&(bar)[XB_TMO], 1u); break; } } } } while (0)

struct XcdBarrier { unsigned* bar; unsigned x; volatile LAS unsigned* st; };

__device__ __forceinline__ XcdBarrier xcd_barrier_post(unsigned* bar, volatile LAS unsigned* st) {
    XcdBarrier b; b.bar = bar; b.x = xb_xcc_id(); b.st = st;
    if (threadIdx.x == 0) (void)xb_add(&bar[XB_XCNT(b.x)], 1u);
    return b;
}
__device__ __forceinline__ void xcd_barrier_complete(unsigned* bar, unsigned x, unsigned& nloc, unsigned& nx) {
    const unsigned G = gridDim.x * gridDim.y * gridDim.z;
    unsigned sum, cnt, mine, sp = 0u;
    for (;;) {
        sum = 0u; cnt = 0u; mine = 0u;
#pragma unroll
        for (unsigned j = 0; j < 16; ++j) { const unsigned c = xb_ld(&bar[XB_XCNT(j)]); sum += c; cnt += (c > 0u) ? 1u : 0u; mine = (j == x) ? c : mine; }
        if (sum == G) break;
        __builtin_amdgcn_s_sleep(1);
        if ((++sp & 255u) == 0u) { if (xb_ld(&bar[XB_TMO])) break; if (sp > XB_SPIN_CAP) { atomicAdd(&bar[XB_TMO], 1u); break; } }
    }
    nloc = mine > 0u ? mine : 1u; nx = cnt > 0u ? cnt : 1u;
}
__device__ __forceinline__ void xcd_barrier(const XcdBarrier& b) {
    asm volatile("s_waitcnt vmcnt(0)" ::: "memory");
    __syncthreads();
    if (threadIdx.x == 0) {
        unsigned* bar = b.bar;
        __builtin_amdgcn_s_waitcnt(0);
        unsigned nloc = b.st[0], nx = b.st[1];
        if (nloc == 0u) { xcd_barrier_complete(bar, b.x, nloc, nx); b.st[0] = nloc; b.st[1] = nx; }
        const unsigned old = xb_add(&bar[XB_XSUB(b.x)], 1u);
        const unsigned gen = old / nloc;
        if (old + 1u == (gen + 1u) * nloc) {
            __builtin_amdgcn_fence(__ATOMIC_RELEASE, "agent");
            asm volatile("s_waitcnt vmcnt(0)" ::: "memory");
            const unsigned og = xb_add(&bar[XB_TOP], 1u);
            const unsigned tg = og / nx;
            if (og + 1u == (tg + 1u) * nx) xb_add(&bar[XB_TOPGEN], 1u);
            else XB_SPIN(xb_ld(&bar[XB_TOPGEN]) == tg, bar);
            __builtin_amdgcn_fence(__ATOMIC_ACQUIRE, "agent");
            xb_add(&bar[XB_XGEN(b.x)], 1u);
            asm volatile("s_waitcnt vmcnt(0)" ::: "memory");
        } else {
            XB_SPIN(xb_ld(&bar[XB_XGEN(b.x)]) == gen, bar);
            __builtin_amdgcn_fence(__ATOMIC_ACQUIRE, "agent");
            asm volatile("s_waitcnt vmcnt(0)" ::: "memory");
        }
    }
    __syncthreads();
}

struct Args { const float* in[N_IN]; float* out; unsigned char* ws; int ph_lo, ph_hi; };

struct Frame {
    LAS unsigned char* lds;
    unsigned* ctl;
    int tid, lane, wave, G;
    const float* in[N_IN];
    const int* pos;
    float* out; unsigned char* outb; unsigned char* ws;
};

struct ARowGlobal {
    const bf16* base; size_t ld; int m0; const int* gather;
    __device__ __forceinline__ void load4(int r, int k, float (&o)[4]) const {
        const size_t row = gather ? (size_t)gather[m0 + r] : (size_t)(m0 + r);
        const u32x2 v = *(const u32x2*)(base + row * ld + k);
        o[0] = __uint_as_float(v.x << 16); o[1] = __uint_as_float(v.x & 0xffff0000u); o[2] = __uint_as_float(v.y << 16); o[3] = __uint_as_float(v.y & 0xffff0000u);
    }
};
struct ARowLds {
    const LAS bf16* base;
    __device__ __forceinline__ void load4(int r, int k, float (&o)[4]) const {
        const u32x2 v = *(const LAS u32x2*)(base + r * 256 + k);
        o[0] = __uint_as_float(v.x << 16); o[1] = __uint_as_float(v.x & 0xffff0000u); o[2] = __uint_as_float(v.y << 16); o[3] = __uint_as_float(v.y & 0xffff0000u);
    }
};
template <class ARow>
__device__ __forceinline__ void ngemm_acc(LAS float* As, LAS float* Bs, const ARow& arow, const float* __restrict__ W, int ldw, int K, int n0, int Nvalid, float (&acc)[8][4]) {
    const int tid = threadIdx.x, ty = tid >> 5, tx = tid & 31;
    const int ar = tid >> 2, ak = (tid & 3) * 4;
    const int bk = tid >> 5, bn = (tid & 31) * 4;
    for (int k0 = 0; k0 < K; k0 += 16) {
        float a4[4]; arow.load4(ar, k0 + ak, a4);
        f32x4 b4 = (f32x4){0.f, 0.f, 0.f, 0.f};
        if (n0 + bn < Nvalid) b4 = *(const f32x4*)(W + (size_t)(k0 + bk) * ldw + n0 + bn);
        __syncthreads();
        As[(ak + 0) * 132 + ar] = a4[0]; As[(ak + 1) * 132 + ar] = a4[1]; As[(ak + 2) * 132 + ar] = a4[2]; As[(ak + 3) * 132 + ar] = a4[3];
        *(LAS f32x4*)(Bs + bk * 132 + bn) = b4;
        __syncthreads();
#pragma unroll 4
        for (int kk = 0; kk < 16; ++kk) {
            const f32x4 a0 = *(const LAS f32x4*)(As + kk * 132 + ty * 8), a1 = *(const LAS f32x4*)(As + kk * 132 + ty * 8 + 4);
            const f32x4 b = *(const LAS f32x4*)(Bs + kk * 132 + tx * 4);
#pragma unroll
            for (int j = 0; j < 4; ++j) {
                acc[0][j] += a0[0] * b[j]; acc[1][j] += a0[1] * b[j]; acc[2][j] += a0[2] * b[j]; acc[3][j] += a0[3] * b[j];
                acc[4][j] += a1[0] * b[j]; acc[5][j] += a1[1] * b[j]; acc[6][j] += a1[2] * b[j]; acc[7][j] += a1[3] * b[j];
            }
        }
    }
    __syncthreads();
}
#define ZERO_ACC(a) do { _Pragma("unroll") for (int _i = 0; _i < 8; ++_i) _Pragma("unroll") for (int _j = 0; _j < 4; ++_j) a[_i][_j] = 0.f; } while (0)


namespace g2 {
typedef short bf16x8 __attribute__((ext_vector_type(8)));
typedef int v4i_t __attribute__((ext_vector_type(4)));
typedef int v8i_t __attribute__((ext_vector_type(8)));
constexpr int BM = 256, BK = 64, HALF = 128, HTB = HALF * BK * 2, STAGE_BYTES = 8 * HTB, NXCD = 8, WGM = 8;
__host__ __device__ __forceinline__ int lds_byte(int r, int c) { const int st = (r >> 4) * 2 + (c >> 5), rr = r & 15, cc = c & 31, ob = rr * 64 + cc * 2; return st * 1024 + (ob ^ (((ob >> 9) & 1) << 5)); }
__host__ __device__ __forceinline__ void stage_rc(int b, int& R, int& C) { const int st = b / 1024, sb = b % 1024, swz = sb ^ (((sb >> 9) & 1) << 5); R = (st >> 1) * 16 + swz / 64; C = (st & 1) * 32 + (swz % 64) / 2; }
__host__ __device__ __forceinline__ int perm32(int rho) { const int n = rho >> 4, i = rho & 15; return 8 * (i >> 2) + 4 * n + (i & 3); }
__device__ __forceinline__ unsigned cvt_pk_bf16(float lo, float hi) { unsigned r; asm volatile("v_cvt_pk_bf16_f32 %0, %1, %2" : "=v"(r) : "v"(lo), "v"(hi)); return r; }

struct UnitMN { int pm, pn; };
struct DenseOrder {
    typedef UnitMN Unit;
    int nM, nN, nwg, G, c, Kk, pnoff, pncut, pnskip;
    const char* A; const char* Bt;
    __device__ void init(int M, int N, int K, const void* A_, const void* Bt_, int G_, int c_) { nM = M / BM; nN = N / BM; nwg = nM * nN; G = G_; c = c_; Kk = K; A = (const char*)A_; Bt = (const char*)Bt_; pnoff = 0; pncut = 1 << 20; pnskip = 0; }
    __device__ __forceinline__ bool next(int i, Unit& u) const {
        const long L = (long)i * G + c; if (L >= nwg) return false;
        int wgid = (int)L; { const int q = nwg / NXCD, r = nwg % NXCD, xcd = wgid % NXCD, off = wgid / NXCD; wgid = (xcd < r ? xcd * (q + 1) : r * (q + 1) + (xcd - r) * q) + off; }
        const int nig = WGM * nN, gid = wgid / nig, fm = gid * WGM, gsz = (nM - fm) < WGM ? (nM - fm) : WGM;
        u.pm = fm + ((wgid % nig) % gsz); u.pn = (wgid % nig) / gsz; if (u.pn >= pncut) u.pn += pnskip; u.pn += pnoff; return true;
    }
    __device__ __forceinline__ int K(const Unit&) const { return Kk; }
    __device__ __forceinline__ const char* a_base(const Unit&) const { return A; }
    __device__ __forceinline__ unsigned a_row_off(const Unit& u, int r) const { return (unsigned)(u.pm * BM + r) * (unsigned)(Kk * 2); }
    __device__ __forceinline__ const char* b_base(const Unit& u) const { return Bt + (size_t)u.pn * BM * Kk * 2; }
};

template <class E, class U> __device__ __forceinline__ auto epi_unit_start(const E& e, const U& u, int wid, int lane, int) -> decltype(e.unit_start(u, wid, lane)) { return e.unit_start(u, wid, lane); }
template <class E, class U> __device__ __forceinline__ void epi_unit_start(const E&, const U&, int, int, long) {}
template <class S> constexpr auto sched_a_resident(int) -> decltype(S::A_RESIDENT) { return S::A_RESIDENT; }
template <class S> constexpr bool sched_a_resident(long) { return false; }
template <class S, class U> __device__ __forceinline__ auto sched_a_new(const S& s, const U& u, int) -> decltype(s.a_new(u)) { return s.a_new(u); }
template <class S, class U> __device__ __forceinline__ bool sched_a_new(const S&, const U&, long) { return true; }
template <class Epi, class Sched, bool F8 = false, bool ALIGN_EPI = true>
__device__ __forceinline__ void gemm_phase(LAS unsigned char* lds, const Sched& S, const Epi& E, int f8_scale_b = 127) {
    int tid = threadIdx.x; asm volatile("" : "+v"(tid));
    const int wid = __builtin_amdgcn_readfirstlane(tid >> 6), lane = tid & 63, wr = wid >> 2, wc = wid & 3, fr = lane & 15, fq = lane >> 4;
#define G2_RC(i, R, Rb, C2) int R, Rb; unsigned C2; { int _R, _C; stage_rc(tid * 16 + (i) * 8192, _R, _C); R = _R; Rb = Epi::PERM ? (64 * (_R >> 5) + 16 * ((_R & 15) >> 2) + 4 * ((_R & 31) >> 4) + (_R & 3)) : _R; C2 = (unsigned)_C * 2u; }
    const size_t kstep = (size_t)(BK * 2);
    const unsigned ldsw = (unsigned)wid * 1024u;
    const int aoff = lds_byte(wr * 64 + fr, fq * 8), boff = lds_byte(wc * 32 + fr, fq * 8);
#define G2_SA(b, h) (((b) * 2 + (h)) * HTB)
#define G2_SB(b, h) ((4 + (b) * 2 + (h)) * HTB)
#define G2_STAGE(bufoff, gbase, voff) do { _Pragma("unroll") for (int _i = 0; _i < 2; ++_i) \
        __builtin_amdgcn_global_load_lds((const unsigned*)((const char*)(gbase) + (voff)[_i]), (LAS unsigned*)(lds + (bufoff) + ldsw + _i * 8192), 16, 0, 0); } while (0)
#define G2_LDA(dst, b, h) do { _Pragma("unroll") for (int m = 0; m < 4; ++m) { const v4i_t _lo = *(const LAS v4i_t*)(lds + G2_SA(b, h) + aoff + m * 2048), _hi = *(const LAS v4i_t*)(lds + G2_SA(b, h) + aoff + m * 2048 + 1024); \
        dst[m] = __builtin_shufflevector(_lo, _hi, 0, 1, 2, 3, 4, 5, 6, 7); } } while (0)
#define G2_LDB(dst, b, h) do { _Pragma("unroll") for (int n = 0; n < 2; ++n) { const v4i_t _lo = *(const LAS v4i_t*)(lds + G2_SB(b, h) + boff + n * 2048), _hi = *(const LAS v4i_t*)(lds + G2_SB(b, h) + boff + n * 2048 + 1024); \
        dst[n] = __builtin_shufflevector(_lo, _hi, 0, 1, 2, 3, 4, 5, 6, 7); } } while (0)
#define G2_MMA(ai, bj, At, Bt) do { __builtin_amdgcn_s_setprio(1); _Pragma("unroll") for (int m = 0; m < 4; ++m) _Pragma("unroll") for (int n = 0; n < 2; ++n) { \
        if constexpr (F8) asm volatile("v_mfma_scale_f32_16x16x128_f8f6f4 %0, %1, %2, %0, %3, %4 op_sel_hi:[0,0,0]" : "+v"(acc[ai][bj][m][n]) : "v"(Bt[n]), "v"(At[m]), "v"(f8_sb), "v"(f8_sa)); \
        else { acc[ai][bj][m][n] = __builtin_amdgcn_mfma_f32_16x16x32_bf16(__builtin_bit_cast(bf16x8, __builtin_shufflevector(Bt[n], Bt[n], 0, 1, 2, 3)), __builtin_bit_cast(bf16x8, __builtin_shufflevector(At[m], At[m], 0, 1, 2, 3)), acc[ai][bj][m][n], 0, 0, 0); \
               acc[ai][bj][m][n] = __builtin_amdgcn_mfma_f32_16x16x32_bf16(__builtin_bit_cast(bf16x8, __builtin_shufflevector(Bt[n], Bt[n], 4, 5, 6, 7)), __builtin_bit_cast(bf16x8, __builtin_shufflevector(At[m], At[m], 4, 5, 6, 7)), acc[ai][bj][m][n], 0, 0, 0); } } \
        __builtin_amdgcn_s_setprio(0); } while (0)
#define G2_WAIT_V(n) asm volatile("s_waitcnt vmcnt(" #n ")" ::: "memory")
#define G2_WAIT_L(n) asm volatile("s_waitcnt lgkmcnt(" #n ")" ::: "memory")
#define G2_BAR __builtin_amdgcn_s_barrier()
#define G2_STAGE_IF(c, bufoff, gbase, voff) do { if (!AR || (c)) G2_STAGE(bufoff, gbase, voff); } while (0)
#define G2_WAIT_VA() do { if constexpr (AR) G2_WAIT_V(4); else G2_WAIT_V(8); } while (0)
#define G2_SCHED __builtin_amdgcn_sched_barrier(0)
    const int f8_sb = f8_scale_b, f8_sa = 127;
    typename Sched::Unit cur, nxt; int ui = 0;
    if (!S.next(0, cur)) return;
    f32x4 acc[2][2][4][2];
#pragma unroll
    for (int a = 0; a < 2; ++a)
#pragma unroll
        for (int b = 0; b < 2; ++b)
#pragma unroll
            for (int m = 0; m < 4; ++m)
#pragma unroll
                for (int n = 0; n < 2; ++n) acc[a][b][m][n] = (f32x4){0.f, 0.f, 0.f, 0.f};
    v8i_t At[4], B0[2], B1[2];
    unsigned vA0[2], vA1[2], vN0[2], vN1[2], vBc[2], vBN[2];
    int Kc = S.K(cur); asm volatile("" : "+s"(Kc)); int nt = Kc / BK;
    constexpr int HROWS = Epi::PERM ? 8 : HALF;
    size_t hc = (size_t)HROWS * Kc * 2, hN = hc;
#pragma unroll
    for (int i = 0; i < 2; ++i) { G2_RC(i, R, Rb, C2); vA0[i] = S.a_row_off(cur, R) + C2; vA1[i] = S.a_row_off(cur, HALF + R) + C2; vN0[i] = vA0[i]; vN1[i] = vA1[i];
        vBc[i] = (unsigned)(Rb * Kc) * 2u + C2; vBN[i] = vBc[i]; }
    const char* cA = S.a_base(cur);
    const char* cB = S.b_base(cur);
    epi_unit_start(E, cur, wid, lane, 0);
    G2_STAGE(G2_SB(0, 0), cB, vBc); G2_STAGE(G2_SB(0, 1), cB + hc, vBc); G2_STAGE(G2_SA(0, 0), cA, vA0); G2_STAGE(G2_SA(0, 1), cA, vA1);
    if (wr == 1) G2_BAR;
    G2_WAIT_V(2); G2_BAR;
    G2_STAGE(G2_SB(1, 0), cB + kstep, vBc); G2_STAGE(G2_SA(1, 0), cA + kstep, vA0); G2_STAGE(G2_SB(1, 1), cB + hc + kstep, vBc);
    G2_WAIT_V(6); G2_BAR;
    bool has_next = S.next(1, nxt);
    typename Sched::Unit nn;
    constexpr bool AR = sched_a_resident<Sched>(0);
    bool curA = true;
    for (;;) {
        const bool has_nn = has_next ? S.next(ui + 2, nn) : false;
        const char* nA = has_next ? S.a_base(nxt) : cA; const char* nB = has_next ? S.b_base(nxt) : cB;
        int Kn = has_next ? S.K(nxt) : Kc; asm volatile("" : "+s"(Kn));
        const bool nxtA = AR ? (has_next && sched_a_new(S, nxt, 0)) : true;
        unsigned vP0[2], vP1[2];
        if (has_next) {
#pragma unroll
            for (int i = 0; i < 2; ++i) { G2_RC(i, R, Rb, C2); (void)Rb; vP0[i] = S.a_row_off(nxt, R) + C2; vP1[i] = S.a_row_off(nxt, HALF + R) + C2; } }
        for (int t = 0; t < nt; t += 2) {
            const bool last = (t == nt - 2);
            const char* a1 = cA + (size_t)(t + 1) * kstep;
            const char* a2 = last ? nA : cA + (size_t)(t + 2) * kstep; const char* b2 = last ? nB : cB + (size_t)(t + 2) * kstep;
            const char* a3 = a2 + kstep; const char* b3 = b2 + kstep;
            if (last && has_next) { hN = (size_t)HROWS * Kn * 2;
#pragma unroll
                for (int i = 0; i < 2; ++i) { G2_RC(i, R, Rb, C2); (void)R; vN0[i] = vP0[i]; vN1[i] = vP1[i]; vBN[i] = (unsigned)(Rb * Kn) * 2u + C2; } }
            G2_LDB(B0, 0, 0); G2_LDB(B1, 0, 1); G2_SCHED; G2_LDA(At, 0, 0); G2_STAGE_IF(curA, G2_SA(1, 1), a1, vA1);
            G2_WAIT_VA(); G2_WAIT_L(0); G2_BAR; G2_MMA(0, 0, At, B0); G2_MMA(0, 1, At, B1); G2_BAR; G2_SCHED;
            G2_LDA(At, 0, 1); G2_STAGE(G2_SB(0, 0), b2, vBN); G2_STAGE(G2_SB(0, 1), b2 + hN, vBN); G2_STAGE_IF(nxtA, G2_SA(0, 0), a2, vN0);
            G2_WAIT_VA(); G2_WAIT_L(0); G2_BAR; G2_MMA(1, 0, At, B0); G2_MMA(1, 1, At, B1); G2_BAR; G2_SCHED;
            G2_LDB(B0, 1, 0); G2_LDB(B1, 1, 1); G2_SCHED; G2_LDA(At, 1, 0); G2_STAGE_IF(nxtA, G2_SA(0, 1), a2, vN1);
            G2_WAIT_VA(); G2_WAIT_L(0); G2_BAR; G2_MMA(0, 0, At, B0); G2_MMA(0, 1, At, B1); G2_BAR; G2_SCHED;
            G2_LDA(At, 1, 1); G2_STAGE(G2_SB(1, 0), b3, vBN); G2_STAGE(G2_SB(1, 1), b3 + hN, vBN); G2_STAGE_IF(nxtA, G2_SA(1, 0), a3, vN0);
            G2_WAIT_VA(); G2_WAIT_L(0); G2_BAR; G2_MMA(1, 0, At, B0); G2_MMA(1, 1, At, B1); G2_BAR; G2_SCHED;
        }
        if constexpr (ALIGN_EPI) { if (wr == 0) G2_BAR; }
        int t2 = threadIdx.x; asm volatile("" : "+v"(t2));
        const bool zero = E(acc, cur, wr, wc, t2 & 15, (t2 & 63) >> 4);
        if (!has_next) break;
        if (zero) {
#pragma unroll
        for (int a = 0; a < 2; ++a)
#pragma unroll
            for (int b = 0; b < 2; ++b)
#pragma unroll
                for (int m = 0; m < 4; ++m)
#pragma unroll
                    for (int n = 0; n < 2; ++n) acc[a][b][m][n] = (f32x4){0.f, 0.f, 0.f, 0.f};
        }
        cur = nxt; nxt = nn; has_next = has_nn; cA = nA; cB = nB; Kc = Kn; nt = Kc / BK; hc = hN; ++ui;
        if constexpr (AR) curA = nxtA;
        { int t4 = threadIdx.x; asm volatile("" : "+v"(t4)); epi_unit_start(E, cur, __builtin_amdgcn_readfirstlane(t4 >> 6), t4 & 63, 0); }
#pragma unroll
        for (int i = 0; i < 2; ++i) { vA0[i] = vN0[i]; vA1[i] = vN1[i]; vBc[i] = vBN[i]; }
        if constexpr (ALIGN_EPI) { if (wr == 1) G2_BAR; }
    }
    G2_WAIT_V(0);
    if constexpr (!ALIGN_EPI) { if (wr == 0) G2_BAR; }
    G2_BAR;
#undef G2_RC
#undef G2_SA
#undef G2_SB
#undef G2_STAGE
#undef G2_LDA
#undef G2_LDB
#undef G2_MMA
#undef G2_WAIT_V
#undef G2_WAIT_L
#undef G2_BAR
#undef G2_STAGE_IF
#undef G2_WAIT_VA
#undef G2_SCHED
}
}

__device__ __forceinline__ void tr_item(const float* __restrict__ W, int ldw, int k0, int n0src, bf16* WT, int Kd, int drow0, LAS float* scr, int lane) {
#pragma unroll 8
    for (int i = 0; i < 32; ++i) { const int kk = 2 * i + (lane >> 5); scr[kk * 33 + (lane & 31)] = W[(size_t)(k0 + kk) * ldw + n0src + (lane & 31)]; }
    asm volatile("s_waitcnt lgkmcnt(0)" ::: "memory");
    const int c = lane & 7;
#pragma unroll
    for (int j = 0; j < 4; ++j) { const int n = (lane >> 3) + 8 * j; const LAS float* sp = scr + (8 * c) * 33 + n;
        u32x4 o; o.x = pk2(sp[0 * 33], sp[1 * 33]); o.y = pk2(sp[2 * 33], sp[3 * 33]); o.z = pk2(sp[4 * 33], sp[5 * 33]); o.w = pk2(sp[6 * 33], sp[7 * 33]);
        *(u32x4*)(WT + (size_t)(drow0 + n) * Kd + k0 + 8 * c) = o; }
    asm volatile("s_waitcnt lgkmcnt(0)" ::: "memory");
}


__device__ __forceinline__ unsigned pk4_fp8(float a, float b, float c, float d) { int r = __builtin_amdgcn_cvt_pk_fp8_f32(a, b, 0, false); r = __builtin_amdgcn_cvt_pk_fp8_f32(c, d, r, true); return (unsigned)r; }
__device__ __forceinline__ void tr_item8p(const float* __restrict__ Wcol  , int ldw, int k0, unsigned char* WT, int Kd, int drow0, float sc, LAS float* scr, int lane) {
#pragma unroll 8
    for (int i = 0; i < 32; ++i) { const int kk = 2 * i + (lane >> 5); scr[kk * 33 + (lane & 31)] = Wcol[(size_t)(k0 + kk) * ldw] * sc; }
    asm volatile("s_waitcnt lgkmcnt(0)" ::: "memory");
    const int c = lane & 7;
#pragma unroll
    for (int j = 0; j < 4; ++j) { const int n = (lane >> 3) + 8 * j; const LAS float* sp = scr + (8 * c) * 33 + n;
        u32x2 o; o.x = pk4_fp8(sp[0 * 33], sp[1 * 33], sp[2 * 33], sp[3 * 33]); o.y = pk4_fp8(sp[4 * 33], sp[5 * 33], sp[6 * 33], sp[7 * 33]);
        *(u32x2*)(WT + (size_t)(drow0 + n) * Kd + k0 + 8 * c) = o; }
    asm volatile("s_waitcnt lgkmcnt(0)" ::: "memory");
}
__device__ __forceinline__ void tr_item8(const float* __restrict__ W, int ldw, int k0, int n0src, unsigned char* WT, int Kd, int drow0, float sc, LAS float* scr, int lane) {
    tr_item8p(W + n0src + (lane & 31), ldw, k0, WT, Kd, drow0, sc, scr, lane);
}
__device__ __forceinline__ void ph_cvt_small(Frame& F) {
    LAS float* scr = (LAS float*)(F.lds) + F.wave * (64 * 33);
    const int nmod = F.G > 96 + 32 ? 96 : 0; const int gw = ((int)blockIdx.x - nmod) * NWAVES + F.wave, NGW = (F.G - nmod) * NWAVES;
    constexpr int I_IN = 16 * 232, I_BA = 4 * 32, I_BB = 16 * 32, I_OUT = 16 * 32, I_R = 16 * 8, I_SGU = 16 * 16, I_SD = 4 * 32;
    constexpr int NIT = I_IN + I_BA + I_BB + I_OUT + I_R + I_SGU + I_SD;
    if (gw >= 0)
    for (int it = gw; it < NIT + 1; it += NGW) {
        int r = it;
        if (r < I_IN) { const int kb = r / 232, nb = r % 232, d0 = nb * 32;
#if !(INPROJ_FP8 && GATES_GEMM && GATES_FP8)
            tr_item(F.in[I_WIN], INW, kb * 64, d0 < 5376 ? d0 : d0 + 8, (bf16*)(F.ws + WS_WIN_T), 1024, d0, scr, F.lane);
#endif
#if INPROJ_FP8
            tr_item8(F.in[I_WIN], INW, kb * 64, d0 < 5376 ? d0 : d0 + 8, F.ws + WS_WIN_T8, 1024, d0, 32.0f, scr, F.lane);
#endif
            continue; } r -= I_IN;
#if BO_FP8
        if (r < I_BA) { const int kb = r / 32, nb = r % 32; tr_item8(F.in[I_WBA], 1024, kb * 64, nb * 32, F.ws + WS_WBA_T, 256, nb * 32, 32.0f, scr, F.lane); continue; } r -= I_BA;
        if (r < I_BB) { const int kb = r / 32, nb = r % 32; tr_item8(F.in[I_WBB], 1024, kb * 64, nb * 32, F.ws + WS_WBB_T, 1024, nb * 32, 32.0f, scr, F.lane); continue; } r -= I_BB;
        if (r < I_OUT) { const int kb = r / 32, nb = r % 32; tr_item8(F.in[I_WOUT], 1024, kb * 64, nb * 32, F.ws + WS_WOUT_T, 1024, nb * 32, 32.0f, scr, F.lane); continue; } r -= I_OUT;
#else
        if (r < I_BA) { const int kb = r / 32, nb = r % 32; tr_item(F.in[I_WBA], 1024, kb * 64, nb * 32, (bf16*)(F.ws + WS_WBA_T), 256, nb * 32, scr, F.lane); continue; } r -= I_BA;
        if (r < I_BB) { const int kb = r / 32, nb = r % 32; tr_item(F.in[I_WBB], 1024, kb * 64, nb * 32, (bf16*)(F.ws + WS_WBB_T), 1024, nb * 32, scr, F.lane); continue; } r -= I_BB;
        if (r < I_OUT) { const int kb = r / 32, nb = r % 32; tr_item(F.in[I_WOUT], 1024, kb * 64, nb * 32, (bf16*)(F.ws + WS_WOUT_T), 1024, nb * 32, scr, F.lane); continue; } r -= I_OUT;
#endif
        if (r < I_R) { const int kb = r / 8, nb = r % 8; tr_item(F.in[I_RW], 256, kb * 64, nb * 32, (bf16*)(F.ws + WS_WR_T), 1024, nb * 32, scr, F.lane); continue; } r -= I_R;
        if (r < I_SGU) { const int kb = r / 16, nb = r % 16, d0 = nb * 32, pn = d0 >> 8, q = d0 & 255; const bool up = q >= 128; const int src = pn * 128 + (q & 127);
            tr_item(up ? F.in[I_WSU] : F.in[I_WSG], 256, kb * 64, src, (bf16*)(F.ws + WS_WSGU_T), 1024, d0, scr, F.lane); continue; } r -= I_SGU;
        if (r < I_SD) { const int kb = r / 32, nb = r % 32; tr_item(F.in[I_WSD], 1024, kb * 64, nb * 32, (bf16*)(F.ws + WS_WSD_T), 256, nb * 32, scr, F.lane); continue; } r -= I_SD;
        { float* W8T = (float*)(F.ws + WS_W8T); const float* W = F.in[I_WIN];
          for (int i = F.lane; i < 8 * 1024; i += 64) { const int k = i >> 3, g = i & 7; W8T[i] = W[(size_t)k * INW + 5376 + g]; } }
    }
#if GATES_GEMM && GATES_FP8
    { unsigned char* WT8 = F.ws + WS_WIN_T8 + (size_t)7424 * 1024; const float* W = F.in[I_WIN];
      for (int i = blockIdx.x * NTHR + F.tid; i < 256 * 1024 / 8; i += F.G * NTHR) { const int rr = i >> 7, k0 = (i & 127) * 8; u32x2 o = (u32x2){0u, 0u};
          if (rr < 8) { float v[8];
#pragma unroll
              for (int e = 0; e < 8; ++e) v[e] = W[(size_t)(k0 + e) * INW + 5376 + rr] * 32.0f;
              o.x = pk4_fp8(v[0], v[1], v[2], v[3]); o.y = pk4_fp8(v[4], v[5], v[6], v[7]); }
          *(u32x2*)(WT8 + (size_t)rr * 1024 + k0) = o; } }
#endif
#if GATES_GEMM && !GATES_FP8
    { bf16* WT = (bf16*)(F.ws + WS_WIN_T) + (size_t)7424 * 1024; const float* W = F.in[I_WIN];
      for (int i = blockIdx.x * NTHR + F.tid; i < 256 * 1024 / 8; i += F.G * NTHR) { const int rr = i >> 7, k0 = (i & 127) * 8; u32x4 o = (u32x4){0u, 0u, 0u, 0u};
          if (rr < 8) { float v[8];
#pragma unroll
              for (int e = 0; e < 8; ++e) v[e] = W[(size_t)(k0 + e) * INW + 5376 + rr];
              o.x = pk2(v[0], v[1]); o.y = pk2(v[2], v[3]); o.z = pk2(v[4], v[5]); o.w = pk2(v[6], v[7]); }
          *(u32x4*)(WT + (size_t)rr * 1024 + k0) = o; } }
#endif
}

__device__ __forceinline__ void ph_mod(Frame& F) {
    LAS float* scT = (LAS float*)F.lds;
    const float* c = F.in[I_C]; const float* W = F.in[I_WADA]; const float* bias = F.in[I_BADA];
    float* mod = (float*)(F.ws + WS_MOD);
    bool filled = false;
    for (int vb = blockIdx.x; vb < 96; vb += F.G) {
        __syncthreads();
        if (!filled) { for (int i = F.tid; i < 32 * 1024; i += NTHR) { const int b = i >> 10, k = i & 1023; const float v = c[i]; scT[k * 32 + b] = v / (1.0f + expf(-v)); } filled = true; }
        __syncthreads();
        const int n = vb * 64 + F.lane;
        float acc[32];
#pragma unroll
        for (int b = 0; b < 32; ++b) acc[b] = 0.f;
#pragma unroll 4
        for (int kk = 0; kk < 128; ++kk) { const int k = F.wave * 128 + kk;
            const float w = W[(size_t)k * 6144 + n];
#pragma unroll
            for (int b4 = 0; b4 < 8; ++b4) { const f32x4 sv = *(const LAS f32x4*)(scT + k * 32 + b4 * 4);
                acc[b4 * 4 + 0] += sv[0] * w; acc[b4 * 4 + 1] += sv[1] * w; acc[b4 * 4 + 2] += sv[2] * w; acc[b4 * 4 + 3] += sv[3] * w; } }
        __syncthreads();
        LAS float* part = (LAS float*)F.lds;
#pragma unroll
        for (int b = 0; b < 32; ++b) part[(F.wave * 32 + b) * 64 + F.lane] = acc[b];
        filled = false;
        __syncthreads();
        for (int i = F.tid; i < 32 * 64; i += NTHR) { const int b = i >> 6, col = i & 63; float sum = bias[vb * 64 + col];
#pragma unroll
            for (int w8 = 0; w8 < 8; ++w8) sum += part[(w8 * 32 + b) * 64 + col];
            mod[b * 6144 + vb * 64 + col] = sum; }
    }
}

__device__ __forceinline__ float wave_sum8(const float (&v)[8], int lane) {
    float a[4], b2[2], c;
#pragma unroll
    for (int i = 0; i < 4; ++i) { const float keep = (lane & 1) ? v[2 * i + 1] : v[2 * i], give = (lane & 1) ? v[2 * i] : v[2 * i + 1]; a[i] = keep + __shfl_xor(give, 1); }
#pragma unroll
    for (int i = 0; i < 2; ++i) { const float keep = (lane & 2) ? a[2 * i + 1] : a[2 * i], give = (lane & 2) ? a[2 * i] : a[2 * i + 1]; b2[i] = keep + __shfl_xor(give, 2); }
    { const float keep = (lane & 4) ? b2[1] : b2[0], give = (lane & 4) ? b2[0] : b2[1]; c = keep + __shfl_xor(give, 4); }
    c += __shfl_xor(c, 8); c += __shfl_xor(c, 16); c += __shfl_xor(c, 32);
    return c;
}
__device__ __forceinline__ void ph_norm1(Frame& F, int mode = 0) {
    const float* x = F.in[I_X]; const float* g = F.in[I_GPREMIX]; const float* mod = (const float*)(F.ws + WS_MOD);
    bf16* H = (bf16*)(F.outb + OUT_H);
    const float* W8T = (const float*)(F.ws + WS_W8T); float* GATES = (float*)(F.ws + WS_GATES); float* ROPE = (float*)(F.ws + WS_ROPE); const float* bg = F.in[I_BGATES];
    const float inv = powf(500000.0f, -(float)(F.lane & 7) / 8.0f); const float bgl = bg[F.lane & 7];
    for (int ci = blockIdx.x * NWAVES + F.wave; ci < T / 32; ci += F.G * NWAVES) {
        const int tb = ci * 32, b = tb / SEQ; const float* sh = mod + b * 6144, *scl = sh + 1024;
        f32x4 gs[4], h1[4];
#pragma unroll
        for (int j = 0; j < 4; ++j) { const int c = F.lane * 4 + 256 * j; const f32x4 gg = *(const f32x4*)(g + c), s1 = *(const f32x4*)(scl + c); h1[j] = *(const f32x4*)(sh + c); gs[j] = gg * (s1 + 1.0f); }
        const int posv = F.pos[tb + (F.lane & 31)];
        f32x4 vn[4];
#pragma unroll
        for (int j = 0; j < 4; ++j) vn[j] = *(const f32x4*)(x + (size_t)tb * D + F.lane * 4 + 256 * j);
#pragma unroll 1
        for (int i = 0; i < 32; ++i) {
            const int t = tb + i;
            asm volatile("" ::: "memory");
            f32x4 v[4]; float ss = 0.f;
#pragma unroll
            for (int j = 0; j < 4; ++j) { v[j] = vn[j]; ss += v[j][0] * v[j][0] + v[j][1] * v[j][1] + v[j][2] * v[j][2] + v[j][3] * v[j][3]; }
            if (i + 1 < 32) {
#pragma unroll
                for (int j = 0; j < 4; ++j) vn[j] = *(const f32x4*)(x + (size_t)(t + 1) * D + F.lane * 4 + 256 * j); }
            const float rstd = rsqrtf(wave_sum(ss) * (1.0f / D) + EPS);
            float gacc[8];
#pragma unroll
            for (int gi = 0; gi < 8; ++gi) gacc[gi] = 0.f;
#pragma unroll
            for (int j = 0; j < 4; ++j) { const int c = F.lane * 4 + 256 * j;
                const f32x4 o = v[j] * rstd * gs[j] + h1[j];
#if !(INPROJ_FP8 && GATES_GEMM && GATES_FP8)
                { u32x2 w; w.x = pk2(o[0], o[1]); w.y = pk2(o[2], o[3]); *(u32x2*)(H + (size_t)t * D + c) = w; }
#endif
#if INPROJ_FP8
                *(unsigned*)(F.ws + WS_H8 + (size_t)t * D + c) = pk4_fp8(o[0], o[1], o[2], o[3]);
#endif
                if (mode != 1 && !GATES_GEMM)
#pragma unroll
                for (int e = 0; e < 4; ++e) { const f32x4 wa = *(const f32x4*)(W8T + (size_t)(c + e) * 8), wb = *(const f32x4*)(W8T + (size_t)(c + e) * 8 + 4);
                    gacc[0] += o[e] * wa[0]; gacc[1] += o[e] * wa[1]; gacc[2] += o[e] * wa[2]; gacc[3] += o[e] * wa[3]; gacc[4] += o[e] * wb[0]; gacc[5] += o[e] * wb[1]; gacc[6] += o[e] * wb[2]; gacc[7] += o[e] * wb[3]; }
                asm volatile("" ::: "memory"); }
#if GATES_GEMM
            const float gsum = 0.f;
#else
            if (mode == 1) continue;
            const float gsum = wave_sum8(gacc, F.lane);
#endif
            const float ang = (float)__builtin_amdgcn_readlane(posv, i) * inv; const float kk = rintf(ang * 0.15915494309189535f);
            float rv = fmaf(ang, 0.15915494309189535f, -kk); rv = fmaf(ang, 6.4206383e-9f, rv);
            if (!GATES_GEMM) { if (F.lane < 8) GATES[(size_t)t * 8 + F.lane] = gsum + bgl; }
            ROPE[(size_t)t * 16 + (F.lane & 15)] = (F.lane & 8) ? __builtin_amdgcn_sinf(rv) : __builtin_amdgcn_cosf(rv);
        }
    }
}

__device__ __forceinline__ void ph_inproj_naive(Frame& F) {
    LAS float* As = (LAS float*)F.lds; LAS float* Bs = As + 16 * 132;
    const bf16* H = (const bf16*)(F.outb + OUT_H); const float* W = F.in[I_WIN]; const float* bg = F.in[I_BGATES];
    bf16* Q = (bf16*)(F.ws + WS_Q); bf16* Kt = (bf16*)(F.ws + WS_K); bf16* V = (bf16*)(F.ws + WS_V); bf16* MQK = (bf16*)(F.ws + WS_MQK); bf16* MV = (bf16*)(F.ws + WS_MV);
    bf16* MO = (bf16*)(F.ws + WS_MO); bf16* GAB = (bf16*)(F.ws + WS_GAB); float* GATES = (float*)(F.ws + WS_GATES);
    constexpr int NTN = (INW + 127) / 128;
    const int ty = F.tid >> 5, tx = F.tid & 31;
    for (int vb = blockIdx.x; vb < (T / 128) * NTN; vb += F.G) {
        const int tm = vb / NTN, tn = vb % NTN, m0 = tm * 128, n0 = tn * 128;
        float acc[8][4]; ZERO_ACC(acc);
        ARowGlobal ar{H, (size_t)D, m0, nullptr};
        ngemm_acc(As, Bs, ar, W, INW, D, n0, INW, acc);
#pragma unroll
        for (int i = 0; i < 8; ++i)
#pragma unroll
            for (int j = 0; j < 4; ++j) {
                const size_t row = (size_t)(m0 + ty * 8 + i); const int col = n0 + tx * 4 + j; const float v = acc[i][j];
                if (col < 768) Q[row * 768 + col] = (bf16)f2bf(v);
                else if (col < 1536) Kt[row * 768 + col - 768] = (bf16)f2bf(v);
                else if (col < 2304) V[row * 768 + col - 1536] = (bf16)f2bf(v);
                else if (col < 3328) MQK[row * 1024 + col - 2304] = (bf16)f2bf(v);
                else if (col < 4352) MV[row * 1024 + col - 3328] = (bf16)f2bf(v);
                else if (col < 5376) MO[row * 1024 + col - 4352] = (bf16)f2bf(v);
                else if (col < 5384) GATES[row * 8 + col - 5376] = v + bg[col - 5376];
                else if (col < INW) GAB[row * 2048 + col - 5384] = (bf16)f2bf(v);
            }
    }
}


__device__ __forceinline__ float fsig(float x) { return __builtin_amdgcn_rcpf(1.0f + __builtin_amdgcn_exp2f(-1.4426950408889634f * x)); }

__device__ __forceinline__ unsigned pk4_sig_u8(const f32x4 v) { int r = 0;
    r = __builtin_amdgcn_cvt_pk_u8_f32(256.0f * fsig(v[0]) - 0.5f, 0, r); r = __builtin_amdgcn_cvt_pk_u8_f32(256.0f * fsig(v[1]) - 0.5f, 1, r);
    r = __builtin_amdgcn_cvt_pk_u8_f32(256.0f * fsig(v[2]) - 0.5f, 2, r); r = __builtin_amdgcn_cvt_pk_u8_f32(256.0f * fsig(v[3]) - 0.5f, 3, r); return (unsigned)r; }
__device__ __forceinline__ f32x4 unpk4_sig_u8(unsigned w) { return (f32x4){((float)(w & 0xffu) + 0.5f) * (1.0f / 256.0f), ((float)((w >> 8) & 0xffu) + 0.5f) * (1.0f / 256.0f), ((float)((w >> 16) & 0xffu) + 0.5f) * (1.0f / 256.0f), ((float)(w >> 24) + 0.5f) * (1.0f / 256.0f)}; }
struct EpiInproj {
    static constexpr bool PERM = true;
    unsigned char* ws; const float* rope; int nostore; const float* bgates;
    __device__ __forceinline__ bool operator()(const f32x4 (&acc)[2][2][4][2], const g2::UnitMN& u, int wr, int wc, int fr, int fq) const {
        if (nostore == 1) { if (acc[0][0][0][0][0] == 123.456f) ws[0] = 1; return true; }
        const int pn = u.pn; size_t boff; int ld, colt;
        if (pn == 29) {
            if (wc == 0 && fq == 0) { float* GT = (float*)(ws + WS_GATES); const f32x4 b0 = *(const f32x4*)bgates, b1 = *(const f32x4*)(bgates + 4);
#pragma unroll
                for (int ai = 0; ai < 2; ++ai)
#pragma unroll
                    for (int m = 0; m < 4; ++m) { const size_t row = (size_t)(u.pm * 256 + wr * 64 + fr + ai * 128 + m * 16);
                        *(f32x4*)(GT + row * 8) = acc[ai][0][m][0] + b0; *(f32x4*)(GT + row * 8 + 4) = acc[ai][0][m][1] + b1; } }
            return true; }
        if (pn < 9) { boff = pn < 3 ? WS_Q : (pn < 6 ? WS_K : WS_V); ld = 768; colt = (pn % 3) * 256; }
        else if (pn < 13) { boff = WS_MQK; ld = 1024; colt = (pn - 9) * 256; }
        else if (pn < 17) { boff = WS_MV; ld = 1024; colt = (pn - 13) * 256; }
        else if (pn < 21) { boff = WS_MO; ld = 1024; colt = (pn - 17) * 256; }
        else { boff = WS_GAB; ld = 2048; colt = (pn - 21) * 256; }
        bf16* base = (bf16*)(ws + boff);
#if GATES_U8
        if (pn >= 17) {
            unsigned char* b8 = ws + (pn < 21 ? WS_MO : WS_GAB); const int ld8 = pn < 21 ? 1024 : 2048, col8 = (pn < 21 ? (pn - 17) : (pn - 21)) * 256 + wc * 64 + 16 * fq; const int row0g = u.pm * 256 + wr * 64 + fr;
#pragma unroll
            for (int ai = 0; ai < 2; ++ai)
#pragma unroll
                for (int m = 0; m < 4; ++m) { const size_t row = (size_t)(row0g + ai * 128 + m * 16);
                    u32x4 w; w.x = pk4_sig_u8(acc[ai][0][m][0]); w.y = pk4_sig_u8(acc[ai][0][m][1]); w.z = pk4_sig_u8(acc[ai][1][m][0]); w.w = pk4_sig_u8(acc[ai][1][m][1]);
                    __builtin_nontemporal_store(w, (u32x4*)(b8 + row * ld8 + col8)); }
            return true; }
#endif
        const bool do_rope = (pn < 6) && (fq == 0);
        const int row0 = u.pm * 256 + wr * 64 + fr, col0 = colt + wc * 64 + 16 * fq;
#pragma unroll
        for (int ai = 0; ai < 2; ++ai) {
            f32x4 rc[4][4];
            if (do_rope) {
#pragma unroll
                for (int m = 0; m < 4; ++m) { const f32x4* rp = (const f32x4*)(rope + (size_t)(row0 + ai * 128 + m * 16) * 16); rc[m][0] = rp[0]; rc[m][1] = rp[1]; rc[m][2] = rp[2]; rc[m][3] = rp[3]; } }
#pragma unroll
            for (int m = 0; m < 4; ++m) {
                const size_t row = (size_t)(row0 + ai * 128 + m * 16);
                f32x4 a0 = acc[ai][0][m][0], a1 = acc[ai][0][m][1], b0 = acc[ai][1][m][0], b1 = acc[ai][1][m][1];
                if (do_rope) { const f32x4 c0 = rc[m][0], c1 = rc[m][1], s0 = rc[m][2], s1 = rc[m][3];
                    const f32x4 x0 = a0 * c0 - b0 * s0, x1 = a1 * c1 - b1 * s1, y0 = b0 * c0 + a0 * s0, y1 = b1 * c1 + a1 * s1; a0 = x0; a1 = x1; b0 = y0; b1 = y1; }
                u32x4 w0, w1; w0.x = g2::cvt_pk_bf16(a0[0], a0[1]); w0.y = g2::cvt_pk_bf16(a0[2], a0[3]); w0.z = g2::cvt_pk_bf16(a1[0], a1[1]); w0.w = g2::cvt_pk_bf16(a1[2], a1[3]);
                w1.x = g2::cvt_pk_bf16(b0[0], b0[1]); w1.y = g2::cvt_pk_bf16(b0[2], b0[3]); w1.z = g2::cvt_pk_bf16(b1[0], b1[1]); w1.w = g2::cvt_pk_bf16(b1[2], b1[3]);
                __builtin_nontemporal_store(w0, (u32x4*)(base + row * ld + col0)); if (nostore != 2) __builtin_nontemporal_store(w1, (u32x4*)(base + row * ld + col0 + 8));
            } }
        return true;
    }
};
__device__ __forceinline__ void ph_inproj_fast(Frame& F, int nostore = 0) {
#if STAGGER_NS > 0
    {
      const unsigned long long t0 = __builtin_amdgcn_s_memrealtime(); const unsigned long long dl = (unsigned long long)((blockIdx.x >> 3) & 15) * (STAGGER_NS / 10) / 16;
      while (__builtin_amdgcn_s_memrealtime() - t0 < dl) __builtin_amdgcn_s_sleep(4); }
#endif
#if INPROJ_FP8
    { g2::DenseOrder S; S.init(T, 30 * 256, D / 2, F.ws + WS_H8, F.ws + WS_WIN_T8, F.G, (int)blockIdx.x);
      EpiInproj E{F.ws, (const float*)(F.ws + WS_ROPE), nostore, F.in[I_BGATES]};
      g2::gemm_phase<EpiInproj, g2::DenseOrder, true>(F.lds, S, E, 127 - 5); }
#if !GATES_FP8
#if GATES_GEMM
    { g2::DenseOrder S; S.init(T, 1 * 256, D, F.outb + OUT_H, F.ws + WS_WIN_T, F.G, (int)blockIdx.x); S.pnoff = 29;
#else
    { g2::DenseOrder S; S.init(T, 4 * 256, D, F.outb + OUT_H, F.ws + WS_WIN_T, F.G, (int)blockIdx.x); S.pnoff = 9;
#endif
      EpiInproj E{F.ws, (const float*)(F.ws + WS_ROPE), nostore, F.in[I_BGATES]};
      g2::gemm_phase<EpiInproj, g2::DenseOrder>(F.lds, S, E); }
#endif
#else
    g2::DenseOrder S; S.init(T, 7424, D, F.outb + OUT_H, F.ws + WS_WIN_T, F.G, (int)blockIdx.x);
    EpiInproj E{F.ws, (const float*)(F.ws + WS_ROPE), nostore, F.in[I_BGATES]};
    g2::gemm_phase<EpiInproj, g2::DenseOrder>(F.lds, S, E);
#endif
}


__device__ __forceinline__ void unpack8(const u32x4 w, float (&o)[8]) {
#pragma unroll
    for (int e = 0; e < 4; ++e) { o[2 * e] = __uint_as_float(w[e] << 16); o[2 * e + 1] = __uint_as_float(w[e] & 0xffff0000u); }
}
struct UnitBr { int pm, pn, sub; };
struct BranchOrder {
    typedef UnitBr Unit;
    g2::DenseOrder d; const char *YA, *YB, *WA, *WB;
    __device__ __forceinline__ bool next(int i, Unit& u) const { g2::UnitMN t; if (!d.next(i >> 1, t)) return false; u.pm = t.pm; u.pn = t.pn; u.sub = i & 1; return true; }
    __device__ __forceinline__ int K(const Unit& u) const { return u.sub ? 1024 : 256; }
    __device__ __forceinline__ const char* a_base(const Unit& u) const { return u.sub ? YB : YA; }
    __device__ __forceinline__ unsigned a_row_off(const Unit& u, int r) const { return (unsigned)(u.pm * 256 + r) * (u.sub ? 2048u : 512u); }
    __device__ __forceinline__ const char* b_base(const Unit& u) const { return u.sub ? WB + (size_t)u.pn * 256 * 2048 : WA + (size_t)u.pn * 256 * 512; }
};
struct EpiBranch {
    static constexpr bool PERM = true;
    const bf16* GAB; bf16* MG;
    __device__ __forceinline__ bool operator()(f32x4 (&acc)[2][2][4][2], const UnitBr& u, int wr, int wc, int fr, int fq) const {
        const int row0 = u.pm * 256 + wr * 64 + fr, col0 = u.pn * 256 + wc * 64 + 16 * fq;
#pragma unroll
        for (int ai = 0; ai < 2; ++ai)
#pragma unroll
            for (int m = 0; m < 4; ++m) { const size_t row = (size_t)(row0 + ai * 128 + m * 16);
                u32x4 wout[2];
#if GATES_U8
                { const unsigned char* g8 = (const unsigned char*)GAB + row * 2048 + col0; const u32x4 gbq = *(const u32x4*)(g8 + 1024);
                  if (u.sub == 0) { const u32x4 gaq = *(const u32x4*)g8;
#pragma unroll
                      for (int bj = 0; bj < 2; ++bj)
#pragma unroll
                          for (int n = 0; n < 2; ++n) { const f32x4 sa = unpk4_sig_u8(gaq[2 * bj + n]), sb = unpk4_sig_u8(gbq[2 * bj + n]);
#pragma unroll
                              for (int e = 0; e < 4; ++e) acc[ai][bj][m][n][e] *= sa[e] * __builtin_amdgcn_rcpf(sb[e]); } }
                  else {
#pragma unroll
                      for (int bj = 0; bj < 2; ++bj) { const f32x4 s0 = unpk4_sig_u8(gbq[2 * bj]), s1 = unpk4_sig_u8(gbq[2 * bj + 1]); const f32x4 v0 = acc[ai][bj][m][0] * s0, v1 = acc[ai][bj][m][1] * s1;
                          wout[bj].x = g2::cvt_pk_bf16(v0[0], v0[1]); wout[bj].y = g2::cvt_pk_bf16(v0[2], v0[3]); wout[bj].z = g2::cvt_pk_bf16(v1[0], v1[1]); wout[bj].w = g2::cvt_pk_bf16(v1[2], v1[3]); } } }
#else
#pragma unroll
                for (int bj = 0; bj < 2; ++bj) { const int col = col0 + 8 * bj;
                    float gb[8]; unpack8(*(const u32x4*)(GAB + row * 2048 + 1024 + col), gb);
                    if (u.sub == 0) { float ga[8]; unpack8(*(const u32x4*)(GAB + row * 2048 + col), ga);
#pragma unroll
                        for (int e = 0; e < 4; ++e) { acc[ai][bj][m][0][e] *= fsig(ga[e]) * (1.0f + __builtin_amdgcn_exp2f(-1.4426950408889634f * gb[e]));
                                                      acc[ai][bj][m][1][e] *= fsig(ga[4 + e]) * (1.0f + __builtin_amdgcn_exp2f(-1.4426950408889634f * gb[4 + e])); } }
                    else { f32x4 v0, v1;
#pragma unroll
                        for (int e = 0; e < 4; ++e) { v0[e] = acc[ai][bj][m][0][e] * fsig(gb[e]); v1[e] = acc[ai][bj][m][1][e] * fsig(gb[4 + e]); }
                        wout[bj].x = g2::cvt_pk_bf16(v0[0], v0[1]); wout[bj].y = g2::cvt_pk_bf16(v0[2], v0[3]); wout[bj].z = g2::cvt_pk_bf16(v1[0], v1[1]); wout[bj].w = g2::cvt_pk_bf16(v1[2], v1[3]); } }
#endif
                if (u.sub != 0) { *(u32x4*)(MG + row * 1024 + col0) = wout[0]; *(u32x4*)(MG + row * 1024 + col0 + 8) = wout[1]; } }
        return u.sub != 0;
    }
};
__device__ __forceinline__ void ph_branch_fast(Frame& F) {
    BranchOrder S; S.d.init(T, 1024, 1024, nullptr, nullptr, F.G, (int)blockIdx.x);
    S.YA = (const char*)(F.outb + OUT_YA); S.YB = (const char*)(F.outb + OUT_YB); S.WA = (const char*)(F.ws + WS_WBA_T); S.WB = (const char*)(F.ws + WS_WBB_T);
    EpiBranch E{(const bf16*)(F.ws + WS_GAB), (bf16*)(F.ws + WS_MERGED)};
    g2::gemm_phase<EpiBranch, BranchOrder>(F.lds, S, E);
}
struct EpiBf16Plain {
    static constexpr bool PERM = true;
    bf16* O; int ld;
    __device__ __forceinline__ bool operator()(const f32x4 (&acc)[2][2][4][2], const g2::UnitMN& u, int wr, int wc, int fr, int fq) const {
        const int row0 = u.pm * 256 + wr * 64 + fr, col0 = u.pn * 256 + wc * 64 + 16 * fq;
#pragma unroll
        for (int ai = 0; ai < 2; ++ai)
#pragma unroll
            for (int m = 0; m < 4; ++m) { bf16* rp = O + (size_t)(row0 + ai * 128 + m * 16) * ld + col0;
#pragma unroll
                for (int bj = 0; bj < 2; ++bj) { const f32x4 v0 = acc[ai][bj][m][0], v1 = acc[ai][bj][m][1];
                    u32x4 w; w.x = g2::cvt_pk_bf16(v0[0], v0[1]); w.y = g2::cvt_pk_bf16(v0[2], v0[3]); w.z = g2::cvt_pk_bf16(v1[0], v1[1]); w.w = g2::cvt_pk_bf16(v1[2], v1[3]);
                    *(u32x4*)(rp + bj * 8) = w; } }
        return true;
    }
};
struct EpiF32Plain {
    static constexpr bool PERM = false;
    float* O; int ld;
    __device__ __forceinline__ bool operator()(const f32x4 (&acc)[2][2][4][2], const g2::UnitMN& u, int wr, int wc, int fr, int fq) const {
        const int row0 = u.pm * 256 + wr * 64 + fr, col0 = u.pn * 256 + wc * 32 + 4 * fq;
#pragma unroll
        for (int ai = 0; ai < 2; ++ai)
#pragma unroll
            for (int m = 0; m < 4; ++m) { float* rp = O + (size_t)(row0 + ai * 128 + m * 16) * ld + col0;
#pragma unroll
                for (int bj = 0; bj < 2; ++bj)
#pragma unroll
                    for (int n = 0; n < 2; ++n) *(f32x4*)(rp + bj * 128 + n * 16) = acc[ai][bj][m][n]; }
        return true;
    }
};
__device__ __forceinline__ void ph_outproj_fast(Frame& F) {
    g2::DenseOrder S; S.init(T, 1024, 1024, F.ws + WS_MERGED, F.ws + WS_WOUT_T, F.G, (int)blockIdx.x);
    EpiBf16Plain E{(bf16*)(F.ws + WS_YMIX), 1024};
    g2::gemm_phase<EpiBf16Plain, g2::DenseOrder>(F.lds, S, E);
}
__device__ __forceinline__ void ph_router_fast(Frame& F);
template <class BlockIter> __device__ __forceinline__ void ph_topk4(Frame& F, const BlockIter& BI);
__device__ __forceinline__ void ph_router_fast(Frame& F) {
    g2::DenseOrder S; S.init(T, 256, 1024, F.ws + WS_H2, F.ws + WS_WR_T, F.G, (int)blockIdx.x);
    EpiF32Plain E{(float*)(F.ws + WS_LOGITS), 256};
    g2::gemm_phase<EpiF32Plain, g2::DenseOrder>(F.lds, S, E);
}
__device__ __forceinline__ void ph_cvt_experts(Frame& F) {
    LAS float* scr = (LAS float*)(F.lds) + F.wave * (64 * 33);
    const int gw = blockIdx.x * NWAVES + F.wave, NGW = F.G * NWAVES;
    for (int it = gw; it < NE * 384; it += NGW) {
        const int e = it / 384, r = it % 384;
        if (r < 256) { const int kb = r >> 4, nb = r & 15, d0 = nb * 32, pn = d0 >> 8, q = d0 & 255; const bool up = q >= 128; const int src = pn * 128 + (q & 127);
            tr_item((up ? F.in[I_WEU] : F.in[I_WEG]) + (size_t)e * 1024 * 256, 256, kb * 64, src, (bf16*)(F.ws + WS_WGU) + (size_t)e * 512 * 1024, 1024, d0, scr, F.lane); }
        else { const int q = r - 256, kb = q >> 5, nb = q & 31;
            tr_item(F.in[I_WED] + (size_t)e * 256 * 1024, 1024, kb * 64, nb * 32, (bf16*)(F.ws + WS_WD) + (size_t)e * 1024 * 256, 256, nb * 32, scr, F.lane); }
    }
}

constexpr int CVT_BATCH = 128, CVT_NBATCH = (NE + 1) * 384 / CVT_BATCH;
struct CvtD { const float* Wq; int ldw, k0; unsigned char* WT; int Kd, drow0; float sc; };
__device__ __forceinline__ CvtD cvt_desc(Frame& F, int it) {
    CvtD d; const int e = it / 384, r = it % 384; const bool sh = e == NE;
    if (r < 256) { const int kb = r >> 4, nb = r & 15, d0 = nb * 32, pn = d0 >> 8;
        const int cc = (d0 & 255) + 4 * (F.lane & 7); const bool up = (cc >> 3) & 1; const int col = pn * 128 + 8 * (cc >> 4) + (cc & 7);
        const float* pg = sh ? F.in[I_WSG] : F.in[I_WEG] + (size_t)e * 1024 * 256; const float* pu = sh ? F.in[I_WSU] : F.in[I_WEU] + (size_t)e * 1024 * 256;
        d.Wq = (up ? pu : pg) + col; d.ldw = 256; d.k0 = kb * 64; d.WT = sh ? F.ws + WS_WSGU8 : F.ws + WS_WGU8 + (size_t)e * 512 * 1024; d.Kd = 1024; d.drow0 = d0; d.sc = 32.0f; }
    else { const int q = r - 256, kb = q >> 5, nb = q & 31;
        const float* W = sh ? F.in[I_WSD] : F.in[I_WED] + (size_t)e * 256 * 1024;
        d.Wq = W + nb * 32 + 4 * (F.lane & 7); d.ldw = 1024; d.k0 = kb * 64; d.WT = sh ? F.ws + WS_WSD8 : F.ws + WS_WD8 + (size_t)e * 1024 * 256; d.Kd = 256; d.drow0 = nb * 32; d.sc = 16.0f; }
    return d;
}
struct CvtR { f32x4 v[8]; };
__device__ __forceinline__ void cvt_load(const CvtD& d, CvtR& R, int lane) {
    const int kg = lane >> 3;
#pragma unroll
    for (int i = 0; i < 8; ++i) R.v[i] = *(const f32x4*)(d.Wq + (size_t)(d.k0 + kg + 8 * i) * d.ldw);
}
__device__ __forceinline__ void cvt_store(const CvtD& d, const CvtR& R, LAS float* scr, int lane) {
    const int kg = lane >> 3, q4 = (lane & 7) * 4;
#pragma unroll
    for (int i = 0; i < 8; ++i) { const f32x4 v = R.v[i] * d.sc; LAS float* p = scr + (kg + 8 * i) * 33 + q4; p[0] = v[0]; p[1] = v[1]; p[2] = v[2]; p[3] = v[3]; }
    asm volatile("s_waitcnt lgkmcnt(0)" ::: "memory");
    const int c = lane & 7;
#pragma unroll
    for (int j = 0; j < 4; ++j) { const int n = (lane >> 3) + 8 * j; const LAS float* sp = scr + (8 * c) * 33 + n;
        u32x2 o; o.x = pk4_fp8(sp[0 * 33], sp[1 * 33], sp[2 * 33], sp[3 * 33]); o.y = pk4_fp8(sp[4 * 33], sp[5 * 33], sp[6 * 33], sp[7 * 33]);
        *(u32x2*)(d.WT + (size_t)(d.drow0 + n) * d.Kd + d.k0 + 8 * c) = o; }
    asm volatile("s_waitcnt lgkmcnt(0)" ::: "memory");
}
__device__ __forceinline__ void cvt_experts8_batch(Frame& F, int batch) {
    LAS float* scr = (LAS float*)(F.lds) + F.wave * (64 * 33);
    const int it0 = batch * CVT_BATCH + F.wave;
    CvtD d = cvt_desc(F, it0); CvtR R; cvt_load(d, R, F.lane);
#pragma unroll 1
    for (int k = 0; k < CVT_BATCH / NWAVES; ++k) {
        const CvtD dc = d; const CvtR Rc = R;
        if (k + 1 < CVT_BATCH / NWAVES) { d = cvt_desc(F, it0 + NWAVES * (k + 1)); cvt_load(d, R, F.lane); }
        cvt_store(dc, Rc, scr, F.lane);
    }
}
struct UnitEx { int u, sub, e; };
struct GuOrder {
    typedef UnitEx Unit;
    int NT, nun, G, vcu; const int* UNITEXP; const int* ROWTOK; const char *H2, *WGU, *WSGU;
    __device__ __forceinline__ bool next(int i, Unit& x) const { const int L = i * G + vcu; if (L >= nun) return false; x.u = L >> 1; x.sub = L & 1; x.e = x.u < NT ? UNITEXP[x.u] : -1; return true; }
    __device__ __forceinline__ int K(const Unit&) const { return 1024; }
    __device__ __forceinline__ const char* a_base(const Unit&) const { return H2; }
    __device__ __forceinline__ unsigned a_row_off(const Unit& x, int r) const { return (unsigned)ROWTOK[(unsigned)(x.u * 256 + r)] * 2048u; }
    __device__ __forceinline__ const char* b_base(const Unit& x) const { return (x.e >= 0 ? WGU + (size_t)x.e * (512 * 1024 * 2) : WSGU) + (size_t)x.sub * (256 * 1024 * 2); }
};
struct EpiGu {
    static constexpr bool PERM = true;
    int NT; bf16 *HIDR, *HIDS;
    __device__ __forceinline__ bool operator()(const f32x4 (&acc)[2][2][4][2], const UnitEx& x, int wr, int wc, int fr, int fq) const {
        bf16* base = x.e >= 0 ? HIDR + (size_t)x.u * 256 * 256 : HIDS + (size_t)(x.u - NT) * 256 * 256;
        const int row0 = wr * 64 + fr, col0 = x.sub * 128 + wc * 32 + 8 * fq;
#pragma unroll
        for (int ai = 0; ai < 2; ++ai)
#pragma unroll
            for (int m = 0; m < 4; ++m) { const f32x4 g0 = acc[ai][0][m][0], g1 = acc[ai][0][m][1], u0 = acc[ai][1][m][0], u1 = acc[ai][1][m][1]; f32x4 h0, h1;
#pragma unroll
                for (int e = 0; e < 4; ++e) { h0[e] = g0[e] * fsig(g0[e]) * u0[e]; h1[e] = g1[e] * fsig(g1[e]) * u1[e]; }
                u32x4 w; w.x = g2::cvt_pk_bf16(h0[0], h0[1]); w.y = g2::cvt_pk_bf16(h0[2], h0[3]); w.z = g2::cvt_pk_bf16(h1[0], h1[1]); w.w = g2::cvt_pk_bf16(h1[2], h1[3]);
                *(u32x4*)(base + (size_t)(row0 + ai * 128 + m * 16) * 256 + col0) = w; asm volatile("" ::: "memory"); }
        return true;
    }
};
struct DownOrder {
    typedef UnitEx Unit;
    int NT, nun, G, vcu; const int* UNITEXP; const char *HIDR, *HIDS, *WD, *WSD;
    __device__ __forceinline__ bool next(int i, Unit& x) const { const int L = i * G + vcu; if (L >= nun) return false; x.u = L >> 2; x.sub = L & 3; x.e = x.u < NT ? UNITEXP[x.u] : -1; return true; }
    __device__ __forceinline__ int K(const Unit&) const { return 256; }
    __device__ __forceinline__ const char* a_base(const Unit& x) const { return x.e >= 0 ? HIDR : HIDS; }
    __device__ __forceinline__ unsigned a_row_off(const Unit& x, int r) const { return (unsigned)((x.e >= 0 ? x.u : x.u - NT) * 256 + r) * 512u; }
    __device__ __forceinline__ const char* b_base(const Unit& x) const { return (x.e >= 0 ? WD + (size_t)x.e * (1024 * 256 * 2) : WSD) + (size_t)x.sub * (256 * 256 * 2); }
};
struct EpiDown {
    static constexpr bool PERM = false;
    const int* ROWTOK; const float* ROWW; float* out;
    __device__ __forceinline__ bool operator()(const f32x4 (&acc)[2][2][4][2], const UnitEx& x, int wr, int wc, int fr, int fq) const {
        const int row0 = x.u * 256 + wr * 64 + fr; const unsigned col0 = (unsigned)(x.sub * 256 + wc * 32 + 4 * fq);
#pragma unroll
        for (int ai = 0; ai < 2; ++ai)
#pragma unroll
            for (int m = 0; m < 4; ++m) { const int r = row0 + ai * 128 + m * 16; const unsigned tok = (unsigned)ROWTOK[r]; const float w = ROWW[r];
                const unsigned off = tok * 1024u + col0;
#pragma unroll
                for (int bj = 0; bj < 2; ++bj)
#pragma unroll
                    for (int n = 0; n < 2; ++n)
#pragma unroll
                        for (int e = 0; e < 4; ++e) unsafeAtomicAdd(out + (off + (unsigned)(bj * 128 + n * 16 + e)), acc[ai][bj][m][n][e] * w);
                asm volatile("" ::: "memory"); }
        return true;
    }
};
__device__ __forceinline__ void ph_gu_fast(Frame& F) {
    const int NT = (int)__hip_atomic_load(F.ctl + CW_NT, __ATOMIC_RELAXED, __HIP_MEMORY_SCOPE_AGENT);
    const int bx = blockIdx.x; const int vcu = (F.G % 8 == 0) ? (bx % 8) * (F.G / 8) + bx / 8 : bx;
    GuOrder S{NT, 2 * (NT + T / 256), F.G, vcu, (const int*)(F.ws + WS_UNITEXP), (const int*)(F.ws + WS_ROWTOK), (const char*)(F.ws + WS_H2), (const char*)(F.ws + WS_WGU), (const char*)(F.ws + WS_WSGU_T)};
    EpiGu E{NT, (bf16*)(F.ws + WS_HIDR), (bf16*)(F.ws + WS_HIDS)};
    g2::gemm_phase<EpiGu, GuOrder>(F.lds, S, E);
}
__device__ __forceinline__ void ph_down_fast(Frame& F) {
    const int NT = (int)__hip_atomic_load(F.ctl + CW_NT, __ATOMIC_RELAXED, __HIP_MEMORY_SCOPE_AGENT);
    const int bx = blockIdx.x; const int vcu = (F.G % 8 == 0) ? (bx % 8) * (F.G / 8) + bx / 8 : bx;
    DownOrder S{NT, 4 * (NT + T / 256), F.G, vcu, (const int*)(F.ws + WS_UNITEXP), (const char*)(F.ws + WS_HIDR), (const char*)(F.ws + WS_HIDS), (const char*)(F.ws + WS_WD), (const char*)(F.ws + WS_WSD_T)};
    EpiDown E{(const int*)(F.ws + WS_ROWTOK), (const float*)(F.ws + WS_ROWW), F.out};
    g2::gemm_phase<EpiDown, DownOrder>(F.lds, S, E);
}


__device__ __forceinline__ void ph_rope_naive(Frame& F) {
    bf16* Q = (bf16*)(F.ws + WS_Q); bf16* Kt = (bf16*)(F.ws + WS_K);
    for (int t = blockIdx.x * NWAVES + F.wave; t < T; t += F.G * NWAVES) {
        const float p = (float)F.pos[t];
#pragma unroll
        for (int r = 0; r < 3; ++r) {
            const int it = r * 64 + F.lane;
            const int i = it & 7, head = (it >> 3) % 12, qk = it / 96;
            const float inv = powf(500000.0f, -(float)i / 8.0f);
            const float ang = p * inv; const float cs = cosf(ang), sn = sinf(ang);
            bf16* base = (qk ? Kt : Q) + (size_t)t * 768 + head * 64;
            const float x1 = bf2f(base[i]), x2 = bf2f(base[i + 8]);
            base[i] = (bf16)f2bf(x1 * cs - x2 * sn); base[i + 8] = (bf16)f2bf(x2 * cs + x1 * sn);
        }
    }
}

__device__ __forceinline__ void ph_attn_naive_block(Frame& F, int vb) {
    const bf16* Q = (const bf16*)(F.ws + WS_Q); const bf16* Kt = (const bf16*)(F.ws + WS_K); const bf16* V = (const bf16*)(F.ws + WS_V);
    bf16* YA = (bf16*)(F.outb + OUT_YA);
    const int item = vb * NTHR + F.tid; const int t = item >> 2, j = item & 3; const int b = t / SEQ, s = t % SEQ;
    float acc[64];
#pragma unroll
    for (int d = 0; d < 64; ++d) acc[d] = 0.f;
    float m = -INFINITY, l = 0.f;
    for (int g = 0; g < 3; ++g) {
        const int dil = (g == 0) ? 1 : (g == 1) ? 4 : 16; const int head = g * 4 + j;
        float q[64];
        { const u32x4* qp = (const u32x4*)(Q + (size_t)t * 768 + head * 64);
#pragma unroll
          for (int c = 0; c < 8; ++c) { const u32x4 w = qp[c];
#pragma unroll
              for (int e = 0; e < 4; ++e) { q[c * 8 + 2 * e] = __uint_as_float(w[e] << 16) * 0.125f; q[c * 8 + 2 * e + 1] = __uint_as_float(w[e] & 0xffff0000u) * 0.125f; } } }
        const int lq = s / dil; const int nk = (lq < 128 ? lq : 128) + 1;
        for (int jj = 0; jj < nk; ++jj) {
            const size_t tk = (size_t)b * SEQ + (s - jj * dil);
            const u32x4* kp = (const u32x4*)(Kt + tk * 768 + head * 64);
            float dot = 0.f;
#pragma unroll
            for (int c = 0; c < 8; ++c) { const u32x4 w = kp[c];
#pragma unroll
                for (int e = 0; e < 4; ++e) { dot += q[c * 8 + 2 * e] * __uint_as_float(w[e] << 16); dot += q[c * 8 + 2 * e + 1] * __uint_as_float(w[e] & 0xffff0000u); } }
            const float mn = fmaxf(m, dot); const float corr = expf(m - mn), p = expf(dot - mn);
            l = l * corr + p; m = mn;
            const u32x4* vp = (const u32x4*)(V + tk * 768 + head * 64);
#pragma unroll
            for (int c = 0; c < 8; ++c) { const u32x4 w = vp[c];
#pragma unroll
                for (int e = 0; e < 4; ++e) { acc[c * 8 + 2 * e] = acc[c * 8 + 2 * e] * corr + p * __uint_as_float(w[e] << 16); acc[c * 8 + 2 * e + 1] = acc[c * 8 + 2 * e + 1] * corr + p * __uint_as_float(w[e] & 0xffff0000u); } }
        }
    }
    const float rl = 1.0f / l;
    u32x4* op = (u32x4*)(YA + (size_t)t * 256 + j * 64);
#pragma unroll
    for (int c = 0; c < 8; ++c) { u32x4 w;
#pragma unroll
        for (int e = 0; e < 4; ++e) w[e] = pk2(acc[c * 8 + 2 * e] * rl, acc[c * 8 + 2 * e + 1] * rl);
        op[c] = w; }
}


typedef short v4i16_t __attribute__((ext_vector_type(4)));
typedef short bf16x8_t __attribute__((ext_vector_type(8)));
constexpr int ATT_RS = 144;
constexpr int ATT_ROWS = 272;
constexpr int ATT_UNITS = 48 * 128;
__device__ __forceinline__ void attn_unit_fast(Frame& F, int uidx) {
    const int bj = uidx / 48, r48 = uidx % 48, b = bj >> 2, j = bj & 3, g = r48 >> 4, q16 = r48 & 15;
    const int dil = (g == 0) ? 1 : (g == 1) ? 4 : 16;
    const int rho = (g == 0) ? 0 : (g == 1) ? (q16 >> 2) : q16, n = (g == 0) ? q16 : (g == 1) ? (q16 & 3) : 0;
    const int head = g * 4 + j;
    const bf16* Q = (const bf16*)(F.ws + WS_Q); const bf16* Kg = (const bf16*)(F.ws + WS_K); const bf16* Vg = (const bf16*)(F.ws + WS_V);
    bf16* OG = (bf16*)(F.outb + OUT_OG) + (size_t)g * T * 256; float* LSE = (float*)(F.ws + WS_LSE) + (size_t)g * T * 4;
    LAS unsigned char* Kt = F.lds; LAS unsigned char* Vt = F.lds + ATT_ROWS * ATT_RS;
    const int tid = F.tid, lane = F.lane, w = F.wave, ql = lane & 15, g4 = lane >> 4;
    __syncthreads();
#pragma unroll
    for (int i = 0; i < 4; ++i) { const int p = tid + NTHR * i, row = p >> 3, c = p & 7; const int lk = (n - 1) * 128 + row;
        u32x4 kv = (u32x4){0u, 0u, 0u, 0u}, vv = kv;
        if (lk >= 0) { const size_t off = ((size_t)b * SEQ + (size_t)lk * dil + rho) * 768 + head * 64 + c * 8; kv = *(const u32x4*)(Kg + off); vv = *(const u32x4*)(Vg + off); }
        *(LAS u32x4*)(Kt + row * ATT_RS + c * 16) = kv; *(LAS u32x4*)(Vt + row * ATT_RS + c * 16) = vv; }
    if (tid < 128) { const int row = 256 + (tid >> 3), c = tid & 7; *(LAS u32x4*)(Kt + row * ATT_RS + c * 16) = (u32x4){0u, 0u, 0u, 0u}; *(LAS u32x4*)(Vt + row * ATT_RS + c * 16) = (u32x4){0u, 0u, 0u, 0u}; }
    const int qi = 16 * w + ql; const size_t tq = (size_t)b * SEQ + (size_t)(n * 128 + qi) * dil + rho;
    bf16x8_t Qf[2];
#pragma unroll
    for (int ks = 0; ks < 2; ++ks) Qf[ks] = *(const bf16x8_t*)(Q + tq * 768 + head * 64 + 32 * ks + 8 * g4);
    __syncthreads();
    f32x4 O[4];
#pragma unroll
    for (int dt = 0; dt < 4; ++dt) O[dt] = (f32x4){0.f, 0.f, 0.f, 0.f};
    float m = -INFINITY, lsum = 0.f;
    const float SC = 0.125f * 1.4426950408889634f;
    const int qq = ql >> 2, pp4 = ql & 3;
#pragma unroll 1
    for (int pp = 4; pp >= 0; --pp) {
        const int t0 = w + 2 * pp, t1 = t0 + 1;
        f32x4 S0 = (f32x4){0.f, 0.f, 0.f, 0.f}, S1 = S0;
#pragma unroll
        for (int ks = 0; ks < 2; ++ks) {
            const bf16x8_t k0 = *(const LAS bf16x8_t*)(Kt + (16 * t0 + ql) * ATT_RS + (32 * ks + 8 * g4) * 2);
            const bf16x8_t k1 = *(const LAS bf16x8_t*)(Kt + (16 * t1 + ql) * ATT_RS + (32 * ks + 8 * g4) * 2);
            S0 = __builtin_amdgcn_mfma_f32_16x16x32_bf16(k0, Qf[ks], S0, 0, 0, 0);
            S1 = __builtin_amdgcn_mfma_f32_16x16x32_bf16(k1, Qf[ks], S1, 0, 0, 0);
        }
        float tmax = -INFINITY;
#pragma unroll
        for (int r = 0; r < 4; ++r) {
            const int k0i = 16 * t0 + 4 * g4 + r, k1i = k0i + 16;
            const bool v0 = (k0i >= qi) && (k0i <= qi + 128) && (n > 0 || k0i >= 128), v1 = (k1i >= qi) && (k1i <= qi + 128) && (n > 0 || k1i >= 128);
            S0[r] = v0 ? S0[r] * SC : -INFINITY; S1[r] = v1 ? S1[r] * SC : -INFINITY;
            tmax = fmaxf(tmax, fmaxf(S0[r], S1[r]));
        }
        tmax = fmaxf(tmax, __shfl_xor(tmax, 16)); tmax = fmaxf(tmax, __shfl_xor(tmax, 32));
        const float mn = fmaxf(m, tmax);
        const float corr = __builtin_amdgcn_exp2f(m - mn); m = mn;
        float ps = 0.f; float p0[4], p1[4];
#pragma unroll
        for (int r = 0; r < 4; ++r) { p0[r] = __builtin_amdgcn_exp2f(S0[r] - mn); p1[r] = __builtin_amdgcn_exp2f(S1[r] - mn); ps += p0[r] + p1[r]; }
        lsum = lsum * corr + ps;
        u32x4 pk; pk.x = g2::cvt_pk_bf16(p0[0], p0[1]); pk.y = g2::cvt_pk_bf16(p0[2], p0[3]); pk.z = g2::cvt_pk_bf16(p1[0], p1[1]); pk.w = g2::cvt_pk_bf16(p1[2], p1[3]);
        const bf16x8_t Pf = __builtin_bit_cast(bf16x8_t, pk);
#pragma unroll
        for (int dt = 0; dt < 4; ++dt) {
            O[dt] = O[dt] * corr;
            const v4i16_t lo = __builtin_amdgcn_ds_read_tr16_b64_v4i16((LAS v4i16_t*)(Vt + (16 * t0 + 4 * g4 + qq) * ATT_RS + (16 * dt + 4 * pp4) * 2));
            const v4i16_t hi = __builtin_amdgcn_ds_read_tr16_b64_v4i16((LAS v4i16_t*)(Vt + (16 * t1 + 4 * g4 + qq) * ATT_RS + (16 * dt + 4 * pp4) * 2));
            const bf16x8_t Vf = __builtin_shufflevector(lo, hi, 0, 1, 2, 3, 4, 5, 6, 7);
            O[dt] = __builtin_amdgcn_mfma_f32_16x16x32_bf16(Vf, Pf, O[dt], 0, 0, 0);
        }
    }
    lsum += __shfl_xor(lsum, 16); lsum += __shfl_xor(lsum, 32);
    const float rl = 1.0f / lsum;
#pragma unroll
    for (int dt = 0; dt < 4; ++dt) { u32x2 o; o.x = g2::cvt_pk_bf16(O[dt][0] * rl, O[dt][1] * rl); o.y = g2::cvt_pk_bf16(O[dt][2] * rl, O[dt][3] * rl);
        *(u32x2*)(OG + tq * 256 + j * 64 + 16 * dt + 4 * g4) = o; }
    if (g4 == 0) LSE[tq * 4 + j] = m + __builtin_amdgcn_logf(lsum);
}
struct AttU { int b, j, g, dil, rho, n, head; };
__device__ __forceinline__ AttU att_unit(int uidx) { AttU u; const int bj = uidx / 48, r48 = uidx % 48; u.b = bj >> 2; u.j = bj & 3; u.g = r48 >> 4; const int q16 = r48 & 15;
    u.dil = (u.g == 0) ? 1 : (u.g == 1) ? 4 : 16; u.rho = (u.g == 0) ? 0 : (u.g == 1) ? (q16 >> 2) : q16; u.n = (u.g == 0) ? q16 : (u.g == 1) ? (q16 & 3) : 0; u.head = u.g * 4 + u.j; return u; }
struct AttR { u32x4 kv[4], vv[4]; bf16x8_t q[2]; };
__device__ __forceinline__ void att_load(Frame& F, const AttU& u, AttR& R) {
    const bf16* Q = (const bf16*)(F.ws + WS_Q); const bf16* Kg = (const bf16*)(F.ws + WS_K); const bf16* Vg = (const bf16*)(F.ws + WS_V);
#pragma unroll
    for (int i = 0; i < 4; ++i) { const int p = F.tid + NTHR * i, row = p >> 3, c = p & 7; const int lk = (u.n - 1) * 128 + row;
        R.kv[i] = (u32x4){0u, 0u, 0u, 0u}; R.vv[i] = R.kv[i];
        if (lk >= 0) { const size_t off = ((size_t)u.b * SEQ + (size_t)lk * u.dil + u.rho) * 768 + u.head * 64 + c * 8; R.kv[i] = *(const u32x4*)(Kg + off); R.vv[i] = *(const u32x4*)(Vg + off); } }
    const int qi = 16 * F.wave + (F.lane & 15), g4 = F.lane >> 4; const size_t tq = (size_t)u.b * SEQ + (size_t)(u.n * 128 + qi) * u.dil + u.rho;
#pragma unroll
    for (int ks = 0; ks < 2; ++ks) R.q[ks] = *(const bf16x8_t*)(Q + tq * 768 + u.head * 64 + 32 * ks + 8 * g4);
}
#define ATT_GLOBAL(q) ((((q) / 48) * 8 + xq) * 48 + (q) % 48)
__device__ __forceinline__ void attn_queue_run(Frame& F, unsigned* qc0, volatile LAS unsigned* MISC) {
    const int xq = (int)(blockIdx.x & 7u); unsigned* qc = qc0 + 16 * xq; constexpr int NLOC = ATT_UNITS / 8;
    LAS unsigned char* Kt = F.lds; LAS unsigned char* Vt = F.lds + ATT_ROWS * ATT_RS;
    unsigned nxt = 0u;
    __syncthreads();
    if (F.tid == 0) MISC[0] = atomicAdd(qc, 1u);
    __syncthreads();
    int uidx = (int)MISC[0];
    if (uidx >= NLOC) return;
    uidx = ATT_GLOBAL(uidx);
    if (F.tid == 0) nxt = atomicAdd(qc, 1u);
    AttR R; AttU u = att_unit(uidx); att_load(F, u, R);
    for (;;) {
        const int tid = F.tid, lane = F.lane, w = F.wave, ql = lane & 15, g4 = lane >> 4;
        const int b = u.b, j = u.j, g = u.g, dil = u.dil, rho = u.rho, n = u.n;
        bf16* OG = (bf16*)(F.outb + OUT_OG) + (size_t)g * T * 256; float* LSE = (float*)(F.ws + WS_LSE) + (size_t)g * T * 4;
        __syncthreads();
#pragma unroll
        for (int i = 0; i < 4; ++i) { const int p = tid + NTHR * i, row = p >> 3, c = p & 7; *(LAS u32x4*)(Kt + row * ATT_RS + c * 16) = R.kv[i]; *(LAS u32x4*)(Vt + row * ATT_RS + c * 16) = R.vv[i]; }
        if (tid < 128) { const int row = 256 + (tid >> 3), c = tid & 7; *(LAS u32x4*)(Kt + row * ATT_RS + c * 16) = (u32x4){0u, 0u, 0u, 0u}; *(LAS u32x4*)(Vt + row * ATT_RS + c * 16) = (u32x4){0u, 0u, 0u, 0u}; }
        bf16x8_t Qf[2]; Qf[0] = R.q[0]; Qf[1] = R.q[1];
        if (tid == 0) MISC[0] = nxt;
        __syncthreads();
        const int unl = (int)MISC[0]; const bool more = unl < NLOC; const int un = ATT_GLOBAL(unl);
        AttU u2 = u;
        if (more) { if (tid == 0) nxt = atomicAdd(qc, 1u); u2 = att_unit(un); att_load(F, u2, R); }
        const int qi = 16 * w + ql; const size_t tq = (size_t)b * SEQ + (size_t)(n * 128 + qi) * dil + rho;
    f32x4 O[4];
#pragma unroll
    for (int dt = 0; dt < 4; ++dt) O[dt] = (f32x4){0.f, 0.f, 0.f, 0.f};
    float m = -INFINITY, lsum = 0.f;
    const float SC = 0.125f * 1.4426950408889634f;
    const int qq = ql >> 2, pp4 = ql & 3;
#pragma unroll 1
    for (int pp = 4; pp >= 0; --pp) {
        const int t0 = w + 2 * pp, t1 = t0 + 1;
        f32x4 S0 = (f32x4){0.f, 0.f, 0.f, 0.f}, S1 = S0;
#pragma unroll
        for (int ks = 0; ks < 2; ++ks) {
            const bf16x8_t k0 = *(const LAS bf16x8_t*)(Kt + (16 * t0 + ql) * ATT_RS + (32 * ks + 8 * g4) * 2);
            const bf16x8_t k1 = *(const LAS bf16x8_t*)(Kt + (16 * t1 + ql) * ATT_RS + (32 * ks + 8 * g4) * 2);
            S0 = __builtin_amdgcn_mfma_f32_16x16x32_bf16(k0, Qf[ks], S0, 0, 0, 0);
            S1 = __builtin_amdgcn_mfma_f32_16x16x32_bf16(k1, Qf[ks], S1, 0, 0, 0);
        }
        float tmax = -INFINITY;
#pragma unroll
        for (int r = 0; r < 4; ++r) {
            const int k0i = 16 * t0 + 4 * g4 + r, k1i = k0i + 16;
            const bool v0 = (k0i >= qi) && (k0i <= qi + 128) && (n > 0 || k0i >= 128), v1 = (k1i >= qi) && (k1i <= qi + 128) && (n > 0 || k1i >= 128);
            S0[r] = v0 ? S0[r] * SC : -INFINITY; S1[r] = v1 ? S1[r] * SC : -INFINITY;
            tmax = fmaxf(tmax, fmaxf(S0[r], S1[r]));
        }
        tmax = fmaxf(tmax, __shfl_xor(tmax, 16)); tmax = fmaxf(tmax, __shfl_xor(tmax, 32));
        const float mn = fmaxf(m, tmax);
        const float corr = __builtin_amdgcn_exp2f(m - mn); m = mn;
        float ps = 0.f; float p0[4], p1[4];
#pragma unroll
        for (int r = 0; r < 4; ++r) { p0[r] = __builtin_amdgcn_exp2f(S0[r] - mn); p1[r] = __builtin_amdgcn_exp2f(S1[r] - mn); ps += p0[r] + p1[r]; }
        lsum = lsum * corr + ps;
        u32x4 pk; pk.x = g2::cvt_pk_bf16(p0[0], p0[1]); pk.y = g2::cvt_pk_bf16(p0[2], p0[3]); pk.z = g2::cvt_pk_bf16(p1[0], p1[1]); pk.w = g2::cvt_pk_bf16(p1[2], p1[3]);
        const bf16x8_t Pf = __builtin_bit_cast(bf16x8_t, pk);
#pragma unroll
        for (int dt = 0; dt < 4; ++dt) {
            O[dt] = O[dt] * corr;
            const v4i16_t lo = __builtin_amdgcn_ds_read_tr16_b64_v4i16((LAS v4i16_t*)(Vt + (16 * t0 + 4 * g4 + qq) * ATT_RS + (16 * dt + 4 * pp4) * 2));
            const v4i16_t hi = __builtin_amdgcn_ds_read_tr16_b64_v4i16((LAS v4i16_t*)(Vt + (16 * t1 + 4 * g4 + qq) * ATT_RS + (16 * dt + 4 * pp4) * 2));
            const bf16x8_t Vf = __builtin_shufflevector(lo, hi, 0, 1, 2, 3, 4, 5, 6, 7);
            O[dt] = __builtin_amdgcn_mfma_f32_16x16x32_bf16(Vf, Pf, O[dt], 0, 0, 0);
        }
    }
    lsum += __shfl_xor(lsum, 16); lsum += __shfl_xor(lsum, 32);
    const float rl = 1.0f / lsum;
#pragma unroll
    for (int dt = 0; dt < 4; ++dt) { u32x2 o; o.x = g2::cvt_pk_bf16(O[dt][0] * rl, O[dt][1] * rl); o.y = g2::cvt_pk_bf16(O[dt][2] * rl, O[dt][3] * rl);
        *(u32x2*)(OG + tq * 256 + j * 64 + 16 * dt + 4 * g4) = o; }
    if (g4 == 0) LSE[tq * 4 + j] = m + __builtin_amdgcn_logf(lsum);
        if (!more) break;
        u = u2;
    }
}
#undef ATT_GLOBAL
__device__ __forceinline__ void ph_attn_combine(Frame& F, int own = -1) {
    const bf16* OG = (const bf16*)(F.outb + OUT_OG); const float* LSE = (const float*)(F.ws + WS_LSE); bf16* YA = (bf16*)(F.outb + OUT_YA);
    const int j = F.lane >> 4, c = (F.lane & 15) * 4;
    const int nit = own >= 0 ? ((T / 256 - own + F.G - 1) / F.G) * 32 : (T - (int)(blockIdx.x * NWAVES + F.wave) + F.G * NWAVES - 1) / (F.G * NWAVES);
#define AC_TOK(it) (own >= 0 ? ((own + ((it) >> 5) * F.G) << 8) + F.wave * 32 + ((it) & 31) : (int)(blockIdx.x * NWAVES + F.wave) + (it) * F.G * NWAVES)
#define AC_LOAD(tt) do { _Pragma("unroll") for (int g = 0; g < 3; ++g) { ln[g] = LSE[((size_t)g * T + (tt)) * 4 + j]; wn[g] = *(const u32x2*)(OG + ((size_t)g * T + (tt)) * 256 + j * 64 + c); } } while (0)
    float ln[3]; u32x2 wn[3];
    if (nit > 0) AC_LOAD(AC_TOK(0));
    for (int it = 0; it < nit; ++it) { const int t = AC_TOK(it);
        float l[3], o[3][4]; float mx = -INFINITY;
#pragma unroll
        for (int g = 0; g < 3; ++g) { l[g] = ln[g]; mx = fmaxf(mx, l[g]); const u32x2 w = wn[g];
            o[g][0] = __uint_as_float(w.x << 16); o[g][1] = __uint_as_float(w.x & 0xffff0000u); o[g][2] = __uint_as_float(w.y << 16); o[g][3] = __uint_as_float(w.y & 0xffff0000u); }
        if (it + 1 < nit) AC_LOAD(AC_TOK(it + 1));
        float ws = 0.f, y[4] = {0.f, 0.f, 0.f, 0.f};
#pragma unroll
        for (int g = 0; g < 3; ++g) { const float e = __builtin_amdgcn_exp2f(l[g] - mx); ws += e;
#pragma unroll
            for (int k = 0; k < 4; ++k) y[k] += e * o[g][k]; }
        const float rw = 1.0f / ws;
#if BO_FP8
        { const float r8 = rw * BO_ASC; *(unsigned*)((unsigned char*)YA + (size_t)t * 256 + j * 64 + c) = pk4_fp8(y[0] * r8, y[1] * r8, y[2] * r8, y[3] * r8); }
#else
        u32x2 w; w.x = pk2(y[0] * rw, y[1] * rw); w.y = pk2(y[2] * rw, y[3] * rw);
        *(u32x2*)(YA + (size_t)t * 256 + j * 64 + c) = w;
#endif
    }
#undef AC_LOAD
#undef AC_TOK
}

__device__ __forceinline__ void ph_mlstm_naive_unit(Frame& F, int bh) {
    const int b = bh >> 2, h = bh & 3, tid = F.tid, v = tid & 255, dh = tid >> 8;
    LAS float* qs = (LAS float*)F.lds; LAS float* ks = qs + 128; LAS float* red = ks + 128; LAS float* sc = red + 512;
    const bf16* MQK = (const bf16*)(F.ws + WS_MQK); const bf16* MV = (const bf16*)(F.ws + WS_MV); const bf16* MO = (const bf16*)(F.ws + WS_MO);
    const float* GATES = (const float*)(F.ws + WS_GATES); bf16* YB = (bf16*)(F.outb + OUT_YB);
    const float* cw = F.in[I_CONVW]; const float* cbv = F.in[I_CONVB];
    float C[64];
#pragma unroll
    for (int d = 0; d < 64; ++d) C[d] = 0.f;
    float nst = 0.f, m = 0.f;
    const int ch = (tid < 128) ? (h * 128 + tid) : (512 + h * 128 + ((tid - 128) & 127));
    const float w0 = cw[ch], w1 = cw[1024 + ch], w2 = cw[2048 + ch], w3 = cw[3072 + ch], cb = cbv[ch];
    float xh0 = 0.f, xh1 = 0.f, xh2 = 0.f;
    const float gm = F.in[I_GMLSTM][h * 256 + v];
    __syncthreads();
    for (int s = 0; s < SEQ; ++s) {
        const size_t t = (size_t)b * SEQ + s;
        if (tid < 256) {
            const float xc = bf2f(MQK[t * 1024 + ch]);
            float y = cb + w0 * xh0 + w1 * xh1 + w2 * xh2 + w3 * xc; xh0 = xh1; xh1 = xh2; xh2 = xc;
            y = y / (1.0f + expf(-y));
            if (tid < 128) qs[tid] = y; else ks[tid - 128] = y * 0.08838834764831845f;
        }
        const float ig = GATES[t * 8 + h], fg = GATES[t * 8 + 4 + h];
        const float lf = logsigmoidf_(fg); const float mn = fmaxf(lf + m, ig); const float fd = expf(lf + m - mn), iw = expf(ig - mn); m = mn;
        const float vv = bf2f(MV[t * 1024 + h * 256 + v]);
        __syncthreads();
        float part = 0.f; const float ivv = iw * vv;
#pragma unroll
        for (int d4 = 0; d4 < 16; ++d4) { const f32x4 k4 = *(const LAS f32x4*)(ks + dh * 64 + d4 * 4), q4 = *(const LAS f32x4*)(qs + dh * 64 + d4 * 4);
#pragma unroll
            for (int e = 0; e < 4; ++e) { C[d4 * 4 + e] = fd * C[d4 * 4 + e] + ivv * k4[e]; part += C[d4 * 4 + e] * q4[e]; } }
        red[tid] = part;
        float nq = 0.f;
        if (tid < 128) { nst = fd * nst + iw * ks[tid]; nq = nst * qs[tid]; }
        nq = wave_sum(nq);
        if (F.lane == 0 && F.wave < 2) sc[F.wave] = nq;
        __syncthreads();
        const float num = red[v] + red[v + 256]; const float den = sc[0] + sc[1];
        const float hv = num / fmaxf(fabsf(den), expf(-mn));
        float sq = (dh == 0) ? hv * hv : 0.f; sq = wave_sum(sq);
        if (F.lane == 0) sc[2 + F.wave] = sq;
        __syncthreads();
        if (dh == 0) {
            const float ssum = sc[2] + sc[3] + sc[4] + sc[5];
            float y = hv * rsqrtf(ssum * (1.0f / 256.0f) + EPS) * gm;
            y *= sigmoidf_(bf2f(MO[t * 1024 + h * 256 + v]));
            YB[t * 1024 + h * 256 + v] = (bf16)f2bf(y);
        }
    }
    __syncthreads();
}


typedef float f32x16 __attribute__((ext_vector_type(16)));
typedef __bf16 bf16x2_t __attribute__((ext_vector_type(2)));
__device__ __forceinline__ unsigned cvtpk(float lo, float hi) { const f32x2 v = {lo, hi}; const bf16x2_t b = __builtin_convertvector(v, bf16x2_t); return __builtin_bit_cast(unsigned, b); }
__device__ __forceinline__ int crow32(int reg, int h2) { return (reg & 3) + 8 * (reg >> 2) + 4 * h2; }
constexpr int ML_QS = 272, ML_VS = 528, ML_SS = 144;
constexpr int ML_Q = 0, ML_K = 17408, ML_WKT = 34816, ML_WS = 144, ML_V = 53248, ML_SC = 87040, ML_RAW = 96768, ML_TAB = 131584, ML_H = 0;
#define MFMA32(a, b, c) __builtin_amdgcn_mfma_f32_32x32x16_bf16((a), (b), (c), 0, 0, 0)
__device__ __forceinline__ bf16x8_t tr2(LAS unsigned char* p, int rowstride) {
    const v4i16_t lo = __builtin_amdgcn_ds_read_tr16_b64_v4i16((LAS v4i16_t*)p);
    const v4i16_t hi = __builtin_amdgcn_ds_read_tr16_b64_v4i16((LAS v4i16_t*)(p + 4 * rowstride));
    return __builtin_shufflevector(lo, hi, 0, 1, 2, 3, 4, 5, 6, 7);
}
__device__ __forceinline__ void ml_gate_tables(LAS float* gt, float ig, float fg, float& mcar, int lane) {
    float bb = logsigmoidf_(fg);
#pragma unroll
    for (int o = 1; o < 64; o <<= 1) { const float v = __shfl_up(bb, o); if (lane >= o) bb += v; }
    const float a = ig - bb; float mx = a;
#pragma unroll
    for (int o = 1; o < 64; o <<= 1) { const float v = __shfl_up(mx, o); if (lane >= o) mx = fmaxf(mx, v); }
    const float Ml = fmaxf(mcar, mx);
    const float M63 = __shfl(Ml, 63), b63 = __shfl(bb, 63);
    gt[lane] = a; gt[64 + lane] = Ml; gt[128 + lane] = expf(-(bb + Ml)); gt[192 + lane] = expf(mcar - Ml); gt[256 + lane] = expf(a - M63);
    if (lane == 0) gt[320] = expf(mcar - M63);
    mcar = b63 + M63;
}
static_assert(ML_RAW + 67 * 512 <= MISC_OFF && MISC_OFF + 128 <= ML_TAB && ML_TAB + 11264 <= LDS_BYTES, "mLSTM LDS map");
template <bool FIRST>
__device__ __forceinline__ void ml_dma_raw(LAS unsigned char* L, const bf16* MQK, int b, int h, int c, int w, int lane) {
    const int rr = lane >> 5, seg = (lane >> 4) & 1, c16 = lane & 15;
    unsigned vo = (unsigned)(rr * 1024 + (seg ? 512 + h * 128 : h * 128) + c16 * 8) * 2u; asm volatile("" : "+v"(vo));
    const char* base = (const char*)(MQK + ((size_t)b * SEQ + 64 * c) * 1024) - 3 * 2048;
#pragma unroll
    for (int i = 0; i < 5; ++i) { int p = w * 5 + i; p = p > 33 ? 33 : p;
        const char* g = base + (size_t)p * 4096;
        if ((p < 33 || rr == 0) && (!FIRST || p >= 2 || (p == 1 && rr == 1))) __builtin_amdgcn_global_load_lds((const unsigned*)(g + vo), (LAS unsigned*)(L + ML_RAW + p * 1024), 16, 0, 0); }
}
__device__ __forceinline__ void ml_dma_v(LAS unsigned char* L, const bf16* MV, size_t t0, int h, int w, int lane) {
    unsigned vo = (unsigned)lane * 16u; asm volatile("" : "+v"(vo));
    const char* base = (const char*)(MV + (t0 + w * 8) * 1024 + h * 256);
#pragma unroll
    for (int i = 0; i < 8; ++i) { const int row = w * 8 + i;
        if (lane < 32) __builtin_amdgcn_global_load_lds((const unsigned*)(base + (size_t)i * 2048 + vo), (LAS unsigned*)(L + ML_V + row * ML_VS), 16, 0, 0); }
}
#define ML_SYNC() do { asm volatile("s_waitcnt lgkmcnt(0)" ::: "memory"); __builtin_amdgcn_s_barrier(); asm volatile("" ::: "memory"); } while (0)
__device__ __forceinline__ void mlstm_unit_fast(Frame& F, int bh) {
    const int b = bh >> 2, h = bh & 3, tid = F.tid, lane = F.lane, w = F.wave;
    LAS unsigned char* L = F.lds;
    LAS float* tab = (LAS float*)(L + ML_TAB);
    LAS float *td2 = tab + 1024, *trd = tab + 1088, *tn = tab + 1152, *tcw = tab + 1280, *tgm = tab + 2560;
    const bf16* MQK = (const bf16*)(F.ws + WS_MQK); const bf16* MV = (const bf16*)(F.ws + WS_MV); const bf16* MO = (const bf16*)(F.ws + WS_MO);
    const float* GATES = (const float*)(F.ws + WS_GATES); bf16* YB = (bf16*)(F.outb + OUT_YB);
    const int r32 = lane & 31, h2 = lane >> 5, gq = lane >> 4, i16 = lane & 15, q4 = i16 >> 2, p4 = i16 & 3;
    f32x16 Ct[4];
#pragma unroll
    for (int dt = 0; dt < 4; ++dt)
#pragma unroll
        for (int r = 0; r < 16; ++r) Ct[dt][r] = 0.f;
    float mcar = 0.f;
    __syncthreads();
    if (tid < 128) tn[tid] = 0.f;
    const int cg = tid & 31, tq = tid >> 5; const bool isq = cg < 16;
    if (tid < 256) { int chn = (tid < 128) ? (h * 128 + tid) : (512 + h * 128 + (tid - 128)); asm volatile("" : "+v"(chn)); const float* cw = F.in[I_CONVW];
        tcw[tid] = cw[chn]; tcw[256 + tid] = cw[1024 + chn]; tcw[512 + tid] = cw[2048 + chn]; tcw[768 + tid] = cw[3072 + chn]; tcw[1024 + tid] = F.in[I_CONVB][chn];
        int gi = h * 256 + tid; asm volatile("" : "+v"(gi)); tgm[tid] = F.in[I_GMLSTM][gi]; }
    if (tid < 96) *(LAS u32x4*)(L + ML_RAW + tid * 16) = (u32x4){0u, 0u, 0u, 0u};
    ml_dma_raw<true>(L, MQK, b, h, 0, w, lane);
    ml_dma_v(L, MV, (size_t)b * SEQ, h, w, lane);
    float ign = 0.f, fgn = 0.f;
    if (w == 3) { ign = GATES[((size_t)b * SEQ + lane) * 8 + h]; fgn = GATES[((size_t)b * SEQ + lane) * 8 + 4 + h]; ml_gate_tables(tab, ign, fgn, mcar, lane); }
    asm volatile("s_waitcnt vmcnt(0)" ::: "memory");
#pragma unroll 1
    for (int c = 0; c < SEQ / 64; ++c) {
        const size_t t0 = (size_t)b * SEQ + 64 * c;
        const bool more = c + 1 < SEQ / 64;
        LAS float* gt = tab + (c & 1) * 512;
        LAS float *ta = gt, *tM = gt + 64, *temt = gt + 128, *tin = gt + 192, *te = gt + 256, *tsc = gt + 320;
        asm volatile("s_waitcnt vmcnt(12)" ::: "memory");
        ML_SYNC();
        if (w == 3 && more) { ign = GATES[(t0 + 64 + lane) * 8 + h]; fgn = GATES[(t0 + 64 + lane) * 8 + 4 + h]; }
        {
#pragma unroll
          for (int e4 = 0; e4 < 2; ++e4) {
              const f32x4 w0 = *(const LAS f32x4*)(tcw + 8 * cg + 4 * e4), w1 = *(const LAS f32x4*)(tcw + 256 + 8 * cg + 4 * e4), w2 = *(const LAS f32x4*)(tcw + 512 + 8 * cg + 4 * e4),
                          w3 = *(const LAS f32x4*)(tcw + 768 + 8 * cg + 4 * e4), cb = *(const LAS f32x4*)(tcw + 1024 + 8 * cg + 4 * e4);
              f32x4 xr[7];
#pragma unroll
              for (int j = 0; j < 7; ++j) { const u32x2 rw = *(const LAS u32x2*)(L + ML_RAW + (4 * tq + j) * 512 + cg * 16 + e4 * 8); const unsigned lo = rw.x, hi = rw.y;
                  xr[j] = (f32x4){__uint_as_float(lo << 16), __uint_as_float(lo & 0xffff0000u), __uint_as_float(hi << 16), __uint_as_float(hi & 0xffff0000u)}; }
              f32x4 kv[4];
#pragma unroll
              for (int i = 0; i < 4; ++i) { const int sl = 4 * tq + i;
                  f32x4 v = cb + w0 * xr[i] + w1 * xr[i + 1] + w2 * xr[i + 2] + w3 * xr[i + 3];
#pragma unroll
                  for (int e = 0; e < 4; ++e) v[e] = v[e] * fsig(v[e]);
                  if (isq) { u32x2 o; o.x = pk2(v[0], v[1]); o.y = pk2(v[2], v[3]); *(LAS u32x2*)(L + ML_Q + sl * ML_QS + cg * 16 + e4 * 8) = o; }
                  else { const float es = te[sl]; v = v * 0.08838834764831845f;
                      u32x2 o; o.x = pk2(v[0], v[1]); o.y = pk2(v[2], v[3]); *(LAS u32x2*)(L + ML_K + sl * ML_QS + (cg - 16) * 16 + e4 * 8) = o;
                      kv[i] = v * es; } }
              if (!isq) {
#pragma unroll
                  for (int e = 0; e < 4; ++e) { u32x2 o2; o2.x = pk2(kv[0][e], kv[1][e]); o2.y = pk2(kv[2][e], kv[3][e]);
                      *(LAS u32x2*)(L + ML_WKT + (8 * (cg - 16) + 4 * e4 + e) * ML_WS + 8 * tq) = o2; } } } }
        ML_SYNC();
        if (w == 3 && more) ml_gate_tables(tab + ((c + 1) & 1) * 512, ign, fgn, mcar, lane);
        if (more) ml_dma_raw<false>(L, MQK, b, h, c + 1, w, lane);
        if (w < 3) {
            const int lt = w ? 1 : 0, st = (w == 2) ? 1 : 0;
            f32x16 S;
#pragma unroll
            for (int r = 0; r < 16; ++r) S[r] = 0.f;
#pragma unroll
            for (int ks = 0; ks < 8; ++ks) { const bf16x8_t A = *(const LAS bf16x8_t*)(L + ML_Q + (32 * lt + r32) * ML_QS + (16 * ks + 8 * h2) * 2);
                const bf16x8_t B = *(const LAS bf16x8_t*)(L + ML_K + (32 * st + r32) * ML_QS + (16 * ks + 8 * h2) * 2); S = MFMA32(A, B, S);
                if (ks & 1) asm volatile("" ::: "memory"); }
            const int s = 32 * st + r32; const float as = ta[s];
            const LAS float* tMh = tM + 32 * lt + 4 * h2; LAS unsigned char* scp = L + ML_SC + (32 * lt + 4 * h2) * ML_SS + s * 2; const int lb = 32 * lt + 4 * h2;
#pragma unroll
            for (int r = 0; r < 16; ++r) { const int ro = (r & 3) + 8 * (r >> 2);
                float x = as - tMh[ro]; x = (s <= lb + ro) ? x : -INFINITY;
                *(LAS bf16*)(scp + ro * ML_SS) = (bf16)f2bf(S[r] * __expf(x)); }
        } else if (w >= 4) {
            const int idx = tid - 256, l = idx >> 2, part = idx & 3; float acc = 0.f;
#pragma unroll
            for (int i = 0; i < 4; ++i) { float q8[8]; unpack8(*(const LAS u32x4*)(L + ML_Q + l * ML_QS + (32 * part + 8 * i) * 2), q8);
#pragma unroll
                for (int e = 0; e < 8; ++e) acc += tn[32 * part + 8 * i + e] * q8[e]; }
            acc += __shfl_xor(acc, 1); acc += __shfl_xor(acc, 2);
            if (part == 0) td2[l] = acc;
        }
        if (more) asm volatile("s_waitcnt vmcnt(5)" ::: "memory"); else asm volatile("s_waitcnt vmcnt(0)" ::: "memory");
        ML_SYNC();
        if (tid < 64) { const int l = tid; float d1 = 0.f; const int nb = (l < 32) ? 4 : 8;
            for (int i = 0; i < nb; ++i) { float v8[8]; unpack8(*(const LAS u32x4*)(L + ML_SC + l * ML_SS + i * 16), v8);
#pragma unroll
                for (int e = 0; e < 8; ++e) d1 += v8[e]; }
            const float den = d1 + tin[l] * td2[l]; trd[l] = 1.0f / fmaxf(fabsf(den), temt[l]); }
        bf16x8_t Vf[4];
        { v4i16_t t0_, t1_, t2_, t3_, t4_, t5_, t6_, t7_;
          LAS unsigned char* pv = L + ML_V + (8 * h2 + q4) * ML_VS + (32 * w + 16 * (gq & 1) + 4 * p4) * 2;
          static_assert(ML_VS == 528, "offsets below");
          asm volatile("ds_read_b64_tr_b16 %0, %8\n\tds_read_b64_tr_b16 %1, %8 offset:2112\n\tds_read_b64_tr_b16 %2, %8 offset:8448\n\tds_read_b64_tr_b16 %3, %8 offset:10560\n\t"
                       "ds_read_b64_tr_b16 %4, %8 offset:16896\n\tds_read_b64_tr_b16 %5, %8 offset:19008\n\tds_read_b64_tr_b16 %6, %8 offset:25344\n\tds_read_b64_tr_b16 %7, %8 offset:27456\n\t"
                       "s_waitcnt lgkmcnt(0)"
                       : "=&v"(t0_), "=&v"(t1_), "=&v"(t2_), "=&v"(t3_), "=&v"(t4_), "=&v"(t5_), "=&v"(t6_), "=&v"(t7_) : "v"(pv) : "memory");
          Vf[0] = __builtin_shufflevector(t0_, t1_, 0, 1, 2, 3, 4, 5, 6, 7); Vf[1] = __builtin_shufflevector(t2_, t3_, 0, 1, 2, 3, 4, 5, 6, 7);
          Vf[2] = __builtin_shufflevector(t4_, t5_, 0, 1, 2, 3, 4, 5, 6, 7); Vf[3] = __builtin_shufflevector(t6_, t7_, 0, 1, 2, 3, 4, 5, 6, 7); }
        f32x16 N1[2], N2[2];
#pragma unroll
        for (int lt = 0; lt < 2; ++lt)
#pragma unroll
            for (int r = 0; r < 16; ++r) { N1[lt][r] = 0.f; N2[lt][r] = 0.f; }
#pragma unroll
        for (int ks = 0; ks < 2; ++ks) N1[0] = MFMA32(*(const LAS bf16x8_t*)(L + ML_SC + r32 * ML_SS + (16 * ks + 8 * h2) * 2), Vf[ks], N1[0]);
#pragma unroll
        for (int ks = 0; ks < 4; ++ks) N1[1] = MFMA32(*(const LAS bf16x8_t*)(L + ML_SC + (32 + r32) * ML_SS + (16 * ks + 8 * h2) * 2), Vf[ks], N1[1]);
        asm volatile("" ::: "memory");
#pragma unroll
        for (int dt = 0; dt < 4; ++dt)
#pragma unroll
            for (int s2 = 0; s2 < 2; ++s2) {
                u32x4 pk;
#pragma unroll
                for (int e = 0; e < 4; ++e) pk[e] = cvtpk(Ct[dt][8 * s2 + 2 * e], Ct[dt][8 * s2 + 2 * e + 1]);
                const bf16x8_t Bc = __builtin_bit_cast(bf16x8_t, pk);
#pragma unroll
                for (int lt = 0; lt < 2; ++lt) {
                    const u32x2 lo = *(const LAS u32x2*)(L + ML_Q + (32 * lt + r32) * ML_QS + (32 * dt + 16 * s2 + 4 * h2) * 2);
                    const u32x2 hi = *(const LAS u32x2*)(L + ML_Q + (32 * lt + r32) * ML_QS + (32 * dt + 16 * s2 + 8 + 4 * h2) * 2);
                    const u32x4 a4 = (u32x4){lo.x, lo.y, hi.x, hi.y};
                    N2[lt] = MFMA32(__builtin_bit_cast(bf16x8_t, a4), Bc, N2[lt]); }
                asm volatile("" ::: "memory"); }
        { const float decay = tsc[0];
#pragma unroll
          for (int dt = 0; dt < 4; ++dt) {
#pragma unroll
              for (int r = 0; r < 16; ++r) Ct[dt][r] *= decay;
#pragma unroll
              for (int ks = 0; ks < 4; ++ks) Ct[dt] = MFMA32(*(const LAS bf16x8_t*)(L + ML_WKT + (32 * dt + r32) * ML_WS + (16 * ks + 8 * h2) * 2), Vf[ks], Ct[dt]);
              asm volatile("" ::: "memory"); }
          if (tid < 128) { float acc = decay * tn[tid];
#pragma unroll 8
              for (int s = 0; s < 64; ++s) acc += te[s] * bf2f(*(const LAS bf16*)(L + ML_K + s * ML_QS + tid * 2));
              tn[tid] = acc; } }
        ML_SYNC();
        if (more) ml_dma_v(L, MV, t0 + 64, h, w, lane);
#pragma unroll
        for (int lt = 0; lt < 2; ++lt)
#pragma unroll
            for (int r = 0; r < 16; ++r) { const int ro = 32 * lt + (r & 3) + 8 * (r >> 2); const LAS float* tinh = tin + 4 * h2; const LAS float* trdh = trd + 4 * h2;
                const float hv = (N1[lt][r] + tinh[ro] * N2[lt][r]) * trdh[ro];
                *(LAS bf16*)(L + ML_H + (4 * h2) * ML_VS + (32 * w + r32) * 2 + ro * ML_VS) = (bf16)f2bf(hv); }
#if GATES_U8
        u32x4 moreg[2];
        { const unsigned char* mo = (const unsigned char*)MO + (t0 + (tid >> 3)) * 1024 + h * 256 + (tid & 7) * 32; moreg[0] = *(const u32x4*)mo; moreg[1] = *(const u32x4*)(mo + 16); }
#else
        u32x4 moreg[4];
        { const bf16* mo = MO + (t0 + (tid >> 3)) * 1024 + h * 256 + (tid & 7) * 32;
#pragma unroll
          for (int i = 0; i < 4; ++i) moreg[i] = *(const u32x4*)(mo + 8 * i); }
#endif
        ML_SYNC();
        { const int l = tid >> 3, part = tid & 7; float hv[32]; float ss = 0.f;
#pragma unroll
          for (int i = 0; i < 4; ++i) { float t8[8]; unpack8(*(const LAS u32x4*)(L + ML_H + l * ML_VS + part * 64 + i * 16), t8);
#pragma unroll
              for (int e = 0; e < 8; ++e) { hv[8 * i + e] = t8[e]; ss += t8[e] * t8[e]; } }
          ss += __shfl_xor(ss, 1); ss += __shfl_xor(ss, 2); ss += __shfl_xor(ss, 4);
          const float rstd = rsqrtf(ss * (1.0f / 256.0f) + EPS) * (BO_FP8 ? BO_ASC : 1.0f);
          const LAS float* gm = tgm + part * 32;
#if BO_FP8
          unsigned char* yb8 = (unsigned char*)YB + (t0 + l) * 1024 + h * 256 + part * 32;
#else
          bf16* yb = YB + (t0 + l) * 1024 + h * 256 + part * 32;
#endif
#pragma unroll
          for (int i = 0; i < 4; ++i) { const f32x4 g0 = *(const LAS f32x4*)(gm + 8 * i), g1 = *(const LAS f32x4*)(gm + 8 * i + 4);
#if GATES_U8
              const f32x4 sa = unpk4_sig_u8(moreg[i >> 1][2 * (i & 1)]), sb = unpk4_sig_u8(moreg[i >> 1][2 * (i & 1) + 1]);
              float o[8];
#pragma unroll
              for (int e = 0; e < 8; ++e) o[e] = hv[8 * i + e] * rstd * (e < 4 ? g0[e] * sa[e] : g1[e - 4] * sb[e - 4]);
#else
              float m8[8]; unpack8(moreg[i], m8);
              float o[8];
#pragma unroll
              for (int e = 0; e < 8; ++e) o[e] = hv[8 * i + e] * rstd * (e < 4 ? g0[e] : g1[e - 4]) * fsig(m8[e]);
#endif
#if BO_FP8
              { u32x2 w8; w8.x = pk4_fp8(o[0], o[1], o[2], o[3]); w8.y = pk4_fp8(o[4], o[5], o[6], o[7]);
                *(u32x2*)(yb8 + 8 * i) = w8; }
#else
              u32x4 wv; wv.x = pk2(o[0], o[1]); wv.y = pk2(o[2], o[3]); wv.z = pk2(o[4], o[5]); wv.w = pk2(o[6], o[7]);
              *(u32x4*)(yb + 8 * i) = wv;
#endif
              } }
    }
    __syncthreads();
}

__device__ __forceinline__ void ph_branch_naive(Frame& F) {
    LAS float* As = (LAS float*)F.lds; LAS float* Bs = As + 16 * 132;
    const bf16* YA = (const bf16*)(F.outb + OUT_YA); const bf16* YB = (const bf16*)(F.outb + OUT_YB); const bf16* GAB = (const bf16*)(F.ws + WS_GAB);
    bf16* MG = (bf16*)(F.ws + WS_MERGED);
    const int ty = F.tid >> 5, tx = F.tid & 31;
    for (int vb = blockIdx.x; vb < (T / 128) * 8; vb += F.G) {
        const int tm = vb >> 3, tn = vb & 7, m0 = tm * 128, n0 = tn * 128;
        float a1[8][4], a2[8][4]; ZERO_ACC(a1); ZERO_ACC(a2);
        ARowGlobal ra{YA, (size_t)256, m0, nullptr}; ngemm_acc(As, Bs, ra, F.in[I_WBA], D, 256, n0, D, a1);
        ARowGlobal rb{YB, (size_t)D, m0, nullptr};  ngemm_acc(As, Bs, rb, F.in[I_WBB], D, D, n0, D, a2);
#pragma unroll
        for (int i = 0; i < 8; ++i) { const size_t row = (size_t)(m0 + ty * 8 + i); const int col = n0 + tx * 4;
            const u32x2 ga = *(const u32x2*)(GAB + row * 2048 + col), gb = *(const u32x2*)(GAB + row * 2048 + 1024 + col);
            const float sga[4] = {sigmoidf_(__uint_as_float(ga.x << 16)), sigmoidf_(__uint_as_float(ga.x & 0xffff0000u)), sigmoidf_(__uint_as_float(ga.y << 16)), sigmoidf_(__uint_as_float(ga.y & 0xffff0000u))};
            const float sgb[4] = {sigmoidf_(__uint_as_float(gb.x << 16)), sigmoidf_(__uint_as_float(gb.x & 0xffff0000u)), sigmoidf_(__uint_as_float(gb.y << 16)), sigmoidf_(__uint_as_float(gb.y & 0xffff0000u))};
            float o[4];
#pragma unroll
            for (int j = 0; j < 4; ++j) o[j] = sga[j] * a1[i][j] + sgb[j] * a2[i][j];
            u32x2 w; w.x = pk2(o[0], o[1]); w.y = pk2(o[2], o[3]); *(u32x2*)(MG + row * D + col) = w; }
    }
}

__device__ __forceinline__ void ph_outproj_naive(Frame& F) {
    LAS float* As = (LAS float*)F.lds; LAS float* Bs = As + 16 * 132;
    const bf16* MG = (const bf16*)(F.ws + WS_MERGED); bf16* YM = (bf16*)(F.ws + WS_YMIX);
    const int ty = F.tid >> 5, tx = F.tid & 31;
    for (int vb = blockIdx.x; vb < (T / 128) * 8; vb += F.G) {
        const int tm = vb >> 3, tn = vb & 7, m0 = tm * 128, n0 = tn * 128;
        float a1[8][4]; ZERO_ACC(a1);
        ARowGlobal ra{MG, (size_t)D, m0, nullptr}; ngemm_acc(As, Bs, ra, F.in[I_WOUT], D, D, n0, D, a1);
#pragma unroll
        for (int i = 0; i < 8; ++i) { const size_t row = (size_t)(m0 + ty * 8 + i); const int col = n0 + tx * 4;
            u32x2 w; w.x = pk2(a1[i][0], a1[i][1]); w.y = pk2(a1[i][2], a1[i][3]); *(u32x2*)(YM + row * D + col) = w; }
    }
}

struct X1In { u32x2 ym[4]; f32x4 xv[4]; };
__device__ __forceinline__ void x1_load(Frame& F, int t, X1In& r) {
    const float* x = F.in[I_X]; const bf16* YM = (const bf16*)(F.ws + WS_YMIX);
#pragma unroll
    for (int j = 0; j < 4; ++j) { r.ym[j] = *(const u32x2*)(YM + (size_t)t * D + F.lane * 4 + 256 * j); r.xv[j] = *(const f32x4*)(x + (size_t)t * D + F.lane * 4 + 256 * j); }
}
__device__ __forceinline__ void x1_compute(Frame& F, int t, const X1In& r, f32x4 (&x1)[4]) {
    const float* mod = (const float*)(F.ws + WS_MOD);
    const int b = t / SEQ; const float* gt1 = mod + b * 6144 + 2048; const float* g = F.in[I_GPOSTMIX];
    f32x4 y[4]; float ss = 0.f;
#pragma unroll
    for (int j = 0; j < 4; ++j) { const u32x2 w = r.ym[j];
        y[j][0] = __uint_as_float(w.x << 16); y[j][1] = __uint_as_float(w.x & 0xffff0000u); y[j][2] = __uint_as_float(w.y << 16); y[j][3] = __uint_as_float(w.y & 0xffff0000u);
        ss += y[j][0] * y[j][0] + y[j][1] * y[j][1] + y[j][2] * y[j][2] + y[j][3] * y[j][3]; }
    const float rstd = rsqrtf(wave_sum(ss) * (1.0f / D) + EPS);
#pragma unroll
    for (int j = 0; j < 4; ++j) { const int c = F.lane * 4 + 256 * j; const f32x4 gg = *(const f32x4*)(g + c), gt = *(const f32x4*)(gt1 + c);
#pragma unroll
        for (int e = 0; e < 4; ++e) x1[j][e] = r.xv[j][e] + gt[e] * (y[j][e] * rstd * gg[e]); }
}
__device__ __forceinline__ void x1_row(Frame& F, int t, f32x4 (&x1)[4]) { X1In r; x1_load(F, t, r); x1_compute(F, t, r, x1); }

__device__ __forceinline__ void ph_normmid(Frame& F) {
    const float* mod = (const float*)(F.ws + WS_MOD); const float* g = F.in[I_GPREFFN]; bf16* H2 = (bf16*)(F.ws + WS_H2);
    const int tstep = F.G * NWAVES; int t = blockIdx.x * NWAVES + F.wave;
    X1In rn; if (t < T) x1_load(F, t, rn);
    for (; t < T; t += tstep) {
        const int b = t / SEQ; const float* sh2 = mod + b * 6144 + 3072, *sc2 = mod + b * 6144 + 4096;
        const X1In rc = rn; if (t + tstep < T) x1_load(F, t + tstep, rn);
        f32x4 x1[4]; x1_compute(F, t, rc, x1);
        float ss = 0.f;
#pragma unroll
        for (int j = 0; j < 4; ++j) ss += x1[j][0] * x1[j][0] + x1[j][1] * x1[j][1] + x1[j][2] * x1[j][2] + x1[j][3] * x1[j][3];
        const float rstd = rsqrtf(wave_sum(ss) * (1.0f / D) + EPS);
#pragma unroll
        for (int j = 0; j < 4; ++j) { const int c = F.lane * 4 + 256 * j; const f32x4 gg = *(const f32x4*)(g + c), s2 = *(const f32x4*)(sc2 + c), h2 = *(const f32x4*)(sh2 + c);
            float o[4];
#pragma unroll
            for (int e = 0; e < 4; ++e) o[e] = x1[j][e] * rstd * gg[e] * (1.0f + s2[e]) + h2[e];
            u32x2 w; w.x = pk2(o[0], o[1]); w.y = pk2(o[2], o[3]); *(u32x2*)(H2 + (size_t)t * D + c) = w;
#if MOE_FP8
            *(unsigned*)(F.ws + WS_H2F8 + (size_t)t * D + c) = pk4_fp8(o[0], o[1], o[2], o[3]);
#endif
#if !FAST_MOE2
            *(f32x4*)(F.out + (size_t)t * D + c) = (f32x4){0.f, 0.f, 0.f, 0.f};
#endif
        }
    }
}

__device__ __forceinline__ void ph_normmid_blocks(Frame& F, int vcu) {
    for (int bi = 0; bi * F.G + vcu < T / 256; ++bi) { const int tblk = bi * F.G + vcu;
    const float* mod = (const float*)(F.ws + WS_MOD); bf16* H2 = (bf16*)(F.ws + WS_H2);
    int t = tblk * 256 + F.wave * 32; const int tend = t + 32;
    f32x4 cA[4], cB[4], cC[4];
    { const int b = t / SEQ; const float* gt1 = mod + b * 6144 + 2048, *sh2 = mod + b * 6144 + 3072, *sc2 = mod + b * 6144 + 4096; const float* g1 = F.in[I_GPOSTMIX]; const float* g2p = F.in[I_GPREFFN];
#pragma unroll
      for (int j = 0; j < 4; ++j) { const int c = F.lane * 4 + 256 * j; cA[j] = *(const f32x4*)(gt1 + c) * *(const f32x4*)(g1 + c); cB[j] = *(const f32x4*)(g2p + c) * (*(const f32x4*)(sc2 + c) + 1.0f); cC[j] = *(const f32x4*)(sh2 + c); } }
    X1In rn; x1_load(F, t, rn);
#pragma unroll 1
    for (; t < tend; ++t) {
        const X1In rc = rn; if (t + 1 < tend) x1_load(F, t + 1, rn);
        f32x4 y[4]; float ss = 0.f;
#pragma unroll
        for (int j = 0; j < 4; ++j) { const u32x2 w = rc.ym[j];
            y[j][0] = __uint_as_float(w.x << 16); y[j][1] = __uint_as_float(w.x & 0xffff0000u); y[j][2] = __uint_as_float(w.y << 16); y[j][3] = __uint_as_float(w.y & 0xffff0000u);
            ss += y[j][0] * y[j][0] + y[j][1] * y[j][1] + y[j][2] * y[j][2] + y[j][3] * y[j][3]; }
        const float rstd1 = rsqrtf(wave_sum(ss) * (1.0f / D) + EPS);
        f32x4 x1[4]; float s2 = 0.f;
#pragma unroll
        for (int j = 0; j < 4; ++j) { x1[j] = rc.xv[j] + cA[j] * (y[j] * rstd1); s2 += x1[j][0] * x1[j][0] + x1[j][1] * x1[j][1] + x1[j][2] * x1[j][2] + x1[j][3] * x1[j][3]; }
        const float rstd = rsqrtf(wave_sum(s2) * (1.0f / D) + EPS);
#pragma unroll
        for (int j = 0; j < 4; ++j) { const int c = F.lane * 4 + 256 * j;
            const f32x4 o = x1[j] * rstd * cB[j] + cC[j];
            u32x2 w; w.x = pk2(o[0], o[1]); w.y = pk2(o[2], o[3]); *(u32x2*)(H2 + (size_t)t * D + c) = w;
            { u32x2 wx; wx.x = pk2(x1[j][0], x1[j][1]); wx.y = pk2(x1[j][2], x1[j][3]); *(u32x2*)((bf16*)(F.ws + WS_YMIX) + (size_t)t * D + c) = wx; }
            *(unsigned*)(F.ws + WS_H2F8 + (size_t)t * D + c) = pk4_fp8(o[0], o[1], o[2], o[3]);
        }
    }
}
}

constexpr int HALF_T = T / 2;
__device__ __forceinline__ unsigned char* slot_ptr(unsigned char* ws, unsigned char* outb, int half, int k, int t) {
    const size_t tl = (size_t)(t - half * HALF_T);
    if (k < 2) return outb + (size_t)t * 4096 + k * 2048;
#if MOE_FP8
    int ri;
    if (half == 0) { if (k < 4) return outb + (size_t)(t + HALF_T) * 4096 + (k - 2) * 2048; ri = k - 4; } else ri = k - 2;
    const size_t base = (ri == 0) ? 192 : (ri == 1) ? 256 : (ri == 2) ? 448 : (ri == 3) ? 512 : (ri == 4) ? 576 : (ri == 5) ? 640 : 704;
    return ws + base * MiB + tl * 2048;
#else
    if (half == 0) {
        if (k < 4) return outb + (size_t)(t + HALF_T) * 4096 + (k - 2) * 2048;
        if (k < 6) return ws + (192 + 64 * (size_t)(k - 4)) * MiB + tl * 2048;
        return ws + (512 + 64 * (size_t)(k - 6)) * MiB + tl * 2048;
    }
    if (k < 4) return ws + (192 + 64 * (size_t)(k - 2)) * MiB + tl * 2048;
    if (k < 8) return ws + (512 + 64 * (size_t)(k - 4)) * MiB + tl * 2048;
    return ws + 768 * MiB + tl * 2048;
#endif
}
__device__ __forceinline__ void ph_topk2(Frame& F) {
    const float* LG = (const float*)(F.ws + WS_LOGITS); const float* rb = F.in[I_RB];
    int* TOPI = (int*)(F.ws + WS_TOPI); float* TOPW = (float*)(F.ws + WS_TOPW); int* HIST = (int*)(F.ws + WS_HIST);
    LAS float* selw = (LAS float*)F.lds + F.wave * 512; LAS float* gsw = selw + 256;
    LAS unsigned* hist = (LAS unsigned*)(F.lds + 8 * 512 * 4);
    const int lane = F.lane, hf = lane >> 5;
    for (int tb = blockIdx.x; tb < T / 256; tb += F.G) {
        __syncthreads();
        if (F.tid < 256) hist[F.tid] = 0u;
        __syncthreads();
        for (int it = 0; it < 32; ++it) {
            const int t = tb * 256 + F.wave * 32 + it;
            float sc[4], sel[4];
#pragma unroll
            for (int i = 0; i < 4; ++i) { sc[i] = sigmoidf_(LG[(size_t)t * NE + lane + 64 * i]); sel[i] = sc[i] + rb[lane + 64 * i]; selw[lane + 64 * i] = sel[i]; }
            asm volatile("s_waitcnt lgkmcnt(0)" ::: "memory");
            if (lane < 8) { float m1 = -INFINITY, m2 = -INFINITY;
#pragma unroll
                for (int q = 0; q < 8; ++q) { const f32x4 v = *(const LAS f32x4*)(selw + lane * 32 + q * 4);
#pragma unroll
                    for (int e = 0; e < 4; ++e) { const float x = v[e]; const float lo = fminf(m1, x); m1 = fmaxf(m1, x); m2 = fmaxf(m2, lo); } }
                gsw[lane] = m1 + m2; }
            asm volatile("s_waitcnt lgkmcnt(0)" ::: "memory");
            float gs[8];
            { const f32x4 a = *(const LAS f32x4*)gsw, b2 = *(const LAS f32x4*)(gsw + 4); gs[0] = a[0]; gs[1] = a[1]; gs[2] = a[2]; gs[3] = a[3]; gs[4] = b2[0]; gs[5] = b2[1]; gs[6] = b2[2]; gs[7] = b2[3]; }
            bool gsel[8];
#pragma unroll
            for (int a = 0; a < 8; ++a) { int rank = 0;
#pragma unroll
                for (int c = 0; c < 8; ++c) rank += (gs[c] > gs[a] || (gs[c] == gs[a] && c < a)) ? 1 : 0;
                gsel[a] = rank < 4; }
            asm volatile("" ::: "memory");
#pragma unroll
            for (int i = 0; i < 4; ++i) { const bool ok = hf ? gsel[2 * i + 1] : gsel[2 * i]; if (!ok) sel[i] = -INFINITY; selw[lane + 64 * i] = sel[i]; }
            asm volatile("s_waitcnt lgkmcnt(0)" ::: "memory");
            int rk[4] = {0, 0, 0, 0};
#pragma unroll 4
            for (int q = 0; q < 64; ++q) { const f32x4 v = *(const LAS f32x4*)(selw + q * 4);
#pragma unroll
                for (int e = 0; e < 4; ++e) { const float x = v[e]; const int xe = q * 4 + e;
#pragma unroll
                    for (int i = 0; i < 4; ++i) rk[i] += (x > sel[i] || (x == sel[i] && xe < lane + 64 * i)) ? 1 : 0; } }
            asm volatile("" ::: "memory");
            float part = 0.f;
#pragma unroll
            for (int i = 0; i < 4; ++i) { if (sel[i] == -INFINITY) rk[i] = 999; if (rk[i] < TOPK) part += sc[i]; }
            const float wsum = wave_sum(part);
#pragma unroll
            for (int i = 0; i < 4; ++i) if (rk[i] < TOPK) { TOPI[(size_t)t * TOPK + rk[i]] = lane + 64 * i; TOPW[(size_t)t * TOPK + rk[i]] = sc[i] / wsum * 2.5f; __hip_atomic_fetch_add(&hist[lane + 64 * i], 1u, __ATOMIC_RELAXED, __HIP_MEMORY_SCOPE_WORKGROUP); }
        }
        __syncthreads();
        if (F.tid < 256) HIST[tb * 256 + F.tid] = (int)hist[F.tid];
    }
}

__device__ __forceinline__ unsigned mono_key(float v, int e) {
    unsigned u = __float_as_uint(v); u ^= (u & 0x80000000u) ? 0xffffffffu : 0x80000000u; return (u & 0xffffff00u) | (unsigned)(255 - e); }
struct StrideBlocks { int b0, G; __device__ __forceinline__ int block(int i) const { const int tb = b0 + i * G; return tb < T / 256 ? tb : -1; } };
struct RouterBlocks { g2::DenseOrder S; __device__ __forceinline__ int block(int i) const { g2::UnitMN u; return S.next(i, u) ? u.pm : -1; } };
template <class BlockIter>
__device__ __forceinline__ void ph_topk4(Frame& F, const BlockIter& BI) {
    const float* LG = (const float*)(F.ws + WS_LOGITS); const float* rb = F.in[I_RB];
    int* TOPI = (int*)(F.ws + WS_TOPI); float* TOPW = (float*)(F.ws + WS_TOPW); int* HIST = (int*)(F.ws + WS_HIST);
    LAS float* selw = (LAS float*)F.lds + F.wave * 1280; LAS float* gsw = selw + 512; LAS int* gfl = (LAS int*)(selw + 528); LAS int* resI = (LAS int*)(selw + 768); LAS float* resW = selw + 1024;
    LAS unsigned* hist = (LAS unsigned*)(F.lds + 8 * 1280 * 4);
    const int lane = F.lane, hf = lane >> 5;
    float rbv[4];
#pragma unroll
    for (int i = 0; i < 4; ++i) rbv[i] = rb[lane + 64 * i];
#define LWAIT() asm volatile("s_waitcnt lgkmcnt(0)" ::: "memory")
    for (int bi = 0;; ++bi) {
        const int tb = BI.block(bi); if (tb < 0) break;
        __syncthreads();
        if (F.tid < 256) hist[F.tid] = 0u;
        __syncthreads();
        const int tbase = tb * 256 + F.wave * 32;
        float lgn[2][4];
#pragma unroll
        for (int u = 0; u < 2; ++u)
#pragma unroll
            for (int i = 0; i < 4; ++i) lgn[u][i] = LG[(size_t)(tbase + 16 * u) * NE + lane + 64 * i];
#pragma unroll 1
        for (int it = 0; it < 16; ++it) {
            float sc[2][4], sel[2][4];
#pragma unroll
            for (int u = 0; u < 2; ++u)
#pragma unroll
                for (int i = 0; i < 4; ++i) { sc[u][i] = fsig(lgn[u][i]); sel[u][i] = sc[u][i] + rbv[i]; selw[u * 256 + lane + 64 * i] = sel[u][i]; }
            if (it + 1 < 16) {
#pragma unroll
                for (int u = 0; u < 2; ++u)
#pragma unroll
                    for (int i = 0; i < 4; ++i) lgn[u][i] = LG[(size_t)(tbase + 16 * u + it + 1) * NE + lane + 64 * i]; }
            LWAIT();
            if (lane < 16) { float m1 = -INFINITY, m2 = -INFINITY;
#pragma unroll
                for (int q = 0; q < 8; ++q) { const f32x4 v = *(const LAS f32x4*)(selw + lane * 32 + q * 4);
#pragma unroll
                    for (int e = 0; e < 4; ++e) { const float x = v[e]; const float lo = fminf(m1, x); m1 = fmaxf(m1, x); m2 = fmaxf(m2, lo); } }
                gsw[lane] = m1 + m2; }
            LWAIT();
            if (lane < 16) { const LAS float* gp = gsw + (lane & 8); const f32x4 a = *(const LAS f32x4*)gp, b2 = *(const LAS f32x4*)(gp + 4); const float gs[8] = {a[0], a[1], a[2], a[3], b2[0], b2[1], b2[2], b2[3]};
                const int gl = lane & 7; float me = 0.f;
#pragma unroll
                for (int c = 0; c < 8; ++c) me = (gl == c) ? gs[c] : me;
                int rank = 0;
#pragma unroll
                for (int c = 0; c < 8; ++c) rank += (gs[c] > me || (gs[c] == me && c < gl)) ? 1 : 0;
                gfl[lane] = rank < 4 ? 1 : 0; }
            LWAIT();
            unsigned key[2][4];
#pragma unroll
            for (int u = 0; u < 2; ++u) { const u32x4 a = *(const LAS u32x4*)(gfl + 8 * u), b2 = *(const LAS u32x4*)(gfl + 8 * u + 4); const int fl[8] = {(int)a[0], (int)a[1], (int)a[2], (int)a[3], (int)b2[0], (int)b2[1], (int)b2[2], (int)b2[3]};
#pragma unroll
                for (int i = 0; i < 4; ++i) { const int f = hf ? fl[2 * i + 1] : fl[2 * i]; key[u][i] = f ? mono_key(sel[u][i], lane + 64 * i) : 0u; } }
            unsigned prefix[2] = {0u, 0u};
#pragma unroll
            for (int bit = 31; bit >= 0; --bit)
#pragma unroll
                for (int u = 0; u < 2; ++u) { const unsigned cand = prefix[u] | (1u << bit); int cnt = 0;
#pragma unroll
                    for (int i = 0; i < 4; ++i) cnt += __builtin_popcountll(__builtin_amdgcn_ballot_w64(key[u][i] >= cand));
                    prefix[u] = (cnt >= TOPK) ? cand : prefix[u]; }
#pragma unroll
            for (int u = 0; u < 2; ++u) {
                int slot[4]; bool pick[4]; int base = 0; float part = 0.f;
#pragma unroll
                for (int i = 0; i < 4; ++i) { pick[i] = key[u][i] >= prefix[u]; const unsigned long long bm = __builtin_amdgcn_ballot_w64(pick[i]);
                    slot[i] = base + (int)__builtin_amdgcn_mbcnt_hi((unsigned)(bm >> 32), __builtin_amdgcn_mbcnt_lo((unsigned)bm, 0u)); base += __builtin_popcountll(bm);
                    part += pick[i] ? sc[u][i] : 0.f; }
                const float wsum = wave_sum(part);
                const float sc25 = 2.5f / wsum;
#pragma unroll
                for (int i = 0; i < 4; ++i) if (pick[i]) { const int e = lane + 64 * i, ri = (16 * u + it) * TOPK + slot[i]; resI[ri] = e; resW[ri] = sc[u][i] * sc25; __hip_atomic_fetch_add(&hist[e], 1u, __ATOMIC_RELAXED, __HIP_MEMORY_SCOPE_WORKGROUP); } }
        }
        LWAIT();
        *(u32x4*)(TOPI + (size_t)tbase * TOPK + lane * 4) = *(const LAS u32x4*)(resI + lane * 4); *(f32x4*)(TOPW + (size_t)tbase * TOPK + lane * 4) = *(const LAS f32x4*)(resW + lane * 4);
        __syncthreads();
        if (F.tid < 256) { const unsigned hc = hist[F.tid]; HIST[tb * 256 + F.tid] = (int)hc; ((int*)(F.ws + WS_BASEREL))[tb * 256 + F.tid] = (int)atomicAdd(F.ctl + CW_COUNTS + F.tid, hc); }
    }
#undef LWAIT
}

struct UnitBO { int pm, pn, kind; };
struct BOOrder {
    typedef UnitBO Unit;
    int G, vcu; const char *YA, *YB, *MG, *WA, *WB, *WO;
    __device__ __forceinline__ bool next(int i, Unit& u) const { const int rt = i / 12, j = i - rt * 12; u.pm = rt * G + vcu; if (u.pm >= T / 256) return false;
        if (j < 8) { u.pn = j >> 1; u.kind = j & 1; } else { u.pn = j - 8; u.kind = 2; } return true; }
    static constexpr int EB = BO_FP8 ? 1 : 2;
    __device__ __forceinline__ int K(const Unit& u) const { return (u.kind == 0 ? 256 : 1024) * EB / 2; }
    __device__ __forceinline__ const char* a_base(const Unit& u) const { const char* p = YA; if (u.kind == 1) p = YB; asm volatile("" : "+s"(p)); if (u.kind == 2) p = MG; return p; }
    __device__ __forceinline__ unsigned a_row_off(const Unit& u, int r) const { return (unsigned)(u.pm * 256 + r) * (u.kind == 0 ? 256u * EB : 1024u * EB); }
    __device__ __forceinline__ const char* b_base(const Unit& u) const { const char* p = WA + (size_t)u.pn * 256 * 256 * EB; if (u.kind == 1) p = WB + (size_t)u.pn * 256 * 1024 * EB; asm volatile("" : "+s"(p)); if (u.kind == 2) p = WO + (size_t)u.pn * 256 * 1024 * EB; return p; }
};
struct EpiBO {
    static constexpr bool PERM = true;
    const unsigned char* GAB8; bf16* MG; bf16* YM;
    __device__ __forceinline__ bool operator()(f32x4 (&acc)[2][2][4][2], const UnitBO& u, int wr, int wc, int fr, int fq) const {
        const int row0 = u.pm * 256 + wr * 64 + fr, col0 = u.pn * 256 + wc * 64 + 16 * fq;
        if (u.kind == 0) {
            u32x4 gaq[8], gbq[8];
#pragma unroll
            for (int ai = 0; ai < 2; ++ai)
#pragma unroll
                for (int m = 0; m < 4; ++m) { const unsigned char* g8 = GAB8 + (size_t)(row0 + ai * 128 + m * 16) * 2048 + col0; gaq[ai * 4 + m] = *(const u32x4*)g8; gbq[ai * 4 + m] = *(const u32x4*)(g8 + 1024); }
#pragma unroll
            for (int ai = 0; ai < 2; ++ai)
#pragma unroll
                for (int m = 0; m < 4; ++m)
#pragma unroll
                    for (int bj = 0; bj < 2; ++bj)
#pragma unroll
                        for (int n = 0; n < 2; ++n) { const f32x4 sa = unpk4_sig_u8(gaq[ai * 4 + m][2 * bj + n]), sb = unpk4_sig_u8(gbq[ai * 4 + m][2 * bj + n]);
#pragma unroll
                            for (int e = 0; e < 4; ++e) acc[ai][bj][m][n][e] *= sa[e] * __builtin_amdgcn_rcpf(sb[e]); }
            return false;
        }
        bf16* dbase = YM; if (u.kind == 1) dbase = MG; asm volatile("" : "+s"(dbase));
        u32x4 gbq[8];
        if (u.kind == 1) {
#pragma unroll
            for (int ai = 0; ai < 2; ++ai)
#pragma unroll
                for (int m = 0; m < 4; ++m) gbq[ai * 4 + m] = *(const u32x4*)(GAB8 + (size_t)(row0 + ai * 128 + m * 16) * 2048 + 1024 + col0);
        }
#pragma unroll
        for (int ai = 0; ai < 2; ++ai)
#pragma unroll
            for (int m = 0; m < 4; ++m) { const size_t row = (size_t)(row0 + ai * 128 + m * 16);
                f32x4 s0 = (f32x4){1.f, 1.f, 1.f, 1.f}, s1 = s0, s2 = s0, s3 = s0;
                if (u.kind == 1) { const u32x4 g = gbq[ai * 4 + m]; s0 = unpk4_sig_u8(g[0]); s1 = unpk4_sig_u8(g[1]); s2 = unpk4_sig_u8(g[2]); s3 = unpk4_sig_u8(g[3]); }
                const f32x4 v0 = acc[ai][0][m][0] * s0, v1 = acc[ai][0][m][1] * s1, v2 = acc[ai][1][m][0] * s2, v3 = acc[ai][1][m][1] * s3;
                u32x4 w0, w1; w0.x = g2::cvt_pk_bf16(v0[0], v0[1]); w0.y = g2::cvt_pk_bf16(v0[2], v0[3]); w0.z = g2::cvt_pk_bf16(v1[0], v1[1]); w0.w = g2::cvt_pk_bf16(v1[2], v1[3]);
                w1.x = g2::cvt_pk_bf16(v2[0], v2[1]); w1.y = g2::cvt_pk_bf16(v2[2], v2[3]); w1.z = g2::cvt_pk_bf16(v3[0], v3[1]); w1.w = g2::cvt_pk_bf16(v3[2], v3[3]);
#if BO_FP8
                if (u.kind == 1) { u32x4 o8; o8.x = pk4_fp8(v0[0] * BO_ASC, v0[1] * BO_ASC, v0[2] * BO_ASC, v0[3] * BO_ASC); o8.y = pk4_fp8(v1[0] * BO_ASC, v1[1] * BO_ASC, v1[2] * BO_ASC, v1[3] * BO_ASC);
                    o8.z = pk4_fp8(v2[0] * BO_ASC, v2[1] * BO_ASC, v2[2] * BO_ASC, v2[3] * BO_ASC); o8.w = pk4_fp8(v3[0] * BO_ASC, v3[1] * BO_ASC, v3[2] * BO_ASC, v3[3] * BO_ASC);
                    *(u32x4*)((unsigned char*)MG + row * 1024 + col0) = o8; continue; }
#endif
                bf16* dst = dbase + row * 1024 + col0;
                *(u32x4*)dst = w0; *(u32x4*)(dst + 8) = w1; }
        return true;
    }
};
struct OwnBlocks { int vcu, G; __device__ __forceinline__ int block(int i) const { const int tb = i * G + vcu; return tb < T / 256 ? tb : -1; } };
struct OwnRouterOrder {
    typedef g2::UnitMN Unit;
    int G, vcu; const char *H2, *WR;
    __device__ __forceinline__ bool next(int i, Unit& u) const { u.pm = i * G + vcu; u.pn = 0; return u.pm < T / 256; }
    __device__ __forceinline__ int K(const Unit&) const { return 1024; }
    __device__ __forceinline__ const char* a_base(const Unit&) const { return H2; }
    __device__ __forceinline__ unsigned a_row_off(const Unit& u, int r) const { return (unsigned)(u.pm * 256 + r) * 2048u; }
    __device__ __forceinline__ const char* b_base(const Unit&) const { return WR; }
};
__device__ __forceinline__ void ph_normmid_blocks(Frame& F, int vcu);
__device__ __forceinline__ void ph_tokblock(Frame& F) {
    const int bx = blockIdx.x; const int vcu = (F.G % 8 == 0) ? (bx % 8) * (F.G / 8) + bx / 8 : bx;
#if FUSE_ATTN_COMBINE
    ph_attn_combine(F, vcu);
    asm volatile("s_waitcnt vmcnt(0)" ::: "memory"); __syncthreads();
#endif
    { BOOrder S{F.G, vcu, (const char*)(F.outb + OUT_YA), (const char*)(F.outb + OUT_YB), (const char*)(F.ws + (BO_FP8 ? WS_MERGED8 : WS_MERGED)), (const char*)(F.ws + WS_WBA_T), (const char*)(F.ws + WS_WBB_T), (const char*)(F.ws + WS_WOUT_T)};
      EpiBO E{(const unsigned char*)(F.ws + WS_GAB), (bf16*)(F.ws + (BO_FP8 ? WS_MERGED8 : WS_MERGED)), (bf16*)(F.ws + WS_YMIX)};
#if BO_FP8
      g2::gemm_phase<EpiBO, BOOrder, true>(F.lds, S, E, 127 - 8); }
#else
      g2::gemm_phase<EpiBO, BOOrder>(F.lds, S, E); }
#endif
    asm volatile("s_waitcnt vmcnt(0)" ::: "memory"); __syncthreads();
    ph_normmid_blocks(F, vcu);
    asm volatile("s_waitcnt vmcnt(0)" ::: "memory"); __syncthreads();
    { OwnRouterOrder S{F.G, vcu, (const char*)(F.ws + WS_H2), (const char*)(F.ws + WS_WR_T)};
      EpiF32Plain E{(float*)(F.ws + WS_LOGITS), 256};
      g2::gemm_phase<EpiF32Plain, OwnRouterOrder>(F.lds, S, E); }
    asm volatile("s_waitcnt vmcnt(0)" ::: "memory"); __syncthreads();
    ph_topk4(F, OwnBlocks{vcu, F.G});
}
__device__ __forceinline__ void ph_scan2(Frame& F) {
    if (blockIdx.x != 0) return;
    const int* HIST = (const int*)(F.ws + WS_HIST); int* BASEREL = (int*)(F.ws + WS_BASEREL); int* TSG = (int*)(F.ws + WS_TSG); int* TE = (int*)(F.ws + WS_TE);
    unsigned long long* THOFF = (unsigned long long*)(F.ws + WS_THOFF); unsigned long long* DEST = (unsigned long long*)(F.ws + WS_DEST);
    int* ROWTOK = (int*)(F.ws + WS_ROWTOK); float* ROWW = (float*)(F.ws + WS_ROWW);
    LAS int* pre = (LAS int*)F.lds;
    const int e = F.tid;
    int n0 = 0, n1 = 0;
    __syncthreads();
    if (e < NE) {
        for (int tb = 0; tb < 128; ++tb) { const int c = HIST[tb * 256 + e]; BASEREL[tb * 256 + e] = n0; n0 += c; }
        for (int tb = 128; tb < 256; ++tb) { const int c = HIST[tb * 256 + e]; BASEREL[tb * 256 + e] = n1; n1 += c; }
        pre[e] = (n0 + 255) >> 8; pre[256 + e] = (n1 + 255) >> 8;
    }
    __syncthreads();
    if (F.tid == 0) { int a = 0; for (int i = 0; i < NE; ++i) { const int c = pre[i]; pre[i] = a; a += c; } pre[512] = a;
        int b2 = a + 128; for (int i = 0; i < NE; ++i) { const int c = pre[256 + i]; pre[256 + i] = b2; b2 += c; } pre[513] = b2 - (a + 128);
        F.ctl[CW_NT0] = (unsigned)(a + 128); F.ctl[CW_NT] = (unsigned)(b2 + 128); }
    __syncthreads();
    const int R0 = pre[512], R1 = pre[513];
    unsigned char* dump = F.ws + WS_DUMP;
    if (e < NE) {
        const int ts0 = pre[e], ts1 = pre[256 + e], nt0 = (n0 + 255) >> 8, nt1 = (n1 + 255) >> 8;
        TSG[e] = ts0; TSG[256 + e] = ts1;
        for (int u = 0; u < nt0; ++u) { TE[ts0 + u] = e; THOFF[ts0 + u] = (unsigned long long)WS_HIDR + (unsigned long long)(ts0 + u) * (256 * 512); }
        for (int u = 0; u < nt1; ++u) { TE[ts1 + u] = e; THOFF[ts1 + u] = (unsigned long long)WS_HIDR + (unsigned long long)(ts1 + u - 128) * (256 * 512); }
        for (int r = n0; r < nt0 * 256; ++r) { const int p = ts0 * 256 + r; ROWTOK[p] = p & (T - 1); ROWW[p] = 0.f; DEST[p] = (unsigned long long)dump; }
        for (int r = n1; r < nt1 * 256; ++r) { const int p = ts1 * 256 + r; ROWTOK[p] = p & (T - 1); ROWW[p] = 0.f; DEST[p] = (unsigned long long)dump; }
    }
#pragma unroll 1
    for (int half = 0; half < 2; ++half) { const int tb0 = half ? (R0 + 128 + R1) : R0;
        if (F.tid < 128) { TE[tb0 + F.tid] = 256; THOFF[tb0 + F.tid] = (unsigned long long)WS_HIDS + (unsigned long long)(half * HALF_T + F.tid * 256) * 512; }
        for (int i = F.tid; i < HALF_T; i += NTHR) { const int tok = half * HALF_T + i; const int p = tb0 * 256 + i; ROWTOK[p] = tok; ROWW[p] = 1.0f; DEST[p] = (unsigned long long)slot_ptr(F.ws, F.outb, half, 8, tok); } }
}
__device__ __forceinline__ void ph_scatter2(Frame& F) {
    const int* TOPI = (const int*)(F.ws + WS_TOPI); const float* TOPW = (const float*)(F.ws + WS_TOPW); const int* BASEREL = (const int*)(F.ws + WS_BASEREL); const int* TSG = (const int*)(F.ws + WS_TSG);
    int* ROWTOK = (int*)(F.ws + WS_ROWTOK); float* ROWW = (float*)(F.ws + WS_ROWW); unsigned long long* DEST = (unsigned long long*)(F.ws + WS_DEST);
    LAS unsigned* cur = (LAS unsigned*)F.lds;
    for (int tb = blockIdx.x; tb < T / 256; tb += F.G) {
        const int half = tb >> 7;
        __syncthreads();
        if (F.tid < 256) cur[F.tid] = (unsigned)(TSG[half * 256 + F.tid] * 256 + BASEREL[tb * 256 + F.tid]);
        __syncthreads();
#pragma unroll
        for (int i = 0; i < 4; ++i) { const int item = F.tid + NTHR * i; const int t = tb * 256 + (item >> 3), k = item & 7;
            const int e = TOPI[(size_t)t * TOPK + k]; const unsigned p = __hip_atomic_fetch_add(&cur[e], 1u, __ATOMIC_RELAXED, __HIP_MEMORY_SCOPE_WORKGROUP);
            ROWTOK[p] = t; ROWW[p] = TOPW[(size_t)t * TOPK + k]; DEST[p] = (unsigned long long)slot_ptr(F.ws, F.outb, half, k, t); }
    }
}

#if MOE_FP8
constexpr size_t HIDR_OFF = WS_HIDR8, HIDS_OFF = WS_HIDS8; constexpr int HID_ROWB = 256;
#else
constexpr size_t HIDR_OFF = WS_HIDR, HIDS_OFF = WS_HIDS; constexpr int HID_ROWB = 512;
#endif
__device__ __forceinline__ void ph_scatter3(Frame& F) {
    const int* TOPI = (const int*)(F.ws + WS_TOPI); const float* TOPW = (const float*)(F.ws + WS_TOPW); const int* HIST = (const int*)(F.ws + WS_HIST);
    int* TE = (int*)(F.ws + WS_TE); unsigned long long* THOFF = (unsigned long long*)(F.ws + WS_THOFF);
    int* ROWTOK = (int*)(F.ws + WS_ROWTOK); float* ROWW = (float*)(F.ws + WS_ROWW); unsigned long long* DEST = (unsigned long long*)(F.ws + WS_DEST);
    LAS int* pre = (LAS int*)F.lds;
    LAS unsigned* cur = (LAS unsigned*)(F.lds + 4096);
    LAS int* cnt = (LAS int*)(F.lds + 8192);
    unsigned char* dump = F.ws + WS_DUMP;
    for (int tb = blockIdx.x; tb < T / 256; tb += F.G) {
        const int half = tb >> 7; const int e = F.tid;
        int n0 = 0, n1 = 0, mybase = 0;
        __syncthreads();
        if (e < NE) {
#pragma unroll 8
            for (int t2 = 0; t2 < 128; ++t2) { const int c = HIST[t2 * 256 + e]; if (half == 0 && t2 < tb) mybase += c; n0 += c; }
#pragma unroll 8
            for (int t2 = 128; t2 < 256; ++t2) { const int c = HIST[t2 * 256 + e]; if (half == 1 && t2 < tb) mybase += c; n1 += c; }
            pre[e] = (n0 + 255) >> 8; pre[256 + e] = (n1 + 255) >> 8; cnt[e] = n0; cnt[256 + e] = n1;
        }
        __syncthreads();
        if (F.wave == 0) {
            int v[8]; int s0 = 0, s1 = 0;
#pragma unroll
            for (int i = 0; i < 4; ++i) { v[i] = pre[4 * F.lane + i]; v[4 + i] = pre[256 + 4 * F.lane + i]; s0 += v[i]; s1 += v[4 + i]; }
            int i0 = s0, i1 = s1;
#pragma unroll
            for (int o = 1; o < 64; o <<= 1) { const int a0 = __shfl_up(i0, o), a1 = __shfl_up(i1, o); if (F.lane >= o) { i0 += a0; i1 += a1; } }
            const int R0 = __shfl(i0, 63), R1 = __shfl(i1, 63);
            int x0 = i0 - s0, x1 = R0 + 128 + (i1 - s1);
#pragma unroll
            for (int i = 0; i < 4; ++i) { pre[4 * F.lane + i] = x0; x0 += v[i]; pre[256 + 4 * F.lane + i] = x1; x1 += v[4 + i]; }
            if (F.lane == 0) { pre[512] = R0; pre[513] = R1; if (tb == 0) { F.ctl[CW_NT0] = (unsigned)(R0 + 128); F.ctl[CW_NT] = (unsigned)(R0 + R1 + 256); } }
        }
        __syncthreads();
        const int R0 = pre[512], R1 = pre[513];
        if (e < NE) cur[e] = (unsigned)(pre[half * 256 + e] * 256 + mybase);
        { const int ee = tb; const int ts0 = pre[ee], ts1 = pre[256 + ee], c0 = cnt[ee], c1 = cnt[256 + ee], nt0 = (c0 + 255) >> 8, nt1 = (c1 + 255) >> 8;
          if (F.tid < nt0) { TE[ts0 + F.tid] = ee; THOFF[ts0 + F.tid] = (unsigned long long)HIDR_OFF + (unsigned long long)(ts0 + F.tid) * (256 * HID_ROWB); }
          if (F.tid < nt1) { TE[ts1 + F.tid] = ee; THOFF[ts1 + F.tid] = (unsigned long long)HIDR_OFF + (unsigned long long)(ts1 + F.tid - 128) * (256 * HID_ROWB); }
          if (F.tid < 256) { const int r0p = c0 + F.tid; if (r0p < nt0 * 256) { const int p = ts0 * 256 + r0p; ROWTOK[p] = p & (T - 1); ROWW[p] = 0.f; DEST[p] = (unsigned long long)dump; }
                             const int r1p = c1 + F.tid; if (r1p < nt1 * 256) { const int p = ts1 * 256 + r1p; ROWTOK[p] = p & (T - 1); ROWW[p] = 0.f; DEST[p] = (unsigned long long)dump; } } }
        { const int stile = (half ? (R0 + 128 + R1) : R0) + (tb & 127);
          if (F.tid == 0) { TE[stile] = 256; THOFF[stile] = (unsigned long long)HIDS_OFF + (unsigned long long)(tb * 256) * HID_ROWB; }
          if (F.tid < 256) { const int tok = tb * 256 + F.tid; const int p = stile * 256 + F.tid; ROWTOK[p] = tok; ROWW[p] = 1.0f; DEST[p] = (unsigned long long)slot_ptr(F.ws, F.outb, half, 8, tok); } }
        __syncthreads();
#pragma unroll
        for (int i = 0; i < 4; ++i) { const int item = F.tid + NTHR * i; const int t = tb * 256 + (item >> 3), k = item & 7;
            const int ex = TOPI[(size_t)t * TOPK + k]; const unsigned p = __hip_atomic_fetch_add(&cur[ex], 1u, __ATOMIC_RELAXED, __HIP_MEMORY_SCOPE_WORKGROUP);
            ROWTOK[p] = t; ROWW[p] = TOPW[(size_t)t * TOPK + k]; DEST[p] = (unsigned long long)slot_ptr(F.ws, F.outb, half, k, t); }
    }
}
struct UnitEx2 { int u, sub, e; const char* ab; int par; };
struct GuOrder2 {
    typedef UnitEx2 Unit;
    int nun, G, vcu; const int* TE; const int* ROWTOK; const char *H2, *WGU, *WSGU;
    __device__ __forceinline__ bool next(int i, Unit& x) const { const int L = i * G + vcu; if (L >= nun) return false; x.u = L >> 1; x.sub = L & 1; x.e = TE[x.u]; x.ab = nullptr; return true; }
    __device__ __forceinline__ int K(const Unit&) const { return 1024; }
    __device__ __forceinline__ const char* a_base(const Unit&) const { return H2; }
    __device__ __forceinline__ unsigned a_row_off(const Unit& x, int r) const { return (unsigned)ROWTOK[(unsigned)(x.u * 256 + r)] * 2048u; }
    __device__ __forceinline__ const char* b_base(const Unit& x) const { return (x.e < 256 ? WGU + (size_t)x.e * (512 * 1024 * 2) : WSGU) + (size_t)x.sub * (256 * 1024 * 2); }
};
struct EpiGu2 {
    static constexpr bool PERM = true;
    unsigned char* ws; const unsigned long long* THOFF;
    __device__ __forceinline__ bool operator()(const f32x4 (&acc)[2][2][4][2], const UnitEx2& x, int wr, int wc, int fr, int fq) const {
        bf16* base = (bf16*)(ws + THOFF[x.u]);
        const int row0 = wr * 64 + fr, col0 = x.sub * 128 + wc * 32 + 8 * fq;
#pragma unroll
        for (int ai = 0; ai < 2; ++ai)
#pragma unroll
            for (int m = 0; m < 4; ++m) { const f32x4 g0 = acc[ai][0][m][0], g1 = acc[ai][0][m][1], u0 = acc[ai][1][m][0], u1 = acc[ai][1][m][1]; f32x4 h0, h1;
#pragma unroll
                for (int e = 0; e < 4; ++e) { h0[e] = g0[e] * fsig(g0[e]) * u0[e]; h1[e] = g1[e] * fsig(g1[e]) * u1[e]; }
                u32x4 w; w.x = g2::cvt_pk_bf16(h0[0], h0[1]); w.y = g2::cvt_pk_bf16(h0[2], h0[3]); w.z = g2::cvt_pk_bf16(h1[0], h1[1]); w.w = g2::cvt_pk_bf16(h1[2], h1[3]);
                *(u32x4*)(base + (size_t)(row0 + ai * 128 + m * 16) * 256 + col0) = w; asm volatile("" ::: "memory"); }
        return true;
    }
};
struct DownOrder2 {
    typedef UnitEx2 Unit;
    int tlo, nun, G, vcu; const int* TE; const unsigned long long* THOFF; const char *wsb, *WD, *WSD;
    __device__ __forceinline__ bool next(int i, Unit& x) const { const int L = i * G + vcu; if (L >= nun) return false; x.u = tlo + (L >> 2); x.sub = L & 3; x.e = TE[x.u]; x.ab = nullptr; return true; }
    __device__ __forceinline__ int K(const Unit&) const { return 256; }
    __device__ __forceinline__ const char* a_base(const Unit& x) const { return wsb + THOFF[x.u]; }
    __device__ __forceinline__ unsigned a_row_off(const Unit&, int r) const { return (unsigned)r * 512u; }
    __device__ __forceinline__ const char* b_base(const Unit& x) const { return (x.e < 256 ? WD + (size_t)x.e * (1024 * 256 * 2) : WSD) + (size_t)x.sub * (256 * 256 * 2); }
};
struct EpiDown2 {
    static constexpr bool PERM = true;
    const unsigned long long* DEST; const float* ROWW;
    __device__ __forceinline__ bool operator()(const f32x4 (&acc)[2][2][4][2], const UnitEx2& x, int wr, int wc, int fr, int fq) const {
        const int row0 = x.u * 256 + wr * 64 + fr; const int cb = (x.sub * 256 + wc * 32 + 8 * fq) * 2;
#pragma unroll
        for (int ai = 0; ai < 2; ++ai)
#pragma unroll
            for (int m = 0; m < 4; ++m) { const int r = row0 + ai * 128 + m * 16; unsigned char* dp = (unsigned char*)DEST[r] + cb; const float w = ROWW[r];
#pragma unroll
                for (int bj = 0; bj < 2; ++bj) { const f32x4 v0 = acc[ai][bj][m][0] * w, v1 = acc[ai][bj][m][1] * w;
                    u32x4 o; o.x = g2::cvt_pk_bf16(v0[0], v0[1]); o.y = g2::cvt_pk_bf16(v0[2], v0[3]); o.z = g2::cvt_pk_bf16(v1[0], v1[1]); o.w = g2::cvt_pk_bf16(v1[2], v1[3]);
                    *(u32x4*)(dp + bj * 256) = o; }
                asm volatile("" ::: "memory"); }
        return true;
    }
};
__device__ __forceinline__ void ph_gu2(Frame& F) {
    const int NT = (int)__hip_atomic_load(F.ctl + CW_NT, __ATOMIC_RELAXED, __HIP_MEMORY_SCOPE_AGENT);
    const int bx = blockIdx.x; const int vcu = (F.G % 8 == 0) ? (bx % 8) * (F.G / 8) + bx / 8 : bx;
    GuOrder2 S{2 * NT, F.G, vcu, (const int*)(F.ws + WS_TE), (const int*)(F.ws + WS_ROWTOK), (const char*)(F.ws + WS_H2), (const char*)(F.ws + WS_WGU), (const char*)(F.ws + WS_WSGU_T)};
    EpiGu2 E{F.ws, (const unsigned long long*)(F.ws + WS_THOFF)};
    g2::gemm_phase<EpiGu2, GuOrder2>(F.lds, S, E);
}
__device__ __forceinline__ void ph_down2(Frame& F, int half) {
    const int NT = (int)__hip_atomic_load(F.ctl + CW_NT, __ATOMIC_RELAXED, __HIP_MEMORY_SCOPE_AGENT), NT0 = (int)__hip_atomic_load(F.ctl + CW_NT0, __ATOMIC_RELAXED, __HIP_MEMORY_SCOPE_AGENT);
    const int tlo = half ? NT0 : 0, thi = half ? NT : NT0;
    const int bx = blockIdx.x; const int vcu = (F.G % 8 == 0) ? (bx % 8) * (F.G / 8) + bx / 8 : bx;
    DownOrder2 S{tlo, 4 * (thi - tlo), F.G, vcu, (const int*)(F.ws + WS_TE), (const unsigned long long*)(F.ws + WS_THOFF), (const char*)F.ws, (const char*)(F.ws + WS_WD), (const char*)(F.ws + WS_WSD_T)};
    EpiDown2 E{(const unsigned long long*)(F.ws + WS_DEST), (const float*)(F.ws + WS_ROWW)};
    g2::gemm_phase<EpiDown2, DownOrder2>(F.lds, S, E);
}

struct GuOrder8 {
    typedef UnitEx2 Unit;
    int nun, G, vcu; const int* TE; const int* ROWTOK; const char *H2, *WGU, *WSGU; const unsigned long long* THOFF;
    __device__ __forceinline__ bool next(int i, Unit& x) const { const int L = i * G + vcu; if (L >= nun) return false; x.u = L >> 1; x.sub = L & 1; x.par = 0; x.e = TE[x.u]; x.ab = (const char*)THOFF[x.u]; return true; }
    __device__ __forceinline__ int K(const Unit&) const { return 512; }
    __device__ __forceinline__ const char* a_base(const Unit&) const { return H2; }
    __device__ __forceinline__ unsigned a_row_off(const Unit& x, int r) const { return (unsigned)ROWTOK[(unsigned)(x.u * 256 + r)] * 1024u; }
    __device__ __forceinline__ const char* b_base(const Unit& x) const { return (x.e < 256 ? WGU + (size_t)x.e * (512 * 1024) : WSGU) + (size_t)x.sub * (256 * 1024); }
};
struct EpiGu8 {
    static constexpr bool PERM = true;
    unsigned char* ws; const unsigned long long* THOFF;
    __device__ __forceinline__ bool operator()(const f32x4 (&acc)[2][2][4][2], const UnitEx2& x, int wr, int wc, int fr, int fq) const {
        unsigned char* base = ws + (size_t)x.ab;
        const int row0 = wr * 64 + fr, col0 = x.sub * 128 + wc * 32 + 8 * fq;
#pragma unroll
        for (int ai = 0; ai < 2; ++ai)
#pragma unroll
            for (int m = 0; m < 4; ++m) { const f32x4 g0 = acc[ai][0][m][0], g1 = acc[ai][0][m][1], u0 = acc[ai][1][m][0], u1 = acc[ai][1][m][1]; f32x4 h0, h1;
#pragma unroll
                for (int e = 0; e < 4; ++e) { h0[e] = g0[e] * fsig(g0[e]) * u0[e]; h1[e] = g1[e] * fsig(g1[e]) * u1[e]; }
                u32x2 w; w.x = pk4_fp8(h0[0], h0[1], h0[2], h0[3]); w.y = pk4_fp8(h1[0], h1[1], h1[2], h1[3]);
                *(u32x2*)(base + (size_t)(row0 + ai * 128 + m * 16) * 256 + col0) = w; asm volatile("" ::: "memory"); }
        return true;
    }
};
struct DownOrder8 {
    typedef UnitEx2 Unit;
    static constexpr bool A_RESIDENT = DOWN_A_RESIDENT;
    __device__ __forceinline__ bool a_new(const Unit& x) const { return x.sub == 0; }
    int tlo, nun, G, vcu; const int* TE; const unsigned long long* THOFF; const char *wsb, *WD, *WSD;
    __device__ __forceinline__ bool next(int i, Unit& x) const { const int tl = (i >> 2) * G + vcu; if (4 * tl >= nun) return false; x.u = tlo + tl; x.sub = i & 3; x.par = (i >> 2) & 1; x.e = TE[x.u]; x.ab = wsb + THOFF[x.u]; return true; }
    __device__ __forceinline__ int K(const Unit&) const { return 128; }
    __device__ __forceinline__ const char* a_base(const Unit& x) const { return x.ab; }
    __device__ __forceinline__ unsigned a_row_off(const Unit&, int r) const { return (unsigned)r * 256u; }
    __device__ __forceinline__ const char* b_base(const Unit& x) const { return (x.e < 256 ? WD + (size_t)x.e * (1024 * 256) : WSD) + (size_t)x.sub * (256 * 256); }
};
__device__ __forceinline__ void ph_gu8(Frame& F) {
    const int NT = (int)__hip_atomic_load(F.ctl + CW_NT, __ATOMIC_RELAXED, __HIP_MEMORY_SCOPE_AGENT);
    const int bx = blockIdx.x; const int vcu = (F.G % 8 == 0) ? (bx % 8) * (F.G / 8) + bx / 8 : bx;
    GuOrder8 S{2 * NT, F.G, vcu, (const int*)(F.ws + WS_TE), (const int*)(F.ws + WS_ROWTOK), (const char*)(F.ws + WS_H2F8), (const char*)(F.ws + WS_WGU8), (const char*)(F.ws + WS_WSGU8), (const unsigned long long*)(F.ws + WS_THOFF)};
    EpiGu8 E{F.ws, (const unsigned long long*)(F.ws + WS_THOFF)};
    g2::gemm_phase<EpiGu8, GuOrder8, true>(F.lds, S, E, 127 - 5);
}
__device__ __forceinline__ void ph_down8(Frame& F, int half) {
    const int NT = (int)__hip_atomic_load(F.ctl + CW_NT, __ATOMIC_RELAXED, __HIP_MEMORY_SCOPE_AGENT), NT0 = (int)__hip_atomic_load(F.ctl + CW_NT0, __ATOMIC_RELAXED, __HIP_MEMORY_SCOPE_AGENT);
    const int tlo = half ? NT0 : 0, thi = half ? NT : NT0;
    const int bx = blockIdx.x; const int vcu = (F.G % 8 == 0) ? (bx % 8) * (F.G / 8) + bx / 8 : bx;
    DownOrder8 S{tlo, 4 * (thi - tlo), F.G, vcu, (const int*)(F.ws + WS_TE), (const unsigned long long*)(F.ws + WS_THOFF), (const char*)F.ws, (const char*)(F.ws + WS_WD8), (const char*)(F.ws + WS_WSD8)};
    EpiDown2 E{(const unsigned long long*)(F.ws + WS_DEST), (const float*)(F.ws + WS_ROWW)};
    g2::gemm_phase<EpiDown2, DownOrder8, true>(F.lds, S, E, 127 - 4);
}
__device__ __forceinline__ void ph_combine2(Frame& F, int half) {
    const float* mod = (const float*)(F.ws + WS_MOD); const float* g = F.in[I_GPOSTFFN];
    for (int t = half * HALF_T + blockIdx.x * NWAVES + F.wave; t < (half + 1) * HALF_T; t += F.G * NWAVES) {
        const int b = t / SEQ; const float* gt2 = mod + b * 6144 + 5120;
        float y[16];
#pragma unroll
        for (int i = 0; i < 16; ++i) y[i] = 0.f;
#pragma unroll
        for (int k = 0; k < 9; ++k) { const unsigned char* sp = slot_ptr(F.ws, F.outb, half, k, t);
#pragma unroll
            for (int j = 0; j < 4; ++j) { const u32x2 w = *(const u32x2*)(sp + (F.lane * 4 + 256 * j) * 2);
                y[4 * j + 0] += __uint_as_float(w.x << 16); y[4 * j + 1] += __uint_as_float(w.x & 0xffff0000u); y[4 * j + 2] += __uint_as_float(w.y << 16); y[4 * j + 3] += __uint_as_float(w.y & 0xffff0000u); } }
        f32x4 x1[4]; x1_row(F, t, x1);
        float ss = 0.f;
#pragma unroll
        for (int i = 0; i < 16; ++i) ss += y[i] * y[i];
        const float rstd = rsqrtf(wave_sum(ss) * (1.0f / D) + EPS);
#pragma unroll
        for (int j = 0; j < 4; ++j) { const int c = F.lane * 4 + 256 * j; const f32x4 gg = *(const f32x4*)(g + c), gt = *(const f32x4*)(gt2 + c);
            f32x4 o;
#pragma unroll
            for (int e = 0; e < 4; ++e) o[e] = x1[j][e] + gt[e] * (y[4 * j + e] * rstd * gg[e]);
            *(f32x4*)(F.out + (size_t)t * D + c) = o; }
    }
}


constexpr float SLOT_SC = 16.0f;
__device__ __forceinline__ unsigned char* slot8_ptr(unsigned char* ws, unsigned char* outb, int k, int t) {
    if (k < 4) return outb + (size_t)t * 4096 + k * 1024;
    const int ri = k - 4; const size_t base = (ri == 0) ? 192 : (ri == 1) ? 256 : (ri == 2) ? 320 : (ri == 3) ? 384 : 736;
    return ws + base * MiB + (size_t)t * 1024;
}
constexpr size_t YS_A = 192 * MiB, YS_B = 736 * MiB; constexpr int YS_NA = 262144;
__device__ __forceinline__ unsigned char* ys_row(unsigned char* ws, int p) { return ws + (p < YS_NA ? YS_A + (size_t)p * 1024 : YS_B + (size_t)(p - YS_NA) * 1024); }
static_assert(YS_NA % 256 == 0 && YS_A + (size_t)YS_NA * 1024 <= WS_HIDS8 && YS_B + (size_t)(T * 8 + 256 * 255 - YS_NA) * 1024 <= WS_NEED, "dense MoE output map");
__device__ __forceinline__ void ph_scatter4(Frame& F) {
    const int* TOPI = (const int*)(F.ws + WS_TOPI); const float* TOPW = (const float*)(F.ws + WS_TOPW); const int* HIST = (const int*)(F.ws + WS_HIST);
    int* TE = (int*)(F.ws + WS_TE); unsigned long long* THOFF = (unsigned long long*)(F.ws + WS_THOFF);
    int* ROWTOK = (int*)(F.ws + WS_ROWTOK); float* ROWW = (float*)(F.ws + WS_ROWW); int* POS = (int*)(F.ws + WS_DEST);
    LAS int* pre = (LAS int*)F.lds;
    LAS unsigned* cur = (LAS unsigned*)(F.lds + 4096);
    LAS int* cnt = (LAS int*)(F.lds + 8192);
    for (int tb = blockIdx.x; tb < T / 256; tb += F.G) {
        const int e = F.tid; int n0 = 0, mybase = 0;
        __syncthreads();
        if (e < NE) {
            n0 = (int)__hip_atomic_load(F.ctl + CW_COUNTS + e, __ATOMIC_RELAXED, __HIP_MEMORY_SCOPE_AGENT); mybase = ((const int*)(F.ws + WS_BASEREL))[tb * 256 + e];
            pre[e] = (n0 + 255) >> 8; cnt[e] = n0;
        }
        __syncthreads();
        if (F.wave == 0) { int v[4]; int s0 = 0;
#pragma unroll
            for (int i = 0; i < 4; ++i) { v[i] = pre[4 * F.lane + i]; s0 += v[i]; }
            int i0 = s0;
#pragma unroll
            for (int o = 1; o < 64; o <<= 1) { const int a0 = __shfl_up(i0, o); if (F.lane >= o) i0 += a0; }
            const int R = __shfl(i0, 63); int x0 = i0 - s0;
#pragma unroll
            for (int i = 0; i < 4; ++i) { pre[4 * F.lane + i] = x0; x0 += v[i]; }
            if (F.lane == 0) { pre[512] = R; if (tb == 0) { F.ctl[CW_NT0] = (unsigned)R; F.ctl[CW_NT] = (unsigned)(R + 256); } } }
        __syncthreads();
        const int R = pre[512];
        if (e < NE) cur[e] = (unsigned)(pre[e] * 256 + mybase);
        { const int ee = tb; const int ts0 = pre[ee], c0 = cnt[ee], nt0 = (c0 + 255) >> 8;
          if (F.tid < nt0) { TE[ts0 + F.tid] = ee; THOFF[ts0 + F.tid] = (unsigned long long)HIDR_OFF + (unsigned long long)(ts0 + F.tid) * (256 * HID_ROWB); }
          if (F.tid < 256) { const int r0p = c0 + F.tid; if (r0p < nt0 * 256) { const int p = ts0 * 256 + r0p; ROWTOK[p] = p & (T - 1); ROWW[p] = 0.f; } } }
        { const int stile = R + tb;
          if (F.tid == 0) { TE[stile] = 256; THOFF[stile] = (unsigned long long)HIDS_OFF + (unsigned long long)(tb * 256) * HID_ROWB; }
          if (F.tid < 256) { const int tok = tb * 256 + F.tid; const int p = stile * 256 + F.tid; ROWTOK[p] = tok; ROWW[p] = 1.0f; } }
        __syncthreads();
#pragma unroll
        for (int i = 0; i < 4; ++i) { const int item = F.tid + NTHR * i; const int t = tb * 256 + (item >> 3), k = item & 7;
            const int ex = TOPI[(size_t)t * TOPK + k]; const unsigned p = __hip_atomic_fetch_add(&cur[ex], 1u, __ATOMIC_RELAXED, __HIP_MEMORY_SCOPE_WORKGROUP);
            ROWTOK[p] = t; ROWW[p] = TOPW[(size_t)t * TOPK + k]; POS[(size_t)t * TOPK + k] = (int)p; }
    }
}
struct EpiDown8 {
    static constexpr bool PERM = true;
    unsigned char* ws; unsigned char* outb; const float* ROWW; int R; int dbg; unsigned char* dbgbase; LAS float* wl;
    __device__ __forceinline__ void unit_start(const UnitEx2& x, int wid, int lane) const {
        if (x.sub == 0) __builtin_amdgcn_global_load_lds((const unsigned*)(ROWW + x.u * 256 + (wid & 3) * 64 + lane), (LAS unsigned*)(wl + x.par * 256 + (wid & 3) * 64), 4, 0, 0); }
    __device__ __forceinline__ bool operator()(const f32x4 (&acc)[2][2][4][2], const UnitEx2& x, int wr, int wc, int fr, int fq) const {
        const int rl = wr * 64 + fr; const int cb = x.sub * 256 + wc * 64 + 16 * fq;
        const bool sh = x.e == 256;
        unsigned char* base = sh ? outb + (size_t)(x.u - R) * (256 * 4096) : ys_row(ws, x.u * 256); const int pitch = sh ? 4096 : 1024;
        if (dbg == 2) base = dbgbase + (size_t)((x.u * 256) & 65535) * 1024;
        float wv[8];
#pragma unroll
        for (int q = 0; q < 8; ++q) wv[q] = wl[x.par * 256 + rl + (q >> 2) * 128 + (q & 3) * 16];
#pragma unroll
        for (int ai = 0; ai < 2; ++ai)
#pragma unroll
            for (int m = 0; m < 4; ++m) { const int i = rl + ai * 128 + m * 16; unsigned char* dp = base + (size_t)i * (dbg == 2 ? 1024 : pitch) + cb; const float w = wv[ai * 4 + m] * SLOT_SC;
                if (dbg == 1) { if (acc[ai][0][m][0][0] == 123.456f) dp[0] = 1; continue; }
                const f32x4 a0 = acc[ai][0][m][0] * w, a1 = acc[ai][0][m][1] * w, b0 = acc[ai][1][m][0] * w, b1 = acc[ai][1][m][1] * w;
                u32x4 o; o.x = pk4_fp8(a0[0], a0[1], a0[2], a0[3]); o.y = pk4_fp8(a1[0], a1[1], a1[2], a1[3]); o.z = pk4_fp8(b0[0], b0[1], b0[2], b0[3]); o.w = pk4_fp8(b1[0], b1[1], b1[2], b1[3]);
                *(u32x4*)dp = o;
                asm volatile("" ::: "memory"); }
        return true;
    }
};
__device__ __forceinline__ void ph_down9(Frame& F, int dbg = 0) {
    const int NT = (int)__hip_atomic_load(F.ctl + CW_NT, __ATOMIC_RELAXED, __HIP_MEMORY_SCOPE_AGENT);
    const int bx = blockIdx.x; const int vcu = (F.G % 8 == 0) ? (bx % 8) * (F.G / 8) + bx / 8 : bx;
    DownOrder8 S{0, 4 * NT, F.G, vcu, (const int*)(F.ws + WS_TE), (const unsigned long long*)(F.ws + WS_THOFF), (const char*)F.ws, (const char*)(F.ws + WS_WD8), (const char*)(F.ws + WS_WSD8)};
    const int R = (int)__hip_atomic_load(F.ctl + CW_NT0, __ATOMIC_RELAXED, __HIP_MEMORY_SCOPE_AGENT);
    EpiDown8 E{F.ws, F.outb, (const float*)(F.ws + WS_ROWW), R, dbg, F.ws + 640 * MiB, (LAS float*)(F.lds + 131584 + 2048)};
    g2::gemm_phase<EpiDown8, DownOrder8, true, DOWN_ALIGN>(F.lds, S, E, 127 - 4);
}
struct X1B { u32x2 xm[4]; };
__device__ __forceinline__ void x1b_load(Frame& F, int t, X1B& r) {
    const bf16* XM = (const bf16*)(F.ws + WS_YMIX);
#pragma unroll
    for (int j = 0; j < 4; ++j) r.xm[j] = *(const u32x2*)(XM + (size_t)t * D + F.lane * 4 + 256 * j);
}
__device__ __forceinline__ void ph_combine9(Frame& F) {
    const float* mod = (const float*)(F.ws + WS_MOD); const float* g = F.in[I_GPOSTFFN];
    const int* POS = (const int*)(F.ws + WS_DEST);
#define C9_TOK(qq) ((int)((blockIdx.x + ((qq) >> 5) * F.G) << 8) + F.wave + 8 * ((qq) & 31))
#define C9_POS(tt) (((tt) < T) ? POS[(size_t)(tt) * TOPK + (F.lane & 7)] : 0)
#define C9_LOAD(SN, tt, pp) do { _Pragma("unroll") for (int k = 0; k < 9; ++k) { \
        const unsigned char* sp = (k < 8) ? ys_row(F.ws, __builtin_amdgcn_readlane((pp), k)) : F.outb + (size_t)(tt) * 4096; \
        _Pragma("unroll") for (int j = 0; j < 4; ++j) SN[k][j] = *(const int*)(sp + F.lane * 4 + 256 * j); } } while (0)
#define C9_STEP(SN, tt, tn1, tnx, pnx) do { \
        float y[16]; \
        _Pragma("unroll") for (int i = 0; i < 16; ++i) y[i] = 0.f; \
        _Pragma("unroll") for (int k = 0; k < 9; ++k) _Pragma("unroll") for (int j = 0; j < 4; ++j) { const int w = SN[k][j]; \
            y[4 * j + 0] += __builtin_amdgcn_cvt_f32_fp8(w, 0); y[4 * j + 1] += __builtin_amdgcn_cvt_f32_fp8(w, 1); y[4 * j + 2] += __builtin_amdgcn_cvt_f32_fp8(w, 2); y[4 * j + 3] += __builtin_amdgcn_cvt_f32_fp8(w, 3); } \
        const X1B rc = rn; \
        if ((tn1) < T) x1b_load(F, (tn1), rn); \
        if ((tnx) < T) C9_LOAD(SN, (tnx), (pnx)); \
        f32x4 x1[4]; \
        _Pragma("unroll") for (int j = 0; j < 4; ++j) { const u32x2 w = rc.xm[j]; x1[j] = (f32x4){__uint_as_float(w.x << 16), __uint_as_float(w.x & 0xffff0000u), __uint_as_float(w.y << 16), __uint_as_float(w.y & 0xffff0000u)}; } \
        float ss = 0.f; \
        _Pragma("unroll") for (int i = 0; i < 16; ++i) ss += y[i] * y[i]; \
        const float rstd = rsqrtf(wave_sum(ss) * (1.0f / (D * SLOT_SC * SLOT_SC)) + EPS);            \
        _Pragma("unroll") for (int j = 0; j < 4; ++j) { const int c = F.lane * 4 + 256 * j; \
            f32x4 o; \
            _Pragma("unroll") for (int e = 0; e < 4; ++e) o[e] = x1[j][e] + coef[j][e] * (y[4 * j + e] * rstd); \
            *(f32x4*)(F.out + (size_t)(tt) * D + c) = o; } } while (0)
    X1B rn; int sA[9][4], sB[9][4];
    f32x4 coef[4]; int cofb = -1;
    int q = 0, t0 = C9_TOK(0), t1 = C9_TOK(1);
    { const int p0 = C9_POS(t0), p1 = C9_POS(t1);
      if (t0 < T) { x1b_load(F, t0, rn); C9_LOAD(sA, t0, p0); }
      if (t1 < T) C9_LOAD(sB, t1, p1); }
    int p2 = C9_POS(C9_TOK(2)), p3 = C9_POS(C9_TOK(3));
    for (; t0 < T; q += 2) {
        { int ln = F.lane; asm volatile("" : "+v"(ln)); F.lane = ln; }
        const int t2 = C9_TOK(q + 2), t3 = C9_TOK(q + 3);
        if (t0 / SEQ != cofb) { cofb = t0 / SEQ; const float* gt2 = mod + cofb * 6144 + 5120;
#pragma unroll
            for (int j = 0; j < 4; ++j) { const int c = F.lane * 4 + 256 * j; coef[j] = *(const f32x4*)(g + c) * *(const f32x4*)(gt2 + c) * (1.0f / SLOT_SC); } }
        const int p4 = C9_POS(C9_TOK(q + 4)), p5 = C9_POS(C9_TOK(q + 5));
        C9_STEP(sA, t0, t1, t2, p2);
        if (t1 < T) C9_STEP(sB, t1, t2, t3, p3);
        t0 = t2; t1 = t3; p2 = p4; p3 = p5;
    }
#undef C9_STEP
#undef C9_LOAD
#undef C9_POS
#undef C9_TOK
}
__device__ __forceinline__ void ph_router_naive(Frame& F) {
    LAS float* As = (LAS float*)F.lds; LAS float* Bs = As + 16 * 132;
    const bf16* H2 = (const bf16*)(F.ws + WS_H2); float* LG = (float*)(F.ws + WS_LOGITS);
    const int ty = F.tid >> 5, tx = F.tid & 31;
    for (int vb = blockIdx.x; vb < (T / 128) * 2; vb += F.G) {
        const int tm = vb >> 1, tn = vb & 1, m0 = tm * 128, n0 = tn * 128;
        float a1[8][4]; ZERO_ACC(a1);
        ARowGlobal ra{H2, (size_t)D, m0, nullptr}; ngemm_acc(As, Bs, ra, F.in[I_RW], NE, D, n0, NE, a1);
#pragma unroll
        for (int i = 0; i < 8; ++i) { const size_t row = (size_t)(m0 + ty * 8 + i); const int col = n0 + tx * 4;
            *(f32x4*)(LG + row * NE + col) = (f32x4){a1[i][0], a1[i][1], a1[i][2], a1[i][3]}; }
    }
}

__device__ __forceinline__ float half_max(float v) {
#pragma unroll
    for (int o = 1; o < 32; o <<= 1) v = fmaxf(v, __shfl_xor(v, o));
    return v;
}
__device__ __forceinline__ void ph_topk(Frame& F) {
    const float* LG = (const float*)(F.ws + WS_LOGITS); const float* rb = F.in[I_RB];
    int* TOPI = (int*)(F.ws + WS_TOPI); float* TOPW = (float*)(F.ws + WS_TOPW); unsigned* counts = F.ctl + CW_COUNTS;
    const int lane = F.lane, hf = lane >> 5;
    for (int t = blockIdx.x * NWAVES + F.wave; t < T; t += F.G * NWAVES) {
        float sc[4], sel[4];
#pragma unroll
        for (int i = 0; i < 4; ++i) { sc[i] = sigmoidf_(LG[(size_t)t * NE + lane + 64 * i]); sel[i] = sc[i] + rb[lane + 64 * i]; }
        float gs[8];
#pragma unroll
        for (int i = 0; i < 4; ++i) {
            const float m1 = half_max(sel[i]);
            const unsigned long long bal = __ballot(sel[i] == m1); const unsigned hb = hf ? (unsigned)(bal >> 32) : (unsigned)bal;
            const int first = __ffs(hb) - 1;
            const float v2 = ((lane & 31) == first) ? -INFINITY : sel[i];
            const float m2 = half_max(v2);
            const float g = m1 + m2;
            const float go = __shfl_xor(g, 32);
            gs[2 * i] = hf ? go : g; gs[2 * i + 1] = hf ? g : go;
        }
        bool gsel[8];
#pragma unroll
        for (int a = 0; a < 8; ++a) { int rank = 0;
#pragma unroll
            for (int c = 0; c < 8; ++c) rank += (gs[c] > gs[a] || (gs[c] == gs[a] && c < a)) ? 1 : 0;
            gsel[a] = rank < 4; }
#pragma unroll
        for (int i = 0; i < 4; ++i) { const bool ok = hf ? gsel[2 * i + 1] : gsel[2 * i]; if (!ok) sel[i] = -INFINITY; }
        int myidx = 0; float myw = 0.f; float wsum = 0.f;
#pragma unroll
        for (int k = 0; k < TOPK; ++k) {
            float bv = sel[0]; int bi = lane;
#pragma unroll
            for (int i = 1; i < 4; ++i) if (sel[i] > bv) { bv = sel[i]; bi = lane + 64 * i; }
#pragma unroll
            for (int o = 1; o < 64; o <<= 1) { const float ov = __shfl_xor(bv, o); const int oi = __shfl_xor(bi, o); if (ov > bv || (ov == bv && oi < bi)) { bv = ov; bi = oi; } }
            const int ol = bi & 63, oi = bi >> 6;
            float s = (oi == 0) ? sc[0] : (oi == 1) ? sc[1] : (oi == 2) ? sc[2] : sc[3];
            s = __shfl(s, ol);
            if (lane == ol) { if (oi == 0) sel[0] = -INFINITY; else if (oi == 1) sel[1] = -INFINITY; else if (oi == 2) sel[2] = -INFINITY; else sel[3] = -INFINITY; }
            wsum += s;
            if (lane == k) { myidx = bi; myw = s; }
        }
        if (lane < TOPK) { TOPI[(size_t)t * TOPK + lane] = myidx; TOPW[(size_t)t * TOPK + lane] = myw / wsum * 2.5f; atomicAdd(&counts[myidx], 1u); }
    }
}


__device__ __forceinline__ void ph_topk_serial(Frame& F) {
    const float* LG = (const float*)(F.ws + WS_LOGITS); const float* rb = F.in[I_RB];
    int* TOPI = (int*)(F.ws + WS_TOPI); float* TOPW = (float*)(F.ws + WS_TOPW); unsigned* counts = F.ctl + CW_COUNTS;
    LAS float* sel = (LAS float*)F.lds + F.wave * 1024; LAS float* scr = sel + 256; LAS float* gsc = scr + 256; LAS int* gok = (LAS int*)(gsc + 8); LAS int* bi = gok + 8; LAS float* bw = (LAS float*)(bi + 8);
    for (int t = blockIdx.x * NWAVES + F.wave; t < T; t += F.G * NWAVES) {
        for (int i = 0; i < 4; ++i) { const int e = F.lane + 64 * i; const float s = sigmoidf_(LG[(size_t)t * NE + e]); scr[e] = s; sel[e] = s + rb[e]; }
        __builtin_amdgcn_s_waitcnt(0);
        if (F.lane == 0) {
            for (int g = 0; g < 8; ++g) { float m1 = -INFINITY, m2 = -INFINITY; for (int q = 0; q < 32; ++q) { const float v = sel[g * 32 + q]; if (v > m1) { m2 = m1; m1 = v; } else if (v > m2) m2 = v; } gsc[g] = m1 + m2; gok[g] = 0; }
            for (int k = 0; k < 4; ++k) { int best = -1; float bv = -INFINITY; for (int g = 0; g < 8; ++g) if (!gok[g] && gsc[g] > bv) { bv = gsc[g]; best = g; } gok[best] = 1; }
            for (int e = 0; e < 256; ++e) if (!gok[e >> 5]) sel[e] = -INFINITY;
            float ws = 0.f;
            for (int k = 0; k < 8; ++k) { int best = 0; float bv = -INFINITY; for (int e = 0; e < 256; ++e) if (sel[e] > bv) { bv = sel[e]; best = e; } sel[best] = -INFINITY; bi[k] = best; bw[k] = scr[best]; ws += scr[best]; }
            for (int k = 0; k < 8; ++k) { TOPI[(size_t)t * 8 + k] = bi[k]; TOPW[(size_t)t * 8 + k] = bw[k] / ws * 2.5f; atomicAdd(&counts[bi[k]], 1u); }
        }
        __builtin_amdgcn_s_waitcnt(0);
    }
}

__device__ __forceinline__ void ph_scan(Frame& F) {
    if (blockIdx.x != 0) return;
    LAS int* pre = (LAS int*)F.lds;
    unsigned* counts = F.ctl + CW_COUNTS; int* ROWTOK = (int*)(F.ws + WS_ROWTOK); float* ROWW = (float*)(F.ws + WS_ROWW);
    int* UNITEXP = (int*)(F.ws + WS_UNITEXP); int* EXPTILE0 = (int*)(F.ws + WS_EXPTILE0);
    __syncthreads();
    int n = 0, nt = 0;
    if (F.tid < NE) { n = (int)counts[F.tid]; nt = (n + 255) >> 8; pre[F.tid] = nt; }
    __syncthreads();
    if (F.tid == 0) { int s = 0; for (int e = 0; e < NE; ++e) { const int c = pre[e]; pre[e] = s; s += c; } F.ctl[CW_NT] = (unsigned)s; }
    __syncthreads();
    if (F.tid < NE) {
        const int t0 = pre[F.tid]; EXPTILE0[F.tid] = t0;
        for (int u = 0; u < nt; ++u) UNITEXP[t0 + u] = F.tid;
        for (int r = n; r < nt * 256; ++r) { ROWTOK[t0 * 256 + r] = (t0 * 256 + r) & (T - 1); ROWW[t0 * 256 + r] = 0.f; }
    }
    __syncthreads();
    { const int NTv = (int)F.ctl[CW_NT];
      for (int i = F.tid; i < T; i += NTHR) { ROWTOK[NTv * 256 + i] = i; ROWW[NTv * 256 + i] = 1.0f; } }
}

__device__ __forceinline__ void ph_scatter(Frame& F) {
    const int* TOPI = (const int*)(F.ws + WS_TOPI); const float* TOPW = (const float*)(F.ws + WS_TOPW);
    int* ROWTOK = (int*)(F.ws + WS_ROWTOK); float* ROWW = (float*)(F.ws + WS_ROWW); const int* EXPTILE0 = (const int*)(F.ws + WS_EXPTILE0);
    unsigned* cursor = F.ctl + CW_CURSOR;
    for (int i = blockIdx.x * NTHR + F.tid; i < T * TOPK; i += F.G * NTHR) {
        const int e = TOPI[i]; const unsigned p = atomicAdd(&cursor[e], 1u);
        const size_t r = (size_t)EXPTILE0[e] * 256 + p;
        ROWTOK[r] = i >> 3; ROWW[r] = TOPW[i];
    }
}

__device__ __forceinline__ void ph_experts_naive(Frame& F) {
    LAS float* As = (LAS float*)F.lds; LAS float* Bs = As + 16 * 132; LAS bf16* hid = (LAS bf16*)(F.lds + 32768);
    const bf16* H2 = (const bf16*)(F.ws + WS_H2);
    const int* ROWTOK = (const int*)(F.ws + WS_ROWTOK); const float* ROWW = (const float*)(F.ws + WS_ROWW); const int* UNITEXP = (const int*)(F.ws + WS_UNITEXP);
    const int NT = (int)__hip_atomic_load(F.ctl + CW_NT, __ATOMIC_RELAXED, __HIP_MEMORY_SCOPE_AGENT);
    const int ty = F.tid >> 5, tx = F.tid & 31;
    const int nvb = 2 * NT + T / 128;
    for (int vb = blockIdx.x; vb < nvb; vb += F.G) {
        const bool shared = vb >= 2 * NT;
        const float *Wg, *Wu, *Wd; int r0; const int* gather;
        if (shared) { Wg = F.in[I_WSG]; Wu = F.in[I_WSU]; Wd = F.in[I_WSD]; r0 = (vb - 2 * NT) * 128; gather = nullptr; }
        else { const int u = vb >> 1; const int e = UNITEXP[u]; Wg = F.in[I_WEG] + (size_t)e * 1024 * 256; Wu = F.in[I_WEU] + (size_t)e * 1024 * 256; Wd = F.in[I_WED] + (size_t)e * 256 * 1024;
               r0 = u * 256 + (vb & 1) * 128; gather = ROWTOK; }
        ARowGlobal ra{H2, (size_t)D, r0, gather};
        for (int nh = 0; nh < 2; ++nh) {
            float ag[8][4], au[8][4]; ZERO_ACC(ag); ZERO_ACC(au);
            ngemm_acc(As, Bs, ra, Wg, 256, D, nh * 128, 256, ag);
            ngemm_acc(As, Bs, ra, Wu, 256, D, nh * 128, 256, au);
#pragma unroll
            for (int i = 0; i < 8; ++i) { float o[4];
#pragma unroll
                for (int j = 0; j < 4; ++j) { const float g = ag[i][j]; o[j] = g / (1.0f + expf(-g)) * au[i][j]; }
                u32x2 w; w.x = pk2(o[0], o[1]); w.y = pk2(o[2], o[3]); *(LAS u32x2*)(hid + (ty * 8 + i) * 256 + nh * 128 + tx * 4) = w; }
        }
        __syncthreads();
        ARowLds rl{hid};
        for (int nc = 0; nc < 8; ++nc) {
            float ad[8][4]; ZERO_ACC(ad);
            ngemm_acc(As, Bs, rl, Wd, D, 256, nc * 128, D, ad);
#pragma unroll
            for (int i = 0; i < 8; ++i) { const int r = r0 + ty * 8 + i; const int tok = shared ? r : ROWTOK[r]; const float w = shared ? 1.0f : ROWW[r];
                if (w != 0.f) {
#pragma unroll
                    for (int j = 0; j < 4; ++j) unsafeAtomicAdd(F.out + (size_t)tok * D + nc * 128 + tx * 4 + j, ad[i][j] * w); } }
        }
        __syncthreads();
    }
}


__device__ __forceinline__ void ph_experts_brute(Frame& F) {
    LAS float* hs = (LAS float*)F.lds;
    LAS float* hid = hs + 1024;
    LAS float* pg = hid + 256;
    const bf16* H2 = (const bf16*)(F.ws + WS_H2); const int* TOPI = (const int*)(F.ws + WS_TOPI); const float* TOPW = (const float*)(F.ws + WS_TOPW);
    const int tid = F.tid, j = tid & 255, kh = tid >> 8;
    for (int t = blockIdx.x; t < T; t += F.G) {
        __syncthreads();
        hs[tid] = bf2f(H2[(size_t)t * D + tid]); hs[tid + 512] = bf2f(H2[(size_t)t * D + tid + 512]);
        float o0 = 0.f, o1 = 0.f;
        __syncthreads();
        for (int k9 = 0; k9 < 9; ++k9) {
            const float *Wg, *Wu, *Wd; float w;
            if (k9 == 8) { Wg = F.in[I_WSG]; Wu = F.in[I_WSU]; Wd = F.in[I_WSD]; w = 1.0f; }
            else { const int e = TOPI[(size_t)t * 8 + k9]; w = TOPW[(size_t)t * 8 + k9]; Wg = F.in[I_WEG] + (size_t)e * 1024 * 256; Wu = F.in[I_WEU] + (size_t)e * 1024 * 256; Wd = F.in[I_WED] + (size_t)e * 256 * 1024; }
            float g = 0.f, u = 0.f;
            for (int k = kh * 512; k < kh * 512 + 512; ++k) { const float hv = hs[k]; g += hv * Wg[(size_t)k * 256 + j]; u += hv * Wu[(size_t)k * 256 + j]; }
            pg[tid] = g; pg[512 + tid] = u;
            __syncthreads();
            if (tid < 256) { const float gg = pg[tid] + pg[tid + 256], uu = pg[512 + tid] + pg[512 + tid + 256]; hid[tid] = gg / (1.0f + expf(-gg)) * uu * w; }
            __syncthreads();
            for (int q = 0; q < 256; ++q) { const float hv = hid[q]; o0 += hv * Wd[(size_t)q * 1024 + tid]; o1 += hv * Wd[(size_t)q * 1024 + tid + 512]; }
        }
        F.out[(size_t)t * D + tid] = o0; F.out[(size_t)t * D + tid + 512] = o1;
    }
}

__device__ __forceinline__ void ph_final(Frame& F) {
    const float* mod = (const float*)(F.ws + WS_MOD); const float* g = F.in[I_GPOSTFFN];
    for (int t = blockIdx.x * NWAVES + F.wave; t < T; t += F.G * NWAVES) {
        const int b = t / SEQ; const float* gt2 = mod + b * 6144 + 5120;
        f32x4 x1[4]; x1_row(F, t, x1);
        f32x4 y[4]; float ss = 0.f;
#pragma unroll
        for (int j = 0; j < 4; ++j) { y[j] = *(const f32x4*)(F.out + (size_t)t * D + F.lane * 4 + 256 * j); ss += y[j][0] * y[j][0] + y[j][1] * y[j][1] + y[j][2] * y[j][2] + y[j][3] * y[j][3]; }
        const float rstd = rsqrtf(wave_sum(ss) * (1.0f / D) + EPS);
#pragma unroll
        for (int j = 0; j < 4; ++j) { const int c = F.lane * 4 + 256 * j; const f32x4 gg = *(const f32x4*)(g + c), gt = *(const f32x4*)(gt2 + c);
            f32x4 o;
#pragma unroll
            for (int e = 0; e < 4; ++e) o[e] = x1[j][e] + DBG_MOE_SCALE * gt[e] * (y[j][e] * rstd * gg[e]);
#if DBG_STAMP_A >= 0
            { const float dl = (float)(F.ctl[CW_STAMP + DBG_STAMP_B] - F.ctl[CW_STAMP + DBG_STAMP_A]) * 1e-6f; const f32x4 xv = *(const f32x4*)(F.in[I_X] + (size_t)t * D + c); o = o + xv * dl; }
#endif
            *(f32x4*)(F.out + (size_t)t * D + c) = o; }
    }
}

enum { PH_MOD = 0, PH_NORM1, PH_INPROJ, PH_ROPE, PH_MIX, PH_BRANCH, PH_OUTPROJ, PH_NORMMID, PH_ROUTER, PH_TOPK, PH_SCAN, PH_SCATTER, PH_EXPERTS, PH_FINAL, N_PHASES };

__global__ void __launch_bounds__(NTHR, 2) mk_fwd(Args args) {
    extern __shared__ __attribute__((aligned(16))) unsigned char lds_raw[];
    Frame F;
    F.lds = (LAS unsigned char*)lds_raw;
    F.tid = threadIdx.x; F.lane = F.tid & 63; F.wave = __builtin_amdgcn_readfirstlane(F.tid >> 6); F.G = gridDim.x;
#pragma unroll
    for (int i = 0; i < N_IN; ++i) F.in[i] = args.in[i];
    F.pos = (const int*)args.in[I_POS];
    F.out = args.out; F.outb = (unsigned char*)args.out; F.ws = args.ws; F.ctl = (unsigned*)(args.ws + WS_CTL);
    volatile LAS unsigned* MISC = (volatile LAS unsigned*)(F.lds + MISC_OFF);
    if (F.tid < 32) MISC[F.tid] = 0u;
    __syncthreads();
    const int lo = args.ph_lo, hi = args.ph_hi;
#define STAMP(id) do { if (DBG_STAMP_A >= 0 && blockIdx.x == 0 && threadIdx.x == 0) F.ctl[CW_STAMP + (id)] = (unsigned)wall_clock64(); } while (0)
#define REFRESH() do { int _t = threadIdx.x; asm volatile("" : "+v"(_t)); F.tid = _t; F.lane = _t & 63; F.wave = __builtin_amdgcn_readfirstlane(_t >> 6); } while (0)
    XcdBarrier bar; bar.bar = F.ctl + CW_BAR; bar.x = 0; bar.st = nullptr;
    if (hi - lo > 1) bar = xcd_barrier_post(F.ctl + CW_BAR, MISC + 8);
#ifndef PH_MASK
#define PH_MASK 0xFFFFFFu
#endif
#define IN(k) ((((PH_MASK) >> (k)) & 1u) && lo <= (k) && (k) < hi)
#define SEAM(k) do { if (IN(k) && IN((k) + 1)) xcd_barrier(bar); } while (0)

    STAMP(0);
    if (IN(PH_MOD)) { REFRESH(); ph_mod(F); ph_cvt_small(F); if (DUP == 0) { __syncthreads(); ph_mod(F); ph_cvt_small(F); } } SEAM(PH_MOD); STAMP(1);
    if (IN(PH_NORM1)) { REFRESH(); ph_norm1(F); if (DUP == 1) ph_norm1(F); if (DUP == 30) { int md = 1; asm volatile("" : "+s"(md)); ph_norm1(F, md); } } SEAM(PH_NORM1); STAMP(2);
#if FAST_INPROJ
    if (IN(PH_INPROJ)) { REFRESH(); ph_inproj_fast(F); if (DUP == 2) ph_inproj_fast(F); if (DUP == 20 || DUP == 21 || DUP == 22) { int ns = (DUP == 20) ? 1 : (DUP == 21) ? 2 : 0; asm volatile("" : "+s"(ns)); ph_inproj_fast(F, ns); } }
    SEAM(PH_INPROJ); STAMP(3);
#else
    if (IN(PH_INPROJ)) { REFRESH(); ph_inproj_naive(F); }
    SEAM(PH_INPROJ);
    if (IN(PH_ROPE)) { REFRESH(); ph_rope_naive(F); }
    SEAM(PH_ROPE);
#endif
    if (IN(PH_MIX)) { REFRESH();
#if FAST_ATTN
#if FAST_MLSTM
        if (blockIdx.x < 128) { int nrep = (DUP == 3) ? 2 : 1; asm volatile("" : "+s"(nrep));
#pragma unroll 1
            for (int rep = 0; rep < nrep; ++rep) mlstm_unit_fast(F, blockIdx.x); }
#else
        if (blockIdx.x < 128) ph_mlstm_naive_unit(F, blockIdx.x);
#endif
        { int first = (blockIdx.x >= 128 && (int)((blockIdx.x >> 3) & 3) < MIX_CVT_FIRST) ? 1 : 0; first = __builtin_amdgcn_readfirstlane(first);
#if MOE_FP8
          if (first) for (;;) {
              __syncthreads();
              if (F.tid == 0) MISC[0] = atomicAdd(F.ctl + CW_CVTQ, 1u);
              __syncthreads();
              const int bt = (int)MISC[0];
              if (bt >= CVT_NBATCH) break;
              cvt_experts8_batch(F, bt);
          }
#endif
#if ATTN_PIPE
          attn_queue_run(F, F.ctl + CW_ATTQ, MISC);
#else
          for (;;) {
              __syncthreads();
              if (F.tid == 0) MISC[0] = atomicAdd(F.ctl + CW_ATTQ, 1u);
              __syncthreads();
              const int uidx = (int)MISC[0];
              if (uidx >= ATT_UNITS) break;
              attn_unit_fast(F, uidx);
          }
#endif
#if MOE_FP8
          for (;;) {
              __syncthreads();
              if (F.tid == 0) MISC[0] = atomicAdd(F.ctl + CW_CVTQ, 1u);
              __syncthreads();
              const int bt = (int)MISC[0];
              if (bt >= CVT_NBATCH) break;
              cvt_experts8_batch(F, bt);
          }
#endif
        }
#else
        for (int vb = blockIdx.x; vb < 128 + 512; vb += F.G) { if (vb < 128) ph_mlstm_naive_unit(F, vb); else ph_attn_naive_block(F, vb - 128); }
#endif
    } SEAM(PH_MIX); STAMP(4);
#if FAST_ATTN
#if !(FUSE_ATTN_COMBINE && FUSE_TOKBLOCK)
    if (IN(PH_MIX)) { REFRESH(); ph_attn_combine(F); if (DUP == 13) ph_attn_combine(F); xcd_barrier(bar); }
#endif
#endif
    STAMP(5);
#if FUSE_TOKBLOCK
    if (IN(PH_BRANCH)) { REFRESH(); ph_tokblock(F); }
#else
#if FAST_BRANCH
    if (IN(PH_BRANCH)) { REFRESH(); ph_branch_fast(F); if (DUP == 4) ph_branch_fast(F); }
    SEAM(PH_BRANCH); STAMP(6);
    if (IN(PH_OUTPROJ)) { REFRESH(); ph_outproj_fast(F); if (DUP == 5) ph_outproj_fast(F); }
    SEAM(PH_OUTPROJ); STAMP(7);
#else
    if (IN(PH_BRANCH)) { REFRESH(); ph_branch_naive(F); }
    SEAM(PH_BRANCH);
    if (IN(PH_OUTPROJ)) { REFRESH(); ph_outproj_naive(F); }
    SEAM(PH_OUTPROJ);
#endif
    if (IN(PH_NORMMID)) { REFRESH(); ph_normmid(F);
#if FAST_EXPERTS
#if MOE_FP8
        if (DUP == 6) ph_normmid(F);
#else
        ph_cvt_experts(F); if (DUP == 6) { ph_normmid(F); ph_cvt_experts(F); }
#endif
#endif
    }
    SEAM(PH_NORMMID); STAMP(8);
#if FAST_ROUTER
    if (IN(PH_ROUTER)) { REFRESH(); ph_router_fast(F); if (DUP == 7) ph_router_fast(F);
#if FUSE_ROUTER_TOPK
        asm volatile("s_waitcnt vmcnt(0)" ::: "memory"); __syncthreads();
        REFRESH(); { RouterBlocks RB; RB.S.init(T, 256, 1024, nullptr, nullptr, F.G, (int)blockIdx.x); ph_topk4(F, RB); }
#endif
    }
#else
    if (IN(PH_ROUTER)) { REFRESH(); ph_router_naive(F); }
#endif
#if !FUSE_ROUTER_TOPK
    SEAM(PH_ROUTER);
#endif
    STAMP(9);
#endif
    #if FAST_MOE2
#if FAST_TOPK4
    if (IN(PH_TOPK) && !FUSE_ROUTER_TOPK && !FUSE_TOKBLOCK) { REFRESH(); ph_topk4(F, StrideBlocks{(int)blockIdx.x, F.G}); }
#else
    if (IN(PH_TOPK)) { REFRESH(); ph_topk2(F); if (DUP == 8) ph_topk2(F); }
#endif
    SEAM(PH_TOPK); STAMP(10);
#if SLOT8
    if (IN(PH_SCATTER)) { REFRESH(); ph_scatter4(F); if (DUP == 9) ph_scatter4(F); } SEAM(PH_SCATTER); STAMP(12);
    if (IN(PH_EXPERTS)) { REFRESH(); ph_gu8(F); if (DUP == 10) ph_gu8(F); xcd_barrier(bar); STAMP(13); REFRESH(); ph_down9(F); if (DUP == 11) ph_down9(F); if (DUP == 40 || DUP == 41) { int dm = (DUP == 40) ? 1 : 2; asm volatile("" : "+s"(dm)); ph_down9(F, dm); } }
    SEAM(PH_EXPERTS); STAMP(14);
    if (IN(PH_FINAL)) { REFRESH(); ph_combine9(F); if (DUP == 12) { __syncthreads(); ph_combine9(F); } }
#else
    if (IN(PH_SCATTER)) { REFRESH(); ph_scatter3(F); } SEAM(PH_SCATTER); STAMP(12);
#if MOE_FP8
    if (IN(PH_EXPERTS)) { REFRESH(); ph_gu8(F); if (DUP == 10) ph_gu8(F); xcd_barrier(bar); STAMP(13); REFRESH(); ph_down8(F, 0); if (DUP == 11) ph_down8(F, 0); xcd_barrier(bar); REFRESH(); ph_combine2(F, 0); xcd_barrier(bar); REFRESH(); ph_down8(F, 1); }
#else
    if (IN(PH_EXPERTS)) { REFRESH(); ph_gu2(F); if (DUP == 10) ph_gu2(F); xcd_barrier(bar); STAMP(13); REFRESH(); ph_down2(F, 0); if (DUP == 11) ph_down2(F, 0); xcd_barrier(bar); REFRESH(); ph_combine2(F, 0); xcd_barrier(bar); REFRESH(); ph_down2(F, 1); }
#endif
    SEAM(PH_EXPERTS); STAMP(14);
    if (IN(PH_FINAL)) { REFRESH(); ph_combine2(F, 1); if (DUP == 12) { __syncthreads(); } }
#endif
#else
#if DBG_TOPK_SERIAL
    if (IN(PH_TOPK)) { REFRESH(); ph_topk_serial(F); }
#else
    if (IN(PH_TOPK)) { REFRESH(); ph_topk(F); }
#endif
    SEAM(PH_TOPK); STAMP(10);
    if (IN(PH_SCAN)) { REFRESH(); ph_scan(F); } SEAM(PH_SCAN); STAMP(11);
    if (IN(PH_SCATTER)) { REFRESH(); ph_scatter(F); } SEAM(PH_SCATTER); STAMP(12);
#if DBG_BRUTE
    if (IN(PH_EXPERTS)) { REFRESH(); ph_experts_brute(F); }
#elif FAST_EXPERTS
    if (IN(PH_EXPERTS)) { REFRESH(); ph_gu_fast(F); xcd_barrier(bar); STAMP(13); REFRESH(); ph_down_fast(F); }
#else
    if (IN(PH_EXPERTS)) { REFRESH(); ph_experts_naive(F); }
#endif
    SEAM(PH_EXPERTS); STAMP(14);
    if (IN(PH_FINAL)) { REFRESH(); ph_final(F); }
#endif
#undef IN
#undef SEAM
}

extern "C" void kernel_launch(void* const* d_in, const int* in_sizes, int n_in, void* d_out, int out_size, void* d_ws, size_t ws_size, hipStream_t stream) {
    static int grid = 0;
    if (grid == 0) {
        if (n_in != N_IN || out_size != T * D || ws_size < WS_NEED) { fprintf(stderr, "kernel_launch: unexpected shapes (n_in %d, out %d, ws %zu); nothing launched\n", n_in, out_size, ws_size); grid = -1; return; }
        int dev = 0, cus = 0, per_cu = 0;
        if (hipGetDevice(&dev) != hipSuccess || hipDeviceGetAttribute(&cus, hipDeviceAttributeMultiprocessorCount, dev) != hipSuccess) { grid = -1; return; }
        if (hipFuncSetAttribute((const void*)mk_fwd, hipFuncAttributeMaxDynamicSharedMemorySize, LDS_BYTES) != hipSuccess) { fprintf(stderr, "kernel_launch: hipFuncSetAttribute failed\n"); grid = -1; return; }
        if (hipOccupancyMaxActiveBlocksPerMultiprocessor(&per_cu, (const void*)mk_fwd, NTHR, LDS_BYTES) != hipSuccess || per_cu < 1) fprintf(stderr, "kernel_launch: occupancy query reports %d\n", per_cu);
        (void)hipGetLastError();
        grid = cus;
    }
    if (grid < 0) return;
    if (hipMemsetAsync((char*)d_ws + WS_CTL, 0, CTL_ZERO_BYTES, stream) != hipSuccess) return;
    Args a{};
    for (int i = 0; i < N_IN; ++i) a.in[i] = (const float*)d_in[i];
    a.out = (float*)d_out; a.ws = (unsigned char*)d_ws;
#if MK_SPLIT
    for (int p = 0; p < N_PHASES; ++p) { a.ph_lo = p; a.ph_hi = p + 1; hipLaunchKernelGGL(mk_fwd, dim3(grid), dim3(NTHR), LDS_BYTES, stream, a); }
#elif defined(MK_CUTS)
    { const int cuts[] = MK_CUTS; const int nc = sizeof(cuts) / sizeof(int);
      for (int i = 0; i + 1 < nc; ++i) { a.ph_lo = cuts[i]; a.ph_hi = cuts[i + 1];
          if (i) hipMemsetAsync((char*)d_ws + WS_CTL + CW_BAR * 4, 0, XCD_BAR_WORDS * 4, stream);
          hipLaunchKernelGGL(mk_fwd, dim3(grid), dim3(NTHR), LDS_BYTES, stream, a); } }
#else
    a.ph_lo = 0; a.ph_hi = N_PHASES;
    hipLaunchKernelGGL(mk_fwd, dim3(grid), dim3(NTHR), LDS_BYTES, stream, a);
#endif
}
```
